# Optimizing an MI355X kernel written in HIP

```python
import math
import jax, jax.numpy as jnp
from jax import lax
import numpy as np

D_MODEL = 2048
BATCH = 4
SEQ = 2048
DEPTH = 1
DEC_BATCH = 128
DEC_SEQ = 8
PAST_LEN = 16384
PAGE_SIZE = 128

D_CONV = D_MODEL // 2
D_SSM = D_MODEL - D_CONV
CONV_WIDTH = 31
SSM_GROUP_CH = 16
N_SSM_GROUPS = D_SSM // SSM_GROUP_CH
SSM_STATE = 64
D_FF = ((8 * D_MODEL // 3 + 255) // 256) * 256
D_IN = 2 * D_CONV + D_SSM
EPS = 1e-6
DT_MIN = 1e-3
DT_MAX = 1e-1

kernel_name = "hymba_conformer_conv_s5_decode_step"


def rmsnorm(x, g):
    xf = x.astype(jnp.float32)
    y = xf * lax.rsqrt(jnp.mean(xf * xf, axis=-1, keepdims=True) + EPS) * g.astype(jnp.float32)
    return y.astype(x.dtype)


def conformer_conv(v, gate, conv_buf, conv_w, conv_b, ln_g, ln_b):
    u = v * jax.nn.sigmoid(gate)
    up = jnp.concatenate([conv_buf.astype(u.dtype), u], axis=1)
    y = lax.conv_general_dilated(
        up, conv_w.astype(u.dtype)[:, None, :], window_strides=(1,), padding='VALID',
        dimension_numbers=('NWC', 'WIO', 'NWC'), feature_group_count=D_CONV)
    y = y.astype(jnp.float32) + conv_b.astype(jnp.float32)
    mu = jnp.mean(y, axis=-1, keepdims=True)
    yc = y - mu
    var = jnp.mean(yc * yc, axis=-1, keepdims=True)
    y = yc * lax.rsqrt(var + EPS) * ln_g.astype(jnp.float32) + ln_b.astype(jnp.float32)
    y = jax.nn.silu(y)
    new_buf = up[:, -(CONV_WIDTH - 1):]
    return y.astype(v.dtype), new_buf


def _complex_scan_op(e1, e2):
    a1r, a1i, b1r, b1i = e1
    a2r, a2i, b2r, b2i = e2
    ar = a2r * a1r - a2i * a1i
    ai = a2r * a1i + a2i * a1r
    br = a2r * b1r - a2i * b1i + b2r
    bi = a2r * b1i + a2i * b1r + b2i
    return (ar, ai, br, bi)


def s5_mixer(u, h_re, h_im, A_re, A_im, log_dt, B_re, B_im, C_re, C_im, D, w_glu):
    b, l, _ = u.shape
    f32 = jnp.float32
    uf = u.astype(f32).reshape(b, l, N_SSM_GROUPS, SSM_GROUP_CH)
    Ar = A_re.astype(f32); Ai = A_im.astype(f32)
    dt = jnp.exp(log_dt.astype(f32))[:, None]
    mag = jnp.exp(dt * Ar)
    ab_re = mag * jnp.cos(dt * Ai)
    ab_im = mag * jnp.sin(dt * Ai)
    den = Ar * Ar + Ai * Ai
    nr = ab_re - 1.0
    ni = ab_im
    k_re = (nr * Ar + ni * Ai) / den
    k_im = (ni * Ar - nr * Ai) / den
    Br = B_re.astype(f32); Bi = B_im.astype(f32)
    Bb_re = k_re[..., None] * Br - k_im[..., None] * Bi
    Bb_im = k_re[..., None] * Bi + k_im[..., None] * Br
    bu_re = jnp.einsum('blgc,gpc->blgp', uf, Bb_re)
    bu_im = jnp.einsum('blgc,gpc->blgp', uf, Bb_im)
    hr = h_re.astype(f32); hi = h_im.astype(f32)
    bu_re = bu_re.at[:, 0].add(ab_re * hr - ab_im * hi)
    bu_im = bu_im.at[:, 0].add(ab_re * hi + ab_im * hr)
    a_re = jnp.broadcast_to(ab_re, bu_re.shape)
    a_im = jnp.broadcast_to(ab_im, bu_re.shape)
    _, _, hs_re, hs_im = lax.associative_scan(_complex_scan_op, (a_re, a_im, bu_re, bu_im), axis=1)
    y = (jnp.einsum('blgp,gcp->blgc', hs_re, C_re.astype(f32))
         - jnp.einsum('blgp,gcp->blgc', hs_im, C_im.astype(f32)))
    y = y + D.astype(f32).reshape(N_SSM_GROUPS, SSM_GROUP_CH) * uf
    y = jax.nn.gelu(y.reshape(b, l, D_SSM))
    y = y * jax.nn.sigmoid(y @ w_glu.astype(f32))
    return y.astype(u.dtype), hs_re[:, -1], hs_im[:, -1]


def hybrid_layer(x, conv_buf, h_re, h_im, norm_mix, w_in, conv_w, conv_b, conv_ln_g, conv_ln_b,
                 ssm_A_re, ssm_A_im, ssm_log_dt, ssm_B_re, ssm_B_im, ssm_C_re, ssm_C_im, ssm_D,
                 w_glu, gnorm_conv, gnorm_ssm, w_out, norm_ffn, w_ffn_gate, w_ffn_up, w_ffn_down):
    xn = rmsnorm(x, norm_mix)
    proj = xn @ w_in
    c_val = proj[..., :D_CONV]
    c_gate = proj[..., D_CONV:2 * D_CONV]
    s_in = proj[..., 2 * D_CONV:]
    yc, new_buf = conformer_conv(c_val, c_gate, conv_buf, conv_w, conv_b, conv_ln_g, conv_ln_b)
    ys, nh_re, nh_im = s5_mixer(s_in, h_re, h_im, ssm_A_re, ssm_A_im, ssm_log_dt,
                                ssm_B_re, ssm_B_im, ssm_C_re, ssm_C_im, ssm_D, w_glu)
    mix = jnp.concatenate([rmsnorm(yc, gnorm_conv), rmsnorm(ys, gnorm_ssm)], axis=-1) @ w_out
    h = x + mix.astype(x.dtype)
    hn = rmsnorm(h, norm_ffn)
    ff = (jax.nn.silu(hn @ w_ffn_gate) * (hn @ w_ffn_up)) @ w_ffn_down
    h = h + ff.astype(x.dtype)
    return h, new_buf, nh_re, nh_im


def setup_inputs(seed: int = 0) -> dict:
    key = jax.random.key(seed)
    ks = jax.random.split(key, 32)
    f32 = jnp.float32
    nrm = lambda k, shape, s: jax.random.normal(k, shape, f32) * s
    L = DEPTH
    x_prompt = nrm(ks[0], (BATCH, SEQ, D_MODEL), 1.0)
    x_sample = nrm(ks[1], (DEC_BATCH, DEC_SEQ, D_MODEL), 1.0)
    state_conv = nrm(ks[2], (L, DEC_BATCH, CONV_WIDTH - 1, D_CONV), 0.5)
    state_ssm_re = nrm(ks[3], (L, DEC_BATCH, N_SSM_GROUPS, SSM_STATE), 0.5)
    state_ssm_im = nrm(ks[4], (L, DEC_BATCH, N_SSM_GROUPS, SSM_STATE), 0.5)
    norm_mix = 1.0 + nrm(ks[5], (L, D_MODEL), 0.02)
    w_in = nrm(ks[6], (L, D_MODEL, D_IN), D_MODEL ** -0.5)
    conv_w = nrm(ks[7], (L, CONV_WIDTH, D_CONV), CONV_WIDTH ** -0.5)
    conv_b = nrm(ks[8], (L, D_CONV), 0.02)
    conv_ln_g = 1.0 + nrm(ks[9], (L, D_CONV), 0.02)
    conv_ln_b = nrm(ks[10], (L, D_CONV), 0.02)
    n = jnp.arange(SSM_STATE, dtype=f32)
    ssm_A_re = -0.5 * jnp.exp(nrm(ks[11], (L, N_SSM_GROUPS, SSM_STATE), 0.01))
    ssm_A_im = math.pi * n + nrm(ks[12], (L, N_SSM_GROUPS, SSM_STATE), 0.01)
    ssm_log_dt = jax.random.uniform(ks[13], (L, N_SSM_GROUPS), f32,
                                    math.log(DT_MIN), math.log(DT_MAX))
    ssm_B_re = nrm(ks[14], (L, N_SSM_GROUPS, SSM_STATE, SSM_GROUP_CH), (2 * SSM_GROUP_CH) ** -0.5)
    ssm_B_im = nrm(ks[15], (L, N_SSM_GROUPS, SSM_STATE, SSM_GROUP_CH), (2 * SSM_GROUP_CH) ** -0.5)
    ssm_C_re = nrm(ks[16], (L, N_SSM_GROUPS, SSM_GROUP_CH, SSM_STATE), (2 * SSM_STATE) ** -0.5)
    ssm_C_im = nrm(ks[17], (L, N_SSM_GROUPS, SSM_GROUP_CH, SSM_STATE), (2 * SSM_STATE) ** -0.5)
    ssm_D = nrm(ks[18], (L, D_SSM), 1.0)
    w_glu = nrm(ks[19], (L, D_SSM, D_SSM), D_SSM ** -0.5)
    gnorm_conv = 1.0 + nrm(ks[20], (L, D_CONV), 0.02)
    gnorm_ssm = 1.0 + nrm(ks[21], (L, D_SSM), 0.02)
    w_out = nrm(ks[22], (L, D_MODEL, D_MODEL), D_MODEL ** -0.5)
    norm_ffn = 1.0 + nrm(ks[23], (L, D_MODEL), 0.02)
    w_ffn_gate = nrm(ks[24], (L, D_MODEL, D_FF), D_MODEL ** -0.5)
    w_ffn_up = nrm(ks[25], (L, D_MODEL, D_FF), D_MODEL ** -0.5)
    w_ffn_down = nrm(ks[26], (L, D_FF, D_MODEL), D_FF ** -0.5)
    norm_final = 1.0 + nrm(ks[27], (D_MODEL,), 0.02)
    return {"x_prompt": x_prompt, "x_sample": x_sample, "state_conv": state_conv,
            "state_ssm_re": state_ssm_re, "state_ssm_im": state_ssm_im,
            "norm_mix": norm_mix, "w_in": w_in, "conv_w": conv_w, "conv_b": conv_b,
            "conv_ln_g": conv_ln_g, "conv_ln_b": conv_ln_b, "ssm_A_re": ssm_A_re,
            "ssm_A_im": ssm_A_im, "ssm_log_dt": ssm_log_dt, "ssm_B_re": ssm_B_re,
            "ssm_B_im": ssm_B_im, "ssm_C_re": ssm_C_re, "ssm_C_im": ssm_C_im, "ssm_D": ssm_D,
            "w_glu": w_glu, "gnorm_conv": gnorm_conv, "gnorm_ssm": gnorm_ssm, "w_out": w_out,
            "norm_ffn": norm_ffn, "w_ffn_gate": w_ffn_gate, "w_ffn_up": w_ffn_up,
            "w_ffn_down": w_ffn_down, "norm_final": norm_final}


def reference(x_prompt, x_sample, state_conv, state_ssm_re, state_ssm_im,
              norm_mix, w_in, conv_w, conv_b, conv_ln_g, conv_ln_b,
              ssm_A_re, ssm_A_im, ssm_log_dt, ssm_B_re, ssm_B_im, ssm_C_re, ssm_C_im, ssm_D,
              w_glu, gnorm_conv, gnorm_ssm, w_out, norm_ffn, w_ffn_gate, w_ffn_up, w_ffn_down,
              norm_final):
    hp = x_prompt
    hs = x_sample
    pc, pr, pi_, sc, sr, si = [], [], [], [], [], []
    for d in range(DEPTH):
        params = (norm_mix[d], w_in[d], conv_w[d], conv_b[d], conv_ln_g[d], conv_ln_b[d],
                  ssm_A_re[d], ssm_A_im[d], ssm_log_dt[d], ssm_B_re[d], ssm_B_im[d],
                  ssm_C_re[d], ssm_C_im[d], ssm_D[d], w_glu[d], gnorm_conv[d], gnorm_ssm[d],
                  w_out[d], norm_ffn[d], w_ffn_gate[d], w_ffn_up[d], w_ffn_down[d])
        b = hp.shape[0]
        buf0 = jnp.zeros((b, CONV_WIDTH - 1, D_CONV), hp.dtype)
        h0 = jnp.zeros((b, N_SSM_GROUPS, SSM_STATE), jnp.float32)
        hp, nbuf, nr, ni = hybrid_layer(hp, buf0, h0, h0, *params)
        pc.append(nbuf); pr.append(nr); pi_.append(ni)
        hs, nbuf, nr, ni = hybrid_layer(hs, state_conv[d], state_ssm_re[d], state_ssm_im[d], *params)
        sc.append(nbuf); sr.append(nr); si.append(ni)
    y_prompt = rmsnorm(hp, norm_final)
    y_sample = rmsnorm(hs, norm_final)
    new_conv_prompt = jnp.stack(pc, axis=0)
    new_ssm_re_prompt = jnp.stack(pr, axis=0)
    new_ssm_im_prompt = jnp.stack(pi_, axis=0)
    new_conv_sample = jnp.stack(sc, axis=0)
    new_ssm_re_sample = jnp.stack(sr, axis=0)
    new_ssm_im_sample = jnp.stack(si, axis=0)
    return (y_prompt, y_sample, new_conv_prompt, new_ssm_re_prompt, new_ssm_im_prompt,
            new_conv_sample, new_ssm_re_sample, new_ssm_im_sample)
```

```cpp
#include <hip/hip_runtime.h>
#include <cstdio>
#include <cmath>

namespace v0 {
constexpr int D = 2048, DC = 1024, DS = 1024, DIN = 3072, DFF = 5632, NG = 64, NP = 64, CH = 16, KW = 31;
constexpr int BATCH = 4, SEQ = 2048, DB = 128, DSQ = 8;
constexpr int MP = BATCH * SEQ, MS = DB * DSQ, M = MP + MS;
constexpr float EPS = 1e-6f;

__device__ __forceinline__ float sigmoidf_(float x) { return 1.f / (1.f + expf(-x)); }
__device__ __forceinline__ float siluf_(float x) { return x * sigmoidf_(x); }
__device__ __forceinline__ float gelu_tanh(float x) { return 0.5f * x * (1.f + tanhf(0.7978845608028654f * (x + 0.044715f * x * x * x))); }

__device__ __forceinline__ float block_sum(float v, float* red) {
#pragma unroll
    for (int o = 32; o >= 1; o >>= 1) v += __shfl_xor(v, o);
    __syncthreads();
    if ((threadIdx.x & 63) == 0) red[threadIdx.x >> 6] = v;
    __syncthreads();
    float s = 0.f;
    for (int i = 0; i < (int)(blockDim.x >> 6); ++i) s += red[i];
    return s;
}

__global__ void k_rmsnorm(const float* xa, const float* xb, const float* g, float* out, int ncols, int ldo, int ldx) {
    __shared__ float red[8];
    const int row = blockIdx.x;
    const float* x = (xb && row >= MP) ? xb + (size_t)(row - MP) * ldx : xa + (size_t)row * ldx;
    float s = 0.f;
    for (int c = threadIdx.x; c < ncols; c += blockDim.x) { float v = x[c]; s += v * v; }
    s = block_sum(s, red);
    const float r = rsqrtf(s / ncols + EPS);
    for (int c = threadIdx.x; c < ncols; c += blockDim.x) out[(size_t)row * ldo + c] = x[c] * r * g[c];
}

template <bool DUAL> __global__ void __launch_bounds__(256) k_gemm(const float* A, int lda, const float* B, const float* B2, int ldb, float* C, int ldc, int K) {
    __shared__ float As[16][65];
    __shared__ float Bs[16][64];
    __shared__ float Bs2[DUAL ? 16 : 1][64];
    const int tx = threadIdx.x & 15, ty = threadIdx.x >> 4;
    const int m0 = blockIdx.y * 64, n0 = blockIdx.x * 64;
    float acc[4][4] = {}, acc2[4][4] = {};
#pragma unroll 1
    for (int k0 = 0; k0 < K; k0 += 16) {
        for (int i = threadIdx.x; i < 64 * 16; i += 256) { int r = i >> 4, c = i & 15; As[c][r] = A[(size_t)(m0 + r) * lda + k0 + c]; }
        for (int i = threadIdx.x; i < 16 * 64; i += 256) { int r = i >> 6, c = i & 63; Bs[r][c] = B[(size_t)(k0 + r) * ldb + n0 + c]; if (DUAL) Bs2[r][c] = B2[(size_t)(k0 + r) * ldb + n0 + c]; }
        __syncthreads();
#pragma unroll
        for (int k = 0; k < 16; ++k) {
            float a[4], b[4], b2[4];
#pragma unroll
            for (int i = 0; i < 4; ++i) { a[i] = As[k][ty * 4 + i]; b[i] = Bs[k][tx * 4 + i]; b2[i] = DUAL ? Bs2[DUAL ? k : 0][tx * 4 + i] : 0.f; }
#pragma unroll
            for (int i = 0; i < 4; ++i)
#pragma unroll
                for (int j = 0; j < 4; ++j) { acc[i][j] += a[i] * b[j]; if (DUAL) acc2[i][j] += a[i] * b2[j]; }
        }
        __syncthreads();
    }
#pragma unroll
    for (int i = 0; i < 4; ++i)
#pragma unroll
        for (int j = 0; j < 4; ++j) {
            float v = acc[i][j];
            if (DUAL) v = siluf_(v) * acc2[i][j];
            C[(size_t)(m0 + ty * 4 + i) * ldc + n0 + tx * 4 + j] = v;
        }
}

__global__ void k_glu_u(float* proj) {
    const size_t i = (size_t)blockIdx.x * blockDim.x + threadIdx.x;
    if (i >= (size_t)M * DC) return;
    const size_t row = i / DC; const int c = (int)(i % DC);
    float* p = proj + row * DIN;
    p[c] = p[c] * sigmoidf_(p[DC + c]);
}

__global__ void k_conv(const float* proj, const float* state_conv, const float* cw, const float* cb, const float* lg, const float* lb,
                       const float* gn, float* mixA) {
    __shared__ float red[8];
    const int row = blockIdx.x;
    int seqbase, t, T; const float* buf = nullptr;
    if (row < MP) { seqbase = (row / SEQ) * SEQ; t = row % SEQ; T = SEQ; }
    else { int b = (row - MP) / DSQ; seqbase = MP + b * DSQ; t = (row - MP) % DSQ; T = DSQ; buf = state_conv + (size_t)b * (KW - 1) * DC; }
    (void)T;
    float y[4]; float s = 0.f;
#pragma unroll
    for (int j = 0; j < 4; ++j) {
        const int c = threadIdx.x + 256 * j;
        float acc = cb[c];
        for (int k = 0; k < KW; ++k) {
            const int tt = t + k - (KW - 1);
            float v;
            if (tt >= 0) v = proj[(size_t)(seqbase + tt) * DIN + c];
            else v = buf ? buf[(size_t)(tt + KW - 1) * DC + c] : 0.f;
            acc += cw[k * DC + c] * v;
        }
        y[j] = acc; s += acc;
    }
    const float mu = block_sum(s, red) / DC;
    float q = 0.f;
#pragma unroll
    for (int j = 0; j < 4; ++j) { y[j] -= mu; q += y[j] * y[j]; }
    const float var = block_sum(q, red) / DC;
    const float rs = rsqrtf(var + EPS);
    float q2 = 0.f;
#pragma unroll
    for (int j = 0; j < 4; ++j) { const int c = threadIdx.x + 256 * j; float v = y[j] * rs * lg[c] + lb[c]; v = siluf_(v); y[j] = v; q2 += v * v; }
    const float r2 = rsqrtf(block_sum(q2, red) / DC + EPS);
#pragma unroll
    for (int j = 0; j < 4; ++j) { const int c = threadIdx.x + 256 * j; mixA[(size_t)row * D + c] = y[j] * r2 * gn[c]; }
}

__global__ void k_newconv(const float* proj, const float* state_conv, float* ncp, float* ncs) {
    const size_t i = (size_t)blockIdx.x * blockDim.x + threadIdx.x;
    const size_t np = (size_t)BATCH * (KW - 1) * DC, ns = (size_t)DB * (KW - 1) * DC;
    if (i < np) { const int c = (int)(i % DC); const int j = (int)((i / DC) % (KW - 1)); const int b = (int)(i / ((size_t)DC * (KW - 1)));
        ncp[i] = proj[(size_t)(b * SEQ + SEQ - (KW - 1) + j) * DIN + c]; }
    else if (i < np + ns) { const size_t k = i - np; const int c = (int)(k % DC); const int j = (int)((k / DC) % (KW - 1)); const int b = (int)(k / ((size_t)DC * (KW - 1)));
        const int idx = j + DSQ;
        ncs[k] = idx < (KW - 1) ? state_conv[((size_t)b * (KW - 1) + idx) * DC + c] : proj[(size_t)(MP + b * DSQ + idx - (KW - 1)) * DIN + c]; }
}

__global__ void __launch_bounds__(64) k_ssm(float* proj, const float* h0re, const float* h0im, const float* Are, const float* Aim, const float* logdt,
                      const float* Bre, const float* Bim, const float* Cre, const float* Cim, const float* Dk,
                      float* nrp, float* nip, float* nrs, float* nis) {
    __shared__ float hr[64], hi[64], us[16];
    const int g = blockIdx.x % NG, seq = blockIdx.x / NG, p = threadIdx.x;
    int base, T; float h_re = 0.f, h_im = 0.f;
    if (seq < BATCH) { base = seq * SEQ; T = SEQ; }
    else { const int b = seq - BATCH; base = MP + b * DSQ; T = DSQ; h_re = h0re[((size_t)b * NG + g) * NP + p]; h_im = h0im[((size_t)b * NG + g) * NP + p]; }
    const float ar = Are[g * NP + p], ai = Aim[g * NP + p];
    const float dt = expf(logdt[g]);
    const float mag = expf(dt * ar);
    const float abr = mag * cosf(dt * ai), abi = mag * sinf(dt * ai);
    const float den = ar * ar + ai * ai, nr = abr - 1.f, ni = abi;
    const float kr = (nr * ar + ni * ai) / den, ki = (ni * ar - nr * ai) / den;
    float bbr[16], bbi[16];
#pragma unroll
    for (int c = 0; c < 16; ++c) { const float br = Bre[((size_t)g * NP + p) * CH + c], bi = Bim[((size_t)g * NP + p) * CH + c]; bbr[c] = kr * br - ki * bi; bbi[c] = kr * bi + ki * br; }
    const int c16 = p & 15;
    for (int t = 0; t < T; ++t) {
        float* urow = proj + (size_t)(base + t) * DIN + 2 * DC + g * CH;
        if (p < 16) us[p] = urow[p];
        __syncthreads();
        float bur = 0.f, bui = 0.f;
#pragma unroll
        for (int c = 0; c < 16; ++c) { bur += us[c] * bbr[c]; bui += us[c] * bbi[c]; }
        const float nre = abr * h_re - abi * h_im + bur, nim = abr * h_im + abi * h_re + bui;
        h_re = nre; h_im = nim;
        hr[p] = h_re; hi[p] = h_im;
        __syncthreads();
        if (p < 16) {
            float y = 0.f;
            for (int q = 0; q < 64; ++q) y += hr[q] * Cre[((size_t)g * CH + c16) * NP + q] - hi[q] * Cim[((size_t)g * CH + c16) * NP + q];
            y += Dk[g * CH + c16] * us[c16];
            urow[c16] = gelu_tanh(y);
        }
        __syncthreads();
    }
    if (seq < BATCH) { nrp[((size_t)seq * NG + g) * NP + p] = h_re; nip[((size_t)seq * NG + g) * NP + p] = h_im; }
    else { const int b = seq - BATCH; nrs[((size_t)b * NG + g) * NP + p] = h_re; nis[((size_t)b * NG + g) * NP + p] = h_im; }
}

__global__ void k_glu_ssm(const float* proj, const float* gn, float* mixA) {
    __shared__ float red[8];
    const int row = blockIdx.x; float y[4]; float q = 0.f;
#pragma unroll
    for (int j = 0; j < 4; ++j) { const int c = threadIdx.x + 256 * j; const float gg = proj[(size_t)row * DIN + 2 * DC + c], z = proj[(size_t)row * DIN + DC + c]; y[j] = gg * sigmoidf_(z); q += y[j] * y[j]; }
    const float r = rsqrtf(block_sum(q, red) / DS + EPS);
#pragma unroll
    for (int j = 0; j < 4; ++j) { const int c = threadIdx.x + 256 * j; mixA[(size_t)row * D + DC + c] = y[j] * r * gn[c]; }
}

__global__ void k_resid(const float* xa, const float* xb, const float* mix, float* out) {
    const size_t i = (size_t)blockIdx.x * blockDim.x + threadIdx.x;
    if (i >= (size_t)M * D) return;
    const size_t row = i / D;
    const float x = row < MP ? xa[i] : xb[i - (size_t)MP * D];
    out[i] = x + mix[i];
}
__global__ void k_add(float* out, const float* ff, size_t n) {
    const size_t i = (size_t)blockIdx.x * blockDim.x + threadIdx.x;
    if (i < n) out[i] += ff[i];
}
}

extern "C" void kernel_launch(void* const* d_in, const int* in_sizes, int n_in, void* d_out, int out_size, void* d_ws, size_t ws_size, hipStream_t stream) {
    using namespace v0;
    const float* x_prompt = (const float*)d_in[0]; const float* x_sample = (const float*)d_in[1];
    const float* state_conv = (const float*)d_in[2]; const float* st_re = (const float*)d_in[3]; const float* st_im = (const float*)d_in[4];
    const float* norm_mix = (const float*)d_in[5]; const float* w_in = (const float*)d_in[6];
    const float* conv_w = (const float*)d_in[7]; const float* conv_b = (const float*)d_in[8]; const float* ln_g = (const float*)d_in[9]; const float* ln_b = (const float*)d_in[10];
    const float* A_re = (const float*)d_in[11]; const float* A_im = (const float*)d_in[12]; const float* log_dt = (const float*)d_in[13];
    const float* B_re = (const float*)d_in[14]; const float* B_im = (const float*)d_in[15]; const float* C_re = (const float*)d_in[16]; const float* C_im = (const float*)d_in[17];
    const float* Dk = (const float*)d_in[18]; const float* w_glu = (const float*)d_in[19]; const float* gn_conv = (const float*)d_in[20]; const float* gn_ssm = (const float*)d_in[21];
    const float* w_out = (const float*)d_in[22]; const float* norm_ffn = (const float*)d_in[23]; const float* w_gate = (const float*)d_in[24]; const float* w_up = (const float*)d_in[25];
    const float* w_down = (const float*)d_in[26]; const float* norm_final = (const float*)d_in[27];
    float* out = (float*)d_out;
    float* y = out;
    float* ncp = out + (size_t)M * D;
    float* nrp = ncp + (size_t)BATCH * (KW - 1) * DC;
    float* nip = nrp + (size_t)BATCH * NG * NP;
    float* ncs = nip + (size_t)BATCH * NG * NP;
    float* nrs = ncs + (size_t)DB * (KW - 1) * DC;
    float* nis = nrs + (size_t)DB * NG * NP;
    const size_t need = ((size_t)M * D + (size_t)M * DIN + (size_t)M * D) * 4;
    if (ws_size < need || n_in != 28) { fprintf(stderr, "kernel_launch: ws too small (%zu < %zu) or n_in %d\n", ws_size, need, n_in); return; }
    float* bufA = (float*)d_ws;
    float* proj = bufA + (size_t)M * D;
    float* mixA = proj + (size_t)M * DIN;
    k_rmsnorm<<<M, 256, 0, stream>>>(x_prompt, x_sample, norm_mix, bufA, D, D, D);
    k_gemm<false><<<dim3(DIN / 64, M / 64), 256, 0, stream>>>(bufA, D, w_in, nullptr, DIN, proj, DIN, D);
    k_glu_u<<<(unsigned)(((size_t)M * DC + 255) / 256), 256, 0, stream>>>(proj);
    k_conv<<<M, 256, 0, stream>>>(proj, state_conv, conv_w, conv_b, ln_g, ln_b, gn_conv, mixA);
    k_newconv<<<(unsigned)(((size_t)(BATCH + DB) * (KW - 1) * DC + 255) / 256), 256, 0, stream>>>(proj, state_conv, ncp, ncs);
    k_ssm<<<(BATCH + DB) * NG, 64, 0, stream>>>(proj, st_re, st_im, A_re, A_im, log_dt, B_re, B_im, C_re, C_im, Dk, nrp, nip, nrs, nis);
    k_gemm<false><<<dim3(DS / 64, M / 64), 256, 0, stream>>>(proj + 2 * DC, DIN, w_glu, nullptr, DS, proj + DC, DIN, DS);
    k_glu_ssm<<<M, 256, 0, stream>>>(proj, gn_ssm, mixA);
    k_gemm<false><<<dim3(D / 64, M / 64), 256, 0, stream>>>(mixA, D, w_out, nullptr, D, bufA, D, D);
    k_resid<<<(unsigned)(((size_t)M * D + 255) / 256), 256, 0, stream>>>(x_prompt, x_sample, bufA, y);
    k_rmsnorm<<<M, 256, 0, stream>>>(y, nullptr, norm_ffn, bufA, D, D, D);
    const int RC = M / 4;
    for (int ch = 0; ch < 4; ++ch) {
        float* act = proj; float* ff = mixA;
        k_gemm<true><<<dim3(DFF / 64, RC / 64), 256, 0, stream>>>(bufA + (size_t)ch * RC * D, D, w_gate, w_up, DFF, act, DFF, D);
        k_gemm<false><<<dim3(D / 64, RC / 64), 256, 0, stream>>>(act, DFF, w_down, nullptr, D, ff, D, DFF);
        k_add<<<(unsigned)(((size_t)RC * D + 255) / 256), 256, 0, stream>>>(y + (size_t)ch * RC * D, ff, (size_t)RC * D);
    }
    k_rmsnorm<<<M, 256, 0, stream>>>(y, nullptr, norm_final, y, D, D, D);
}
```

```cpp
#include <hip/hip_runtime.h>
#include <cstdio>
#include <cstdint>
#define MK_N_LAUNCHES 9
namespace pg8 {
#define PG8_LAS __attribute__((address_space(3)))
typedef unsigned short bf16_t;
typedef short bf16x8 __attribute__((ext_vector_type(8)));
typedef float f32x4 __attribute__((ext_vector_type(4)));
typedef unsigned u32x4 __attribute__((ext_vector_type(4)));
constexpr int BM = 256, BK = 64, HALF = 128, HTB = HALF * BK * 2  , STAGE_BYTES = 8 * HTB, NXCD = 8, WGM = 8;

__host__ __device__ __forceinline__ int lds_byte(int r, int c) { const int st = (r >> 4) * 2 + (c >> 5), rr = r & 15, cc = c & 31, ob = rr * 64 + cc * 2; return st * 1024 + (ob ^ (((ob >> 9) & 1) << 5)); }
__host__ __device__ __forceinline__ void stage_rc(int b, int& R, int& C) { const int st = b / 1024, sb = b % 1024, swz = sb ^ (((sb >> 9) & 1) << 5); R = (st >> 1) * 16 + swz / 64; C = (st & 1) * 32 + (swz % 64) / 2; }
__host__ __device__ __forceinline__ int perm32(int rho) { const int n = rho >> 4, i = rho & 15; return 8 * (i >> 2) + 4 * n + (i & 3); }

struct Unit { int pm, pn; };
struct Gemm { const bf16_t* A; const bf16_t* Bt; int M, N, K; };

struct StaticOrder {
    int nM, nN, nwg, G, c;
    __host__ __device__ void init(int M, int N, int G_, int c_) { nM = M / BM; nN = N / BM; nwg = nM * nN; G = G_; c = c_; }
    __host__ __device__ bool next(int i, Unit& u) const {
        const long L = (long)i * G + c; if (L >= nwg) return false;
        int wgid = (int)L; { const int q = nwg / NXCD, r = nwg % NXCD, xcd = wgid % NXCD, off = wgid / NXCD; wgid = (xcd < r ? xcd * (q + 1) : r * (q + 1) + (xcd - r) * q) + off; }
        const int nig = WGM * nN, gid = wgid / nig, fm = gid * WGM, gsz = (nM - fm) < WGM ? (nM - fm) : WGM;
        u.pm = fm + ((wgid % nig) % gsz); u.pn = (wgid % nig) / gsz; return true;
    }
    __device__ __forceinline__ void a_ready(const Unit&) const {}
    __device__ __forceinline__ void done(const Unit&) const {}
};

__device__ __forceinline__ unsigned cvt_pk_bf16(float lo, float hi) { unsigned r; asm volatile("v_cvt_pk_bf16_f32 %0, %1, %2" : "=v"(r) : "v"(lo), "v"(hi)); return r; }
template <class Epi, class Sched, bool ALIGN_EPI = false, bool SP2 = false>
__device__ __forceinline__ void gemm_phase(PG8_LAS unsigned char* lds, const Gemm g, const Sched& S, const Epi& E) {
    const int tid = threadIdx.x, wid = __builtin_amdgcn_readfirstlane(tid >> 6), lane = tid & 63, wr = wid >> 2, wc = wid & 3, fr = lane & 15, fq = lane >> 4;
    const int K = g.K, nt = K / BK;
    unsigned voffA[2], voffB[2];
#pragma unroll
    for (int i = 0; i < 2; ++i) { int R, C; stage_rc(tid * 16 + i * 8192, R, C); const int Rb = Epi::PERM ? ((R & ~31) + perm32(R & 31)) : R;
        voffA[i] = (unsigned)(R * K + C) * 2u; voffB[i] = (unsigned)(Rb * K + C) * 2u; }
    const size_t kstep = (size_t)(BK * 2);
    const size_t hstep = (size_t)HALF * K * 2;
    const size_t tstep = 2 * hstep;
    const unsigned ldsw = (unsigned)wid * 1024u;
    const int aoff = lds_byte(wr * 64 + fr, fq * 8), boff = lds_byte(wc * 32 + fr, fq * 8);
#define PG8_SA(b, h) (((b) * 2 + (h)) * HTB)
#define PG8_SB(b, h) ((4 + (b) * 2 + (h)) * HTB)
#define PG8_STAGE(bufoff, gbase, voff) do { _Pragma("unroll") for (int _i = 0; _i < 2; ++_i) \
        __builtin_amdgcn_global_load_lds((const unsigned*)((const char*)(gbase) + (voff)[_i]), (PG8_LAS unsigned*)(lds + (bufoff) + ldsw + _i * 8192), 16, 0, 0); } while (0)
#define PG8_LDA(dst, b, h) do { _Pragma("unroll") for (int m = 0; m < 4; ++m) _Pragma("unroll") for (int k = 0; k < 2; ++k) dst[m][k] = *(const PG8_LAS bf16x8*)(lds + PG8_SA(b, h) + aoff + m * 2048 + k * 1024); } while (0)
#define PG8_LDB(dst, b, h) do { _Pragma("unroll") for (int n = 0; n < 2; ++n) _Pragma("unroll") for (int k = 0; k < 2; ++k) dst[n][k] = *(const PG8_LAS bf16x8*)(lds + PG8_SB(b, h) + boff + n * 2048 + k * 1024); } while (0)
#define PG8_MMA(ai, bj, At, Bt) do { __builtin_amdgcn_s_setprio(1); _Pragma("unroll") for (int m = 0; m < 4; ++m) _Pragma("unroll") for (int n = 0; n < 2; ++n) _Pragma("unroll") for (int k = 0; k < 2; ++k) \
        acc[ai][bj][m][n] = __builtin_amdgcn_mfma_f32_16x16x32_bf16(Bt[n][k], At[m][k], acc[ai][bj][m][n], 0, 0, 0); __builtin_amdgcn_s_setprio(0); } while (0)
#define PG8_WAIT_V(n) asm volatile("s_waitcnt vmcnt(" #n ")" ::: "memory")
#define PG8_WAIT_L(n) asm volatile("s_waitcnt lgkmcnt(" #n ")" ::: "memory")
#define PG8_BAR __builtin_amdgcn_s_barrier()
#define PG8_SCHED __builtin_amdgcn_sched_barrier(0)
    Unit cur, nxt; int ui = 0;
    if (!S.next(0, cur)) return;
    f32x4 acc[2][2][4][2];
#pragma unroll
    for (int a = 0; a < 2; ++a)
#pragma unroll
        for (int b = 0; b < 2; ++b)
#pragma unroll
            for (int m = 0; m < 4; ++m)
#pragma unroll
                for (int n = 0; n < 2; ++n) acc[a][b][m][n] = (f32x4){0.f, 0.f, 0.f, 0.f};
    bf16x8 At[4][2], B0[2][2], B1[2][2];
    const char* cA = (const char*)g.A + (size_t)cur.pm * tstep; const char* cB = (const char*)g.Bt + (size_t)cur.pn * tstep;
    S.a_ready(cur);
    if constexpr (SP2) {
        PG8_STAGE(PG8_SB(0, 0), cB, voffB); PG8_STAGE(PG8_SB(0, 1), cB + hstep, voffB); PG8_STAGE(PG8_SA(0, 0), cA, voffA); PG8_STAGE(PG8_SA(0, 1), cA + hstep, voffA);
        if (wr == 1) PG8_BAR;
        PG8_WAIT_V(2); PG8_BAR;
        PG8_STAGE(PG8_SB(1, 0), cB + kstep, voffB); PG8_STAGE(PG8_SA(1, 0), cA + kstep, voffA); PG8_STAGE(PG8_SB(1, 1), cB + hstep + kstep, voffB);
        PG8_WAIT_V(6); PG8_BAR;
    } else {
        PG8_STAGE(PG8_SB(0, 0), cB, voffB); PG8_STAGE(PG8_SA(0, 0), cA, voffA); PG8_STAGE(PG8_SB(0, 1), cB + hstep, voffB); PG8_STAGE(PG8_SA(0, 1), cA + hstep, voffA);
        if (wr == 1) PG8_BAR;
        PG8_WAIT_V(4); PG8_BAR;
        PG8_STAGE(PG8_SB(1, 0), cB + kstep, voffB); PG8_STAGE(PG8_SA(1, 0), cA + kstep, voffA); PG8_STAGE(PG8_SB(1, 1), cB + hstep + kstep, voffB);
        PG8_WAIT_V(6); PG8_BAR;
    }
    for (;;) {
        const bool has_next = S.next(ui + 1, nxt);
        const char* nA = has_next ? (const char*)g.A + (size_t)nxt.pm * tstep : cA; const char* nB = has_next ? (const char*)g.Bt + (size_t)nxt.pn * tstep : cB;
        for (int t = 0; t < nt; t += 2) {
            const bool last = (t == nt - 2);
            const char* a1 = cA + (size_t)(t + 1) * kstep;
            const char* a2 = last ? nA : cA + (size_t)(t + 2) * kstep; const char* b2 = last ? nB : cB + (size_t)(t + 2) * kstep;
            const char* a3 = a2 + kstep; const char* b3 = b2 + kstep;
            if (last && has_next) S.a_ready(nxt);
            if constexpr (SP2) {
            PG8_LDB(B0, 0, 0); PG8_LDB(B1, 0, 1); PG8_SCHED; PG8_LDA(At, 0, 0); PG8_STAGE(PG8_SA(1, 1), a1 + hstep, voffA);
            PG8_WAIT_V(8); PG8_WAIT_L(0); PG8_BAR; PG8_MMA(0, 0, At, B0); PG8_MMA(0, 1, At, B1); PG8_BAR; PG8_SCHED;
            PG8_LDA(At, 0, 1); PG8_STAGE(PG8_SB(0, 0), b2, voffB); PG8_STAGE(PG8_SB(0, 1), b2 + hstep, voffB); PG8_STAGE(PG8_SA(0, 0), a2, voffA);
            PG8_WAIT_V(8); PG8_WAIT_L(0); PG8_BAR; PG8_MMA(1, 0, At, B0); PG8_MMA(1, 1, At, B1); PG8_BAR; PG8_SCHED;
            PG8_LDB(B0, 1, 0); PG8_LDB(B1, 1, 1); PG8_SCHED; PG8_LDA(At, 1, 0); PG8_STAGE(PG8_SA(0, 1), a2 + hstep, voffA);
            PG8_WAIT_V(8); PG8_WAIT_L(0); PG8_BAR; PG8_MMA(0, 0, At, B0); PG8_MMA(0, 1, At, B1); PG8_BAR; PG8_SCHED;
            PG8_LDA(At, 1, 1); PG8_STAGE(PG8_SB(1, 0), b3, voffB); PG8_STAGE(PG8_SB(1, 1), b3 + hstep, voffB); PG8_STAGE(PG8_SA(1, 0), a3, voffA);
            PG8_WAIT_V(8); PG8_WAIT_L(0); PG8_BAR; PG8_MMA(1, 0, At, B0); PG8_MMA(1, 1, At, B1); PG8_BAR; PG8_SCHED;
            } else {
            PG8_LDB(B0, 0, 0); PG8_SCHED; PG8_LDA(At, 0, 0); PG8_STAGE(PG8_SA(1, 1), a1 + hstep, voffA);
            PG8_WAIT_L(8); PG8_BAR; PG8_WAIT_L(0); PG8_MMA(0, 0, At, B0); PG8_BAR; PG8_SCHED;
            PG8_LDB(B1, 0, 1); PG8_STAGE(PG8_SB(0, 0), b2, voffB);
            PG8_BAR; PG8_WAIT_L(0); PG8_MMA(0, 1, At, B1); PG8_BAR;
            PG8_LDA(At, 0, 1); PG8_STAGE(PG8_SA(0, 0), a2, voffA);
            PG8_BAR; PG8_WAIT_L(0); PG8_MMA(1, 0, At, B0); PG8_BAR; PG8_SCHED;
            PG8_STAGE(PG8_SB(0, 1), b2 + hstep, voffB);
            PG8_WAIT_V(6); PG8_BAR; PG8_MMA(1, 1, At, B1); PG8_BAR;
            PG8_LDB(B0, 1, 0); PG8_SCHED; PG8_LDA(At, 1, 0); PG8_STAGE(PG8_SA(0, 1), a2 + hstep, voffA);
            PG8_WAIT_L(8); PG8_BAR; PG8_WAIT_L(0); PG8_MMA(0, 0, At, B0); PG8_BAR; PG8_SCHED;
            PG8_LDB(B1, 1, 1); PG8_STAGE(PG8_SB(1, 0), b3, voffB);
            PG8_BAR; PG8_WAIT_L(0); PG8_MMA(0, 1, At, B1); PG8_BAR;
            PG8_LDA(At, 1, 1); PG8_STAGE(PG8_SA(1, 0), a3, voffA);
            PG8_BAR; PG8_WAIT_L(0); PG8_MMA(1, 0, At, B0); PG8_BAR; PG8_SCHED;
            PG8_STAGE(PG8_SB(1, 1), b3 + hstep, voffB);
            PG8_WAIT_V(6); PG8_BAR; PG8_MMA(1, 1, At, B1); PG8_BAR;
            }
        }
        if constexpr (ALIGN_EPI) { if (wr == 0) PG8_BAR; }
        if constexpr (!Epi::AFTER_DRAIN) { E(acc, cur, wr, wc, fr, fq); S.done(cur); }
        if (!has_next) break;
#pragma unroll
        for (int a = 0; a < 2; ++a)
#pragma unroll
            for (int b = 0; b < 2; ++b)
#pragma unroll
                for (int m = 0; m < 4; ++m)
#pragma unroll
                    for (int n = 0; n < 2; ++n) acc[a][b][m][n] = (f32x4){0.f, 0.f, 0.f, 0.f};
        cur = nxt; cA = nA; cB = nB; ++ui;
        if constexpr (ALIGN_EPI) { if (wr == 1) PG8_BAR; }
    }
    PG8_WAIT_V(0);
    if constexpr (!ALIGN_EPI) { if (wr == 0) PG8_BAR; }
    PG8_BAR;
    if constexpr (Epi::AFTER_DRAIN) { E.fused(acc, cur, wr, wc, fr, fq, lds, wid, lane); S.done(cur); }
#undef PG8_SA
#undef PG8_SB
#undef PG8_STAGE
#undef PG8_LDA
#undef PG8_LDB
#undef PG8_MMA
#undef PG8_WAIT_V
#undef PG8_WAIT_L
#undef PG8_BAR
#undef PG8_SCHED
}
}

namespace pg8 {
constexpr float RMS_EPS = 1e-6f;
__device__ __forceinline__ float fsig(float x) { return __builtin_amdgcn_rcpf(1.0f + __builtin_amdgcn_exp2f(x * -1.4426950408889634f)); }
__device__ __forceinline__ float bflo(unsigned w) { return __builtin_bit_cast(float, w << 16); }
__device__ __forceinline__ float bfhi(unsigned w) { return __builtin_bit_cast(float, w & 0xffff0000u); }
__device__ __forceinline__ u32x4 pack8(const f32x4& a, const f32x4& b) { u32x4 w; w.x = cvt_pk_bf16(a[0], a[1]); w.y = cvt_pk_bf16(a[2], a[3]); w.z = cvt_pk_bf16(b[0], b[1]); w.w = cvt_pk_bf16(b[2], b[3]); return w; }
__device__ __forceinline__ float sq4(const f32x4& a) { return (a[0] * a[0] + a[1] * a[1]) + (a[2] * a[2] + a[3] * a[3]); }
__device__ __forceinline__ void row_atomic(float* p, float q, int fq) { q += __shfl_xor(q, 16); q += __shfl_xor(q, 32); if (fq == 0) (void)__hip_atomic_fetch_add(p, q, __ATOMIC_RELAXED, __HIP_MEMORY_SCOPE_AGENT); }

struct EpiIn {
    static constexpr bool PERM = true, AFTER_DRAIN = false;
    bf16_t* U; bf16_t* S; const float* rx;
    __device__ __forceinline__ void operator()(const f32x4 (&acc)[2][2][4][2], const Unit& u, int wr, int wc, int fr, int fq) const {
        const int row0 = u.pm * BM + wr * 64 + fr;
        if (u.pn < 8) {
            const int col0 = u.pn * 128 + wc * 32 + 8 * fq;
#pragma unroll
            for (int ai = 0; ai < 2; ++ai)
#pragma unroll
                for (int m = 0; m < 4; ++m) { const int row = row0 + ai * HALF + m * 16; const float r = rx[row];
                    f32x4 v0, v1;
#pragma unroll
                    for (int j = 0; j < 4; ++j) { v0[j] = (acc[ai][0][m][0][j] * r) * fsig(acc[ai][1][m][0][j] * r); v1[j] = (acc[ai][0][m][1][j] * r) * fsig(acc[ai][1][m][1][j] * r); }
                    *(u32x4*)(U + (size_t)row * 1024 + col0) = pack8(v0, v1); }
        } else {
            const int col0 = (u.pn - 8) * 256 + wc * 32 + 8 * fq;
#pragma unroll
            for (int ai = 0; ai < 2; ++ai)
#pragma unroll
                for (int m = 0; m < 4; ++m) { const int row = row0 + ai * HALF + m * 16; const float r = rx[row];
#pragma unroll
                    for (int bj = 0; bj < 2; ++bj) *(u32x4*)(S + (size_t)row * 1024 + col0 + bj * HALF) = pack8(acc[ai][bj][m][0] * r, acc[ai][bj][m][1] * r); }
        }
    }
};
struct EpiGlu {
    static constexpr bool PERM = true, AFTER_DRAIN = false;
    const bf16_t* G; bf16_t* MIX; float* ssq;
    __device__ __forceinline__ void operator()(const f32x4 (&acc)[2][2][4][2], const Unit& u, int wr, int wc, int fr, int fq) const {
        const int row0 = u.pm * BM + wr * 64 + fr, col0 = u.pn * BM + wc * 32 + 8 * fq;
#pragma unroll
        for (int ai = 0; ai < 2; ++ai)
#pragma unroll
            for (int m = 0; m < 4; ++m) { const int row = row0 + ai * HALF + m * 16; float q = 0.f;
#pragma unroll
                for (int bj = 0; bj < 2; ++bj) { const u32x4 gw = *(const u32x4*)(G + (size_t)row * 1024 + col0 + bj * HALF);
                    f32x4 g0 = {bflo(gw.x), bfhi(gw.x), bflo(gw.y), bfhi(gw.y)}, g1 = {bflo(gw.z), bfhi(gw.z), bflo(gw.w), bfhi(gw.w)}, y0, y1;
#pragma unroll
                    for (int j = 0; j < 4; ++j) { y0[j] = g0[j] * fsig(acc[ai][bj][m][0][j]); y1[j] = g1[j] * fsig(acc[ai][bj][m][1][j]); }
                    q += sq4(y0) + sq4(y1);
                    *(u32x4*)(MIX + (size_t)row * 2048 + 1024 + col0 + bj * HALF) = pack8(y0, y1); }
                row_atomic(ssq + row, q, fq); }
    }
};
struct EpiOut {
    static constexpr bool PERM = true, AFTER_DRAIN = false;
    const float* xp; const float* xs; float* H; bf16_t* HB; float* ssq;
    __device__ __forceinline__ void operator()(const f32x4 (&acc)[2][2][4][2], const Unit& u, int wr, int wc, int fr, int fq) const {
        const int row0 = u.pm * BM + wr * 64 + fr, col0 = u.pn * BM + wc * 32 + 8 * fq;
        const float* xb = (u.pm < 32) ? xp : xs - (size_t)8192 * 2048;
#pragma unroll
        for (int ai = 0; ai < 2; ++ai)
#pragma unroll
            for (int m = 0; m < 4; ++m) { const int row = row0 + ai * HALF + m * 16; float q = 0.f;
#pragma unroll
                for (int bj = 0; bj < 2; ++bj) { const size_t off = (size_t)row * 2048 + col0 + bj * HALF;
                    const f32x4 h0 = *(const f32x4*)(xb + off) + acc[ai][bj][m][0], h1 = *(const f32x4*)(xb + off + 4) + acc[ai][bj][m][1];
                    q += sq4(h0) + sq4(h1);
                    *(f32x4*)(H + off) = h0; *(f32x4*)(H + off + 4) = h1; *(u32x4*)(HB + off) = pack8(h0, h1); }
                row_atomic(ssq + row, q, fq); }
    }
};
struct EpiUp {
    static constexpr bool PERM = true, AFTER_DRAIN = false;
    bf16_t* ACT; const float* ssq;
    __device__ __forceinline__ void operator()(const f32x4 (&acc)[2][2][4][2], const Unit& u, int wr, int wc, int fr, int fq) const {
        const int row0 = u.pm * BM + wr * 64 + fr, col0 = u.pn * 128 + wc * 32 + 8 * fq;
#pragma unroll
        for (int ai = 0; ai < 2; ++ai)
#pragma unroll
            for (int m = 0; m < 4; ++m) { const int row = row0 + ai * HALF + m * 16; const float r = __builtin_amdgcn_rsqf(ssq[row] * (1.0f / 2048.0f) + RMS_EPS);
                f32x4 v0, v1;
#pragma unroll
                for (int j = 0; j < 4; ++j) { const float a0 = acc[ai][0][m][0][j] * r, a1 = acc[ai][0][m][1][j] * r;
                    v0[j] = a0 * fsig(a0) * (acc[ai][1][m][0][j] * r); v1[j] = a1 * fsig(a1) * (acc[ai][1][m][1][j] * r); }
                *(u32x4*)(ACT + (size_t)row * 5632 + col0) = pack8(v0, v1); }
    }
};
struct EpiDown {
    static constexpr bool PERM = true, AFTER_DRAIN = false;
    float* H; float* ssq;
    __device__ __forceinline__ void operator()(const f32x4 (&acc)[2][2][4][2], const Unit& u, int wr, int wc, int fr, int fq) const {
        const int row0 = u.pm * BM + wr * 64 + fr, col0 = u.pn * BM + wc * 32 + 8 * fq;
#pragma unroll
        for (int ai = 0; ai < 2; ++ai)
#pragma unroll
            for (int m = 0; m < 4; ++m) { const int row = row0 + ai * HALF + m * 16; float q = 0.f;
#pragma unroll
                for (int bj = 0; bj < 2; ++bj) { float* p = H + (size_t)row * 2048 + col0 + bj * HALF;
                    const f32x4 o0 = *(const f32x4*)p + acc[ai][bj][m][0], o1 = *(const f32x4*)(p + 4) + acc[ai][bj][m][1];
                    q += sq4(o0) + sq4(o1);
                    *(f32x4*)p = o0; *(f32x4*)(p + 4) = o1; }
                row_atomic(ssq + row, q, fq); }
    }
};
}

constexpr int NWAVES = 8;
#ifndef MK_N_LAUNCHES
#define MK_N_LAUNCHES 1
#endif
constexpr int NPH = 9;
constexpr int N_LAUNCHES = MK_N_LAUNCHES;

constexpr int D = 2048, DC = 1024, DS = 1024, DIN = 3072, DFF = 5632, NG = 64, NP = 64, CH = 16, KW = 31;
constexpr int BATCH = 4, SEQ = 2048, DB = 128, DSQ = 8;
constexpr int MP = BATCH * SEQ, MS = DB * DSQ, M = MP + MS;

constexpr size_t MiB = 1u << 20;
constexpr size_t WS_CTL = 0, CTL_ZERO_BYTES = 1 * MiB;
constexpr size_t WS_TAB = 1 * MiB;
constexpr size_t WS_WGU = 2 * MiB, WS_WDN = 46 * MiB, WS_XB = 68 * MiB;
constexpr size_t WS_WIN = 104 * MiB, WS_WGL = 116 * MiB, WS_WOUT = 118 * MiB;
constexpr size_t WS_U = 126 * MiB, WS_S = 144 * MiB, WS_G = 162 * MiB, WS_MIX = 180 * MiB;
constexpr size_t WS_ACT = 104 * MiB;
constexpr size_t WS_END = 216 * MiB;
static_assert(WS_WGU + (size_t)2 * DFF * D * 2 <= WS_WDN && WS_WDN + (size_t)D * DFF * 2 <= WS_XB && WS_XB + (size_t)M * D * 2 <= WS_WIN, "ws map 1");
static_assert(WS_WIN + (size_t)DIN * D * 2 <= WS_WGL && WS_WGL + (size_t)DS * DS * 2 <= WS_WOUT && WS_WOUT + (size_t)D * D * 2 <= WS_U, "ws map 2");
static_assert(WS_U + (size_t)M * DC * 2 <= WS_S && WS_S + (size_t)M * DS * 2 <= WS_G && WS_G + (size_t)M * DS * 2 <= WS_MIX && WS_MIX + (size_t)M * D * 2 <= WS_END, "ws map 3");
static_assert(WS_ACT + (size_t)M * DFF * 2 <= WS_END, "ws map 4");
constexpr int CW_TMO = 0, CW_CODE = 1;
constexpr int CW_BAR = 4096;
constexpr int CW_SSQ_S = 16384, CW_SSQ_H = CW_SSQ_S + M, CW_SSQ_O = CW_SSQ_H + M;
constexpr int CW_RX = 65536;
static_assert((CW_RX + M) * 4 <= (int)CTL_ZERO_BYTES && CW_SSQ_O + M <= CW_RX, "ctl map");
constexpr size_t TAB_AB = 0;
constexpr size_t TAB_BBT = 64 * 1024;
constexpr size_t TAB_CQ = 512 * 1024;

constexpr int RING_OFF = 0, RING_BYTES = 131072;
constexpr int LDSCTL_OFF = RING_BYTES, MISC_OFF = LDSCTL_OFF + 320;
constexpr int LDS_BYTES = 147456;
static_assert(MISC_OFF + 128 <= LDS_BYTES, "LDS map");

#define GAS __attribute__((address_space(1)))
#define LAS __attribute__((address_space(3)))
typedef unsigned short bf16;
typedef unsigned v4u __attribute__((ext_vector_type(4)));
typedef unsigned v2u __attribute__((ext_vector_type(2)));
typedef float f32x4 __attribute__((ext_vector_type(4)));
typedef float f32x2 __attribute__((ext_vector_type(2)));
typedef float f32x16 __attribute__((ext_vector_type(16)));
typedef short bf16x8 __attribute__((ext_vector_type(8)));
typedef GAS unsigned gu32;
#define RLX_AGENT __ATOMIC_RELAXED, __HIP_MEMORY_SCOPE_AGENT
#define LDS_WAIT() asm volatile("s_waitcnt lgkmcnt(0)" ::: "memory")
#define VM_WAIT() asm volatile("s_waitcnt vmcnt(0)" ::: "memory")
__device__ __forceinline__ unsigned f2bf(float f) { unsigned u = __builtin_bit_cast(unsigned, f); return (u + 0x7fffu + ((u >> 16) & 1u)) >> 16; }
__device__ __forceinline__ unsigned pk2(float lo, float hi) { return f2bf(lo) | (f2bf(hi) << 16); }
__device__ __forceinline__ float bf_lo(unsigned w) { return __builtin_bit_cast(float, w << 16); }
__device__ __forceinline__ float bf_hi(unsigned w) { return __builtin_bit_cast(float, w & 0xffff0000u); }
__device__ __forceinline__ float wave_sum(float v) {
#pragma unroll
    for (int o = 1; o < 64; o <<= 1) v += __shfl_xor(v, o);
    return v;
}
__device__ __forceinline__ float fsigm(float x) { return __builtin_amdgcn_rcpf(1.0f + __builtin_amdgcn_exp2f(x * -1.4426950408889634f)); }
__device__ __forceinline__ float gelu_tanh_f(float x) {
    const float u2 = 1.5957691216057308f * (x + 0.044715f * x * x * x);
    return x * fsigm(u2);
}

#define XB_TMO      128
#define XB_XCNT(j)  (256  + 64 * (j))
#define XB_XSUB(j)  (1280 + 64 * (j))
#define XB_XGEN(j)  (2304 + 64 * (j))
#define XB_TOP      3328
#define XB_TOPGEN   3392
#define XCD_BAR_WORDS 3456
#define XB_SPIN_CAP (1u << 18)

__device__ __forceinline__ unsigned xb_ld(unsigned* p)              { return __hip_atomic_load(p, __ATOMIC_RELAXED, __HIP_MEMORY_SCOPE_AGENT); }
__device__ __forceinline__ unsigned xb_add(unsigned* p, unsigned v) { return __hip_atomic_fetch_add(p, v, __ATOMIC_RELAXED, __HIP_MEMORY_SCOPE_AGENT); }
__device__ __forceinline__ unsigned xb_xcc_id() { return (unsigned)__builtin_amdgcn_s_getreg((3 << 11) | 20) & 0xFu; }
#define XB_SPIN(cond, bar) do { unsigned _sp = 0; while (cond) { __builtin_amdgcn_s_sleep(1); \
    if ((++_sp & 255u) == 0u) { if (xb_ld(&(bar)[XB_TMO])) break; if (_sp > XB_SPIN_CAP) { atomicAdd(&(bar)[XB_TMO], 1u); break; } } } } while (0)

struct XcdBarrier {
    unsigned* bar; unsigned x;
    volatile LAS unsigned* st;
};

__device__ __forceinline__ XcdBarrier xcd_barrier_post(unsigned* bar, volatile LAS unsigned* st) {
    XcdBarrier b; b.bar = bar; b.x = xb_xcc_id(); b.st = st;
    if (threadIdx.x == 0) (void)xb_add(&bar[XB_XCNT(b.x)], 1u);
    return b;
}
__device__ __forceinline__ void xcd_barrier_complete(unsigned* bar, unsigned x, unsigned& nloc, unsigned& nx) {
    const unsigned G = gridDim.x * gridDim.y * gridDim.z;
    unsigned sum, cnt, mine, sp = 0u;
    for (;;) {
        sum = 0u; cnt = 0u; mine = 0u;
#pragma unroll
        for (unsigned j = 0; j < 16; ++j) { const unsigned c = xb_ld(&bar[XB_XCNT(j)]); sum += c; cnt += (c > 0u) ? 1u : 0u; mine = (j == x) ? c : mine; }
        if (sum == G) break;
        __builtin_amdgcn_s_sleep(1);
        if ((++sp & 255u) == 0u) { if (xb_ld(&bar[XB_TMO])) break; if (sp > XB_SPIN_CAP) { atomicAdd(&bar[XB_TMO], 1u); break; } }
    }
    nloc = mine > 0u ? mine : 1u; nx = cnt > 0u ? cnt : 1u;
}

__device__ __forceinline__ void xcd_barrier(const XcdBarrier& b) {
    asm volatile("s_waitcnt vmcnt(0)" ::: "memory");
    __syncthreads();
    if (threadIdx.x == 0) {
        unsigned* bar = b.bar;
        __builtin_amdgcn_s_waitcnt(0);
        unsigned nloc = b.st[0], nx = b.st[1];
        if (nloc == 0u) { xcd_barrier_complete(bar, b.x, nloc, nx); b.st[0] = nloc; b.st[1] = nx; }
        const unsigned old = xb_add(&bar[XB_XSUB(b.x)], 1u);
        const unsigned gen = old / nloc;
        if (old + 1u == (gen + 1u) * nloc) {
            __builtin_amdgcn_fence(__ATOMIC_RELEASE, "agent");
            asm volatile("s_waitcnt vmcnt(0)" ::: "memory");
            const unsigned og = xb_add(&bar[XB_TOP], 1u);
            const unsigned tg = og / nx;
            if (og + 1u == (tg + 1u) * nx) xb_add(&bar[XB_TOPGEN], 1u);
            else XB_SPIN(xb_ld(&bar[XB_TOPGEN]) == tg, bar);
            __builtin_amdgcn_fence(__ATOMIC_ACQUIRE, "agent");
            xb_add(&bar[XB_XGEN(b.x)], 1u);
            asm volatile("s_waitcnt vmcnt(0)" ::: "memory");
        } else {
            XB_SPIN(xb_ld(&bar[XB_XGEN(b.x)]) == gen, bar);
            __builtin_amdgcn_fence(__ATOMIC_ACQUIRE, "agent");
            asm volatile("s_waitcnt vmcnt(0)" ::: "memory");
        }
    }
    __syncthreads();
}

__device__ __forceinline__ void p0_transpose_item(const float* W, int N, const float* gain, bf16* WT, int K, int out_row0, LAS float* scr, int k0, int n0, int lane) {
    const int kr = lane >> 3, nq = lane & 7;
#pragma unroll
    for (int i = 0; i < 8; ++i) { const int kk = 8 * i + kr; const f32x4 v = *(const GAS f32x4*)(W + (size_t)(k0 + kk) * N + n0 + 4 * nq);
        const float gk = gain ? gain[k0 + kk] : 1.0f; LAS float* d = scr + kk * 33 + 4 * nq; d[0] = v.x * gk; d[1] = v.y * gk; d[2] = v.z * gk; d[3] = v.w * gk; }
    LDS_WAIT(); asm volatile("" ::: "memory");
    const int c = lane & 7;
#pragma unroll
    for (int j = 0; j < 4; ++j) { const int n = (lane >> 3) + 8 * j; const LAS float* s = scr + (8 * c) * 33 + n;
        v4u o; o.x = pk2(s[0 * 33], s[1 * 33]); o.y = pk2(s[2 * 33], s[3 * 33]); o.z = pk2(s[4 * 33], s[5 * 33]); o.w = pk2(s[6 * 33], s[7 * 33]);
        *(GAS v4u*)(WT + (size_t)(out_row0 + n) * K + k0 + 8 * c) = o; }
    LDS_WAIT(); asm volatile("" ::: "memory");
}

struct P0Args {
    const float *xp, *xs, *norm_mix, *w_in, *w_glu, *gn_conv, *gn_ssm, *w_out, *norm_ffn, *w_gate, *w_up, *w_down;
    const float *A_re, *A_im, *log_dt, *B_re, *B_im, *C_re, *C_im;
    bf16 *WIN, *WGL, *WOUT, *WGU, *WDN, *XB; float* rx; unsigned char* tab;
};
__device__ __forceinline__ void p0_prologue(const P0Args& a, LAS unsigned char* lds, int vcu, int G, int wave, int lane, int tid) {
    LAS float* scr = (LAS float*)(lds + RING_OFF + wave * 16384);
    const int gw = vcu * NWAVES + wave, NGW = G * NWAVES;
    { const int gt = vcu * (NWAVES * 64) + tid;
      if (gt < NG * NP) { const int g = gt >> 6, p = gt & 63;
        const float ar = a.A_re[gt], ai = a.A_im[gt], dt = expf(a.log_dt[g]);
        const float th = dt * ai, e1 = expm1f(dt * ar), sh = sinf(0.5f * th), cm1 = -2.0f * sh * sh, cs = 1.0f + cm1;
        const float nr = e1 * cs + cm1, ni = (1.0f + e1) * sinf(th);
        const float abr = 1.0f + nr, abi = ni, den = ar * ar + ai * ai;
        const float kr = (nr * ar + ni * ai) / den, ki = (ni * ar - nr * ai) / den;
        float* AB = (float*)(a.tab + TAB_AB); AB[gt * 2] = abr; AB[gt * 2 + 1] = abi;
        bf16* BBT = (bf16*)(a.tab + TAB_BBT); bf16* CQ = (bf16*)(a.tab + TAB_CQ);
#pragma unroll
        for (int c = 0; c < 16; ++c) { const float br = a.B_re[(size_t)gt * CH + c], bi = a.B_im[(size_t)gt * CH + c];
            BBT[((size_t)(g * 2 + 0) * NP + p) * CH + c] = (bf16)f2bf(kr * br - ki * bi);
            BBT[((size_t)(g * 2 + 1) * NP + p) * CH + c] = (bf16)f2bf(kr * bi + ki * br);
            CQ[((size_t)g * CH + c) * 128 + 2 * p] = (bf16)f2bf(a.C_re[((size_t)g * CH + c) * NP + p]);
            CQ[((size_t)g * CH + c) * 128 + 2 * p + 1] = (bf16)f2bf(-a.C_im[((size_t)g * CH + c) * NP + p]); }
      } }
    constexpr int I_IN = (D / 64) * (DIN / 32), I_GL = (DS / 64) * (DS / 32), I_OUT = (D / 64) * (D / 32), I_GA = (D / 64) * (DFF / 32), I_DN = (DFF / 64) * (D / 32);
    constexpr int NITEMS = I_IN + I_GL + I_OUT + 2 * I_GA + I_DN;
    for (int it = gw; it < NITEMS; it += NGW) {
        int r = it;
        if (r < I_IN) { const int nb = r % (DIN / 32), kb = r / (DIN / 32), n0 = 32 * nb;
            int orow; if (n0 < 2048) { const int bjv = n0 >> 10, ch = n0 & 1023; orow = 256 * (ch >> 7) + 128 * bjv + (ch & 127); } else orow = n0;
            p0_transpose_item(a.w_in, DIN, a.norm_mix, a.WIN, D, orow, scr, 64 * kb, n0, lane); continue; } r -= I_IN;
        if (r < I_GL) { const int nb = r % (DS / 32), kb = r / (DS / 32);
            p0_transpose_item(a.w_glu, DS, nullptr, a.WGL, DS, 32 * nb, scr, 64 * kb, 32 * nb, lane); continue; } r -= I_GL;
        if (r < I_OUT) { const int nb = r % (D / 32), kb = r / (D / 32), k0 = 64 * kb;
            p0_transpose_item(a.w_out, D, k0 < 1024 ? a.gn_conv : a.gn_ssm - 1024, a.WOUT, D, 32 * nb, scr, k0, 32 * nb, lane); continue; } r -= I_OUT;
        if (r < I_GA) { const int nb = r % (DFF / 32), kb = r / (DFF / 32), n0 = 32 * nb;
            p0_transpose_item(a.w_gate, DFF, a.norm_ffn, a.WGU, D, 256 * (n0 >> 7) + (n0 & 127), scr, 64 * kb, n0, lane); continue; } r -= I_GA;
        if (r < I_GA) { const int nb = r % (DFF / 32), kb = r / (DFF / 32), n0 = 32 * nb;
            p0_transpose_item(a.w_up, DFF, a.norm_ffn, a.WGU, D, 256 * (n0 >> 7) + 128 + (n0 & 127), scr, 64 * kb, n0, lane); continue; } r -= I_GA;
        { const int nb = r % (D / 32), kb = r / (D / 32);
            p0_transpose_item(a.w_down, D, nullptr, a.WDN, DFF, 32 * nb, scr, 64 * kb, 32 * nb, lane); }
    }
    for (int row = gw; row < M; row += NGW) {
        const float* x = row < MP ? a.xp + (size_t)row * D : a.xs + (size_t)(row - MP) * D;
        const GAS f32x4* xr = (const GAS f32x4*)x + lane;
        f32x4 v[8]; float s = 0.f;
#pragma unroll
        for (int j = 0; j < 8; ++j) { v[j] = xr[64 * j]; s += (v[j].x * v[j].x + v[j].y * v[j].y) + (v[j].z * v[j].z + v[j].w * v[j].w); }
        s = wave_sum(s);
        if (lane == 0) a.rx[row] = 1.0f / sqrtf(s * (1.0f / D) + 1e-6f);
        GAS v2u* o8 = (GAS v2u*)(a.XB + (size_t)row * D) + lane;
#pragma unroll
        for (int j = 0; j < 8; ++j) { v2u o; o.x = pk2(v[j].x, v[j].y); o.y = pk2(v[j].z, v[j].w); o8[64 * j] = o; }
    }
}

struct P2Args {
    const bf16* UC; const bf16* SI; bf16* G; bf16* MIX;
    const float *state_conv, *h0re, *h0im, *conv_w, *conv_b, *ln_g, *ln_b, *Dk;
    const unsigned char* tab;
    float *ncp, *nrp, *nip, *ncs, *nrs, *nis;
};
constexpr int P2_RED_OFF = 0, P2_TILE_OFF = 4096, P2_TILE_B = 4352, P2_TROW = 272, P2_SX_OFF = 81920;

__device__ __forceinline__ void p2_conv(const P2Args& a, LAS unsigned char* lds, int vcu, int G, int wave, int lane, int tid) {
    LAS float* red = (LAS float*)(lds + P2_RED_OFF);
    LAS float* tot = red + 128;
    const int c0 = 2 * tid;
    f32x2 w[KW];
#pragma unroll
    for (int k = 0; k < KW; ++k) w[k] = *(const GAS f32x2*)(a.conv_w + k * DC + c0);
    const f32x2 bias = *(const GAS f32x2*)(a.conv_b + c0), lg = *(const GAS f32x2*)(a.ln_g + c0), lb = *(const GAS f32x2*)(a.ln_b + c0);
    for (int it = vcu; it < 1024 + DB; it += G) {
        int rowbase, t0; const float* hist = nullptr;
        if (it < 1024) { rowbase = (it >> 8) * SEQ; t0 = (it & 255) * 8; } else { const int b = it - 1024; rowbase = MP + b * DSQ; t0 = 0; hist = a.state_conv + (size_t)b * (KW - 1) * DC; }
        f32x2 acc[8];
#pragma unroll
        for (int j = 0; j < 8; ++j) acc[j] = bias;
#pragma unroll
        for (int r = 0; r < 8 + KW - 1; ++r) {
            const int tt = t0 - (KW - 1) + r; f32x2 v = {0.f, 0.f};
            if (tt >= 0) { const unsigned pk = *(const GAS unsigned*)(a.UC + (size_t)(rowbase + tt) * DC + c0); v.x = bf_lo(pk); v.y = bf_hi(pk); }
            else if (hist) v = *(const GAS f32x2*)(hist + (size_t)(tt + KW - 1) * DC + c0);
#pragma unroll
            for (int j = 0; j < 8; ++j) { const int k = r - j; if (k >= 0 && k < KW) acc[j] += w[k] * v; }
        }
        float st[16];
#pragma unroll
        for (int j = 0; j < 8; ++j) { st[j] = acc[j].x + acc[j].y; st[8 + j] = acc[j].x * acc[j].x + acc[j].y * acc[j].y; }
#pragma unroll
        for (int j = 0; j < 16; ++j) st[j] = wave_sum(st[j]);
        __syncthreads();
        if (lane == 0) {
#pragma unroll
            for (int j = 0; j < 16; ++j) red[wave * 16 + j] = st[j]; }
        __syncthreads();
        if (tid < 16) { float s = 0.f;
#pragma unroll
            for (int wv = 0; wv < 8; ++wv) s += red[wv * 16 + tid];
            tot[tid] = s; }
        __syncthreads();
        float q[8];
#pragma unroll
        for (int j = 0; j < 8; ++j) { const float mu = tot[j] * (1.0f / DC), var = tot[8 + j] * (1.0f / DC) - mu * mu, rs = 1.0f / sqrtf(var + 1e-6f);
            f32x2 y = (acc[j] - mu) * rs * lg + lb; y.x = y.x * fsigm(y.x); y.y = y.y * fsigm(y.y); acc[j] = y; q[j] = y.x * y.x + y.y * y.y; }
#pragma unroll
        for (int j = 0; j < 8; ++j) q[j] = wave_sum(q[j]);
        __syncthreads();
        if (lane == 0) {
#pragma unroll
            for (int j = 0; j < 8; ++j) red[wave * 16 + j] = q[j]; }
        __syncthreads();
        if (tid < 8) { float s = 0.f;
#pragma unroll
            for (int wv = 0; wv < 8; ++wv) s += red[wv * 16 + tid];
            tot[tid] = s; }
        __syncthreads();
#pragma unroll
        for (int j = 0; j < 8; ++j) { const float r2 = 1.0f / sqrtf(tot[j] * (1.0f / DC) + 1e-6f);
            *(GAS unsigned*)(a.MIX + (size_t)(rowbase + t0 + j) * D + c0) = pk2(acc[j].x * r2, acc[j].y * r2); }
    }
    __syncthreads();
}

__device__ __forceinline__ void p2_newconv(const P2Args& a, int vcu, int G, int tid) {
    constexpr int NPV = BATCH * (KW - 1) * (DC / 4), NSV = DB * (KW - 1) * (DC / 4);
    for (int idx = vcu * (NWAVES * 64) + tid; idx < NPV + NSV; idx += G * NWAVES * 64) {
        if (idx < NPV) { const int c4 = idx & 255, j = (idx >> 8) % (KW - 1), b = idx / ((KW - 1) * 256);
            const v2u pk = *(const GAS v2u*)(a.UC + (size_t)(b * SEQ + SEQ - (KW - 1) + j) * DC + 4 * c4);
            const f32x4 v = {bf_lo(pk.x), bf_hi(pk.x), bf_lo(pk.y), bf_hi(pk.y)};
            *(GAS f32x4*)(a.ncp + (size_t)idx * 4) = v; }
        else { const int k = idx - NPV; const int c4 = k & 255, j = (k >> 8) % (KW - 1), b = k / ((KW - 1) * 256); const int id = j + DSQ; f32x4 v;
            if (id < KW - 1) v = *(const GAS f32x4*)(a.state_conv + ((size_t)b * (KW - 1) + id) * DC + 4 * c4);
            else { const v2u pk = *(const GAS v2u*)(a.UC + (size_t)(MP + b * DSQ + id - (KW - 1)) * DC + 4 * c4); v = (f32x4){bf_lo(pk.x), bf_hi(pk.x), bf_lo(pk.y), bf_hi(pk.y)}; }
            *(GAS f32x4*)(a.ncs + (size_t)k * 4) = v; }
    }
}

#define SSM_STEP(i) do { \
        const float nAr = __builtin_fmaf(aAr, hAr, __builtin_fmaf(-aAi, hAi, d00[i])), nAi = __builtin_fmaf(aAr, hAi, __builtin_fmaf(aAi, hAr, d01[i])); \
        const float nBr = __builtin_fmaf(aBr, hBr, __builtin_fmaf(-aBi, hBi, d10[i])), nBi = __builtin_fmaf(aBr, hBi, __builtin_fmaf(aBi, hBr, d11[i])); \
        hAr = nAr; hAi = nAi; hBr = nBr; hBi = nBi; } while (0)
#define SSM_MFMA(afrag) do { const f32x16 z16 = {0.f,0.f,0.f,0.f,0.f,0.f,0.f,0.f,0.f,0.f,0.f,0.f,0.f,0.f,0.f,0.f}; \
        d00 = __builtin_amdgcn_mfma_f32_32x32x16_bf16(afrag, bfr[0][0], z16, 0, 0, 0); d01 = __builtin_amdgcn_mfma_f32_32x32x16_bf16(afrag, bfr[0][1], z16, 0, 0, 0); \
        d10 = __builtin_amdgcn_mfma_f32_32x32x16_bf16(afrag, bfr[1][0], z16, 0, 0, 0); d11 = __builtin_amdgcn_mfma_f32_32x32x16_bf16(afrag, bfr[1][1], z16, 0, 0, 0); } while (0)
#define SSM_EMIT(rowb0, rowb1) do { \
        LDS_WAIT(); __builtin_amdgcn_wave_barrier(); \
        _Pragma("unroll") for (int s_ = 0; s_ < 2; ++s_) { \
            f32x4 y_ = {0.f, 0.f, 0.f, 0.f}; \
            _Pragma("unroll") for (int ks = 0; ks < 4; ++ks) { const bf16x8 hf = *(const LAS bf16x8*)(tile + s_ * P2_TILE_B + (lane & 15) * P2_TROW + ks * 64 + (lane >> 4) * 16); \
                y_ = __builtin_amdgcn_mfma_f32_16x16x32_bf16(hf, cfr[ks], y_, 0, 0, 0); } \
            const int rb_ = s_ ? (rowb1) : (rowb0); \
            _Pragma("unroll") for (int i_ = 0; i_ < 4; ++i_) { const size_t o_ = (size_t)(rb_ + 4 * (lane >> 4) + i_) * DS + g * CH + (lane & 15); \
                const float u_ = __builtin_bit_cast(float, (unsigned)a.SI[o_] << 16); \
                a.G[o_] = (bf16)f2bf(gelu_tanh_f(y_[i_] + dsk * u_)); } } \
        LDS_WAIT(); __builtin_amdgcn_wave_barrier(); } while (0)
#define SSM_TILE_ROW(i) do { v2u hw_; hw_.x = pk2(hAr, hAi); hw_.y = pk2(hBr, hBi); *(LAS v2u*)(mytile + (i) * P2_TROW) = hw_; } while (0)

__device__ __forceinline__ void p2_ssm(const P2Args& a, LAS unsigned char* lds, int vcu, int G, int wave, int lane, int tid) {
    const int col = lane & 31, half = lane >> 5;
    const int r = lane & 31, s_r = (r >> 2) & 1, i_r = (r & 3) + 4 * (r >> 3), kc = lane >> 5;
    LAS unsigned char* tile = lds + P2_TILE_OFF + wave * 2 * P2_TILE_B;
    LAS unsigned char* mytile = tile + half * P2_TILE_B + col * 8;
    LAS f32x4* SX = (LAS f32x4*)(lds + P2_SX_OFF);
    for (int it = vcu; it < BATCH * NG; it += G) {
        const int g = it & (NG - 1), pb = it >> 6;
        const float* AB = (const float*)(a.tab + TAB_AB) + (size_t)(g * NP + 2 * col) * 2;
        const f32x4 ab4 = *(const GAS f32x4*)AB;
        const float aAr = ab4.x, aAi = ab4.y, aBr = ab4.z, aBi = ab4.w;
        bf16x8 bfr[2][2], cfr[4];
#pragma unroll
        for (int pair = 0; pair < 2; ++pair)
#pragma unroll
            for (int ri = 0; ri < 2; ++ri) bfr[pair][ri] = *(const GAS bf16x8*)((const bf16*)(a.tab + TAB_BBT) + ((size_t)(g * 2 + ri) * NP + 2 * col + pair) * CH + 8 * kc);
#pragma unroll
        for (int ks = 0; ks < 4; ++ks) cfr[ks] = *(const GAS bf16x8*)((const bf16*)(a.tab + TAB_CQ) + ((size_t)g * CH + (lane & 15)) * 128 + 32 * ks + 8 * (lane >> 4));
        const float dsk = a.Dk[g * CH + (lane & 15)];
        f32x16 d00, d01, d10, d11;
        {
            const bf16* abase = a.SI + (size_t)(pb * SEQ + (2 * wave + s_r) * 128 + i_r) * DS + g * CH + 8 * kc;
            float hAr = 0.f, hAi = 0.f, hBr = 0.f, hBi = 0.f;
            bf16x8 af = *(const GAS bf16x8*)abase;
#pragma unroll 1
            for (int blk = 0; blk < 8; ++blk) {
                const bf16x8 afn = *(const GAS bf16x8*)(abase + (size_t)((blk + 1) & 7) * 16 * DS);
                SSM_MFMA(af);
#pragma unroll
                for (int i = 0; i < 16; ++i) SSM_STEP(i);
                af = afn;
            }
            __syncthreads();
            SX[(2 * wave + half) * 32 + col] = (f32x4){hAr, hAi, hBr, hBi};
            __syncthreads();
            float pAr = aAr, pAi = aAi, pBr = aBr, pBi = aBi;
#pragma unroll
            for (int sq = 0; sq < 7; ++sq) { const float t0 = pAr * pAr - pAi * pAi, t1 = 2.0f * pAr * pAi, t2 = pBr * pBr - pBi * pBi, t3 = 2.0f * pBr * pBi; pAr = t0; pAi = t1; pBr = t2; pBi = t3; }
            hAr = 0.f; hAi = 0.f; hBr = 0.f; hBi = 0.f;
            const int mine = 2 * wave + half;
            for (int s2 = 0; s2 < mine; ++s2) { const f32x4 sv = SX[s2 * 32 + col];
                const float nAr = pAr * hAr - pAi * hAi + sv.x, nAi = pAr * hAi + pAi * hAr + sv.y, nBr = pBr * hBr - pBi * hBi + sv.z, nBi = pBr * hBi + pBi * hBr + sv.w;
                hAr = nAr; hAi = nAi; hBr = nBr; hBi = nBi; }
            af = *(const GAS bf16x8*)abase;
#pragma unroll 1
            for (int blk = 0; blk < 8; ++blk) {
                const bf16x8 afn = *(const GAS bf16x8*)(abase + (size_t)((blk + 1) & 7) * 16 * DS);
                SSM_MFMA(af);
#pragma unroll
                for (int i = 0; i < 16; ++i) { SSM_STEP(i); SSM_TILE_ROW(i); }
                const int rb = pb * SEQ + (2 * wave) * 128 + blk * 16;
                SSM_EMIT(rb, rb + 128);
                af = afn;
            }
            if (mine == 15) { const size_t o = ((size_t)pb * NG + g) * NP + 2 * col;
                *(GAS f32x2*)(a.nrp + o) = (f32x2){hAr, hBr}; *(GAS f32x2*)(a.nip + o) = (f32x2){hAi, hBi}; }
        }
        {
            const int bA_load = 32 * pb + 4 * wave + 2 * s_r, bA = 32 * pb + 4 * wave + 2 * half;
            const bf16x8 af = *(const GAS bf16x8*)(a.SI + (size_t)(MP + bA_load * DSQ + i_r) * DS + g * CH + 8 * kc);
            SSM_MFMA(af);
            size_t o = ((size_t)bA * NG + g) * NP + 2 * col;
            f32x2 t0 = *(const GAS f32x2*)(a.h0re + o), t1 = *(const GAS f32x2*)(a.h0im + o);
            float hAr = t0.x, hBr = t0.y, hAi = t1.x, hBi = t1.y;
#pragma unroll
            for (int i = 0; i < 8; ++i) { SSM_STEP(i); SSM_TILE_ROW(i); }
            *(GAS f32x2*)(a.nrs + o) = (f32x2){hAr, hBr}; *(GAS f32x2*)(a.nis + o) = (f32x2){hAi, hBi};
            o += (size_t)NG * NP;
            t0 = *(const GAS f32x2*)(a.h0re + o); t1 = *(const GAS f32x2*)(a.h0im + o);
            hAr = t0.x; hBr = t0.y; hAi = t1.x; hBi = t1.y;
#pragma unroll
            for (int i = 8; i < 16; ++i) { SSM_STEP(i); SSM_TILE_ROW(i); }
            *(GAS f32x2*)(a.nrs + o) = (f32x2){hAr, hBr}; *(GAS f32x2*)(a.nis + o) = (f32x2){hAi, hBi};
            const int rb = MP + (32 * pb + 4 * wave) * DSQ;
            SSM_EMIT(rb, rb + 16);
        }
    }
    __syncthreads();
}

struct Args { const float* in[28]; float* out; unsigned char* ws; int ph_lo, ph_hi, li, pad; };
__global__ void __launch_bounds__(NWAVES * 64, 2) mk_fwd(Args args) {
    __shared__ __attribute__((aligned(16))) unsigned char lds_raw[LDS_BYTES];
    LAS unsigned char* lds = (LAS unsigned char*)lds_raw;
    volatile LAS unsigned* MISC = (volatile LAS unsigned*)(lds + MISC_OFF);
    const int tid = threadIdx.x, lane = tid & 63, wave = __builtin_amdgcn_readfirstlane(tid >> 6);
    const int G = gridDim.x; const int bx = blockIdx.x; const int vcu = (G % 8 == 0) ? (bx % 8) * (G / 8) + bx / 8 : bx;
    unsigned char* ws = args.ws;
    gu32* ctl = (gu32*)(ws + WS_CTL);
    for (int u = tid; u < (LDS_BYTES - LDSCTL_OFF) / 4; u += NWAVES * 64) ((LAS unsigned*)(lds + LDSCTL_OFF))[u] = 0u;
    __syncthreads();
    XcdBarrier bar; bar.bar = (unsigned*)(ctl + CW_BAR); bar.x = 0; bar.st = nullptr;
    if (N_LAUNCHES != NPH) bar = xcd_barrier_post((unsigned*)(ctl + CW_BAR), MISC + 8);
#define GRID_BAR(seam) do { if (N_LAUNCHES == NPH) { if (tid == 0) __hip_atomic_store(ctl + CW_TMO, 0xBADBA0u | (unsigned)(seam), RLX_AGENT); } else { xcd_barrier(bar); } } while (0)
    const int lo = args.ph_lo, hi = args.ph_hi;
#define IN(k) (lo <= (k) && (k) < hi)
#define BOTH(k) (IN(k) && IN((k) + 1))
    float* out = args.out;
    float* Y = out;
    float* ncp = out + (size_t)M * D;
    float* nrp = ncp + (size_t)BATCH * (KW - 1) * DC;
    float* nip = nrp + (size_t)BATCH * NG * NP;
    float* ncs = nip + (size_t)BATCH * NG * NP;
    float* nrs = ncs + (size_t)DB * (KW - 1) * DC;
    float* nis = nrs + (size_t)DB * NG * NP;
    bf16 *WGU = (bf16*)(ws + WS_WGU), *WDN = (bf16*)(ws + WS_WDN), *XB = (bf16*)(ws + WS_XB), *WIN = (bf16*)(ws + WS_WIN), *WGL = (bf16*)(ws + WS_WGL), *WOUT = (bf16*)(ws + WS_WOUT);
    bf16 *UC = (bf16*)(ws + WS_U), *SI = (bf16*)(ws + WS_S), *GB = (bf16*)(ws + WS_G), *MIX = (bf16*)(ws + WS_MIX), *ACT = (bf16*)(ws + WS_ACT);
    float* ssq_s = (float*)(ws + WS_CTL) + CW_SSQ_S; float* ssq_h = (float*)(ws + WS_CTL) + CW_SSQ_H; float* ssq_o = (float*)(ws + WS_CTL) + CW_SSQ_O; float* rx = (float*)(ws + WS_CTL) + CW_RX;
    const int gw = vcu * NWAVES + wave, NGW = G * NWAVES;

    if (IN(0)) {
        P0Args a; a.xp = args.in[0]; a.xs = args.in[1]; a.norm_mix = args.in[5]; a.w_in = args.in[6]; a.w_glu = args.in[19]; a.gn_conv = args.in[20]; a.gn_ssm = args.in[21]; a.w_out = args.in[22];
        a.norm_ffn = args.in[23]; a.w_gate = args.in[24]; a.w_up = args.in[25]; a.w_down = args.in[26];
        a.A_re = args.in[11]; a.A_im = args.in[12]; a.log_dt = args.in[13]; a.B_re = args.in[14]; a.B_im = args.in[15]; a.C_re = args.in[16]; a.C_im = args.in[17];
        a.WIN = WIN; a.WGL = WGL; a.WOUT = WOUT; a.WGU = WGU; a.WDN = WDN; a.XB = XB; a.rx = rx; a.tab = ws + WS_TAB;
        p0_prologue(a, lds, vcu, G, wave, lane, tid);
        if (BOTH(0)) GRID_BAR(0);
    }
    if (IN(1)) {
        pg8::Gemm g{XB, WIN, M, DIN, D}; pg8::StaticOrder S; S.init(M, DIN, G, (int)blockIdx.x);
        pg8::EpiIn E{UC, SI, rx};
        pg8::gemm_phase<pg8::EpiIn, pg8::StaticOrder, true, true>(lds + RING_OFF, g, S, E);
        if (BOTH(1)) GRID_BAR(1);
    }
    if (IN(2)) {
        P2Args a; a.UC = UC; a.SI = SI; a.G = GB; a.MIX = MIX; a.state_conv = args.in[2]; a.h0re = args.in[3]; a.h0im = args.in[4];
        a.conv_w = args.in[7]; a.conv_b = args.in[8]; a.ln_g = args.in[9]; a.ln_b = args.in[10]; a.Dk = args.in[18]; a.tab = ws + WS_TAB;
        a.ncp = ncp; a.nrp = nrp; a.nip = nip; a.ncs = ncs; a.nrs = nrs; a.nis = nis;
        p2_ssm(a, lds, vcu, G, wave, lane, tid);
        p2_conv(a, lds, vcu, G, wave, lane, tid);
        p2_newconv(a, vcu, G, tid);
        if (BOTH(2)) GRID_BAR(2);
    }
    if (IN(3)) {
        pg8::Gemm g{GB, WGL, M, DS, DS}; pg8::StaticOrder S; S.init(M, DS, G, (int)blockIdx.x);
        pg8::EpiGlu E{GB, MIX, ssq_s};
        pg8::gemm_phase<pg8::EpiGlu, pg8::StaticOrder, true, true>(lds + RING_OFF, g, S, E);
        if (BOTH(3)) GRID_BAR(3);
    }
    if (IN(4)) {
        for (int row = gw; row < M; row += NGW) {
            const float r = 1.0f / sqrtf(__hip_atomic_load(ssq_s + row, RLX_AGENT) * (1.0f / DS) + 1e-6f);
            GAS v4u* p = (GAS v4u*)(MIX + (size_t)row * D + DC) + 2 * lane;
#pragma unroll
            for (int j = 0; j < 2; ++j) { v4u w = p[j]; w.x = pk2(bf_lo(w.x) * r, bf_hi(w.x) * r); w.y = pk2(bf_lo(w.y) * r, bf_hi(w.y) * r); w.z = pk2(bf_lo(w.z) * r, bf_hi(w.z) * r); w.w = pk2(bf_lo(w.w) * r, bf_hi(w.w) * r); p[j] = w; }
        }
        if (BOTH(4)) GRID_BAR(4);
    }
    if (IN(5)) {
        pg8::Gemm g{MIX, WOUT, M, D, D}; pg8::StaticOrder S; S.init(M, D, G, (int)blockIdx.x);
        pg8::EpiOut E{args.in[0], args.in[1], Y, XB, ssq_h};
        pg8::gemm_phase<pg8::EpiOut, pg8::StaticOrder, true, true>(lds + RING_OFF, g, S, E);
        if (BOTH(5)) GRID_BAR(5);
    }
    if (IN(6)) {
        pg8::Gemm g{XB, WGU, M, 2 * DFF, D}; pg8::StaticOrder S; S.init(M, 2 * DFF, G, (int)blockIdx.x);
        pg8::EpiUp E{ACT, ssq_h};
        pg8::gemm_phase<pg8::EpiUp, pg8::StaticOrder, true, true>(lds + RING_OFF, g, S, E);
        if (BOTH(6)) GRID_BAR(6);
    }
    if (IN(7)) {
        pg8::Gemm g{ACT, WDN, M, D, DFF}; pg8::StaticOrder S; S.init(M, D, G, (int)blockIdx.x);
        pg8::EpiDown E{Y, ssq_o};
        pg8::gemm_phase<pg8::EpiDown, pg8::StaticOrder, true, true>(lds + RING_OFF, g, S, E);
        if (BOTH(7)) GRID_BAR(7);
    }
    if (IN(8)) {
        const float* gfin = args.in[27];
        for (int row = gw; row < M; row += NGW) {
            const float r = 1.0f / sqrtf(__hip_atomic_load(ssq_o + row, RLX_AGENT) * (1.0f / D) + 1e-6f);
            GAS f32x4* p = (GAS f32x4*)(Y + (size_t)row * D) + lane; const GAS f32x4* gp = (const GAS f32x4*)gfin + lane;
#pragma unroll
            for (int j = 0; j < 8; ++j) p[64 * j] = p[64 * j] * r * gp[64 * j];
        }
    }
#undef IN
#undef BOTH
#undef GRID_BAR
}

extern "C" void kernel_launch(void* const* d_in, const int* in_sizes, int n_in, void* d_out, int out_size, void* d_ws, size_t ws_size, hipStream_t stream) {
    static int grid = 0;
    if (grid == 0) {
        const long want_out = (long)M * D + (long)(BATCH + DB) * ((KW - 1) * DC + 2 * NG * NP);
        if (n_in != 28 || in_sizes[0] != MP * D || (long)out_size != want_out || ws_size < WS_END) {
            fprintf(stderr, "kernel_launch: unexpected shapes (n_in %d, in0 %d, out %d (want %ld), ws %zu (need %zu)); nothing launched\n", n_in, n_in > 0 ? in_sizes[0] : -1, out_size, want_out, ws_size, (size_t)WS_END); grid = -1; return; }
        int dev = 0, cus = 0;
        if (hipGetDevice(&dev) != hipSuccess || hipDeviceGetAttribute(&cus, hipDeviceAttributeMultiprocessorCount, dev) != hipSuccess) { fprintf(stderr, "kernel_launch: device query failed\n"); grid = -1; return; }
        grid = cus;
    }
    if (grid < 0) return;
    if (hipMemsetAsync((char*)d_ws + WS_CTL, 0, CTL_ZERO_BYTES, stream) != hipSuccess) { fprintf(stderr, "kernel_launch: memset failed\n"); return; }
    Args a{};
    for (int i = 0; i < 28; ++i) a.in[i] = (const float*)d_in[i];
    a.out = (float*)d_out; a.ws = (unsigned char*)d_ws;
    for (int li = 0; li < N_LAUNCHES; ++li) {
        if (N_LAUNCHES == NPH) { a.ph_lo = li; a.ph_hi = li + 1; } else { a.ph_lo = 0; a.ph_hi = NPH; }
        a.li = li;
        hipLaunchKernelGGL(mk_fwd, dim3(grid), dim3(NWAVES * 64), 0, stream, a);
        const hipError_t le = hipPeekAtLastError();
        if (le != hipSuccess) { fprintf(stderr, "kernel_launch: launch %d failed: %s\n", li, hipGetErrorName(le)); break; }
    }
}
```

```cpp
#include <hip/hip_runtime.h>
#include <cstdio>
#include <cstdint>
#define MK_N_LAUNCHES 1
namespace pg8 {
#define PG8_LAS __attribute__((address_space(3)))
typedef unsigned short bf16_t;
typedef short bf16x8 __attribute__((ext_vector_type(8)));
typedef float f32x4 __attribute__((ext_vector_type(4)));
typedef unsigned u32x4 __attribute__((ext_vector_type(4)));
constexpr int BM = 256, BK = 64, HALF = 128, HTB = HALF * BK * 2  , STAGE_BYTES = 8 * HTB, NXCD = 8, WGM = 8;

__host__ __device__ __forceinline__ int lds_byte(int r, int c) { const int st = (r >> 4) * 2 + (c >> 5), rr = r & 15, cc = c & 31, ob = rr * 64 + cc * 2; return st * 1024 + (ob ^ (((ob >> 9) & 1) << 5)); }
__host__ __device__ __forceinline__ void stage_rc(int b, int& R, int& C) { const int st = b / 1024, sb = b % 1024, swz = sb ^ (((sb >> 9) & 1) << 5); R = (st >> 1) * 16 + swz / 64; C = (st & 1) * 32 + (swz % 64) / 2; }
__host__ __device__ __forceinline__ int perm32(int rho) { const int n = rho >> 4, i = rho & 15; return 8 * (i >> 2) + 4 * n + (i & 3); }

struct Unit { int pm, pn; };
struct Gemm { const bf16_t* A; const bf16_t* Bt; int M, N, K; };

struct StaticOrder {
    int nM, nN, nwg, G, c;
    __host__ __device__ void init(int M, int N, int G_, int c_) { nM = M / BM; nN = N / BM; nwg = nM * nN; G = G_; c = c_; }
    __host__ __device__ bool next(int i, Unit& u) const {
        const long L = (long)i * G + c; if (L >= nwg) return false;
        int wgid = (int)L; { const int q = nwg / NXCD, r = nwg % NXCD, xcd = wgid % NXCD, off = wgid / NXCD; wgid = (xcd < r ? xcd * (q + 1) : r * (q + 1) + (xcd - r) * q) + off; }
        const int nig = WGM * nN, gid = wgid / nig, fm = gid * WGM, gsz = (nM - fm) < WGM ? (nM - fm) : WGM;
        u.pm = fm + ((wgid % nig) % gsz); u.pn = (wgid % nig) / gsz; return true;
    }
    __device__ __forceinline__ void a_ready(const Unit&) const {}
    __device__ __forceinline__ void done(const Unit&) const {}
};

__device__ __forceinline__ unsigned cvt_pk_bf16(float lo, float hi) { unsigned r; asm volatile("v_cvt_pk_bf16_f32 %0, %1, %2" : "=v"(r) : "v"(lo), "v"(hi)); return r; }
template <class Epi, class Sched, bool ALIGN_EPI = false, bool SP2 = false>
__device__ __forceinline__ void gemm_phase(PG8_LAS unsigned char* lds, const Gemm g, const Sched& S, const Epi& E) {
    const int tid = threadIdx.x, wid = __builtin_amdgcn_readfirstlane(tid >> 6), lane = tid & 63, wr = wid >> 2, wc = wid & 3, fr = lane & 15, fq = lane >> 4;
    const int K = g.K, nt = K / BK;
    unsigned voffA[2], voffB[2];
#pragma unroll
    for (int i = 0; i < 2; ++i) { int R, C; stage_rc(tid * 16 + i * 8192, R, C); const int Rb = Epi::PERM ? ((R & ~31) + perm32(R & 31)) : R;
        voffA[i] = (unsigned)(R * K + C) * 2u; voffB[i] = (unsigned)(Rb * K + C) * 2u; }
    const size_t kstep = (size_t)(BK * 2);
    const size_t hstep = (size_t)HALF * K * 2;
    const size_t tstep = 2 * hstep;
    const unsigned ldsw = (unsigned)wid * 1024u;
    const int aoff = lds_byte(wr * 64 + fr, fq * 8), boff = lds_byte(wc * 32 + fr, fq * 8);
#define PG8_SA(b, h) (((b) * 2 + (h)) * HTB)
#define PG8_SB(b, h) ((4 + (b) * 2 + (h)) * HTB)
#define PG8_STAGE(bufoff, gbase, voff) do { _Pragma("unroll") for (int _i = 0; _i < 2; ++_i) \
        __builtin_amdgcn_global_load_lds((const unsigned*)((const char*)(gbase) + (voff)[_i]), (PG8_LAS unsigned*)(lds + (bufoff) + ldsw + _i * 8192), 16, 0, 0); } while (0)
#define PG8_LDA(dst, b, h) do { _Pragma("unroll") for (int m = 0; m < 4; ++m) _Pragma("unroll") for (int k = 0; k < 2; ++k) dst[m][k] = *(const PG8_LAS bf16x8*)(lds + PG8_SA(b, h) + aoff + m * 2048 + k * 1024); } while (0)
#define PG8_LDB(dst, b, h) do { _Pragma("unroll") for (int n = 0; n < 2; ++n) _Pragma("unroll") for (int k = 0; k < 2; ++k) dst[n][k] = *(const PG8_LAS bf16x8*)(lds + PG8_SB(b, h) + boff + n * 2048 + k * 1024); } while (0)
#define PG8_MMA(ai, bj, At, Bt) do { __builtin_amdgcn_s_setprio(1); _Pragma("unroll") for (int m = 0; m < 4; ++m) _Pragma("unroll") for (int n = 0; n < 2; ++n) _Pragma("unroll") for (int k = 0; k < 2; ++k) \
        acc[ai][bj][m][n] = __builtin_amdgcn_mfma_f32_16x16x32_bf16(Bt[n][k], At[m][k], acc[ai][bj][m][n], 0, 0, 0); __builtin_amdgcn_s_setprio(0); } while (0)
#define PG8_WAIT_V(n) asm volatile("s_waitcnt vmcnt(" #n ")" ::: "memory")
#define PG8_WAIT_L(n) asm volatile("s_waitcnt lgkmcnt(" #n ")" ::: "memory")
#define PG8_BAR __builtin_amdgcn_s_barrier()
#define PG8_SCHED __builtin_amdgcn_sched_barrier(0)
    Unit cur, nxt; int ui = 0;
    if (!S.next(0, cur)) return;
    f32x4 acc[2][2][4][2];
#pragma unroll
    for (int a = 0; a < 2; ++a)
#pragma unroll
        for (int b = 0; b < 2; ++b)
#pragma unroll
            for (int m = 0; m < 4; ++m)
#pragma unroll
                for (int n = 0; n < 2; ++n) acc[a][b][m][n] = (f32x4){0.f, 0.f, 0.f, 0.f};
    bf16x8 At[4][2], B0[2][2], B1[2][2];
    const char* cA = (const char*)g.A + (size_t)cur.pm * tstep; const char* cB = (const char*)g.Bt + (size_t)cur.pn * tstep;
    S.a_ready(cur);
    if constexpr (SP2) {
        PG8_STAGE(PG8_SB(0, 0), cB, voffB); PG8_STAGE(PG8_SB(0, 1), cB + hstep, voffB); PG8_STAGE(PG8_SA(0, 0), cA, voffA); PG8_STAGE(PG8_SA(0, 1), cA + hstep, voffA);
        if (wr == 1) PG8_BAR;
        PG8_WAIT_V(2); PG8_BAR;
        PG8_STAGE(PG8_SB(1, 0), cB + kstep, voffB); PG8_STAGE(PG8_SA(1, 0), cA + kstep, voffA); PG8_STAGE(PG8_SB(1, 1), cB + hstep + kstep, voffB);
        PG8_WAIT_V(6); PG8_BAR;
    } else {
        PG8_STAGE(PG8_SB(0, 0), cB, voffB); PG8_STAGE(PG8_SA(0, 0), cA, voffA); PG8_STAGE(PG8_SB(0, 1), cB + hstep, voffB); PG8_STAGE(PG8_SA(0, 1), cA + hstep, voffA);
        if (wr == 1) PG8_BAR;
        PG8_WAIT_V(4); PG8_BAR;
        PG8_STAGE(PG8_SB(1, 0), cB + kstep, voffB); PG8_STAGE(PG8_SA(1, 0), cA + kstep, voffA); PG8_STAGE(PG8_SB(1, 1), cB + hstep + kstep, voffB);
        PG8_WAIT_V(6); PG8_BAR;
    }
    for (;;) {
        const bool has_next = S.next(ui + 1, nxt);
        const char* nA = has_next ? (const char*)g.A + (size_t)nxt.pm * tstep : cA; const char* nB = has_next ? (const char*)g.Bt + (size_t)nxt.pn * tstep : cB;
        for (int t = 0; t < nt; t += 2) {
            const bool last = (t == nt - 2);
            const char* a1 = cA + (size_t)(t + 1) * kstep;
            const char* a2 = last ? nA : cA + (size_t)(t + 2) * kstep; const char* b2 = last ? nB : cB + (size_t)(t + 2) * kstep;
            const char* a3 = a2 + kstep; const char* b3 = b2 + kstep;
            if (last && has_next) S.a_ready(nxt);
            if constexpr (SP2) {
            PG8_LDB(B0, 0, 0); PG8_LDB(B1, 0, 1); PG8_SCHED; PG8_LDA(At, 0, 0); PG8_STAGE(PG8_SA(1, 1), a1 + hstep, voffA);
            PG8_WAIT_V(8); PG8_WAIT_L(0); PG8_BAR; PG8_MMA(0, 0, At, B0); PG8_MMA(0, 1, At, B1); PG8_BAR; PG8_SCHED;
            PG8_LDA(At, 0, 1); PG8_STAGE(PG8_SB(0, 0), b2, voffB); PG8_STAGE(PG8_SB(0, 1), b2 + hstep, voffB); PG8_STAGE(PG8_SA(0, 0), a2, voffA);
            PG8_WAIT_V(8); PG8_WAIT_L(0); PG8_BAR; PG8_MMA(1, 0, At, B0); PG8_MMA(1, 1, At, B1); PG8_BAR; PG8_SCHED;
            PG8_LDB(B0, 1, 0); PG8_LDB(B1, 1, 1); PG8_SCHED; PG8_LDA(At, 1, 0); PG8_STAGE(PG8_SA(0, 1), a2 + hstep, voffA);
            PG8_WAIT_V(8); PG8_WAIT_L(0); PG8_BAR; PG8_MMA(0, 0, At, B0); PG8_MMA(0, 1, At, B1); PG8_BAR; PG8_SCHED;
            PG8_LDA(At, 1, 1); PG8_STAGE(PG8_SB(1, 0), b3, voffB); PG8_STAGE(PG8_SB(1, 1), b3 + hstep, voffB); PG8_STAGE(PG8_SA(1, 0), a3, voffA);
            PG8_WAIT_V(8); PG8_WAIT_L(0); PG8_BAR; PG8_MMA(1, 0, At, B0); PG8_MMA(1, 1, At, B1); PG8_BAR; PG8_SCHED;
            } else {
            PG8_LDB(B0, 0, 0); PG8_SCHED; PG8_LDA(At, 0, 0); PG8_STAGE(PG8_SA(1, 1), a1 + hstep, voffA);
            PG8_WAIT_L(8); PG8_BAR; PG8_WAIT_L(0); PG8_MMA(0, 0, At, B0); PG8_BAR; PG8_SCHED;
            PG8_LDB(B1, 0, 1); PG8_STAGE(PG8_SB(0, 0), b2, voffB);
            PG8_BAR; PG8_WAIT_L(0); PG8_MMA(0, 1, At, B1); PG8_BAR;
            PG8_LDA(At, 0, 1); PG8_STAGE(PG8_SA(0, 0), a2, voffA);
            PG8_BAR; PG8_WAIT_L(0); PG8_MMA(1, 0, At, B0); PG8_BAR; PG8_SCHED;
            PG8_STAGE(PG8_SB(0, 1), b2 + hstep, voffB);
            PG8_WAIT_V(6); PG8_BAR; PG8_MMA(1, 1, At, B1); PG8_BAR;
            PG8_LDB(B0, 1, 0); PG8_SCHED; PG8_LDA(At, 1, 0); PG8_STAGE(PG8_SA(0, 1), a2 + hstep, voffA);
            PG8_WAIT_L(8); PG8_BAR; PG8_WAIT_L(0); PG8_MMA(0, 0, At, B0); PG8_BAR; PG8_SCHED;
            PG8_LDB(B1, 1, 1); PG8_STAGE(PG8_SB(1, 0), b3, voffB);
            PG8_BAR; PG8_WAIT_L(0); PG8_MMA(0, 1, At, B1); PG8_BAR;
            PG8_LDA(At, 1, 1); PG8_STAGE(PG8_SA(1, 0), a3, voffA);
            PG8_BAR; PG8_WAIT_L(0); PG8_MMA(1, 0, At, B0); PG8_BAR; PG8_SCHED;
            PG8_STAGE(PG8_SB(1, 1), b3 + hstep, voffB);
            PG8_WAIT_V(6); PG8_BAR; PG8_MMA(1, 1, At, B1); PG8_BAR;
            }
        }
        if constexpr (ALIGN_EPI) { if (wr == 0) PG8_BAR; }
        if constexpr (!Epi::AFTER_DRAIN) { E(acc, cur, wr, wc, fr, fq); S.done(cur); }
        if (!has_next) break;
#pragma unroll
        for (int a = 0; a < 2; ++a)
#pragma unroll
            for (int b = 0; b < 2; ++b)
#pragma unroll
                for (int m = 0; m < 4; ++m)
#pragma unroll
                    for (int n = 0; n < 2; ++n) acc[a][b][m][n] = (f32x4){0.f, 0.f, 0.f, 0.f};
        cur = nxt; cA = nA; cB = nB; ++ui;
        if constexpr (ALIGN_EPI) { if (wr == 1) PG8_BAR; }
    }
    PG8_WAIT_V(0);
    if constexpr (!ALIGN_EPI) { if (wr == 0) PG8_BAR; }
    PG8_BAR;
    if constexpr (Epi::AFTER_DRAIN) { E.fused(acc, cur, wr, wc, fr, fq, lds, wid, lane); S.done(cur); }
#undef PG8_SA
#undef PG8_SB
#undef PG8_STAGE
#undef PG8_LDA
#undef PG8_LDB
#undef PG8_MMA
#undef PG8_WAIT_V
#undef PG8_WAIT_L
#undef PG8_BAR
#undef PG8_SCHED
}
}

namespace pg8 {
constexpr float RMS_EPS = 1e-6f;
__device__ __forceinline__ float fsig(float x) { return __builtin_amdgcn_rcpf(1.0f + __builtin_amdgcn_exp2f(x * -1.4426950408889634f)); }
__device__ __forceinline__ float bflo(unsigned w) { return __builtin_bit_cast(float, w << 16); }
__device__ __forceinline__ float bfhi(unsigned w) { return __builtin_bit_cast(float, w & 0xffff0000u); }
__device__ __forceinline__ u32x4 pack8(const f32x4& a, const f32x4& b) { u32x4 w; w.x = cvt_pk_bf16(a[0], a[1]); w.y = cvt_pk_bf16(a[2], a[3]); w.z = cvt_pk_bf16(b[0], b[1]); w.w = cvt_pk_bf16(b[2], b[3]); return w; }
__device__ __forceinline__ float sq4(const f32x4& a) { return (a[0] * a[0] + a[1] * a[1]) + (a[2] * a[2] + a[3] * a[3]); }
__device__ __forceinline__ void row_atomic(float* p, float q, int fq) { q += __shfl_xor(q, 16); q += __shfl_xor(q, 32); if (fq == 0) (void)__hip_atomic_fetch_add(p, q, __ATOMIC_RELAXED, __HIP_MEMORY_SCOPE_AGENT); }

struct EpiIn {
    static constexpr bool PERM = true, AFTER_DRAIN = false;
    bf16_t* U; bf16_t* S; const float* rx;
    __device__ __forceinline__ void operator()(const f32x4 (&acc)[2][2][4][2], const Unit& u, int wr, int wc, int fr, int fq) const {
        const int row0 = u.pm * BM + wr * 64 + fr;
        if (u.pn < 8) {
            const int col0 = u.pn * 128 + wc * 32 + 8 * fq;
#pragma unroll
            for (int ai = 0; ai < 2; ++ai)
#pragma unroll
                for (int m = 0; m < 4; ++m) { const int row = row0 + ai * HALF + m * 16; const float r = rx[row];
                    f32x4 v0, v1;
#pragma unroll
                    for (int j = 0; j < 4; ++j) { v0[j] = (acc[ai][0][m][0][j] * r) * fsig(acc[ai][1][m][0][j] * r); v1[j] = (acc[ai][0][m][1][j] * r) * fsig(acc[ai][1][m][1][j] * r); }
                    *(u32x4*)(U + (size_t)row * 1024 + col0) = pack8(v0, v1); }
        } else {
            const int col0 = (u.pn - 8) * 256 + wc * 32 + 8 * fq;
#pragma unroll
            for (int ai = 0; ai < 2; ++ai)
#pragma unroll
                for (int m = 0; m < 4; ++m) { const int row = row0 + ai * HALF + m * 16; const float r = rx[row];
#pragma unroll
                    for (int bj = 0; bj < 2; ++bj) *(u32x4*)(S + (size_t)row * 1024 + col0 + bj * HALF) = pack8(acc[ai][bj][m][0] * r, acc[ai][bj][m][1] * r); }
        }
    }
};
struct EpiGlu {
    static constexpr bool PERM = true, AFTER_DRAIN = false;
    const bf16_t* G; bf16_t* MIX; float* ssq;
    __device__ __forceinline__ void operator()(const f32x4 (&acc)[2][2][4][2], const Unit& u, int wr, int wc, int fr, int fq) const {
        const int row0 = u.pm * BM + wr * 64 + fr, col0 = u.pn * BM + wc * 32 + 8 * fq;
#pragma unroll
        for (int ai = 0; ai < 2; ++ai)
#pragma unroll
            for (int m = 0; m < 4; ++m) { const int row = row0 + ai * HALF + m * 16; float q = 0.f;
#pragma unroll
                for (int bj = 0; bj < 2; ++bj) { const u32x4 gw = *(const u32x4*)(G + (size_t)row * 1024 + col0 + bj * HALF);
                    f32x4 g0 = {bflo(gw.x), bfhi(gw.x), bflo(gw.y), bfhi(gw.y)}, g1 = {bflo(gw.z), bfhi(gw.z), bflo(gw.w), bfhi(gw.w)}, y0, y1;
#pragma unroll
                    for (int j = 0; j < 4; ++j) { y0[j] = g0[j] * fsig(acc[ai][bj][m][0][j]); y1[j] = g1[j] * fsig(acc[ai][bj][m][1][j]); }
                    q += sq4(y0) + sq4(y1);
                    *(u32x4*)(MIX + (size_t)row * 2048 + 1024 + col0 + bj * HALF) = pack8(y0, y1); }
                row_atomic(ssq + row, q, fq); }
    }
};
struct EpiOut {
    static constexpr bool PERM = true, AFTER_DRAIN = false;
    const float* xp; const float* xs; float* H; bf16_t* HB; float* ssq;
    __device__ __forceinline__ void operator()(const f32x4 (&acc)[2][2][4][2], const Unit& u, int wr, int wc, int fr, int fq) const {
        const int row0 = u.pm * BM + wr * 64 + fr, col0 = u.pn * BM + wc * 32 + 8 * fq;
        const float* xb = (u.pm < 32) ? xp : xs - (size_t)8192 * 2048;
#pragma unroll
        for (int ai = 0; ai < 2; ++ai)
#pragma unroll
            for (int m = 0; m < 4; ++m) { const int row = row0 + ai * HALF + m * 16; float q = 0.f;
#pragma unroll
                for (int bj = 0; bj < 2; ++bj) { const size_t off = (size_t)row * 2048 + col0 + bj * HALF;
                    const f32x4 h0 = *(const f32x4*)(xb + off) + acc[ai][bj][m][0], h1 = *(const f32x4*)(xb + off + 4) + acc[ai][bj][m][1];
                    q += sq4(h0) + sq4(h1);
                    *(f32x4*)(H + off) = h0; *(f32x4*)(H + off + 4) = h1; *(u32x4*)(HB + off) = pack8(h0, h1); }
                row_atomic(ssq + row, q, fq); }
    }
};
struct EpiUp {
    static constexpr bool PERM = true, AFTER_DRAIN = false;
    bf16_t* ACT; const float* ssq;
    __device__ __forceinline__ void operator()(const f32x4 (&acc)[2][2][4][2], const Unit& u, int wr, int wc, int fr, int fq) const {
        const int row0 = u.pm * BM + wr * 64 + fr, col0 = u.pn * 128 + wc * 32 + 8 * fq;
#pragma unroll
        for (int ai = 0; ai < 2; ++ai)
#pragma unroll
            for (int m = 0; m < 4; ++m) { const int row = row0 + ai * HALF + m * 16; const float r = __builtin_amdgcn_rsqf(ssq[row] * (1.0f / 2048.0f) + RMS_EPS);
                f32x4 v0, v1;
#pragma unroll
                for (int j = 0; j < 4; ++j) { const float a0 = acc[ai][0][m][0][j] * r, a1 = acc[ai][0][m][1][j] * r;
                    v0[j] = a0 * fsig(a0) * (acc[ai][1][m][0][j] * r); v1[j] = a1 * fsig(a1) * (acc[ai][1][m][1][j] * r); }
                *(u32x4*)(ACT + (size_t)row * 5632 + col0) = pack8(v0, v1); }
    }
};
struct EpiDown {
    static constexpr bool PERM = true, AFTER_DRAIN = false;
    float* H; float* ssq;
    __device__ __forceinline__ void operator()(const f32x4 (&acc)[2][2][4][2], const Unit& u, int wr, int wc, int fr, int fq) const {
        const int row0 = u.pm * BM + wr * 64 + fr, col0 = u.pn * BM + wc * 32 + 8 * fq;
#pragma unroll
        for (int ai = 0; ai < 2; ++ai)
#pragma unroll
            for (int m = 0; m < 4; ++m) { const int row = row0 + ai * HALF + m * 16; float q = 0.f;
#pragma unroll
                for (int bj = 0; bj < 2; ++bj) { float* p = H + (size_t)row * 2048 + col0 + bj * HALF;
                    const f32x4 o0 = *(const f32x4*)p + acc[ai][bj][m][0], o1 = *(const f32x4*)(p + 4) + acc[ai][bj][m][1];
                    q += sq4(o0) + sq4(o1);
                    *(f32x4*)p = o0; *(f32x4*)(p + 4) = o1; }
                row_atomic(ssq + row, q, fq); }
    }
};
}

constexpr int NWAVES = 8;
#ifndef MK_N_LAUNCHES
#define MK_N_LAUNCHES 1
#endif
constexpr int NPH = 9;
constexpr int N_LAUNCHES = MK_N_LAUNCHES;

constexpr int D = 2048, DC = 1024, DS = 1024, DIN = 3072, DFF = 5632, NG = 64, NP = 64, CH = 16, KW = 31;
constexpr int BATCH = 4, SEQ = 2048, DB = 128, DSQ = 8;
constexpr int MP = BATCH * SEQ, MS = DB * DSQ, M = MP + MS;

constexpr size_t MiB = 1u << 20;
constexpr size_t WS_CTL = 0, CTL_ZERO_BYTES = 1 * MiB;
constexpr size_t WS_TAB = 1 * MiB;
constexpr size_t WS_WGU = 2 * MiB, WS_WDN = 46 * MiB, WS_XB = 68 * MiB;
constexpr size_t WS_WIN = 104 * MiB, WS_WGL = 116 * MiB, WS_WOUT = 118 * MiB;
constexpr size_t WS_U = 126 * MiB, WS_S = 144 * MiB, WS_G = 162 * MiB, WS_MIX = 180 * MiB;
constexpr size_t WS_ACT = 104 * MiB;
constexpr size_t WS_END = 216 * MiB;
static_assert(WS_WGU + (size_t)2 * DFF * D * 2 <= WS_WDN && WS_WDN + (size_t)D * DFF * 2 <= WS_XB && WS_XB + (size_t)M * D * 2 <= WS_WIN, "ws map 1");
static_assert(WS_WIN + (size_t)DIN * D * 2 <= WS_WGL && WS_WGL + (size_t)DS * DS * 2 <= WS_WOUT && WS_WOUT + (size_t)D * D * 2 <= WS_U, "ws map 2");
static_assert(WS_U + (size_t)M * DC * 2 <= WS_S && WS_S + (size_t)M * DS * 2 <= WS_G && WS_G + (size_t)M * DS * 2 <= WS_MIX && WS_MIX + (size_t)M * D * 2 <= WS_END, "ws map 3");
static_assert(WS_ACT + (size_t)M * DFF * 2 <= WS_END, "ws map 4");
constexpr int CW_TMO = 0, CW_CODE = 1;
constexpr int CW_BAR = 4096;
constexpr int CW_SSQ_S = 16384, CW_SSQ_H = CW_SSQ_S + M, CW_SSQ_O = CW_SSQ_H + M;
constexpr int CW_RX = 65536;
static_assert((CW_RX + M) * 4 <= (int)CTL_ZERO_BYTES && CW_SSQ_O + M <= CW_RX, "ctl map");
constexpr size_t TAB_AB = 0;
constexpr size_t TAB_BBT = 64 * 1024;
constexpr size_t TAB_CQ = 512 * 1024;

constexpr int RING_OFF = 0, RING_BYTES = 131072;
constexpr int LDSCTL_OFF = RING_BYTES, MISC_OFF = LDSCTL_OFF + 320;
constexpr int LDS_BYTES = 147456;
static_assert(MISC_OFF + 128 <= LDS_BYTES, "LDS map");

#define GAS __attribute__((address_space(1)))
#define LAS __attribute__((address_space(3)))
typedef unsigned short bf16;
typedef unsigned v4u __attribute__((ext_vector_type(4)));
typedef unsigned v2u __attribute__((ext_vector_type(2)));
typedef float f32x4 __attribute__((ext_vector_type(4)));
typedef float f32x2 __attribute__((ext_vector_type(2)));
typedef float f32x16 __attribute__((ext_vector_type(16)));
typedef short bf16x8 __attribute__((ext_vector_type(8)));
typedef GAS unsigned gu32;
#define RLX_AGENT __ATOMIC_RELAXED, __HIP_MEMORY_SCOPE_AGENT
#define LDS_WAIT() asm volatile("s_waitcnt lgkmcnt(0)" ::: "memory")
#define VM_WAIT() asm volatile("s_waitcnt vmcnt(0)" ::: "memory")
__device__ __forceinline__ unsigned f2bf(float f) { unsigned u = __builtin_bit_cast(unsigned, f); return (u + 0x7fffu + ((u >> 16) & 1u)) >> 16; }
__device__ __forceinline__ unsigned pk2(float lo, float hi) { return f2bf(lo) | (f2bf(hi) << 16); }
__device__ __forceinline__ float bf_lo(unsigned w) { return __builtin_bit_cast(float, w << 16); }
__device__ __forceinline__ float bf_hi(unsigned w) { return __builtin_bit_cast(float, w & 0xffff0000u); }
__device__ __forceinline__ float wave_sum(float v) {
#pragma unroll
    for (int o = 1; o < 64; o <<= 1) v += __shfl_xor(v, o);
    return v;
}
__device__ __forceinline__ float fsigm(float x) { return __builtin_amdgcn_rcpf(1.0f + __builtin_amdgcn_exp2f(x * -1.4426950408889634f)); }
__device__ __forceinline__ float gelu_tanh_f(float x) {
    const float u2 = 1.5957691216057308f * (x + 0.044715f * x * x * x);
    return x * fsigm(u2);
}

#define XB_TMO      128
#define XB_XCNT(j)  (256  + 64 * (j))
#define XB_XSUB(j)  (1280 + 64 * (j))
#define XB_XGEN(j)  (2304 + 64 * (j))
#define XB_TOP      3328
#define XB_TOPGEN   3392
#define XCD_BAR_WORDS 3456
#define XB_SPIN_CAP (1u << 18)

__device__ __forceinline__ unsigned xb_ld(unsigned* p)              { return __hip_atomic_load(p, __ATOMIC_RELAXED, __HIP_MEMORY_SCOPE_AGENT); }
__device__ __forceinline__ unsigned xb_add(unsigned* p, unsigned v) { return __hip_atomic_fetch_add(p, v, __ATOMIC_RELAXED, __HIP_MEMORY_SCOPE_AGENT); }
__device__ __forceinline__ unsigned xb_xcc_id() { return (unsigned)__builtin_amdgcn_s_getreg((3 << 11) | 20) & 0xFu; }
#define XB_SPIN(cond, bar) do { unsigned _sp = 0; while (cond) { __builtin_amdgcn_s_sleep(1); \
    if ((++_sp & 255u) == 0u) { if (xb_ld(&(bar)[XB_TMO])) break; if (_sp > XB_SPIN_CAP) { atomicAdd(&(bar)[XB_TMO], 1u); break; } } } } while (0)

struct XcdBarrier {
    unsigned* bar; unsigned x;
    volatile LAS unsigned* st;
};

__device__ __forceinline__ XcdBarrier xcd_barrier_post(unsigned* bar, volatile LAS unsigned* st) {
    XcdBarrier b; b.bar = bar; b.x = xb_xcc_id(); b.st = st;
    if (threadIdx.x == 0) (void)xb_add(&bar[XB_XCNT(b.x)], 1u);
    return b;
}
__device__ __forceinline__ void xcd_barrier_complete(unsigned* bar, unsigned x, unsigned& nloc, unsigned& nx) {
    const unsigned G = gridDim.x * gridDim.y * gridDim.z;
    unsigned sum, cnt, mine, sp = 0u;
    for (;;) {
        sum = 0u; cnt = 0u; mine = 0u;
#pragma unroll
        for (unsigned j = 0; j < 16; ++j) { const unsigned c = xb_ld(&bar[XB_XCNT(j)]); sum += c; cnt += (c > 0u) ? 1u : 0u; mine = (j == x) ? c : mine; }
        if (sum == G) break;
        __builtin_amdgcn_s_sleep(1);
        if ((++sp & 255u) == 0u) { if (xb_ld(&bar[XB_TMO])) break; if (sp > XB_SPIN_CAP) { atomicAdd(&bar[XB_TMO], 1u); break; } }
    }
    nloc = mine > 0u ? mine : 1u; nx = cnt > 0u ? cnt : 1u;
}

__device__ __forceinline__ void xcd_barrier(const XcdBarrier& b) {
    asm volatile("s_waitcnt vmcnt(0)" ::: "memory");
    __syncthreads();
    if (threadIdx.x == 0) {
        unsigned* bar = b.bar;
        __builtin_amdgcn_s_waitcnt(0);
        unsigned nloc = b.st[0], nx = b.st[1];
        if (nloc == 0u) { xcd_barrier_complete(bar, b.x, nloc, nx); b.st[0] = nloc; b.st[1] = nx; }
        const unsigned old = xb_add(&bar[XB_XSUB(b.x)], 1u);
        const unsigned gen = old / nloc;
        if (old + 1u == (gen + 1u) * nloc) {
            __builtin_amdgcn_fence(__ATOMIC_RELEASE, "agent");
            asm volatile("s_waitcnt vmcnt(0)" ::: "memory");
            const unsigned og = xb_add(&bar[XB_TOP], 1u);
            const unsigned tg = og / nx;
            if (og + 1u == (tg + 1u) * nx) xb_add(&bar[XB_TOPGEN], 1u);
            else XB_SPIN(xb_ld(&bar[XB_TOPGEN]) == tg, bar);
            __builtin_amdgcn_fence(__ATOMIC_ACQUIRE, "agent");
            xb_add(&bar[XB_XGEN(b.x)], 1u);
            asm volatile("s_waitcnt vmcnt(0)" ::: "memory");
        } else {
            XB_SPIN(xb_ld(&bar[XB_XGEN(b.x)]) == gen, bar);
            __builtin_amdgcn_fence(__ATOMIC_ACQUIRE, "agent");
            asm volatile("s_waitcnt vmcnt(0)" ::: "memory");
        }
    }
    __syncthreads();
}

__device__ __forceinline__ void p0_transpose_item(const float* W, int N, const float* gain, bf16* WT, int K, int out_row0, LAS float* scr, int k0, int n0, int lane) {
    const int kr = lane >> 3, nq = lane & 7;
#pragma unroll
    for (int i = 0; i < 8; ++i) { const int kk = 8 * i + kr; const f32x4 v = *(const GAS f32x4*)(W + (size_t)(k0 + kk) * N + n0 + 4 * nq);
        const float gk = gain ? gain[k0 + kk] : 1.0f; LAS float* d = scr + kk * 33 + 4 * nq; d[0] = v.x * gk; d[1] = v.y * gk; d[2] = v.z * gk; d[3] = v.w * gk; }
    LDS_WAIT(); asm volatile("" ::: "memory");
    const int c = lane & 7;
#pragma unroll
    for (int j = 0; j < 4; ++j) { const int n = (lane >> 3) + 8 * j; const LAS float* s = scr + (8 * c) * 33 + n;
        v4u o; o.x = pk2(s[0 * 33], s[1 * 33]); o.y = pk2(s[2 * 33], s[3 * 33]); o.z = pk2(s[4 * 33], s[5 * 33]); o.w = pk2(s[6 * 33], s[7 * 33]);
        *(GAS v4u*)(WT + (size_t)(out_row0 + n) * K + k0 + 8 * c) = o; }
    LDS_WAIT(); asm volatile("" ::: "memory");
}

struct P0Args {
    const float *xp, *xs, *norm_mix, *w_in, *w_glu, *gn_conv, *gn_ssm, *w_out, *norm_ffn, *w_gate, *w_up, *w_down;
    const float *A_re, *A_im, *log_dt, *B_re, *B_im, *C_re, *C_im;
    bf16 *WIN, *WGL, *WOUT, *WGU, *WDN, *XB; float* rx; unsigned char* tab;
};
__device__ __forceinline__ void p0_prologue(const P0Args& a, LAS unsigned char* lds, int vcu, int G, int wave, int lane, int tid) {
    LAS float* scr = (LAS float*)(lds + RING_OFF + wave * 16384);
    const int gw = vcu * NWAVES + wave, NGW = G * NWAVES;
    { const int gt = vcu * (NWAVES * 64) + tid;
      if (gt < NG * NP) { const int g = gt >> 6, p = gt & 63;
        const float ar = a.A_re[gt], ai = a.A_im[gt], dt = expf(a.log_dt[g]);
        const float th = dt * ai, e1 = expm1f(dt * ar), sh = sinf(0.5f * th), cm1 = -2.0f * sh * sh, cs = 1.0f + cm1;
        const float nr = e1 * cs + cm1, ni = (1.0f + e1) * sinf(th);
        const float abr = 1.0f + nr, abi = ni, den = ar * ar + ai * ai;
        const float kr = (nr * ar + ni * ai) / den, ki = (ni * ar - nr * ai) / den;
        float* AB = (float*)(a.tab + TAB_AB); AB[gt * 2] = abr; AB[gt * 2 + 1] = abi;
        bf16* BBT = (bf16*)(a.tab + TAB_BBT); bf16* CQ = (bf16*)(a.tab + TAB_CQ);
#pragma unroll
        for (int c = 0; c < 16; ++c) { const float br = a.B_re[(size_t)gt * CH + c], bi = a.B_im[(size_t)gt * CH + c];
            BBT[((size_t)(g * 2 + 0) * NP + p) * CH + c] = (bf16)f2bf(kr * br - ki * bi);
            BBT[((size_t)(g * 2 + 1) * NP + p) * CH + c] = (bf16)f2bf(kr * bi + ki * br);
            CQ[((size_t)g * CH + c) * 128 + 2 * p] = (bf16)f2bf(a.C_re[((size_t)g * CH + c) * NP + p]);
            CQ[((size_t)g * CH + c) * 128 + 2 * p + 1] = (bf16)f2bf(-a.C_im[((size_t)g * CH + c) * NP + p]); }
      } }
    constexpr int I_IN = (D / 64) * (DIN / 32), I_GL = (DS / 64) * (DS / 32), I_OUT = (D / 64) * (D / 32), I_GA = (D / 64) * (DFF / 32), I_DN = (DFF / 64) * (D / 32);
    constexpr int NITEMS = I_IN + I_GL + I_OUT + 2 * I_GA + I_DN;
    for (int it = gw; it < NITEMS; it += NGW) {
        int r = it;
        if (r < I_IN) { const int nb = r % (DIN / 32), kb = r / (DIN / 32), n0 = 32 * nb;
            int orow; if (n0 < 2048) { const int bjv = n0 >> 10, ch = n0 & 1023; orow = 256 * (ch >> 7) + 128 * bjv + (ch & 127); } else orow = n0;
            p0_transpose_item(a.w_in, DIN, a.norm_mix, a.WIN, D, orow, scr, 64 * kb, n0, lane); continue; } r -= I_IN;
        if (r < I_GL) { const int nb = r % (DS / 32), kb = r / (DS / 32);
            p0_transpose_item(a.w_glu, DS, nullptr, a.WGL, DS, 32 * nb, scr, 64 * kb, 32 * nb, lane); continue; } r -= I_GL;
        if (r < I_OUT) { const int nb = r % (D / 32), kb = r / (D / 32), k0 = 64 * kb;
            p0_transpose_item(a.w_out, D, k0 < 1024 ? a.gn_conv : a.gn_ssm - 1024, a.WOUT, D, 32 * nb, scr, k0, 32 * nb, lane); continue; } r -= I_OUT;
        if (r < I_GA) { const int nb = r % (DFF / 32), kb = r / (DFF / 32), n0 = 32 * nb;
            p0_transpose_item(a.w_gate, DFF, a.norm_ffn, a.WGU, D, 256 * (n0 >> 7) + (n0 & 127), scr, 64 * kb, n0, lane); continue; } r -= I_GA;
        if (r < I_GA) { const int nb = r % (DFF / 32), kb = r / (DFF / 32), n0 = 32 * nb;
            p0_transpose_item(a.w_up, DFF, a.norm_ffn, a.WGU, D, 256 * (n0 >> 7) + 128 + (n0 & 127), scr, 64 * kb, n0, lane); continue; } r -= I_GA;
        { const int nb = r % (D / 32), kb = r / (D / 32);
            p0_transpose_item(a.w_down, D, nullptr, a.WDN, DFF, 32 * nb, scr, 64 * kb, 32 * nb, lane); }
    }
    for (int row = gw; row < M; row += NGW) {
        const float* x = row < MP ? a.xp + (size_t)row * D : a.xs + (size_t)(row - MP) * D;
        const GAS f32x4* xr = (const GAS f32x4*)x + lane;
        f32x4 v[8]; float s = 0.f;
#pragma unroll
        for (int j = 0; j < 8; ++j) { v[j] = xr[64 * j]; s += (v[j].x * v[j].x + v[j].y * v[j].y) + (v[j].z * v[j].z + v[j].w * v[j].w); }
        s = wave_sum(s);
        if (lane == 0) a.rx[row] = 1.0f / sqrtf(s * (1.0f / D) + 1e-6f);
        GAS v2u* o8 = (GAS v2u*)(a.XB + (size_t)row * D) + lane;
#pragma unroll
        for (int j = 0; j < 8; ++j) { v2u o; o.x = pk2(v[j].x, v[j].y); o.y = pk2(v[j].z, v[j].w); o8[64 * j] = o; }
    }
}

struct P2Args {
    const bf16* UC; const bf16* SI; bf16* G; bf16* MIX;
    const float *state_conv, *h0re, *h0im, *conv_w, *conv_b, *ln_g, *ln_b, *Dk;
    const unsigned char* tab;
    float *ncp, *nrp, *nip, *ncs, *nrs, *nis;
};
constexpr int P2_RED_OFF = 0, P2_TILE_OFF = 4096, P2_TILE_B = 4352, P2_TROW = 272, P2_SX_OFF = 81920;

__device__ __forceinline__ void p2_conv(const P2Args& a, LAS unsigned char* lds, int vcu, int G, int wave, int lane, int tid) {
    LAS float* red = (LAS float*)(lds + P2_RED_OFF);
    LAS float* tot = red + 128;
    const int c0 = 2 * tid;
    f32x2 w[KW];
#pragma unroll
    for (int k = 0; k < KW; ++k) w[k] = *(const GAS f32x2*)(a.conv_w + k * DC + c0);
    const f32x2 bias = *(const GAS f32x2*)(a.conv_b + c0), lg = *(const GAS f32x2*)(a.ln_g + c0), lb = *(const GAS f32x2*)(a.ln_b + c0);
    for (int it = vcu; it < 1024 + DB; it += G) {
        int rowbase, t0; const float* hist = nullptr;
        if (it < 1024) { rowbase = (it >> 8) * SEQ; t0 = (it & 255) * 8; } else { const int b = it - 1024; rowbase = MP + b * DSQ; t0 = 0; hist = a.state_conv + (size_t)b * (KW - 1) * DC; }
        f32x2 acc[8];
#pragma unroll
        for (int j = 0; j < 8; ++j) acc[j] = bias;
#pragma unroll
        for (int r = 0; r < 8 + KW - 1; ++r) {
            const int tt = t0 - (KW - 1) + r; f32x2 v = {0.f, 0.f};
            if (tt >= 0) { const unsigned pk = *(const GAS unsigned*)(a.UC + (size_t)(rowbase + tt) * DC + c0); v.x = bf_lo(pk); v.y = bf_hi(pk); }
            else if (hist) v = *(const GAS f32x2*)(hist + (size_t)(tt + KW - 1) * DC + c0);
#pragma unroll
            for (int j = 0; j < 8; ++j) { const int k = r - j; if (k >= 0 && k < KW) acc[j] += w[k] * v; }
        }
        float st[16];
#pragma unroll
        for (int j = 0; j < 8; ++j) { st[j] = acc[j].x + acc[j].y; st[8 + j] = acc[j].x * acc[j].x + acc[j].y * acc[j].y; }
#pragma unroll
        for (int j = 0; j < 16; ++j) st[j] = wave_sum(st[j]);
        __syncthreads();
        if (lane == 0) {
#pragma unroll
            for (int j = 0; j < 16; ++j) red[wave * 16 + j] = st[j]; }
        __syncthreads();
        if (tid < 16) { float s = 0.f;
#pragma unroll
            for (int wv = 0; wv < 8; ++wv) s += red[wv * 16 + tid];
            tot[tid] = s; }
        __syncthreads();
        float q[8];
#pragma unroll
        for (int j = 0; j < 8; ++j) { const float mu = tot[j] * (1.0f / DC), var = tot[8 + j] * (1.0f / DC) - mu * mu, rs = 1.0f / sqrtf(var + 1e-6f);
            f32x2 y = (acc[j] - mu) * rs * lg + lb; y.x = y.x * fsigm(y.x); y.y = y.y * fsigm(y.y); acc[j] = y; q[j] = y.x * y.x + y.y * y.y; }
#pragma unroll
        for (int j = 0; j < 8; ++j) q[j] = wave_sum(q[j]);
        __syncthreads();
        if (lane == 0) {
#pragma unroll
            for (int j = 0; j < 8; ++j) red[wave * 16 + j] = q[j]; }
        __syncthreads();
        if (tid < 8) { float s = 0.f;
#pragma unroll
            for (int wv = 0; wv < 8; ++wv) s += red[wv * 16 + tid];
            tot[tid] = s; }
        __syncthreads();
#pragma unroll
        for (int j = 0; j < 8; ++j) { const float r2 = 1.0f / sqrtf(tot[j] * (1.0f / DC) + 1e-6f);
            *(GAS unsigned*)(a.MIX + (size_t)(rowbase + t0 + j) * D + c0) = pk2(acc[j].x * r2, acc[j].y * r2); }
    }
    __syncthreads();
}

__device__ __forceinline__ void p2_newconv(const P2Args& a, int vcu, int G, int tid) {
    constexpr int NPV = BATCH * (KW - 1) * (DC / 4), NSV = DB * (KW - 1) * (DC / 4);
    for (int idx = vcu * (NWAVES * 64) + tid; idx < NPV + NSV; idx += G * NWAVES * 64) {
        if (idx < NPV) { const int c4 = idx & 255, j = (idx >> 8) % (KW - 1), b = idx / ((KW - 1) * 256);
            const v2u pk = *(const GAS v2u*)(a.UC + (size_t)(b * SEQ + SEQ - (KW - 1) + j) * DC + 4 * c4);
            const f32x4 v = {bf_lo(pk.x), bf_hi(pk.x), bf_lo(pk.y), bf_hi(pk.y)};
            *(GAS f32x4*)(a.ncp + (size_t)idx * 4) = v; }
        else { const int k = idx - NPV; const int c4 = k & 255, j = (k >> 8) % (KW - 1), b = k / ((KW - 1) * 256); const int id = j + DSQ; f32x4 v;
            if (id < KW - 1) v = *(const GAS f32x4*)(a.state_conv + ((size_t)b * (KW - 1) + id) * DC + 4 * c4);
            else { const v2u pk = *(const GAS v2u*)(a.UC + (size_t)(MP + b * DSQ + id - (KW - 1)) * DC + 4 * c4); v = (f32x4){bf_lo(pk.x), bf_hi(pk.x), bf_lo(pk.y), bf_hi(pk.y)}; }
            *(GAS f32x4*)(a.ncs + (size_t)k * 4) = v; }
    }
}

#define SSM_STEP(i) do { \
        const float nAr = __builtin_fmaf(aAr, hAr, __builtin_fmaf(-aAi, hAi, d00[i])), nAi = __builtin_fmaf(aAr, hAi, __builtin_fmaf(aAi, hAr, d01[i])); \
        const float nBr = __builtin_fmaf(aBr, hBr, __builtin_fmaf(-aBi, hBi, d10[i])), nBi = __builtin_fmaf(aBr, hBi, __builtin_fmaf(aBi, hBr, d11[i])); \
        hAr = nAr; hAi = nAi; hBr = nBr; hBi = nBi; } while (0)
#define SSM_MFMA(afrag) do { const f32x16 z16 = {0.f,0.f,0.f,0.f,0.f,0.f,0.f,0.f,0.f,0.f,0.f,0.f,0.f,0.f,0.f,0.f}; \
        d00 = __builtin_amdgcn_mfma_f32_32x32x16_bf16(afrag, bfr[0][0], z16, 0, 0, 0); d01 = __builtin_amdgcn_mfma_f32_32x32x16_bf16(afrag, bfr[0][1], z16, 0, 0, 0); \
        d10 = __builtin_amdgcn_mfma_f32_32x32x16_bf16(afrag, bfr[1][0], z16, 0, 0, 0); d11 = __builtin_amdgcn_mfma_f32_32x32x16_bf16(afrag, bfr[1][1], z16, 0, 0, 0); } while (0)
#define SSM_EMIT(rowb0, rowb1) do { \
        LDS_WAIT(); __builtin_amdgcn_wave_barrier(); \
        _Pragma("unroll") for (int s_ = 0; s_ < 2; ++s_) { \
            f32x4 y_ = {0.f, 0.f, 0.f, 0.f}; \
            _Pragma("unroll") for (int ks = 0; ks < 4; ++ks) { const bf16x8 hf = *(const LAS bf16x8*)(tile + s_ * P2_TILE_B + (lane & 15) * P2_TROW + ks * 64 + (lane >> 4) * 16); \
                y_ = __builtin_amdgcn_mfma_f32_16x16x32_bf16(hf, cfr[ks], y_, 0, 0, 0); } \
            const int rb_ = s_ ? (rowb1) : (rowb0); \
            _Pragma("unroll") for (int i_ = 0; i_ < 4; ++i_) { const size_t o_ = (size_t)(rb_ + 4 * (lane >> 4) + i_) * DS + g * CH + (lane & 15); \
                const float u_ = __builtin_bit_cast(float, (unsigned)a.SI[o_] << 16); \
                a.G[o_] = (bf16)f2bf(gelu_tanh_f(y_[i_] + dsk * u_)); } } \
        LDS_WAIT(); __builtin_amdgcn_wave_barrier(); } while (0)
#define SSM_TILE_ROW(i) do { v2u hw_; hw_.x = pk2(hAr, hAi); hw_.y = pk2(hBr, hBi); *(LAS v2u*)(mytile + (i) * P2_TROW) = hw_; } while (0)

__device__ __forceinline__ void p2_ssm(const P2Args& a, LAS unsigned char* lds, int vcu, int G, int wave, int lane, int tid) {
    const int col = lane & 31, half = lane >> 5;
    const int r = lane & 31, s_r = (r >> 2) & 1, i_r = (r & 3) + 4 * (r >> 3), kc = lane >> 5;
    LAS unsigned char* tile = lds + P2_TILE_OFF + wave * 2 * P2_TILE_B;
    LAS unsigned char* mytile = tile + half * P2_TILE_B + col * 8;
    LAS f32x4* SX = (LAS f32x4*)(lds + P2_SX_OFF);
    for (int it = vcu; it < BATCH * NG; it += G) {
        const int g = it & (NG - 1), pb = it >> 6;
        const float* AB = (const float*)(a.tab + TAB_AB) + (size_t)(g * NP + 2 * col) * 2;
        const f32x4 ab4 = *(const GAS f32x4*)AB;
        const float aAr = ab4.x, aAi = ab4.y, aBr = ab4.z, aBi = ab4.w;
        bf16x8 bfr[2][2], cfr[4];
#pragma unroll
        for (int pair = 0; pair < 2; ++pair)
#pragma unroll
            for (int ri = 0; ri < 2; ++ri) bfr[pair][ri] = *(const GAS bf16x8*)((const bf16*)(a.tab + TAB_BBT) + ((size_t)(g * 2 + ri) * NP + 2 * col + pair) * CH + 8 * kc);
#pragma unroll
        for (int ks = 0; ks < 4; ++ks) cfr[ks] = *(const GAS bf16x8*)((const bf16*)(a.tab + TAB_CQ) + ((size_t)g * CH + (lane & 15)) * 128 + 32 * ks + 8 * (lane >> 4));
        const float dsk = a.Dk[g * CH + (lane & 15)];
        f32x16 d00, d01, d10, d11;
        {
            const bf16* abase = a.SI + (size_t)(pb * SEQ + (2 * wave + s_r) * 128 + i_r) * DS + g * CH + 8 * kc;
            float hAr = 0.f, hAi = 0.f, hBr = 0.f, hBi = 0.f;
            bf16x8 af = *(const GAS bf16x8*)abase;
#pragma unroll 1
            for (int blk = 0; blk < 8; ++blk) {
                const bf16x8 afn = *(const GAS bf16x8*)(abase + (size_t)((blk + 1) & 7) * 16 * DS);
                SSM_MFMA(af);
#pragma unroll
                for (int i = 0; i < 16; ++i) SSM_STEP(i);
                af = afn;
            }
            __syncthreads();
            SX[(2 * wave + half) * 32 + col] = (f32x4){hAr, hAi, hBr, hBi};
            __syncthreads();
            float pAr = aAr, pAi = aAi, pBr = aBr, pBi = aBi;
#pragma unroll
            for (int sq = 0; sq < 7; ++sq) { const float t0 = pAr * pAr - pAi * pAi, t1 = 2.0f * pAr * pAi, t2 = pBr * pBr - pBi * pBi, t3 = 2.0f * pBr * pBi; pAr = t0; pAi = t1; pBr = t2; pBi = t3; }
            hAr = 0.f; hAi = 0.f; hBr = 0.f; hBi = 0.f;
            const int mine = 2 * wave + half;
            for (int s2 = 0; s2 < mine; ++s2) { const f32x4 sv = SX[s2 * 32 + col];
                const float nAr = pAr * hAr - pAi * hAi + sv.x, nAi = pAr * hAi + pAi * hAr + sv.y, nBr = pBr * hBr - pBi * hBi + sv.z, nBi = pBr * hBi + pBi * hBr + sv.w;
                hAr = nAr; hAi = nAi; hBr = nBr; hBi = nBi; }
            af = *(const GAS bf16x8*)abase;
#pragma unroll 1
            for (int blk = 0; blk < 8; ++blk) {
                const bf16x8 afn = *(const GAS bf16x8*)(abase + (size_t)((blk + 1) & 7) * 16 * DS);
                SSM_MFMA(af);
#pragma unroll
                for (int i = 0; i < 16; ++i) { SSM_STEP(i); SSM_TILE_ROW(i); }
                const int rb = pb * SEQ + (2 * wave) * 128 + blk * 16;
                SSM_EMIT(rb, rb + 128);
                af = afn;
            }
            if (mine == 15) { const size_t o = ((size_t)pb * NG + g) * NP + 2 * col;
                *(GAS f32x2*)(a.nrp + o) = (f32x2){hAr, hBr}; *(GAS f32x2*)(a.nip + o) = (f32x2){hAi, hBi}; }
        }
        {
            const int bA_load = 32 * pb + 4 * wave + 2 * s_r, bA = 32 * pb + 4 * wave + 2 * half;
            const bf16x8 af = *(const GAS bf16x8*)(a.SI + (size_t)(MP + bA_load * DSQ + i_r) * DS + g * CH + 8 * kc);
            SSM_MFMA(af);
            size_t o = ((size_t)bA * NG + g) * NP + 2 * col;
            f32x2 t0 = *(const GAS f32x2*)(a.h0re + o), t1 = *(const GAS f32x2*)(a.h0im + o);
            float hAr = t0.x, hBr = t0.y, hAi = t1.x, hBi = t1.y;
#pragma unroll
            for (int i = 0; i < 8; ++i) { SSM_STEP(i); SSM_TILE_ROW(i); }
            *(GAS f32x2*)(a.nrs + o) = (f32x2){hAr, hBr}; *(GAS f32x2*)(a.nis + o) = (f32x2){hAi, hBi};
            o += (size_t)NG * NP;
            t0 = *(const GAS f32x2*)(a.h0re + o); t1 = *(const GAS f32x2*)(a.h0im + o);
            hAr = t0.x; hBr = t0.y; hAi = t1.x; hBi = t1.y;
#pragma unroll
            for (int i = 8; i < 16; ++i) { SSM_STEP(i); SSM_TILE_ROW(i); }
            *(GAS f32x2*)(a.nrs + o) = (f32x2){hAr, hBr}; *(GAS f32x2*)(a.nis + o) = (f32x2){hAi, hBi};
            const int rb = MP + (32 * pb + 4 * wave) * DSQ;
            SSM_EMIT(rb, rb + 16);
        }
    }
    __syncthreads();
}

struct Args { const float* in[28]; float* out; unsigned char* ws; int ph_lo, ph_hi, li, pad; };
__global__ void __launch_bounds__(NWAVES * 64, 2) mk_fwd(Args args) {
    __shared__ __attribute__((aligned(16))) unsigned char lds_raw[LDS_BYTES];
    LAS unsigned char* lds = (LAS unsigned char*)lds_raw;
    volatile LAS unsigned* MISC = (volatile LAS unsigned*)(lds + MISC_OFF);
    const int tid = threadIdx.x, lane = tid & 63, wave = __builtin_amdgcn_readfirstlane(tid >> 6);
    const int G = gridDim.x; const int bx = blockIdx.x; const int vcu = (G % 8 == 0) ? (bx % 8) * (G / 8) + bx / 8 : bx;
    unsigned char* ws = args.ws;
    gu32* ctl = (gu32*)(ws + WS_CTL);
    for (int u = tid; u < (LDS_BYTES - LDSCTL_OFF) / 4; u += NWAVES * 64) ((LAS unsigned*)(lds + LDSCTL_OFF))[u] = 0u;
    __syncthreads();
    XcdBarrier bar; bar.bar = (unsigned*)(ctl + CW_BAR); bar.x = 0; bar.st = nullptr;
    if (N_LAUNCHES != NPH) bar = xcd_barrier_post((unsigned*)(ctl + CW_BAR), MISC + 8);
#define GRID_BAR(seam) do { if (N_LAUNCHES == NPH) { if (tid == 0) __hip_atomic_store(ctl + CW_TMO, 0xBADBA0u | (unsigned)(seam), RLX_AGENT); } else { xcd_barrier(bar); } } while (0)
    const int lo = args.ph_lo, hi = args.ph_hi;
#define IN(k) (lo <= (k) && (k) < hi)
#define BOTH(k) (IN(k) && IN((k) + 1))
    float* out = args.out;
    float* Y = out;
    float* ncp = out + (size_t)M * D;
    float* nrp = ncp + (size_t)BATCH * (KW - 1) * DC;
    float* nip = nrp + (size_t)BATCH * NG * NP;
    float* ncs = nip + (size_t)BATCH * NG * NP;
    float* nrs = ncs + (size_t)DB * (KW - 1) * DC;
    float* nis = nrs + (size_t)DB * NG * NP;
    bf16 *WGU = (bf16*)(ws + WS_WGU), *WDN = (bf16*)(ws + WS_WDN), *XB = (bf16*)(ws + WS_XB), *WIN = (bf16*)(ws + WS_WIN), *WGL = (bf16*)(ws + WS_WGL), *WOUT = (bf16*)(ws + WS_WOUT);
    bf16 *UC = (bf16*)(ws + WS_U), *SI = (bf16*)(ws + WS_S), *GB = (bf16*)(ws + WS_G), *MIX = (bf16*)(ws + WS_MIX), *ACT = (bf16*)(ws + WS_ACT);
    float* ssq_s = (float*)(ws + WS_CTL) + CW_SSQ_S; float* ssq_h = (float*)(ws + WS_CTL) + CW_SSQ_H; float* ssq_o = (float*)(ws + WS_CTL) + CW_SSQ_O; float* rx = (float*)(ws + WS_CTL) + CW_RX;
    const int gw = vcu * NWAVES + wave, NGW = G * NWAVES;

    if (IN(0)) {
        P0Args a; a.xp = args.in[0]; a.xs = args.in[1]; a.norm_mix = args.in[5]; a.w_in = args.in[6]; a.w_glu = args.in[19]; a.gn_conv = args.in[20]; a.gn_ssm = args.in[21]; a.w_out = args.in[22];
        a.norm_ffn = args.in[23]; a.w_gate = args.in[24]; a.w_up = args.in[25]; a.w_down = args.in[26];
        a.A_re = args.in[11]; a.A_im = args.in[12]; a.log_dt = args.in[13]; a.B_re = args.in[14]; a.B_im = args.in[15]; a.C_re = args.in[16]; a.C_im = args.in[17];
        a.WIN = WIN; a.WGL = WGL; a.WOUT = WOUT; a.WGU = WGU; a.WDN = WDN; a.XB = XB; a.rx = rx; a.tab = ws + WS_TAB;
        p0_prologue(a, lds, vcu, G, wave, lane, tid);
        if (BOTH(0)) GRID_BAR(0);
    }
    if (IN(1)) {
        pg8::Gemm g{XB, WIN, M, DIN, D}; pg8::StaticOrder S; S.init(M, DIN, G, (int)blockIdx.x);
        pg8::EpiIn E{UC, SI, rx};
        pg8::gemm_phase<pg8::EpiIn, pg8::StaticOrder, true, true>(lds + RING_OFF, g, S, E);
        if (BOTH(1)) GRID_BAR(1);
    }
    if (IN(2)) {
        P2Args a; a.UC = UC; a.SI = SI; a.G = GB; a.MIX = MIX; a.state_conv = args.in[2]; a.h0re = args.in[3]; a.h0im = args.in[4];
        a.conv_w = args.in[7]; a.conv_b = args.in[8]; a.ln_g = args.in[9]; a.ln_b = args.in[10]; a.Dk = args.in[18]; a.tab = ws + WS_TAB;
        a.ncp = ncp; a.nrp = nrp; a.nip = nip; a.ncs = ncs; a.nrs = nrs; a.nis = nis;
        p2_ssm(a, lds, vcu, G, wave, lane, tid);
        p2_conv(a, lds, vcu, G, wave, lane, tid);
        p2_newconv(a, vcu, G, tid);
        if (BOTH(2)) GRID_BAR(2);
    }
    if (IN(3)) {
        pg8::Gemm g{GB, WGL, M, DS, DS}; pg8::StaticOrder S; S.init(M, DS, G, (int)blockIdx.x);
        pg8::EpiGlu E{GB, MIX, ssq_s};
        pg8::gemm_phase<pg8::EpiGlu, pg8::StaticOrder, true, true>(lds + RING_OFF, g, S, E);
        if (BOTH(3)) GRID_BAR(3);
    }
    if (IN(4)) {
        for (int row = gw; row < M; row += NGW) {
            const float r = 1.0f / sqrtf(__hip_atomic_load(ssq_s + row, RLX_AGENT) * (1.0f / DS) + 1e-6f);
            GAS v4u* p = (GAS v4u*)(MIX + (size_t)row * D + DC) + 2 * lane;
#pragma unroll
            for (int j = 0; j < 2; ++j) { v4u w = p[j]; w.x = pk2(bf_lo(w.x) * r, bf_hi(w.x) * r); w.y = pk2(bf_lo(w.y) * r, bf_hi(w.y) * r); w.z = pk2(bf_lo(w.z) * r, bf_hi(w.z) * r); w.w = pk2(bf_lo(w.w) * r, bf_hi(w.w) * r); p[j] = w; }
        }
        if (BOTH(4)) GRID_BAR(4);
    }
    if (IN(5)) {
        pg8::Gemm g{MIX, WOUT, M, D, D}; pg8::StaticOrder S; S.init(M, D, G, (int)blockIdx.x);
        pg8::EpiOut E{args.in[0], args.in[1], Y, XB, ssq_h};
        pg8::gemm_phase<pg8::EpiOut, pg8::StaticOrder, true, true>(lds + RING_OFF, g, S, E);
        if (BOTH(5)) GRID_BAR(5);
    }
    if (IN(6)) {
        pg8::Gemm g{XB, WGU, M, 2 * DFF, D}; pg8::StaticOrder S; S.init(M, 2 * DFF, G, (int)blockIdx.x);
        pg8::EpiUp E{ACT, ssq_h};
        pg8::gemm_phase<pg8::EpiUp, pg8::StaticOrder, true, true>(lds + RING_OFF, g, S, E);
        if (BOTH(6)) GRID_BAR(6);
    }
    if (IN(7)) {
        pg8::Gemm g{ACT, WDN, M, D, DFF}; pg8::StaticOrder S; S.init(M, D, G, (int)blockIdx.x);
        pg8::EpiDown E{Y, ssq_o};
        pg8::gemm_phase<pg8::EpiDown, pg8::StaticOrder, true, true>(lds + RING_OFF, g, S, E);
        if (BOTH(7)) GRID_BAR(7);
    }
    if (IN(8)) {
        const float* gfin = args.in[27];
        for (int row = gw; row < M; row += NGW) {
            const float r = 1.0f / sqrtf(__hip_atomic_load(ssq_o + row, RLX_AGENT) * (1.0f / D) + 1e-6f);
            GAS f32x4* p = (GAS f32x4*)(Y + (size_t)row * D) + lane; const GAS f32x4* gp = (const GAS f32x4*)gfin + lane;
#pragma unroll
            for (int j = 0; j < 8; ++j) p[64 * j] = p[64 * j] * r * gp[64 * j];
        }
    }
#undef IN
#undef BOTH
#undef GRID_BAR
}

extern "C" void kernel_launch(void* const* d_in, const int* in_sizes, int n_in, void* d_out, int out_size, void* d_ws, size_t ws_size, hipStream_t stream) {
    static int grid = 0;
    if (grid == 0) {
        const long want_out = (long)M * D + (long)(BATCH + DB) * ((KW - 1) * DC + 2 * NG * NP);
        if (n_in != 28 || in_sizes[0] != MP * D || (long)out_size != want_out || ws_size < WS_END) {
            fprintf(stderr, "kernel_launch: unexpected shapes (n_in %d, in0 %d, out %d (want %ld), ws %zu (need %zu)); nothing launched\n", n_in, n_in > 0 ? in_sizes[0] : -1, out_size, want_out, ws_size, (size_t)WS_END); grid = -1; return; }
        int dev = 0, cus = 0;
        if (hipGetDevice(&dev) != hipSuccess || hipDeviceGetAttribute(&cus, hipDeviceAttributeMultiprocessorCount, dev) != hipSuccess) { fprintf(stderr, "kernel_launch: device query failed\n"); grid = -1; return; }
        grid = cus;
    }
    if (grid < 0) return;
    if (hipMemsetAsync((char*)d_ws + WS_CTL, 0, CTL_ZERO_BYTES, stream) != hipSuccess) { fprintf(stderr, "kernel_launch: memset failed\n"); return; }
    Args a{};
    for (int i = 0; i < 28; ++i) a.in[i] = (const float*)d_in[i];
    a.out = (float*)d_out; a.ws = (unsigned char*)d_ws;
    for (int li = 0; li < N_LAUNCHES; ++li) {
        if (N_LAUNCHES == NPH) { a.ph_lo = li; a.ph_hi = li + 1; } else { a.ph_lo = 0; a.ph_hi = NPH; }
        a.li = li;
        hipLaunchKernelGGL(mk_fwd, dim3(grid), dim3(NWAVES * 64), 0, stream, a);
        const hipError_t le = hipPeekAtLastError();
        if (le != hipSuccess) { fprintf(stderr, "kernel_launch: launch %d failed: %s\n", li, hipGetErrorName(le)); break; }
    }
}
```

```cpp
#include <hip/hip_runtime.h>
#include <cstdio>
#include <cstdint>
#define MK_N_LAUNCHES 1
namespace pg8 {
#define PG8_LAS __attribute__((address_space(3)))
typedef unsigned short bf16_t;
typedef short bf16x8 __attribute__((ext_vector_type(8)));
typedef float f32x4 __attribute__((ext_vector_type(4)));
typedef unsigned u32x4 __attribute__((ext_vector_type(4)));
constexpr int BM = 256, BK = 64, HALF = 128, HTB = HALF * BK * 2  , STAGE_BYTES = 8 * HTB, NXCD = 8, WGM = 8;

__host__ __device__ __forceinline__ int lds_byte(int r, int c) { const int st = (r >> 4) * 2 + (c >> 5), rr = r & 15, cc = c & 31, ob = rr * 64 + cc * 2; return st * 1024 + (ob ^ (((ob >> 9) & 1) << 5)); }
__host__ __device__ __forceinline__ void stage_rc(int b, int& R, int& C) { const int st = b / 1024, sb = b % 1024, swz = sb ^ (((sb >> 9) & 1) << 5); R = (st >> 1) * 16 + swz / 64; C = (st & 1) * 32 + (swz % 64) / 2; }
__host__ __device__ __forceinline__ int perm32(int rho) { const int n = rho >> 4, i = rho & 15; return 8 * (i >> 2) + 4 * n + (i & 3); }

struct Unit { int pm, pn, k0, nt, mode, need; };
struct Gemm { const bf16_t* A; const bf16_t* Bt; int M, N, K; };

__device__ __forceinline__ unsigned cvt_pk_bf16(float lo, float hi) { unsigned r; asm volatile("v_cvt_pk_bf16_f32 %0, %1, %2" : "=v"(r) : "v"(lo), "v"(hi)); return r; }
template <class Epi, class Sched, bool ALIGN_EPI = false, bool SP2 = false>
__device__ __forceinline__ void gemm_phase(PG8_LAS unsigned char* lds, const Gemm g, Sched& S, const Epi& E) {
    const int tid = threadIdx.x, wid = __builtin_amdgcn_readfirstlane(tid >> 6), lane = tid & 63, wr = wid >> 2, wc = wid & 3, fr = lane & 15, fq = lane >> 4;
    constexpr int K = Sched::KK;
    unsigned voffA[2], voffB[2];
#pragma unroll
    for (int i = 0; i < 2; ++i) { int R, C; stage_rc(tid * 16 + i * 8192, R, C); const int Rb = Epi::PERM ? ((R & ~31) + perm32(R & 31)) : R;
        voffA[i] = (unsigned)(R * K + C) * 2u; voffB[i] = (unsigned)(Rb * K + C) * 2u; }
    const size_t kstep = (size_t)(BK * 2);
    const size_t hstep = (size_t)HALF * K * 2;
    const size_t tstep = 2 * hstep;
    const unsigned ldsw = (unsigned)wid * 1024u;
    const int aoff = lds_byte(wr * 64 + fr, fq * 8), boff = lds_byte(wc * 32 + fr, fq * 8);
#define PG8_SA(b, h) (((b) * 2 + (h)) * HTB)
#define PG8_SB(b, h) ((4 + (b) * 2 + (h)) * HTB)
#define PG8_STAGE(bufoff, gbase, voff) do { _Pragma("unroll") for (int _i = 0; _i < 2; ++_i) \
        __builtin_amdgcn_global_load_lds((const unsigned*)((const char*)(gbase) + (voff)[_i]), (PG8_LAS unsigned*)(lds + (bufoff) + ldsw + _i * 8192), 16, 0, 0); } while (0)
#define PG8_LDA(dst, b, h) do { _Pragma("unroll") for (int m = 0; m < 4; ++m) _Pragma("unroll") for (int k = 0; k < 2; ++k) dst[m][k] = *(const PG8_LAS bf16x8*)(lds + PG8_SA(b, h) + aoff + m * 2048 + k * 1024); } while (0)
#define PG8_LDB(dst, b, h) do { _Pragma("unroll") for (int n = 0; n < 2; ++n) _Pragma("unroll") for (int k = 0; k < 2; ++k) dst[n][k] = *(const PG8_LAS bf16x8*)(lds + PG8_SB(b, h) + boff + n * 2048 + k * 1024); } while (0)
#define PG8_MMA(ai, bj, At, Bt) do { __builtin_amdgcn_s_setprio(1); _Pragma("unroll") for (int m = 0; m < 4; ++m) _Pragma("unroll") for (int n = 0; n < 2; ++n) _Pragma("unroll") for (int k = 0; k < 2; ++k) \
        acc[ai][bj][m][n] = __builtin_amdgcn_mfma_f32_16x16x32_bf16(Bt[n][k], At[m][k], acc[ai][bj][m][n], 0, 0, 0); __builtin_amdgcn_s_setprio(0); } while (0)
#define PG8_WAIT_V(n) asm volatile("s_waitcnt vmcnt(" #n ")" ::: "memory")
#define PG8_WAIT_L(n) asm volatile("s_waitcnt lgkmcnt(" #n ")" ::: "memory")
#define PG8_BAR __builtin_amdgcn_s_barrier()
#define PG8_SCHED __builtin_amdgcn_sched_barrier(0)
    Unit cur, nxt; int ui = 0;
    if (!S.next(0, cur)) return;
    f32x4 acc[2][2][4][2];
#pragma unroll
    for (int a = 0; a < 2; ++a)
#pragma unroll
        for (int b = 0; b < 2; ++b)
#pragma unroll
            for (int m = 0; m < 4; ++m)
#pragma unroll
                for (int n = 0; n < 2; ++n) acc[a][b][m][n] = (f32x4){0.f, 0.f, 0.f, 0.f};
    bf16x8 At[4][2], B0[2][2], B1[2][2];
    const char* cA = (const char*)g.A + (size_t)cur.pm * tstep + (size_t)cur.k0 * kstep; const char* cB = (const char*)g.Bt + (size_t)cur.pn * tstep + (size_t)cur.k0 * kstep;
    S.a_ready(cur);
    if constexpr (SP2) {
        PG8_STAGE(PG8_SB(0, 0), cB, voffB); PG8_STAGE(PG8_SB(0, 1), cB + hstep, voffB); PG8_STAGE(PG8_SA(0, 0), cA, voffA); PG8_STAGE(PG8_SA(0, 1), cA + hstep, voffA);
        if (wr == 1) PG8_BAR;
        PG8_WAIT_V(2); PG8_BAR;
        PG8_STAGE(PG8_SB(1, 0), cB + kstep, voffB); PG8_STAGE(PG8_SA(1, 0), cA + kstep, voffA); PG8_STAGE(PG8_SB(1, 1), cB + hstep + kstep, voffB);
        PG8_WAIT_V(6); PG8_BAR;
    } else {
        PG8_STAGE(PG8_SB(0, 0), cB, voffB); PG8_STAGE(PG8_SA(0, 0), cA, voffA); PG8_STAGE(PG8_SB(0, 1), cB + hstep, voffB); PG8_STAGE(PG8_SA(0, 1), cA + hstep, voffA);
        if (wr == 1) PG8_BAR;
        PG8_WAIT_V(4); PG8_BAR;
        PG8_STAGE(PG8_SB(1, 0), cB + kstep, voffB); PG8_STAGE(PG8_SA(1, 0), cA + kstep, voffA); PG8_STAGE(PG8_SB(1, 1), cB + hstep + kstep, voffB);
        PG8_WAIT_V(6); PG8_BAR;
    }
    for (;;) {
        const bool has_next = S.next(ui + 1, nxt);
        const char* nA = has_next ? (const char*)g.A + (size_t)nxt.pm * tstep + (size_t)nxt.k0 * kstep : cA; const char* nB = has_next ? (const char*)g.Bt + (size_t)nxt.pn * tstep + (size_t)nxt.k0 * kstep : cB;
        const int nt = cur.nt;
        for (int t = 0; t < nt; t += 2) {
            const bool last = (t == nt - 2);
            const char* a1 = cA + (size_t)(t + 1) * kstep;
            const char* a2 = last ? nA : cA + (size_t)(t + 2) * kstep; const char* b2 = last ? nB : cB + (size_t)(t + 2) * kstep;
            const char* a3 = a2 + kstep; const char* b3 = b2 + kstep;
            if (last && has_next) S.a_ready(nxt);
            if constexpr (SP2) {
            PG8_LDB(B0, 0, 0); PG8_LDB(B1, 0, 1); PG8_SCHED; PG8_LDA(At, 0, 0); PG8_STAGE(PG8_SA(1, 1), a1 + hstep, voffA);
            PG8_WAIT_V(8); PG8_WAIT_L(0); PG8_BAR; PG8_MMA(0, 0, At, B0); PG8_MMA(0, 1, At, B1); PG8_BAR; PG8_SCHED;
            PG8_LDA(At, 0, 1); PG8_STAGE(PG8_SB(0, 0), b2, voffB); PG8_STAGE(PG8_SB(0, 1), b2 + hstep, voffB); PG8_STAGE(PG8_SA(0, 0), a2, voffA);
            PG8_WAIT_V(8); PG8_WAIT_L(0); PG8_BAR; PG8_MMA(1, 0, At, B0); PG8_MMA(1, 1, At, B1); PG8_BAR; PG8_SCHED;
            PG8_LDB(B0, 1, 0); PG8_LDB(B1, 1, 1); PG8_SCHED; PG8_LDA(At, 1, 0); PG8_STAGE(PG8_SA(0, 1), a2 + hstep, voffA);
            PG8_WAIT_V(8); PG8_WAIT_L(0); PG8_BAR; PG8_MMA(0, 0, At, B0); PG8_MMA(0, 1, At, B1); PG8_BAR; PG8_SCHED;
            PG8_LDA(At, 1, 1); PG8_STAGE(PG8_SB(1, 0), b3, voffB); PG8_STAGE(PG8_SB(1, 1), b3 + hstep, voffB); PG8_STAGE(PG8_SA(1, 0), a3, voffA);
            PG8_WAIT_V(8); PG8_WAIT_L(0); PG8_BAR; PG8_MMA(1, 0, At, B0); PG8_MMA(1, 1, At, B1); PG8_BAR; PG8_SCHED;
            } else {
            PG8_LDB(B0, 0, 0); PG8_SCHED; PG8_LDA(At, 0, 0); PG8_STAGE(PG8_SA(1, 1), a1 + hstep, voffA);
            PG8_WAIT_L(8); PG8_BAR; PG8_WAIT_L(0); PG8_MMA(0, 0, At, B0); PG8_BAR; PG8_SCHED;
            PG8_LDB(B1, 0, 1); PG8_STAGE(PG8_SB(0, 0), b2, voffB);
            PG8_BAR; PG8_WAIT_L(0); PG8_MMA(0, 1, At, B1); PG8_BAR;
            PG8_LDA(At, 0, 1); PG8_STAGE(PG8_SA(0, 0), a2, voffA);
            PG8_BAR; PG8_WAIT_L(0); PG8_MMA(1, 0, At, B0); PG8_BAR; PG8_SCHED;
            PG8_STAGE(PG8_SB(0, 1), b2 + hstep, voffB);
            PG8_WAIT_V(6); PG8_BAR; PG8_MMA(1, 1, At, B1); PG8_BAR;
            PG8_LDB(B0, 1, 0); PG8_SCHED; PG8_LDA(At, 1, 0); PG8_STAGE(PG8_SA(0, 1), a2 + hstep, voffA);
            PG8_WAIT_L(8); PG8_BAR; PG8_WAIT_L(0); PG8_MMA(0, 0, At, B0); PG8_BAR; PG8_SCHED;
            PG8_LDB(B1, 1, 1); PG8_STAGE(PG8_SB(1, 0), b3, voffB);
            PG8_BAR; PG8_WAIT_L(0); PG8_MMA(0, 1, At, B1); PG8_BAR;
            PG8_LDA(At, 1, 1); PG8_STAGE(PG8_SA(1, 0), a3, voffA);
            PG8_BAR; PG8_WAIT_L(0); PG8_MMA(1, 0, At, B0); PG8_BAR; PG8_SCHED;
            PG8_STAGE(PG8_SB(1, 1), b3 + hstep, voffB);
            PG8_WAIT_V(6); PG8_BAR; PG8_MMA(1, 1, At, B1); PG8_BAR;
            }
        }
        if constexpr (ALIGN_EPI) { if (wr == 0) PG8_BAR; }
        static_assert(ALIGN_EPI && !Epi::AFTER_DRAIN, "the slab exchange needs both halves aligned in the epilogue");
        S.finish(acc, cur, E, tid, wid, wr, wc, fr, fq);
        if (!has_next) break;
#pragma unroll
        for (int a = 0; a < 2; ++a)
#pragma unroll
            for (int b = 0; b < 2; ++b)
#pragma unroll
                for (int m = 0; m < 4; ++m)
#pragma unroll
                    for (int n = 0; n < 2; ++n) acc[a][b][m][n] = (f32x4){0.f, 0.f, 0.f, 0.f};
        cur = nxt; cA = nA; cB = nB; ++ui;
        if constexpr (ALIGN_EPI) { if (wr == 1) PG8_BAR; }
    }
    PG8_WAIT_V(0);
    if constexpr (!ALIGN_EPI) { if (wr == 0) PG8_BAR; }
    PG8_BAR;
    S.finish_last(acc, cur, E, tid, wid, wr, wc, fr, fq);
#undef PG8_SA
#undef PG8_SB
#undef PG8_STAGE
#undef PG8_LDA
#undef PG8_LDB
#undef PG8_MMA
#undef PG8_WAIT_V
#undef PG8_WAIT_L
#undef PG8_BAR
#undef PG8_SCHED
}
}

namespace pg8 {
constexpr float RMS_EPS = 1e-6f;
__device__ __forceinline__ float fsig(float x) { return __builtin_amdgcn_rcpf(1.0f + __builtin_amdgcn_exp2f(x * -1.4426950408889634f)); }
__device__ __forceinline__ float bflo(unsigned w) { return __builtin_bit_cast(float, w << 16); }
__device__ __forceinline__ float bfhi(unsigned w) { return __builtin_bit_cast(float, w & 0xffff0000u); }
__device__ __forceinline__ u32x4 pack8(const f32x4& a, const f32x4& b) { u32x4 w; w.x = cvt_pk_bf16(a[0], a[1]); w.y = cvt_pk_bf16(a[2], a[3]); w.z = cvt_pk_bf16(b[0], b[1]); w.w = cvt_pk_bf16(b[2], b[3]); return w; }
__device__ __forceinline__ float sq4(const f32x4& a) { return (a[0] * a[0] + a[1] * a[1]) + (a[2] * a[2] + a[3] * a[3]); }
__device__ __forceinline__ void row_atomic(float* p, float q, int fq) { q += __shfl_xor(q, 16); q += __shfl_xor(q, 32); if (fq == 0) (void)__hip_atomic_fetch_add(p, q, __ATOMIC_RELAXED, __HIP_MEMORY_SCOPE_AGENT); }


template <int N_, int K_> struct HybridOrder {
    static constexpr size_t SLAB_BYTES = (size_t)BM * BM * 2;
    static constexpr int KK = K_, G = 256, nM = 9216 / BM, nN = N_ / BM, ntp = K_ / (2 * BK), nwg = nM * nN, per = G / 8, q = nwg / 8, R = q / per, pairs = (q - R * per) * ntp, base = pairs / per, rem = pairs - base * per;
    static_assert(nwg % 8 == 0 && K_ % (2 * BK) == 0 && N_ % BM == 0, "HybridOrder shapes");
    int x, j, rend, cur, vcu;
    unsigned char* slab; unsigned* flags; unsigned* tmo;
    __device__ __forceinline__ void init(int bx, unsigned char* slab_, unsigned* flags_, unsigned* tmo_) {
        x = bx & 7; j = bx >> 3;
        cur = j * base + (j < rem ? j : rem); rend = cur + base + (j < rem ? 1 : 0);
        vcu = x * per + j; slab = slab_; flags = flags_; tmo = tmo_;
    }
    __device__ __forceinline__ void tile_of(int wgid, Unit& u) const {
        constexpr int nig = WGM * nN; const int gid = wgid / nig, fm = gid * WGM, gsz = (nM - fm) < WGM ? (nM - fm) : WGM;
        u.pm = fm + ((wgid % nig) % gsz); u.pn = (wgid % nig) / gsz;
    }
    __device__ __forceinline__ bool next(int i, Unit& u) {
        if (i < R) { tile_of(x * q + i * per + j, u); u.k0 = 0; u.nt = 2 * ntp; u.mode = 0; u.need = 0; return true; }
        if (cur >= rend) return false;
        const int t = cur / ntp, off = cur - t * ntp; int len = ntp - off; if (len > rend - cur) len = rend - cur;
        tile_of(x * q + R * per + t, u); u.k0 = 2 * off; u.nt = 2 * len; u.need = ntp - off - len;
        u.mode = off > 0 ? 1 : (u.need > 0 ? 2 : 0);
        cur += len; return true;
    }
    __device__ __forceinline__ void a_ready(const Unit&) const {}
    template <class Epi> __device__ __forceinline__ void finish(f32x4 (&acc)[2][2][4][2], const Unit& u, const Epi& E, int tid, int wid, int wr, int wc, int fr, int fq) const {
        asm volatile("" : "+v"(tid), "+v"(fr), "+v"(fq));
        if (u.mode == 1) {
            __amdgpu_buffer_rsrc_t rs = __builtin_amdgcn_make_buffer_rsrc(slab + (size_t)vcu * SLAB_BYTES, 0, (int)SLAB_BYTES, 0x00020000);
            const int vo = tid * 16;
#pragma unroll
            for (int ai = 0; ai < 2; ++ai)
#pragma unroll
                for (int bj = 0; bj < 2; ++bj)
#pragma unroll
                    for (int m = 0; m < 4; ++m) { __builtin_amdgcn_raw_buffer_store_b128(pack8(acc[ai][bj][m][0], acc[ai][bj][m][1]), rs, vo + (ai * 8 + bj * 4 + m) * 8192, 0, 16); asm volatile("" ::: "memory"); }
            asm volatile("s_waitcnt vmcnt(0)" ::: "memory");
            __builtin_amdgcn_s_barrier();
            if (tid == 0) __hip_atomic_store(flags + 64 * vcu, 1u, __ATOMIC_RELAXED, __HIP_MEMORY_SCOPE_AGENT);
            return;
        }
        if (u.mode == 2) return;
        E(acc, u, wr, wc, fr, fq);
    }
    template <class Epi> __device__ __forceinline__ void finish_last(f32x4 (&acc)[2][2][4][2], const Unit& u, const Epi& E, int tid, int wid, int wr, int wc, int fr, int fq) const {
        if (u.mode != 2) return;
        int ns = 0; { int need = u.need; for (int jj = j + 1; need > 0 && jj < per; ++jj) { const int len = base + (jj < rem ? 1 : 0); if (len == 0) break; need -= (len < need ? len : need); ++ns; } }
        if (wid == 0) {
            for (int k = 1; k <= ns; ++k) { unsigned sp = 0;
                while (__hip_atomic_load(flags + 64 * (vcu + k), __ATOMIC_RELAXED, __HIP_MEMORY_SCOPE_AGENT) == 0u) { __builtin_amdgcn_s_sleep(2);
                    if (++sp > (1u << 20)) { if (tid == 0) __hip_atomic_store(tmo, 0x5AB0u, __ATOMIC_RELAXED, __HIP_MEMORY_SCOPE_AGENT); break; } } }
            __builtin_amdgcn_fence(__ATOMIC_ACQUIRE, "agent"); asm volatile("s_waitcnt vmcnt(0)" ::: "memory");
        }
        asm volatile("" ::: "memory"); __builtin_amdgcn_s_barrier(); asm volatile("" ::: "memory");
        for (int k = 1; k <= ns; ++k) {
            const u32x4* sl = (const u32x4*)(slab + (size_t)(vcu + k) * SLAB_BYTES) + tid;
            u32x4 w[16];
#pragma unroll
            for (int i = 0; i < 16; ++i) w[i] = sl[i * 512];
#pragma unroll
            for (int ai = 0; ai < 2; ++ai)
#pragma unroll
                for (int bj = 0; bj < 2; ++bj)
#pragma unroll
                    for (int m = 0; m < 4; ++m) { const u32x4 v = w[ai * 8 + bj * 4 + m];
                        acc[ai][bj][m][0] += (f32x4){bflo(v.x), bfhi(v.x), bflo(v.y), bfhi(v.y)}; acc[ai][bj][m][1] += (f32x4){bflo(v.z), bfhi(v.z), bflo(v.w), bfhi(v.w)}; }
        }
        E(acc, u, wr, wc, fr, fq);
    }
};
struct EpiIn {
    static constexpr bool PERM = true, AFTER_DRAIN = false;
    bf16_t* U; bf16_t* S; const float* rx;
    __device__ __forceinline__ void operator()(const f32x4 (&acc)[2][2][4][2], const Unit& u, int wr, int wc, int fr, int fq) const {
        const int row0 = u.pm * BM + wr * 64 + fr;
        if (u.pn < 8) {
            const int col0 = u.pn * 128 + wc * 32 + 8 * fq;
#pragma unroll
            for (int ai = 0; ai < 2; ++ai)
#pragma unroll
                for (int m = 0; m < 4; ++m) { const int row = row0 + ai * HALF + m * 16; const float r = rx[row];
                    f32x4 v0, v1;
#pragma unroll
                    for (int j = 0; j < 4; ++j) { v0[j] = (acc[ai][0][m][0][j] * r) * fsig(acc[ai][1][m][0][j] * r); v1[j] = (acc[ai][0][m][1][j] * r) * fsig(acc[ai][1][m][1][j] * r); }
                    *(u32x4*)(U + (size_t)row * 1024 + col0) = pack8(v0, v1); }
        } else {
            const int col0 = (u.pn - 8) * 256 + wc * 32 + 8 * fq;
#pragma unroll
            for (int ai = 0; ai < 2; ++ai)
#pragma unroll
                for (int m = 0; m < 4; ++m) { const int row = row0 + ai * HALF + m * 16; const float r = rx[row];
#pragma unroll
                    for (int bj = 0; bj < 2; ++bj) *(u32x4*)(S + (size_t)row * 1024 + col0 + bj * HALF) = pack8(acc[ai][bj][m][0] * r, acc[ai][bj][m][1] * r); }
        }
    }
};
struct EpiGlu {
    static constexpr bool PERM = true, AFTER_DRAIN = false;
    const bf16_t* G; bf16_t* MIX; float* ssq;
    __device__ __forceinline__ void operator()(const f32x4 (&acc)[2][2][4][2], const Unit& u, int wr, int wc, int fr, int fq) const {
        const int row0 = u.pm * BM + wr * 64 + fr, col0 = u.pn * BM + wc * 32 + 8 * fq;
#pragma unroll
        for (int ai = 0; ai < 2; ++ai)
#pragma unroll
            for (int m = 0; m < 4; ++m) { const int row = row0 + ai * HALF + m * 16; float q = 0.f;
#pragma unroll
                for (int bj = 0; bj < 2; ++bj) { const u32x4 gw = *(const u32x4*)(G + (size_t)row * 1024 + col0 + bj * HALF);
                    f32x4 g0 = {bflo(gw.x), bfhi(gw.x), bflo(gw.y), bfhi(gw.y)}, g1 = {bflo(gw.z), bfhi(gw.z), bflo(gw.w), bfhi(gw.w)}, y0, y1;
#pragma unroll
                    for (int j = 0; j < 4; ++j) { y0[j] = g0[j] * fsig(acc[ai][bj][m][0][j]); y1[j] = g1[j] * fsig(acc[ai][bj][m][1][j]); }
                    q += sq4(y0) + sq4(y1);
                    *(u32x4*)(MIX + (size_t)row * 2048 + 1024 + col0 + bj * HALF) = pack8(y0, y1); }
                row_atomic(ssq + row, q, fq); }
    }
};
struct EpiOut {
    static constexpr bool PERM = true, AFTER_DRAIN = false;
    const float* xp; const float* xs; float* H; bf16_t* HB; float* ssq;
    __device__ __forceinline__ void operator()(const f32x4 (&acc)[2][2][4][2], const Unit& u, int wr, int wc, int fr, int fq) const {
        const int row0 = u.pm * BM + wr * 64 + fr, col0 = u.pn * BM + wc * 32 + 8 * fq;
        const float* xb = (u.pm < 32) ? xp : xs - (size_t)8192 * 2048;
#pragma unroll
        for (int ai = 0; ai < 2; ++ai)
#pragma unroll
            for (int m = 0; m < 4; ++m) { const int row = row0 + ai * HALF + m * 16; float q = 0.f;
#pragma unroll
                for (int bj = 0; bj < 2; ++bj) { const size_t off = (size_t)row * 2048 + col0 + bj * HALF;
                    const f32x4 h0 = *(const f32x4*)(xb + off) + acc[ai][bj][m][0], h1 = *(const f32x4*)(xb + off + 4) + acc[ai][bj][m][1];
                    q += sq4(h0) + sq4(h1);
                    *(f32x4*)(H + off) = h0; *(f32x4*)(H + off + 4) = h1; *(u32x4*)(HB + off) = pack8(h0, h1); }
                row_atomic(ssq + row, q, fq); }
    }
};
struct EpiUp {
    static constexpr bool PERM = true, AFTER_DRAIN = false;
    bf16_t* ACT; const float* ssq;
    __device__ __forceinline__ void operator()(const f32x4 (&acc)[2][2][4][2], const Unit& u, int wr, int wc, int fr, int fq) const {
        const int row0 = u.pm * BM + wr * 64 + fr, col0 = u.pn * 128 + wc * 32 + 8 * fq;
#pragma unroll
        for (int ai = 0; ai < 2; ++ai)
#pragma unroll
            for (int m = 0; m < 4; ++m) { const int row = row0 + ai * HALF + m * 16; const float r = __builtin_amdgcn_rsqf(ssq[row] * (1.0f / 2048.0f) + RMS_EPS);
                f32x4 v0, v1;
#pragma unroll
                for (int j = 0; j < 4; ++j) { const float a0 = acc[ai][0][m][0][j] * r, a1 = acc[ai][0][m][1][j] * r;
                    v0[j] = a0 * fsig(a0) * (acc[ai][1][m][0][j] * r); v1[j] = a1 * fsig(a1) * (acc[ai][1][m][1][j] * r); }
                *(u32x4*)(ACT + (size_t)row * 5632 + col0) = pack8(v0, v1); }
    }
};
struct EpiDown {
    static constexpr bool PERM = true, AFTER_DRAIN = false;
    float* H; float* ssq; float zmul;
    __device__ __forceinline__ void operator()(const f32x4 (&acc)[2][2][4][2], const Unit& u, int wr, int wc, int fr, int fq) const {
        const int row0 = u.pm * BM + wr * 64 + fr, col0 = u.pn * BM + wc * 32 + 8 * fq;
#pragma unroll
        for (int ai = 0; ai < 2; ++ai)
#pragma unroll
            for (int m = 0; m < 4; ++m) { const int row = row0 + ai * HALF + m * 16; float q = 0.f;
#pragma unroll
                for (int bj = 0; bj < 2; ++bj) { float* p = H + (size_t)row * 2048 + col0 + bj * HALF;
                    const f32x4 o0 = *(const f32x4*)p + acc[ai][bj][m][0] * zmul, o1 = *(const f32x4*)(p + 4) + acc[ai][bj][m][1] * zmul;
                    q += sq4(o0) + sq4(o1);
                    *(f32x4*)p = o0; *(f32x4*)(p + 4) = o1; }
                row_atomic(ssq + row, q, fq); }
    }
};
}

constexpr int NWAVES = 8;
#ifndef MK_N_LAUNCHES
#define MK_N_LAUNCHES 1
#endif
constexpr int NPH = 9;
constexpr int N_LAUNCHES = MK_N_LAUNCHES;

constexpr int D = 2048, DC = 1024, DS = 1024, DIN = 3072, DFF = 5632, NG = 64, NP = 64, CH = 16, KW = 31;
constexpr int BATCH = 4, SEQ = 2048, DB = 128, DSQ = 8;
constexpr int MP = BATCH * SEQ, MS = DB * DSQ, M = MP + MS;

constexpr size_t MiB = 1u << 20;
constexpr size_t WS_CTL = 0, CTL_ZERO_BYTES = 1 * MiB;
constexpr size_t WS_TAB = 1 * MiB;
constexpr size_t WS_WGU = 2 * MiB, WS_WDN = 46 * MiB, WS_XB = 68 * MiB;
constexpr size_t WS_WIN = 104 * MiB, WS_WGL = 116 * MiB, WS_WOUT = 118 * MiB;
constexpr size_t WS_U = 126 * MiB, WS_S = 144 * MiB, WS_G = 162 * MiB, WS_MIX = 180 * MiB;
constexpr size_t WS_ACT = 104 * MiB;
constexpr size_t WS_END = 235 * MiB;
constexpr size_t SLAB_P1 = 162 * MiB, SLAB_P3 = 126 * MiB, SLAB_P5 = 126 * MiB, SLAB_P6 = 203 * MiB, SLAB_P7 = 2 * MiB;
static_assert(WS_WGU + (size_t)2 * DFF * D * 2 <= WS_WDN && WS_WDN + (size_t)D * DFF * 2 <= WS_XB && WS_XB + (size_t)M * D * 2 <= WS_WIN, "ws map 1");
static_assert(WS_WIN + (size_t)DIN * D * 2 <= WS_WGL && WS_WGL + (size_t)DS * DS * 2 <= WS_WOUT && WS_WOUT + (size_t)D * D * 2 <= WS_U, "ws map 2");
static_assert(WS_U + (size_t)M * DC * 2 <= WS_S && WS_S + (size_t)M * DS * 2 <= WS_G && WS_G + (size_t)M * DS * 2 <= WS_MIX && WS_MIX + (size_t)M * D * 2 <= WS_END, "ws map 3");
static_assert(WS_ACT + (size_t)M * DFF * 2 <= SLAB_P6 && SLAB_P6 + 32 * MiB <= WS_END && WS_END <= 256 * MiB, "ws map 4");
constexpr int CW_TMO = 0, CW_CODE = 1;
constexpr int CW_BAR = 4096;
constexpr int CW_SSQ_S = 16384, CW_SSQ_H = CW_SSQ_S + M, CW_SSQ_O = CW_SSQ_H + M;
constexpr int CW_DUMMY = CW_SSQ_O + M;
constexpr int CW_FLAGS = 81920, FLAG_SLOT = 16384;
constexpr int CW_RX = 65536;
static_assert((CW_RX + M) * 4 <= (int)CTL_ZERO_BYTES && CW_DUMMY + M <= CW_RX, "ctl map");
constexpr size_t TAB_AB = 0;
constexpr size_t TAB_BBT = 64 * 1024;
constexpr size_t TAB_CQ = 512 * 1024;

constexpr int RING_OFF = 0, RING_BYTES = 131072;
constexpr int LDSCTL_OFF = RING_BYTES, MISC_OFF = LDSCTL_OFF + 320;
constexpr int LDS_BYTES = 147456;
static_assert(MISC_OFF + 128 <= LDS_BYTES, "LDS map");

#define GAS __attribute__((address_space(1)))
#define LAS __attribute__((address_space(3)))
typedef unsigned short bf16;
typedef unsigned v4u __attribute__((ext_vector_type(4)));
typedef unsigned v2u __attribute__((ext_vector_type(2)));
typedef float f32x4 __attribute__((ext_vector_type(4)));
typedef float f32x2 __attribute__((ext_vector_type(2)));
typedef float f32x16 __attribute__((ext_vector_type(16)));
typedef short bf16x8 __attribute__((ext_vector_type(8)));
typedef GAS unsigned gu32;
#define RLX_AGENT __ATOMIC_RELAXED, __HIP_MEMORY_SCOPE_AGENT
#define LDS_WAIT() asm volatile("s_waitcnt lgkmcnt(0)" ::: "memory")
#define VM_WAIT() asm volatile("s_waitcnt vmcnt(0)" ::: "memory")
__device__ __forceinline__ unsigned f2bf(float f) { unsigned u = __builtin_bit_cast(unsigned, f); return (u + 0x7fffu + ((u >> 16) & 1u)) >> 16; }
__device__ __forceinline__ unsigned pk2(float lo, float hi) { return f2bf(lo) | (f2bf(hi) << 16); }
__device__ __forceinline__ float bf_lo(unsigned w) { return __builtin_bit_cast(float, w << 16); }
__device__ __forceinline__ float bf_hi(unsigned w) { return __builtin_bit_cast(float, w & 0xffff0000u); }
__device__ __forceinline__ float wave_sum(float v) {
#pragma unroll
    for (int o = 1; o < 64; o <<= 1) v += __shfl_xor(v, o);
    return v;
}
__device__ __forceinline__ float fsigm(float x) { return __builtin_amdgcn_rcpf(1.0f + __builtin_amdgcn_exp2f(x * -1.4426950408889634f)); }
__device__ __forceinline__ float gelu_tanh_f(float x) {
    const float u2 = 1.5957691216057308f * (x + 0.044715f * x * x * x);
    return x * fsigm(u2);
}

#define XB_TMO      128
#define XB_XCNT(j)  (256  + 64 * (j))
#define XB_XSUB(j)  (1280 + 64 * (j))
#define XB_XGEN(j)  (2304 + 64 * (j))
#define XB_TOP      3328
#define XB_TOPGEN   3392
#define XCD_BAR_WORDS 3456
#define XB_SPIN_CAP (1u << 18)

__device__ __forceinline__ unsigned xb_ld(unsigned* p)              { return __hip_atomic_load(p, __ATOMIC_RELAXED, __HIP_MEMORY_SCOPE_AGENT); }
__device__ __forceinline__ unsigned xb_add(unsigned* p, unsigned v) { return __hip_atomic_fetch_add(p, v, __ATOMIC_RELAXED, __HIP_MEMORY_SCOPE_AGENT); }
__device__ __forceinline__ unsigned xb_xcc_id() { return (unsigned)__builtin_amdgcn_s_getreg((3 << 11) | 20) & 0xFu; }
#define XB_SPIN(cond, bar) do { unsigned _sp = 0; while (cond) { __builtin_amdgcn_s_sleep(1); \
    if ((++_sp & 255u) == 0u) { if (xb_ld(&(bar)[XB_TMO])) break; if (_sp > XB_SPIN_CAP) { atomicAdd(&(bar)[XB_TMO], 1u); break; } } } } while (0)

struct XcdBarrier {
    unsigned* bar; unsigned x;
    volatile LAS unsigned* st;
};

__device__ __forceinline__ XcdBarrier xcd_barrier_post(unsigned* bar, volatile LAS unsigned* st) {
    XcdBarrier b; b.bar = bar; b.x = xb_xcc_id(); b.st = st;
    if (threadIdx.x == 0) (void)xb_add(&bar[XB_XCNT(b.x)], 1u);
    return b;
}
__device__ __forceinline__ void xcd_barrier_complete(unsigned* bar, unsigned x, unsigned& nloc, unsigned& nx) {
    const unsigned G = gridDim.x * gridDim.y * gridDim.z;
    unsigned sum, cnt, mine, sp = 0u;
    for (;;) {
        sum = 0u; cnt = 0u; mine = 0u;
#pragma unroll
        for (unsigned j = 0; j < 16; ++j) { const unsigned c = xb_ld(&bar[XB_XCNT(j)]); sum += c; cnt += (c > 0u) ? 1u : 0u; mine = (j == x) ? c : mine; }
        if (sum == G) break;
        __builtin_amdgcn_s_sleep(1);
        if ((++sp & 255u) == 0u) { if (xb_ld(&bar[XB_TMO])) break; if (sp > XB_SPIN_CAP) { atomicAdd(&bar[XB_TMO], 1u); break; } }
    }
    nloc = mine > 0u ? mine : 1u; nx = cnt > 0u ? cnt : 1u;
}

__device__ __forceinline__ void xcd_barrier(const XcdBarrier& b) {
    asm volatile("s_waitcnt vmcnt(0)" ::: "memory");
    __syncthreads();
    if (threadIdx.x == 0) {
        unsigned* bar = b.bar;
        __builtin_amdgcn_s_waitcnt(0);
        unsigned nloc = b.st[0], nx = b.st[1];
        if (nloc == 0u) { xcd_barrier_complete(bar, b.x, nloc, nx); b.st[0] = nloc; b.st[1] = nx; }
        const unsigned old = xb_add(&bar[XB_XSUB(b.x)], 1u);
        const unsigned gen = old / nloc;
        if (old + 1u == (gen + 1u) * nloc) {
            __builtin_amdgcn_fence(__ATOMIC_RELEASE, "agent");
            asm volatile("s_waitcnt vmcnt(0)" ::: "memory");
            const unsigned og = xb_add(&bar[XB_TOP], 1u);
            const unsigned tg = og / nx;
            if (og + 1u == (tg + 1u) * nx) xb_add(&bar[XB_TOPGEN], 1u);
            else XB_SPIN(xb_ld(&bar[XB_TOPGEN]) == tg, bar);
            __builtin_amdgcn_fence(__ATOMIC_ACQUIRE, "agent");
            xb_add(&bar[XB_XGEN(b.x)], 1u);
            asm volatile("s_waitcnt vmcnt(0)" ::: "memory");
        } else {
            XB_SPIN(xb_ld(&bar[XB_XGEN(b.x)]) == gen, bar);
            __builtin_amdgcn_fence(__ATOMIC_ACQUIRE, "agent");
            asm volatile("s_waitcnt vmcnt(0)" ::: "memory");
        }
    }
    __syncthreads();
}

__device__ __forceinline__ void p0_transpose_item(const float* W, int N, const float* gain, bf16* WT, int K, int out_row0, LAS float* scr, int k0, int n0, int lane) {
    const int kr = lane >> 3, nq = lane & 7;
#pragma unroll
    for (int i = 0; i < 8; ++i) { const int kk = 8 * i + kr; const f32x4 v = *(const GAS f32x4*)(W + (size_t)(k0 + kk) * N + n0 + 4 * nq);
        const float gk = gain ? gain[k0 + kk] : 1.0f; LAS float* d = scr + kk * 33 + 4 * nq; d[0] = v.x * gk; d[1] = v.y * gk; d[2] = v.z * gk; d[3] = v.w * gk; }
    LDS_WAIT(); asm volatile("" ::: "memory");
    const int c = lane & 7;
#pragma unroll
    for (int j = 0; j < 4; ++j) { const int n = (lane >> 3) + 8 * j; const LAS float* s = scr + (8 * c) * 33 + n;
        v4u o; o.x = pk2(s[0 * 33], s[1 * 33]); o.y = pk2(s[2 * 33], s[3 * 33]); o.z = pk2(s[4 * 33], s[5 * 33]); o.w = pk2(s[6 * 33], s[7 * 33]);
        *(GAS v4u*)(WT + (size_t)(out_row0 + n) * K + k0 + 8 * c) = o; }
    LDS_WAIT(); asm volatile("" ::: "memory");
}

struct P0Args {
    const float *xp, *xs, *norm_mix, *w_in, *w_glu, *gn_conv, *gn_ssm, *w_out, *norm_ffn, *w_gate, *w_up, *w_down;
    const float *A_re, *A_im, *log_dt, *B_re, *B_im, *C_re, *C_im;
    bf16 *WIN, *WGL, *WOUT, *WGU, *WDN, *XB; float* rx; unsigned char* tab;
};
__device__ __forceinline__ void p0_prologue(const P0Args& a, LAS unsigned char* lds, int vcu, int G, int wave, int lane, int tid) {
    LAS float* scr = (LAS float*)(lds + RING_OFF + wave * 16384);
    const int gw = vcu * NWAVES + wave, NGW = G * NWAVES;
    { const int gt = vcu * (NWAVES * 64) + tid;
      if (gt < NG * NP) { const int g = gt >> 6, p = gt & 63;
        const float ar = a.A_re[gt], ai = a.A_im[gt], dt = expf(a.log_dt[g]);
        const float th = dt * ai, e1 = expm1f(dt * ar), sh = sinf(0.5f * th), cm1 = -2.0f * sh * sh, cs = 1.0f + cm1;
        const float nr = e1 * cs + cm1, ni = (1.0f + e1) * sinf(th);
        const float abr = 1.0f + nr, abi = ni, den = ar * ar + ai * ai;
        const float kr = (nr * ar + ni * ai) / den, ki = (ni * ar - nr * ai) / den;
        float* AB = (float*)(a.tab + TAB_AB); AB[gt * 2] = abr; AB[gt * 2 + 1] = abi;
        bf16* BBT = (bf16*)(a.tab + TAB_BBT); bf16* CQ = (bf16*)(a.tab + TAB_CQ);
#pragma unroll
        for (int c = 0; c < 16; ++c) { const float br = a.B_re[(size_t)gt * CH + c], bi = a.B_im[(size_t)gt * CH + c];
            BBT[((size_t)(g * 2 + 0) * NP + p) * CH + c] = (bf16)f2bf(kr * br - ki * bi);
            BBT[((size_t)(g * 2 + 1) * NP + p) * CH + c] = (bf16)f2bf(kr * bi + ki * br);
            CQ[((size_t)g * CH + c) * 128 + 2 * p] = (bf16)f2bf(a.C_re[((size_t)g * CH + c) * NP + p]);
            CQ[((size_t)g * CH + c) * 128 + 2 * p + 1] = (bf16)f2bf(-a.C_im[((size_t)g * CH + c) * NP + p]); }
      } }
    constexpr int I_IN = (D / 64) * (DIN / 32), I_GL = (DS / 64) * (DS / 32), I_OUT = (D / 64) * (D / 32), I_GA = (D / 64) * (DFF / 32), I_DN = (DFF / 64) * (D / 32);
    constexpr int NITEMS = I_IN + I_GL + I_OUT + 2 * I_GA + I_DN;
    for (int it = gw; it < NITEMS; it += NGW) {
        int r = it;
        if (r < I_IN) { const int nb = r % (DIN / 32), kb = r / (DIN / 32), n0 = 32 * nb;
            int orow; if (n0 < 2048) { const int bjv = n0 >> 10, ch = n0 & 1023; orow = 256 * (ch >> 7) + 128 * bjv + (ch & 127); } else orow = n0;
            p0_transpose_item(a.w_in, DIN, a.norm_mix, a.WIN, D, orow, scr, 64 * kb, n0, lane); continue; } r -= I_IN;
        if (r < I_GL) { const int nb = r % (DS / 32), kb = r / (DS / 32);
            p0_transpose_item(a.w_glu, DS, nullptr, a.WGL, DS, 32 * nb, scr, 64 * kb, 32 * nb, lane); continue; } r -= I_GL;
        if (r < I_OUT) { const int nb = r % (D / 32), kb = r / (D / 32), k0 = 64 * kb;
            p0_transpose_item(a.w_out, D, k0 < 1024 ? a.gn_conv : a.gn_ssm - 1024, a.WOUT, D, 32 * nb, scr, k0, 32 * nb, lane); continue; } r -= I_OUT;
        if (r < I_GA) { const int nb = r % (DFF / 32), kb = r / (DFF / 32), n0 = 32 * nb;
            p0_transpose_item(a.w_gate, DFF, a.norm_ffn, a.WGU, D, 256 * (n0 >> 7) + (n0 & 127), scr, 64 * kb, n0, lane); continue; } r -= I_GA;
        if (r < I_GA) { const int nb = r % (DFF / 32), kb = r / (DFF / 32), n0 = 32 * nb;
            p0_transpose_item(a.w_up, DFF, a.norm_ffn, a.WGU, D, 256 * (n0 >> 7) + 128 + (n0 & 127), scr, 64 * kb, n0, lane); continue; } r -= I_GA;
        { const int nb = r % (D / 32), kb = r / (D / 32);
            p0_transpose_item(a.w_down, D, nullptr, a.WDN, DFF, 32 * nb, scr, 64 * kb, 32 * nb, lane); }
    }
    for (int row = gw; row < M; row += NGW) {
        const float* x = row < MP ? a.xp + (size_t)row * D : a.xs + (size_t)(row - MP) * D;
        const GAS f32x4* xr = (const GAS f32x4*)x + lane;
        f32x4 v[8]; float s = 0.f;
#pragma unroll
        for (int j = 0; j < 8; ++j) { v[j] = xr[64 * j]; s += (v[j].x * v[j].x + v[j].y * v[j].y) + (v[j].z * v[j].z + v[j].w * v[j].w); }
        s = wave_sum(s);
        if (lane == 0) a.rx[row] = 1.0f / sqrtf(s * (1.0f / D) + 1e-6f);
        GAS v2u* o8 = (GAS v2u*)(a.XB + (size_t)row * D) + lane;
#pragma unroll
        for (int j = 0; j < 8; ++j) { v2u o; o.x = pk2(v[j].x, v[j].y); o.y = pk2(v[j].z, v[j].w); o8[64 * j] = o; }
    }
}

struct P2Args {
    const bf16* UC; const bf16* SI; bf16* G; bf16* MIX;
    const float *state_conv, *h0re, *h0im, *conv_w, *conv_b, *ln_g, *ln_b, *Dk;
    const unsigned char* tab;
    float *ncp, *nrp, *nip, *ncs, *nrs, *nis;
};
constexpr int P2_RED_OFF = 0, P2_TILE_OFF = 4096, P2_TILE_B = 4352, P2_TROW = 272, P2_SX_OFF = 81920;

__device__ __forceinline__ void p2_conv(const P2Args& a, LAS unsigned char* lds, int vcu, int G, int wave, int lane, int tid) {
    LAS float* red = (LAS float*)(lds + P2_RED_OFF);
    LAS float* tot = red + 128;
    const int c0 = 2 * tid;
    f32x2 w[KW];
#pragma unroll
    for (int k = 0; k < KW; ++k) w[k] = *(const GAS f32x2*)(a.conv_w + k * DC + c0);
    const f32x2 bias = *(const GAS f32x2*)(a.conv_b + c0), lg = *(const GAS f32x2*)(a.ln_g + c0), lb = *(const GAS f32x2*)(a.ln_b + c0);
    for (int it = vcu; it < 1024 + DB; it += G) {
        int rowbase, t0; const float* hist = nullptr;
        if (it < 1024) { rowbase = (it >> 8) * SEQ; t0 = (it & 255) * 8; } else { const int b = it - 1024; rowbase = MP + b * DSQ; t0 = 0; hist = a.state_conv + (size_t)b * (KW - 1) * DC; }
        f32x2 acc[8];
#pragma unroll
        for (int j = 0; j < 8; ++j) acc[j] = bias;
#pragma unroll
        for (int r = 0; r < 8 + KW - 1; ++r) {
            const int tt = t0 - (KW - 1) + r; f32x2 v = {0.f, 0.f};
            if (tt >= 0) { const unsigned pk = *(const GAS unsigned*)(a.UC + (size_t)(rowbase + tt) * DC + c0); v.x = bf_lo(pk); v.y = bf_hi(pk); }
            else if (hist) v = *(const GAS f32x2*)(hist + (size_t)(tt + KW - 1) * DC + c0);
#pragma unroll
            for (int j = 0; j < 8; ++j) { const int k = r - j; if (k >= 0 && k < KW) acc[j] += w[k] * v; }
        }
        float st[16];
#pragma unroll
        for (int j = 0; j < 8; ++j) { st[j] = acc[j].x + acc[j].y; st[8 + j] = acc[j].x * acc[j].x + acc[j].y * acc[j].y; }
#pragma unroll
        for (int j = 0; j < 16; ++j) st[j] = wave_sum(st[j]);
        __syncthreads();
        if (lane == 0) {
#pragma unroll
            for (int j = 0; j < 16; ++j) red[wave * 16 + j] = st[j]; }
        __syncthreads();
        if (tid < 16) { float s = 0.f;
#pragma unroll
            for (int wv = 0; wv < 8; ++wv) s += red[wv * 16 + tid];
            tot[tid] = s; }
        __syncthreads();
        float q[8];
#pragma unroll
        for (int j = 0; j < 8; ++j) { const float mu = tot[j] * (1.0f / DC), var = tot[8 + j] * (1.0f / DC) - mu * mu, rs = 1.0f / sqrtf(var + 1e-6f);
            f32x2 y = (acc[j] - mu) * rs * lg + lb; y.x = y.x * fsigm(y.x); y.y = y.y * fsigm(y.y); acc[j] = y; q[j] = y.x * y.x + y.y * y.y; }
#pragma unroll
        for (int j = 0; j < 8; ++j) q[j] = wave_sum(q[j]);
        __syncthreads();
        if (lane == 0) {
#pragma unroll
            for (int j = 0; j < 8; ++j) red[wave * 16 + j] = q[j]; }
        __syncthreads();
        if (tid < 8) { float s = 0.f;
#pragma unroll
            for (int wv = 0; wv < 8; ++wv) s += red[wv * 16 + tid];
            tot[tid] = s; }
        __syncthreads();
#pragma unroll
        for (int j = 0; j < 8; ++j) { const float r2 = 1.0f / sqrtf(tot[j] * (1.0f / DC) + 1e-6f);
            *(GAS unsigned*)(a.MIX + (size_t)(rowbase + t0 + j) * D + c0) = pk2(acc[j].x * r2, acc[j].y * r2); }
    }
    __syncthreads();
}

__device__ __forceinline__ void p2_newconv(const P2Args& a, int vcu, int G, int tid) {
    constexpr int NPV = BATCH * (KW - 1) * (DC / 4), NSV = DB * (KW - 1) * (DC / 4);
    for (int idx = vcu * (NWAVES * 64) + tid; idx < NPV + NSV; idx += G * NWAVES * 64) {
        if (idx < NPV) { const int c4 = idx & 255, j = (idx >> 8) % (KW - 1), b = idx / ((KW - 1) * 256);
            const v2u pk = *(const GAS v2u*)(a.UC + (size_t)(b * SEQ + SEQ - (KW - 1) + j) * DC + 4 * c4);
            const f32x4 v = {bf_lo(pk.x), bf_hi(pk.x), bf_lo(pk.y), bf_hi(pk.y)};
            *(GAS f32x4*)(a.ncp + (size_t)idx * 4) = v; }
        else { const int k = idx - NPV; const int c4 = k & 255, j = (k >> 8) % (KW - 1), b = k / ((KW - 1) * 256); const int id = j + DSQ; f32x4 v;
            if (id < KW - 1) v = *(const GAS f32x4*)(a.state_conv + ((size_t)b * (KW - 1) + id) * DC + 4 * c4);
            else { const v2u pk = *(const GAS v2u*)(a.UC + (size_t)(MP + b * DSQ + id - (KW - 1)) * DC + 4 * c4); v = (f32x4){bf_lo(pk.x), bf_hi(pk.x), bf_lo(pk.y), bf_hi(pk.y)}; }
            *(GAS f32x4*)(a.ncs + (size_t)k * 4) = v; }
    }
}

#define SSM_STEP(i) do { \
        const float nAr = __builtin_fmaf(aAr, hAr, __builtin_fmaf(-aAi, hAi, d00[i])), nAi = __builtin_fmaf(aAr, hAi, __builtin_fmaf(aAi, hAr, d01[i])); \
        const float nBr = __builtin_fmaf(aBr, hBr, __builtin_fmaf(-aBi, hBi, d10[i])), nBi = __builtin_fmaf(aBr, hBi, __builtin_fmaf(aBi, hBr, d11[i])); \
        hAr = nAr; hAi = nAi; hBr = nBr; hBi = nBi; } while (0)
#define SSM_MFMA(afrag) do { const f32x16 z16 = {0.f,0.f,0.f,0.f,0.f,0.f,0.f,0.f,0.f,0.f,0.f,0.f,0.f,0.f,0.f,0.f}; \
        d00 = __builtin_amdgcn_mfma_f32_32x32x16_bf16(afrag, bfr[0][0], z16, 0, 0, 0); d01 = __builtin_amdgcn_mfma_f32_32x32x16_bf16(afrag, bfr[0][1], z16, 0, 0, 0); \
        d10 = __builtin_amdgcn_mfma_f32_32x32x16_bf16(afrag, bfr[1][0], z16, 0, 0, 0); d11 = __builtin_amdgcn_mfma_f32_32x32x16_bf16(afrag, bfr[1][1], z16, 0, 0, 0); } while (0)
#define SSM_EMIT(rowb0, rowb1) do { \
        LDS_WAIT(); __builtin_amdgcn_wave_barrier(); \
        _Pragma("unroll") for (int s_ = 0; s_ < 2; ++s_) { \
            f32x4 y_ = {0.f, 0.f, 0.f, 0.f}; \
            _Pragma("unroll") for (int ks = 0; ks < 4; ++ks) { const bf16x8 hf = *(const LAS bf16x8*)(tile + s_ * P2_TILE_B + (lane & 15) * P2_TROW + ks * 64 + (lane >> 4) * 16); \
                y_ = __builtin_amdgcn_mfma_f32_16x16x32_bf16(hf, cfr[ks], y_, 0, 0, 0); } \
            const int rb_ = s_ ? (rowb1) : (rowb0); \
            _Pragma("unroll") for (int i_ = 0; i_ < 4; ++i_) { const size_t o_ = (size_t)(rb_ + 4 * (lane >> 4) + i_) * DS + g * CH + (lane & 15); \
                const float u_ = __builtin_bit_cast(float, (unsigned)a.SI[o_] << 16); \
                a.G[o_] = (bf16)f2bf(gelu_tanh_f(y_[i_] + dsk * u_)); } } \
        LDS_WAIT(); __builtin_amdgcn_wave_barrier(); } while (0)
#define SSM_TILE_ROW(i) do { v2u hw_; hw_.x = pk2(hAr, hAi); hw_.y = pk2(hBr, hBi); *(LAS v2u*)(mytile + (i) * P2_TROW) = hw_; } while (0)

__device__ __forceinline__ void p2_ssm(const P2Args& a, LAS unsigned char* lds, int vcu, int G, int wave, int lane, int tid) {
    const int col = lane & 31, half = lane >> 5;
    const int r = lane & 31, s_r = (r >> 2) & 1, i_r = (r & 3) + 4 * (r >> 3), kc = lane >> 5;
    LAS unsigned char* tile = lds + P2_TILE_OFF + wave * 2 * P2_TILE_B;
    LAS unsigned char* mytile = tile + half * P2_TILE_B + col * 8;
    LAS f32x4* SX = (LAS f32x4*)(lds + P2_SX_OFF);
    for (int it = vcu; it < BATCH * NG; it += G) {
        const int g = it & (NG - 1), pb = it >> 6;
        const float* AB = (const float*)(a.tab + TAB_AB) + (size_t)(g * NP + 2 * col) * 2;
        const f32x4 ab4 = *(const GAS f32x4*)AB;
        const float aAr = ab4.x, aAi = ab4.y, aBr = ab4.z, aBi = ab4.w;
        bf16x8 bfr[2][2], cfr[4];
#pragma unroll
        for (int pair = 0; pair < 2; ++pair)
#pragma unroll
            for (int ri = 0; ri < 2; ++ri) bfr[pair][ri] = *(const GAS bf16x8*)((const bf16*)(a.tab + TAB_BBT) + ((size_t)(g * 2 + ri) * NP + 2 * col + pair) * CH + 8 * kc);
#pragma unroll
        for (int ks = 0; ks < 4; ++ks) cfr[ks] = *(const GAS bf16x8*)((const bf16*)(a.tab + TAB_CQ) + ((size_t)g * CH + (lane & 15)) * 128 + 32 * ks + 8 * (lane >> 4));
        const float dsk = a.Dk[g * CH + (lane & 15)];
        f32x16 d00, d01, d10, d11;
        {
            const bf16* abase = a.SI + (size_t)(pb * SEQ + (2 * wave + s_r) * 128 + i_r) * DS + g * CH + 8 * kc;
            float hAr = 0.f, hAi = 0.f, hBr = 0.f, hBi = 0.f;
            bf16x8 af = *(const GAS bf16x8*)abase;
#pragma unroll 1
            for (int blk = 0; blk < 8; ++blk) {
                const bf16x8 afn = *(const GAS bf16x8*)(abase + (size_t)((blk + 1) & 7) * 16 * DS);
                SSM_MFMA(af);
#pragma unroll
                for (int i = 0; i < 16; ++i) SSM_STEP(i);
                af = afn;
            }
            __syncthreads();
            SX[(2 * wave + half) * 32 + col] = (f32x4){hAr, hAi, hBr, hBi};
            __syncthreads();
            float pAr = aAr, pAi = aAi, pBr = aBr, pBi = aBi;
#pragma unroll
            for (int sq = 0; sq < 7; ++sq) { const float t0 = pAr * pAr - pAi * pAi, t1 = 2.0f * pAr * pAi, t2 = pBr * pBr - pBi * pBi, t3 = 2.0f * pBr * pBi; pAr = t0; pAi = t1; pBr = t2; pBi = t3; }
            hAr = 0.f; hAi = 0.f; hBr = 0.f; hBi = 0.f;
            const int mine = 2 * wave + half;
            for (int s2 = 0; s2 < mine; ++s2) { const f32x4 sv = SX[s2 * 32 + col];
                const float nAr = pAr * hAr - pAi * hAi + sv.x, nAi = pAr * hAi + pAi * hAr + sv.y, nBr = pBr * hBr - pBi * hBi + sv.z, nBi = pBr * hBi + pBi * hBr + sv.w;
                hAr = nAr; hAi = nAi; hBr = nBr; hBi = nBi; }
            af = *(const GAS bf16x8*)abase;
#pragma unroll 1
            for (int blk = 0; blk < 8; ++blk) {
                const bf16x8 afn = *(const GAS bf16x8*)(abase + (size_t)((blk + 1) & 7) * 16 * DS);
                SSM_MFMA(af);
#pragma unroll
                for (int i = 0; i < 16; ++i) { SSM_STEP(i); SSM_TILE_ROW(i); }
                const int rb = pb * SEQ + (2 * wave) * 128 + blk * 16;
                SSM_EMIT(rb, rb + 128);
                af = afn;
            }
            if (mine == 15) { const size_t o = ((size_t)pb * NG + g) * NP + 2 * col;
                *(GAS f32x2*)(a.nrp + o) = (f32x2){hAr, hBr}; *(GAS f32x2*)(a.nip + o) = (f32x2){hAi, hBi}; }
        }
        {
            const int bA_load = 32 * pb + 4 * wave + 2 * s_r, bA = 32 * pb + 4 * wave + 2 * half;
            const bf16x8 af = *(const GAS bf16x8*)(a.SI + (size_t)(MP + bA_load * DSQ + i_r) * DS + g * CH + 8 * kc);
            SSM_MFMA(af);
            size_t o = ((size_t)bA * NG + g) * NP + 2 * col;
            f32x2 t0 = *(const GAS f32x2*)(a.h0re + o), t1 = *(const GAS f32x2*)(a.h0im + o);
            float hAr = t0.x, hBr = t0.y, hAi = t1.x, hBi = t1.y;
#pragma unroll
            for (int i = 0; i < 8; ++i) { SSM_STEP(i); SSM_TILE_ROW(i); }
            *(GAS f32x2*)(a.nrs + o) = (f32x2){hAr, hBr}; *(GAS f32x2*)(a.nis + o) = (f32x2){hAi, hBi};
            o += (size_t)NG * NP;
            t0 = *(const GAS f32x2*)(a.h0re + o); t1 = *(const GAS f32x2*)(a.h0im + o);
            hAr = t0.x; hBr = t0.y; hAi = t1.x; hBi = t1.y;
#pragma unroll
            for (int i = 8; i < 16; ++i) { SSM_STEP(i); SSM_TILE_ROW(i); }
            *(GAS f32x2*)(a.nrs + o) = (f32x2){hAr, hBr}; *(GAS f32x2*)(a.nis + o) = (f32x2){hAi, hBi};
            const int rb = MP + (32 * pb + 4 * wave) * DSQ;
            SSM_EMIT(rb, rb + 16);
        }
    }
    __syncthreads();
}

struct Args { const float* in[28]; float* out; unsigned char* ws; int lo, hi, dryk, li; };
__global__ void __launch_bounds__(NWAVES * 64, 2) mk_fwd(Args args) {
    __shared__ __attribute__((aligned(16))) unsigned char lds_raw[LDS_BYTES];
    LAS unsigned char* lds = (LAS unsigned char*)lds_raw;
    volatile LAS unsigned* MISC = (volatile LAS unsigned*)(lds + MISC_OFF);
    const int tid = threadIdx.x, lane = tid & 63, wave = __builtin_amdgcn_readfirstlane(tid >> 6);
    const int G = gridDim.x; const int bx = blockIdx.x; const int vcu = (G % 8 == 0) ? (bx % 8) * (G / 8) + bx / 8 : bx;
    unsigned char* ws = args.ws;
    gu32* ctl = (gu32*)(ws + WS_CTL);
    for (int u = tid; u < (LDS_BYTES - LDSCTL_OFF) / 4; u += NWAVES * 64) ((LAS unsigned*)(lds + LDSCTL_OFF))[u] = 0u;
    __syncthreads();
    XcdBarrier bar; bar.bar = (unsigned*)(ctl + CW_BAR) + args.li * XCD_BAR_WORDS; bar.x = 0; bar.st = nullptr;
    if (N_LAUNCHES != NPH) bar = xcd_barrier_post((unsigned*)(ctl + CW_BAR) + args.li * XCD_BAR_WORDS, MISC + 8);
#define GRID_BAR(seam) do { if (N_LAUNCHES == NPH) { if (tid == 0) __hip_atomic_store(ctl + CW_TMO, 0xBADBA0u | (unsigned)(seam), RLX_AGENT); } else { xcd_barrier(bar); } } while (0)
    const int lo = args.lo, hi = args.hi, dryk = args.dryk;
#define DRY(k) (dryk == (k))
#ifndef ONLY_PHASE
#define ONLY_PHASE -1
#endif
#define IN(k) (ONLY_PHASE < 0 ? (lo <= (k) && (k) < hi) : (k) == ONLY_PHASE)
#define BOTH(k) (IN(k) && IN((k) + 1))
    float* out = args.out;
    float* Y = out;
    float* ncp = out + (size_t)M * D;
    float* nrp = ncp + (size_t)BATCH * (KW - 1) * DC;
    float* nip = nrp + (size_t)BATCH * NG * NP;
    float* ncs = nip + (size_t)BATCH * NG * NP;
    float* nrs = ncs + (size_t)DB * (KW - 1) * DC;
    float* nis = nrs + (size_t)DB * NG * NP;
    bf16 *WGU = (bf16*)(ws + WS_WGU), *WDN = (bf16*)(ws + WS_WDN), *XB = (bf16*)(ws + WS_XB), *WIN = (bf16*)(ws + WS_WIN), *WGL = (bf16*)(ws + WS_WGL), *WOUT = (bf16*)(ws + WS_WOUT);
    bf16 *UC = (bf16*)(ws + WS_U), *SI = (bf16*)(ws + WS_S), *GB = (bf16*)(ws + WS_G), *MIX = (bf16*)(ws + WS_MIX), *ACT = (bf16*)(ws + WS_ACT);
    float* ssq_dummy = (float*)(ws + WS_CTL) + CW_DUMMY;
    float* ssq_s = (float*)(ws + WS_CTL) + CW_SSQ_S; float* ssq_h = (float*)(ws + WS_CTL) + CW_SSQ_H; float* ssq_o = (float*)(ws + WS_CTL) + CW_SSQ_O; float* rx = (float*)(ws + WS_CTL) + CW_RX;
    const int gw = vcu * NWAVES + wave, NGW = G * NWAVES;

    if (IN(0)) {
        P0Args a; a.xp = args.in[0]; a.xs = args.in[1]; a.norm_mix = args.in[5]; a.w_in = args.in[6]; a.w_glu = args.in[19]; a.gn_conv = args.in[20]; a.gn_ssm = args.in[21]; a.w_out = args.in[22];
        a.norm_ffn = args.in[23]; a.w_gate = args.in[24]; a.w_up = args.in[25]; a.w_down = args.in[26];
        a.A_re = args.in[11]; a.A_im = args.in[12]; a.log_dt = args.in[13]; a.B_re = args.in[14]; a.B_im = args.in[15]; a.C_re = args.in[16]; a.C_im = args.in[17];
        a.WIN = WIN; a.WGL = WGL; a.WOUT = WOUT; a.WGU = WGU; a.WDN = WDN; a.XB = XB; a.rx = rx; a.tab = ws + WS_TAB;
        p0_prologue(a, lds, vcu, G, wave, lane, tid);
        if (BOTH(0)) GRID_BAR(0);
    }
    if (IN(1)) {
        pg8::Gemm g{XB, WIN, M, DIN, D};
#define SCHED(slot, slabo, N_, K_) typedef pg8::HybridOrder<N_, K_> Sch; Sch S; S.init((int)blockIdx.x, ws + (slabo), (unsigned*)(ctl + CW_FLAGS + (slot) * FLAG_SLOT), (unsigned*)(ctl + CW_TMO))
        SCHED(0, SLAB_P1, DIN, D);
        pg8::EpiIn E{UC, SI, rx};
        pg8::gemm_phase<pg8::EpiIn, Sch, true, true>(lds + RING_OFF, g, S, E);
        if (BOTH(1)) GRID_BAR(1);
    }
    if (IN(2)) {
        P2Args a; a.UC = UC; a.SI = SI; a.G = GB; a.MIX = MIX; a.state_conv = args.in[2]; a.h0re = args.in[3]; a.h0im = args.in[4];
        a.conv_w = args.in[7]; a.conv_b = args.in[8]; a.ln_g = args.in[9]; a.ln_b = args.in[10]; a.Dk = args.in[18]; a.tab = ws + WS_TAB;
        a.ncp = ncp; a.nrp = nrp; a.nip = nip; a.ncs = ncs; a.nrs = nrs; a.nis = nis;
        p2_ssm(a, lds, vcu, G, wave, lane, tid);
        p2_conv(a, lds, vcu, G, wave, lane, tid);
        p2_newconv(a, vcu, G, tid);
        if (BOTH(2)) GRID_BAR(2);
    }
    if (IN(3)) {
        pg8::Gemm g{GB, WGL, M, DS, DS}; SCHED(1, SLAB_P3, DS, DS);
        pg8::EpiGlu E{GB, MIX, DRY(3) ? ssq_dummy : ssq_s};
        pg8::gemm_phase<pg8::EpiGlu, Sch, true, true>(lds + RING_OFF, g, S, E);
        if (BOTH(3)) GRID_BAR(3);
    }
    if (IN(4)) {
        for (int row = gw; row < M; row += NGW) {
            const float r = DRY(4) ? 1.0f : 1.0f / sqrtf(__hip_atomic_load(ssq_s + row, RLX_AGENT) * (1.0f / DS) + 1e-6f);
            GAS v4u* p = (GAS v4u*)(MIX + (size_t)row * D + DC) + 2 * lane;
#pragma unroll
            for (int j = 0; j < 2; ++j) { v4u w = p[j]; w.x = pk2(bf_lo(w.x) * r, bf_hi(w.x) * r); w.y = pk2(bf_lo(w.y) * r, bf_hi(w.y) * r); w.z = pk2(bf_lo(w.z) * r, bf_hi(w.z) * r); w.w = pk2(bf_lo(w.w) * r, bf_hi(w.w) * r); p[j] = w; }
        }
        if (BOTH(4)) GRID_BAR(4);
    }
    if (IN(5)) {
        pg8::Gemm g{MIX, WOUT, M, D, D}; SCHED(2, SLAB_P5, D, D);
        pg8::EpiOut E{args.in[0], args.in[1], Y, XB, DRY(5) ? ssq_dummy : ssq_h};
        pg8::gemm_phase<pg8::EpiOut, Sch, true, true>(lds + RING_OFF, g, S, E);
        if (BOTH(5)) GRID_BAR(5);
    }
    if (IN(6)) {
        pg8::Gemm g{XB, WGU, M, 2 * DFF, D}; SCHED(3, SLAB_P6, 2 * DFF, D);
        pg8::EpiUp E{ACT, ssq_h};
        pg8::gemm_phase<pg8::EpiUp, Sch, true, true>(lds + RING_OFF, g, S, E);
        if (BOTH(6)) GRID_BAR(6);
    }
    if (IN(7)) {
        pg8::Gemm g{ACT, WDN, M, D, DFF}; SCHED(4, SLAB_P7, D, DFF);
        pg8::EpiDown E{Y, DRY(7) ? ssq_dummy : ssq_o, DRY(7) ? 0.0f : 1.0f};
        pg8::gemm_phase<pg8::EpiDown, Sch, true, true>(lds + RING_OFF, g, S, E);
        if (BOTH(7)) GRID_BAR(7);
    }
    if (IN(8)) {
        const float* gfin = args.in[27];
        for (int row = gw; row < M; row += NGW) {
            const float r = DRY(8) ? 1.0f : 1.0f / sqrtf(__hip_atomic_load(ssq_o + row, RLX_AGENT) * (1.0f / D) + 1e-6f);
            GAS f32x4* p = (GAS f32x4*)(Y + (size_t)row * D) + lane; const GAS f32x4* gp = (const GAS f32x4*)gfin + lane;
#pragma unroll
            for (int j = 0; j < 8; ++j) p[64 * j] = p[64 * j] * r * (DRY(8) ? (f32x4){1.f, 1.f, 1.f, 1.f} : gp[64 * j]);
        }
    }
#undef DRY
#undef IN
#undef BOTH
#undef GRID_BAR
}

extern "C" void kernel_launch(void* const* d_in, const int* in_sizes, int n_in, void* d_out, int out_size, void* d_ws, size_t ws_size, hipStream_t stream) {
    static int grid = 0;
    if (grid == 0) {
        const long want_out = (long)M * D + (long)(BATCH + DB) * ((KW - 1) * DC + 2 * NG * NP);
        if (n_in != 28 || in_sizes[0] != MP * D || (long)out_size != want_out || ws_size < WS_END) {
            fprintf(stderr, "kernel_launch: unexpected shapes (n_in %d, in0 %d, out %d (want %ld), ws %zu (need %zu)); nothing launched\n", n_in, n_in > 0 ? in_sizes[0] : -1, out_size, want_out, ws_size, (size_t)WS_END); grid = -1; return; }
        int dev = 0, cus = 0;
        if (hipGetDevice(&dev) != hipSuccess || hipDeviceGetAttribute(&cus, hipDeviceAttributeMultiprocessorCount, dev) != hipSuccess) { fprintf(stderr, "kernel_launch: device query failed\n"); grid = -1; return; }
        if (cus != 256) fprintf(stderr, "kernel_launch: built for 256 CUs, device has %d\n", cus);
        grid = 256;
    }
    if (grid < 0) return;
    if (hipMemsetAsync((char*)d_ws + WS_CTL, 0, CTL_ZERO_BYTES, stream) != hipSuccess) { fprintf(stderr, "kernel_launch: memset failed\n"); return; }
    Args a{};
    for (int i = 0; i < 28; ++i) a.in[i] = (const float*)d_in[i];
    a.out = (float*)d_out; a.ws = (unsigned char*)d_ws;
#ifdef PROBE_PHASE
    constexpr int NL = 2;
#else
    constexpr int NL = N_LAUNCHES;
#endif
    for (int li = 0; li < NL; ++li) {
        a.dryk = -1;
        if (N_LAUNCHES == NPH) { a.lo = li; a.hi = li + 1; } else { a.lo = 0; a.hi = NPH; }
#ifdef PROBE_PHASE
        if (li == 0) { a.lo = 0; a.hi = PROBE_PHASE + 1; } else { a.lo = PROBE_PHASE; a.hi = NPH; a.dryk = PROBE_PHASE; }
#endif
        a.li = li;
        hipLaunchKernelGGL(mk_fwd, dim3(grid), dim3(NWAVES * 64), 0, stream, a);
        const hipError_t le = hipPeekAtLastError();
        if (le != hipSuccess) { fprintf(stderr, "kernel_launch: launch %d failed: %s\n", li, hipGetErrorName(le)); break; }
    }
}
```

```cpp
#include <hip/hip_runtime.h>
#include <cstdio>
#include <cstdint>
#define MK_N_LAUNCHES 1
namespace pg8 {
#define PG8_LAS __attribute__((address_space(3)))
typedef unsigned short bf16_t;
typedef short bf16x8 __attribute__((ext_vector_type(8)));
typedef float f32x4 __attribute__((ext_vector_type(4)));
typedef unsigned u32x4 __attribute__((ext_vector_type(4)));
constexpr int BM = 256, BK = 64, HALF = 128, HTB = HALF * BK * 2  , STAGE_BYTES = 8 * HTB, NXCD = 8, WGM = 8;

__host__ __device__ __forceinline__ int lds_byte(int r, int c) { const int st = (r >> 4) * 2 + (c >> 5), rr = r & 15, cc = c & 31, ob = rr * 64 + cc * 2; return st * 1024 + (ob ^ (((ob >> 9) & 1) << 5)); }
__host__ __device__ __forceinline__ void stage_rc(int b, int& R, int& C) { const int st = b / 1024, sb = b % 1024, swz = sb ^ (((sb >> 9) & 1) << 5); R = (st >> 1) * 16 + swz / 64; C = (st & 1) * 32 + (swz % 64) / 2; }
__host__ __device__ __forceinline__ int perm32(int rho) { const int n = rho >> 4, i = rho & 15; return 8 * (i >> 2) + 4 * n + (i & 3); }

struct Unit { int pm, pn, k0, nt, mode, need; };
struct Gemm { const bf16_t* A; const bf16_t* Bt; int M, N, K; };

__device__ __forceinline__ unsigned cvt_pk_bf16(float lo, float hi) { unsigned r; asm volatile("v_cvt_pk_bf16_f32 %0, %1, %2" : "=v"(r) : "v"(lo), "v"(hi)); return r; }
template <class Epi, class Sched, bool ALIGN_EPI = false, bool SP2 = false>
__device__ __forceinline__ void gemm_phase(PG8_LAS unsigned char* lds, const Gemm g, Sched& S, const Epi& E) {
    const int tid = threadIdx.x, wid = __builtin_amdgcn_readfirstlane(tid >> 6), lane = tid & 63, wr = wid >> 2, wc = wid & 3, fr = lane & 15, fq = lane >> 4;
    constexpr int K = Sched::KK;
    unsigned voffA[2], voffB[2];
#pragma unroll
    for (int i = 0; i < 2; ++i) { int R, C; stage_rc(tid * 16 + i * 8192, R, C); const int Rb = Epi::PERM ? ((R & ~31) + perm32(R & 31)) : R;
        voffA[i] = (unsigned)(R * K + C) * 2u; voffB[i] = (unsigned)(Rb * K + C) * 2u; }
    const size_t kstep = (size_t)(BK * 2);
    const size_t hstep = (size_t)HALF * K * 2;
    const size_t tstep = 2 * hstep;
    const unsigned ldsw = (unsigned)wid * 1024u;
    const int aoff = lds_byte(wr * 64 + fr, fq * 8), boff = lds_byte(wc * 32 + fr, fq * 8);
#define PG8_SA(b, h) (((b) * 2 + (h)) * HTB)
#define PG8_SB(b, h) ((4 + (b) * 2 + (h)) * HTB)
#define PG8_STAGE(bufoff, gbase, voff) do { _Pragma("unroll") for (int _i = 0; _i < 2; ++_i) \
        __builtin_amdgcn_global_load_lds((const unsigned*)((const char*)(gbase) + (voff)[_i]), (PG8_LAS unsigned*)(lds + (bufoff) + ldsw + _i * 8192), 16, 0, 0); } while (0)
#define PG8_LDA(dst, b, h) do { _Pragma("unroll") for (int m = 0; m < 4; ++m) _Pragma("unroll") for (int k = 0; k < 2; ++k) dst[m][k] = *(const PG8_LAS bf16x8*)(lds + PG8_SA(b, h) + aoff + m * 2048 + k * 1024); } while (0)
#define PG8_LDB(dst, b, h) do { _Pragma("unroll") for (int n = 0; n < 2; ++n) _Pragma("unroll") for (int k = 0; k < 2; ++k) dst[n][k] = *(const PG8_LAS bf16x8*)(lds + PG8_SB(b, h) + boff + n * 2048 + k * 1024); } while (0)
#define PG8_MMA(ai, bj, At, Bt) do { __builtin_amdgcn_s_setprio(1); _Pragma("unroll") for (int m = 0; m < 4; ++m) _Pragma("unroll") for (int n = 0; n < 2; ++n) _Pragma("unroll") for (int k = 0; k < 2; ++k) \
        acc[ai][bj][m][n] = __builtin_amdgcn_mfma_f32_16x16x32_bf16(Bt[n][k], At[m][k], acc[ai][bj][m][n], 0, 0, 0); __builtin_amdgcn_s_setprio(0); } while (0)
#define PG8_WAIT_V(n) asm volatile("s_waitcnt vmcnt(" #n ")" ::: "memory")
#define PG8_WAIT_L(n) asm volatile("s_waitcnt lgkmcnt(" #n ")" ::: "memory")
#define PG8_BAR __builtin_amdgcn_s_barrier()
#define PG8_SCHED __builtin_amdgcn_sched_barrier(0)
    Unit cur, nxt; int ui = 0;
    if (!S.next(0, cur)) return;
    f32x4 acc[2][2][4][2];
#pragma unroll
    for (int a = 0; a < 2; ++a)
#pragma unroll
        for (int b = 0; b < 2; ++b)
#pragma unroll
            for (int m = 0; m < 4; ++m)
#pragma unroll
                for (int n = 0; n < 2; ++n) acc[a][b][m][n] = (f32x4){0.f, 0.f, 0.f, 0.f};
    bf16x8 At[4][2], B0[2][2], B1[2][2];
    const char* cA = (const char*)g.A + (size_t)cur.pm * tstep + (size_t)cur.k0 * kstep; const char* cB = (const char*)g.Bt + (size_t)cur.pn * tstep + (size_t)cur.k0 * kstep;
    S.a_ready(cur);
    if constexpr (SP2) {
        PG8_STAGE(PG8_SB(0, 0), cB, voffB); PG8_STAGE(PG8_SB(0, 1), cB + hstep, voffB); PG8_STAGE(PG8_SA(0, 0), cA, voffA); PG8_STAGE(PG8_SA(0, 1), cA + hstep, voffA);
        if (wr == 1) PG8_BAR;
        PG8_WAIT_V(2); PG8_BAR;
        PG8_STAGE(PG8_SB(1, 0), cB + kstep, voffB); PG8_STAGE(PG8_SA(1, 0), cA + kstep, voffA); PG8_STAGE(PG8_SB(1, 1), cB + hstep + kstep, voffB);
        PG8_WAIT_V(6); PG8_BAR;
    } else {
        PG8_STAGE(PG8_SB(0, 0), cB, voffB); PG8_STAGE(PG8_SA(0, 0), cA, voffA); PG8_STAGE(PG8_SB(0, 1), cB + hstep, voffB); PG8_STAGE(PG8_SA(0, 1), cA + hstep, voffA);
        if (wr == 1) PG8_BAR;
        PG8_WAIT_V(4); PG8_BAR;
        PG8_STAGE(PG8_SB(1, 0), cB + kstep, voffB); PG8_STAGE(PG8_SA(1, 0), cA + kstep, voffA); PG8_STAGE(PG8_SB(1, 1), cB + hstep + kstep, voffB);
        PG8_WAIT_V(6); PG8_BAR;
    }
    for (;;) {
        const bool has_next = S.next(ui + 1, nxt);
        const char* nA = has_next ? (const char*)g.A + (size_t)nxt.pm * tstep + (size_t)nxt.k0 * kstep : cA; const char* nB = has_next ? (const char*)g.Bt + (size_t)nxt.pn * tstep + (size_t)nxt.k0 * kstep : cB;
        const int nt = cur.nt;
        for (int t = 0; t < nt; t += 2) {
            const bool last = (t == nt - 2);
            const char* a1 = cA + (size_t)(t + 1) * kstep;
            const char* a2 = last ? nA : cA + (size_t)(t + 2) * kstep; const char* b2 = last ? nB : cB + (size_t)(t + 2) * kstep;
            const char* a3 = a2 + kstep; const char* b3 = b2 + kstep;
            if (last && has_next) S.a_ready(nxt);
            if constexpr (SP2) {
            PG8_LDB(B0, 0, 0); PG8_LDB(B1, 0, 1); PG8_SCHED; PG8_LDA(At, 0, 0); PG8_STAGE(PG8_SA(1, 1), a1 + hstep, voffA);
            PG8_WAIT_V(8); PG8_WAIT_L(0); PG8_BAR; PG8_MMA(0, 0, At, B0); PG8_MMA(0, 1, At, B1); PG8_BAR; PG8_SCHED;
            PG8_LDA(At, 0, 1); PG8_STAGE(PG8_SB(0, 0), b2, voffB); PG8_STAGE(PG8_SB(0, 1), b2 + hstep, voffB); PG8_STAGE(PG8_SA(0, 0), a2, voffA);
            PG8_WAIT_V(8); PG8_WAIT_L(0); PG8_BAR; PG8_MMA(1, 0, At, B0); PG8_MMA(1, 1, At, B1); PG8_BAR; PG8_SCHED;
            PG8_LDB(B0, 1, 0); PG8_LDB(B1, 1, 1); PG8_SCHED; PG8_LDA(At, 1, 0); PG8_STAGE(PG8_SA(0, 1), a2 + hstep, voffA);
            PG8_WAIT_V(8); PG8_WAIT_L(0); PG8_BAR; PG8_MMA(0, 0, At, B0); PG8_MMA(0, 1, At, B1); PG8_BAR; PG8_SCHED;
            PG8_LDA(At, 1, 1); PG8_STAGE(PG8_SB(1, 0), b3, voffB); PG8_STAGE(PG8_SB(1, 1), b3 + hstep, voffB); PG8_STAGE(PG8_SA(1, 0), a3, voffA);
            PG8_WAIT_V(8); PG8_WAIT_L(0); PG8_BAR; PG8_MMA(1, 0, At, B0); PG8_MMA(1, 1, At, B1); PG8_BAR; PG8_SCHED;
            } else {
            PG8_LDB(B0, 0, 0); PG8_SCHED; PG8_LDA(At, 0, 0); PG8_STAGE(PG8_SA(1, 1), a1 + hstep, voffA);
            PG8_WAIT_L(8); PG8_BAR; PG8_WAIT_L(0); PG8_MMA(0, 0, At, B0); PG8_BAR; PG8_SCHED;
            PG8_LDB(B1, 0, 1); PG8_STAGE(PG8_SB(0, 0), b2, voffB);
            PG8_BAR; PG8_WAIT_L(0); PG8_MMA(0, 1, At, B1); PG8_BAR;
            PG8_LDA(At, 0, 1); PG8_STAGE(PG8_SA(0, 0), a2, voffA);
            PG8_BAR; PG8_WAIT_L(0); PG8_MMA(1, 0, At, B0); PG8_BAR; PG8_SCHED;
            PG8_STAGE(PG8_SB(0, 1), b2 + hstep, voffB);
            PG8_WAIT_V(6); PG8_BAR; PG8_MMA(1, 1, At, B1); PG8_BAR;
            PG8_LDB(B0, 1, 0); PG8_SCHED; PG8_LDA(At, 1, 0); PG8_STAGE(PG8_SA(0, 1), a2 + hstep, voffA);
            PG8_WAIT_L(8); PG8_BAR; PG8_WAIT_L(0); PG8_MMA(0, 0, At, B0); PG8_BAR; PG8_SCHED;
            PG8_LDB(B1, 1, 1); PG8_STAGE(PG8_SB(1, 0), b3, voffB);
            PG8_BAR; PG8_WAIT_L(0); PG8_MMA(0, 1, At, B1); PG8_BAR;
            PG8_LDA(At, 1, 1); PG8_STAGE(PG8_SA(1, 0), a3, voffA);
            PG8_BAR; PG8_WAIT_L(0); PG8_MMA(1, 0, At, B0); PG8_BAR; PG8_SCHED;
            PG8_STAGE(PG8_SB(1, 1), b3 + hstep, voffB);
            PG8_WAIT_V(6); PG8_BAR; PG8_MMA(1, 1, At, B1); PG8_BAR;
            }
        }
        if constexpr (ALIGN_EPI) { if (wr == 0) PG8_BAR; }
        static_assert(ALIGN_EPI && !Epi::AFTER_DRAIN, "the slab exchange needs both halves aligned in the epilogue");
        S.finish(acc, cur, E, tid, wid, wr, wc, fr, fq);
        if (!has_next) break;
#pragma unroll
        for (int a = 0; a < 2; ++a)
#pragma unroll
            for (int b = 0; b < 2; ++b)
#pragma unroll
                for (int m = 0; m < 4; ++m)
#pragma unroll
                    for (int n = 0; n < 2; ++n) acc[a][b][m][n] = (f32x4){0.f, 0.f, 0.f, 0.f};
        cur = nxt; cA = nA; cB = nB; ++ui;
        if constexpr (ALIGN_EPI) { if (wr == 1) PG8_BAR; }
    }
    PG8_WAIT_V(0);
    if constexpr (!ALIGN_EPI) { if (wr == 0) PG8_BAR; }
    PG8_BAR;
    S.finish_last(acc, cur, E, tid, wid, wr, wc, fr, fq);
#undef PG8_SA
#undef PG8_SB
#undef PG8_STAGE
#undef PG8_LDA
#undef PG8_LDB
#undef PG8_MMA
#undef PG8_WAIT_V
#undef PG8_WAIT_L
#undef PG8_BAR
#undef PG8_SCHED
}
}

namespace pg8 {
constexpr float RMS_EPS = 1e-6f;
__device__ __forceinline__ float fsig(float x) { return __builtin_amdgcn_rcpf(1.0f + __builtin_amdgcn_exp2f(x * -1.4426950408889634f)); }
__device__ __forceinline__ float bflo(unsigned w) { return __builtin_bit_cast(float, w << 16); }
__device__ __forceinline__ float bfhi(unsigned w) { return __builtin_bit_cast(float, w & 0xffff0000u); }
__device__ __forceinline__ u32x4 pack8(const f32x4& a, const f32x4& b) { u32x4 w; w.x = cvt_pk_bf16(a[0], a[1]); w.y = cvt_pk_bf16(a[2], a[3]); w.z = cvt_pk_bf16(b[0], b[1]); w.w = cvt_pk_bf16(b[2], b[3]); return w; }
__device__ __forceinline__ float sq4(const f32x4& a) { return (a[0] * a[0] + a[1] * a[1]) + (a[2] * a[2] + a[3] * a[3]); }
__device__ __forceinline__ void row_atomic(float* p, float q, int fq) { q += __shfl_xor(q, 16); q += __shfl_xor(q, 32); if (fq == 0) (void)__hip_atomic_fetch_add(p, q, __ATOMIC_RELAXED, __HIP_MEMORY_SCOPE_AGENT); }


template <int N_, int K_> struct HybridOrder {
    static constexpr size_t SLAB_BYTES = (size_t)BM * BM * 2;
    static constexpr int KK = K_, G = 256, nM = 9216 / BM, nN = N_ / BM, ntp = K_ / (2 * BK), nwg = nM * nN, per = G / 8, q = nwg / 8, R = q / per, pairs = (q - R * per) * ntp, base = pairs / per, rem = pairs - base * per;
    static_assert(nwg % 8 == 0 && K_ % (2 * BK) == 0 && N_ % BM == 0, "HybridOrder shapes");
    int x, j, rend, cur, vcu;
    unsigned char* slab; unsigned* flags; unsigned* tmo;
    __device__ __forceinline__ void init(int bx, unsigned char* slab_, unsigned* flags_, unsigned* tmo_) {
        x = bx & 7; j = bx >> 3;
        cur = j * base + (j < rem ? j : rem); rend = cur + base + (j < rem ? 1 : 0);
        vcu = x * per + j; slab = slab_; flags = flags_; tmo = tmo_;
    }
    __device__ __forceinline__ void tile_of(int wgid, Unit& u) const {
        constexpr int nig = WGM * nN; const int gid = wgid / nig, fm = gid * WGM, gsz = (nM - fm) < WGM ? (nM - fm) : WGM;
        u.pm = fm + ((wgid % nig) % gsz); u.pn = (wgid % nig) / gsz;
    }
    __device__ __forceinline__ bool next(int i, Unit& u) {
        if (i < R) { tile_of(x * q + i * per + j, u); u.k0 = 0; u.nt = 2 * ntp; u.mode = 0; u.need = 0; return true; }
        if (cur >= rend) return false;
        const int t = cur / ntp, off = cur - t * ntp; int len = ntp - off; if (len > rend - cur) len = rend - cur;
        tile_of(x * q + R * per + t, u); u.k0 = 2 * off; u.nt = 2 * len; u.need = ntp - off - len;
        u.mode = off > 0 ? 1 : (u.need > 0 ? 2 : 0);
        cur += len; return true;
    }
    __device__ __forceinline__ void a_ready(const Unit&) const {}
    template <class Epi> __device__ __forceinline__ void finish(f32x4 (&acc)[2][2][4][2], const Unit& u, const Epi& E, int tid, int wid, int wr, int wc, int fr, int fq) const {
        asm volatile("" : "+v"(tid), "+v"(fr), "+v"(fq));
        if (u.mode == 1) {
            __amdgpu_buffer_rsrc_t rs = __builtin_amdgcn_make_buffer_rsrc(slab + (size_t)vcu * SLAB_BYTES, 0, (int)SLAB_BYTES, 0x00020000);
            const int vo = tid * 16;
#pragma unroll
            for (int ai = 0; ai < 2; ++ai)
#pragma unroll
                for (int bj = 0; bj < 2; ++bj)
#pragma unroll
                    for (int m = 0; m < 4; ++m) { __builtin_amdgcn_raw_buffer_store_b128(pack8(acc[ai][bj][m][0], acc[ai][bj][m][1]), rs, vo + (ai * 8 + bj * 4 + m) * 8192, 0, 16); asm volatile("" ::: "memory"); }
            asm volatile("s_waitcnt vmcnt(0)" ::: "memory");
            __builtin_amdgcn_s_barrier();
            if (tid == 0) __hip_atomic_store(flags + 64 * vcu, 1u, __ATOMIC_RELAXED, __HIP_MEMORY_SCOPE_AGENT);
            return;
        }
        if (u.mode == 2) return;
        E(acc, u, wr, wc, fr, fq);
    }
    template <class Epi> __device__ __forceinline__ void finish_last(f32x4 (&acc)[2][2][4][2], const Unit& u, const Epi& E, int tid, int wid, int wr, int wc, int fr, int fq) const {
        if (u.mode != 2) return;
        int ns = 0; { int need = u.need; for (int jj = j + 1; need > 0 && jj < per; ++jj) { const int len = base + (jj < rem ? 1 : 0); if (len == 0) break; need -= (len < need ? len : need); ++ns; } }
        if (wid == 0) {
            for (int k = 1; k <= ns; ++k) { unsigned sp = 0;
                while (__hip_atomic_load(flags + 64 * (vcu + k), __ATOMIC_RELAXED, __HIP_MEMORY_SCOPE_AGENT) == 0u) { __builtin_amdgcn_s_sleep(2);
                    if (++sp > (1u << 20)) { if (tid == 0) __hip_atomic_store(tmo, 0x5AB0u, __ATOMIC_RELAXED, __HIP_MEMORY_SCOPE_AGENT); break; } } }
            __builtin_amdgcn_fence(__ATOMIC_ACQUIRE, "agent"); asm volatile("s_waitcnt vmcnt(0)" ::: "memory");
        }
        asm volatile("" ::: "memory"); __builtin_amdgcn_s_barrier(); asm volatile("" ::: "memory");
        for (int k = 1; k <= ns; ++k) {
            const u32x4* sl = (const u32x4*)(slab + (size_t)(vcu + k) * SLAB_BYTES) + tid;
            u32x4 w[16];
#pragma unroll
            for (int i = 0; i < 16; ++i) w[i] = sl[i * 512];
#pragma unroll
            for (int ai = 0; ai < 2; ++ai)
#pragma unroll
                for (int bj = 0; bj < 2; ++bj)
#pragma unroll
                    for (int m = 0; m < 4; ++m) { const u32x4 v = w[ai * 8 + bj * 4 + m];
                        acc[ai][bj][m][0] += (f32x4){bflo(v.x), bfhi(v.x), bflo(v.y), bfhi(v.y)}; acc[ai][bj][m][1] += (f32x4){bflo(v.z), bfhi(v.z), bflo(v.w), bfhi(v.w)}; }
        }
        E(acc, u, wr, wc, fr, fq);
    }
};
struct EpiIn {
    static constexpr bool PERM = true, AFTER_DRAIN = false;
    bf16_t* U; bf16_t* S; const float* rx;
    __device__ __forceinline__ void operator()(const f32x4 (&acc)[2][2][4][2], const Unit& u, int wr, int wc, int fr, int fq) const {
        const int row0 = u.pm * BM + wr * 64 + fr;
        if (u.pn < 8) {
            const int col0 = u.pn * 128 + wc * 32 + 8 * fq;
#pragma unroll
            for (int ai = 0; ai < 2; ++ai)
#pragma unroll
                for (int m = 0; m < 4; ++m) { const int row = row0 + ai * HALF + m * 16; const float r = rx[row];
                    f32x4 v0, v1;
#pragma unroll
                    for (int j = 0; j < 4; ++j) { v0[j] = (acc[ai][0][m][0][j] * r) * fsig(acc[ai][1][m][0][j] * r); v1[j] = (acc[ai][0][m][1][j] * r) * fsig(acc[ai][1][m][1][j] * r); }
                    *(u32x4*)(U + (size_t)row * 1024 + col0) = pack8(v0, v1); }
        } else {
            const int col0 = (u.pn - 8) * 256 + wc * 32 + 8 * fq;
#pragma unroll
            for (int ai = 0; ai < 2; ++ai)
#pragma unroll
                for (int m = 0; m < 4; ++m) { const int row = row0 + ai * HALF + m * 16; const float r = rx[row];
#pragma unroll
                    for (int bj = 0; bj < 2; ++bj) *(u32x4*)(S + (size_t)row * 1024 + col0 + bj * HALF) = pack8(acc[ai][bj][m][0] * r, acc[ai][bj][m][1] * r); }
        }
    }
};
struct EpiGlu {
    static constexpr bool PERM = true, AFTER_DRAIN = false;
    const bf16_t* G; bf16_t* MIX; float* ssq;
    __device__ __forceinline__ void operator()(const f32x4 (&acc)[2][2][4][2], const Unit& u, int wr, int wc, int fr, int fq) const {
        const int row0 = u.pm * BM + wr * 64 + fr, col0 = u.pn * BM + wc * 32 + 8 * fq;
#pragma unroll
        for (int ai = 0; ai < 2; ++ai)
#pragma unroll
            for (int m = 0; m < 4; ++m) { const int row = row0 + ai * HALF + m * 16; float q = 0.f;
#pragma unroll
                for (int bj = 0; bj < 2; ++bj) { const u32x4 gw = *(const u32x4*)(G + (size_t)row * 1024 + col0 + bj * HALF);
                    f32x4 g0 = {bflo(gw.x), bfhi(gw.x), bflo(gw.y), bfhi(gw.y)}, g1 = {bflo(gw.z), bfhi(gw.z), bflo(gw.w), bfhi(gw.w)}, y0, y1;
#pragma unroll
                    for (int j = 0; j < 4; ++j) { y0[j] = g0[j] * fsig(acc[ai][bj][m][0][j]); y1[j] = g1[j] * fsig(acc[ai][bj][m][1][j]); }
                    q += sq4(y0) + sq4(y1);
                    *(u32x4*)(MIX + (size_t)row * 2048 + 1024 + col0 + bj * HALF) = pack8(y0, y1); }
                row_atomic(ssq + row, q, fq); }
    }
};
struct EpiOut {
    static constexpr bool PERM = true, AFTER_DRAIN = false;
    const float* xp; const float* xs; float* H; bf16_t* HB; float* ssq;
    __device__ __forceinline__ void operator()(const f32x4 (&acc)[2][2][4][2], const Unit& u, int wr, int wc, int fr, int fq) const {
        const int row0 = u.pm * BM + wr * 64 + fr, col0 = u.pn * BM + wc * 32 + 8 * fq;
        const float* xb = (u.pm < 32) ? xp : xs - (size_t)8192 * 2048;
#pragma unroll
        for (int ai = 0; ai < 2; ++ai)
#pragma unroll
            for (int m = 0; m < 4; ++m) { const int row = row0 + ai * HALF + m * 16; float q = 0.f;
#pragma unroll
                for (int bj = 0; bj < 2; ++bj) { const size_t off = (size_t)row * 2048 + col0 + bj * HALF;
                    const f32x4 h0 = *(const f32x4*)(xb + off) + acc[ai][bj][m][0], h1 = *(const f32x4*)(xb + off + 4) + acc[ai][bj][m][1];
                    q += sq4(h0) + sq4(h1);
                    *(f32x4*)(H + off) = h0; *(f32x4*)(H + off + 4) = h1; *(u32x4*)(HB + off) = pack8(h0, h1); }
                row_atomic(ssq + row, q, fq); }
    }
};
struct EpiUp {
    static constexpr bool PERM = true, AFTER_DRAIN = false;
    bf16_t* ACT; const float* ssq;
    __device__ __forceinline__ void operator()(const f32x4 (&acc)[2][2][4][2], const Unit& u, int wr, int wc, int fr, int fq) const {
        const int row0 = u.pm * BM + wr * 64 + fr, col0 = u.pn * 128 + wc * 32 + 8 * fq;
#pragma unroll
        for (int ai = 0; ai < 2; ++ai)
#pragma unroll
            for (int m = 0; m < 4; ++m) { const int row = row0 + ai * HALF + m * 16; const float r = __builtin_amdgcn_rsqf(ssq[row] * (1.0f / 2048.0f) + RMS_EPS);
                f32x4 v0, v1;
#pragma unroll
                for (int j = 0; j < 4; ++j) { const float a0 = acc[ai][0][m][0][j] * r, a1 = acc[ai][0][m][1][j] * r;
                    v0[j] = a0 * fsig(a0) * (acc[ai][1][m][0][j] * r); v1[j] = a1 * fsig(a1) * (acc[ai][1][m][1][j] * r); }
                *(u32x4*)(ACT + (size_t)row * 5632 + col0) = pack8(v0, v1); }
    }
};
struct EpiDown {
    static constexpr bool PERM = true, AFTER_DRAIN = false;
    float* H; float* ssq; float zmul;
    __device__ __forceinline__ void operator()(const f32x4 (&acc)[2][2][4][2], const Unit& u, int wr, int wc, int fr, int fq) const {
        const int row0 = u.pm * BM + wr * 64 + fr, col0 = u.pn * BM + wc * 32 + 8 * fq;
#pragma unroll
        for (int ai = 0; ai < 2; ++ai)
#pragma unroll
            for (int m = 0; m < 4; ++m) { const int row = row0 + ai * HALF + m * 16; float q = 0.f;
#pragma unroll
                for (int bj = 0; bj < 2; ++bj) { float* p = H + (size_t)row * 2048 + col0 + bj * HALF;
                    const f32x4 o0 = *(const f32x4*)p + acc[ai][bj][m][0] * zmul, o1 = *(const f32x4*)(p + 4) + acc[ai][bj][m][1] * zmul;
                    q += sq4(o0) + sq4(o1);
                    *(f32x4*)p = o0; *(f32x4*)(p + 4) = o1; }
                row_atomic(ssq + row, q, fq); }
    }
};
}

constexpr int NWAVES = 8;
#ifndef MK_N_LAUNCHES
#define MK_N_LAUNCHES 1
#endif
constexpr int NPH = 9;
constexpr int N_LAUNCHES = MK_N_LAUNCHES;

constexpr int D = 2048, DC = 1024, DS = 1024, DIN = 3072, DFF = 5632, NG = 64, NP = 64, CH = 16, KW = 31;
constexpr int BATCH = 4, SEQ = 2048, DB = 128, DSQ = 8;
constexpr int MP = BATCH * SEQ, MS = DB * DSQ, M = MP + MS;

constexpr size_t MiB = 1u << 20;
constexpr size_t WS_CTL = 0, CTL_ZERO_BYTES = 1 * MiB;
constexpr size_t WS_TAB = 1 * MiB;
constexpr size_t WS_WGU = 2 * MiB, WS_WDN = 46 * MiB, WS_XB = 68 * MiB;
constexpr size_t WS_WIN = 104 * MiB, WS_WGL = 116 * MiB, WS_WOUT = 118 * MiB;
constexpr size_t WS_U = 126 * MiB, WS_S = 144 * MiB, WS_G = 162 * MiB, WS_MIX = 180 * MiB;
constexpr size_t WS_ACT = 104 * MiB;
constexpr size_t WS_END = 235 * MiB;
constexpr size_t SLAB_P1 = 162 * MiB, SLAB_P3 = 126 * MiB, SLAB_P5 = 126 * MiB, SLAB_P6 = 203 * MiB, SLAB_P7 = 2 * MiB;
static_assert(WS_WGU + (size_t)2 * DFF * D * 2 <= WS_WDN && WS_WDN + (size_t)D * DFF * 2 <= WS_XB && WS_XB + (size_t)M * D * 2 <= WS_WIN, "ws map 1");
static_assert(WS_WIN + (size_t)DIN * D * 2 <= WS_WGL && WS_WGL + (size_t)DS * DS * 2 <= WS_WOUT && WS_WOUT + (size_t)D * D * 2 <= WS_U, "ws map 2");
static_assert(WS_U + (size_t)M * DC * 2 <= WS_S && WS_S + (size_t)M * DS * 2 <= WS_G && WS_G + (size_t)M * DS * 2 <= WS_MIX && WS_MIX + (size_t)M * D * 2 <= WS_END, "ws map 3");
static_assert(WS_ACT + (size_t)M * DFF * 2 <= SLAB_P6 && SLAB_P6 + 32 * MiB <= WS_END && WS_END <= 256 * MiB, "ws map 4");
constexpr int CW_TMO = 0, CW_CODE = 1;
constexpr int CW_BAR = 4096;
constexpr int CW_SSQ_S = 16384, CW_SSQ_H = CW_SSQ_S + M, CW_SSQ_O = CW_SSQ_H + M;
constexpr int CW_DUMMY = CW_SSQ_O + M;
constexpr int CW_FLAGS = 81920, FLAG_SLOT = 16384;
constexpr int CW_RX = 65536;
static_assert((CW_RX + M) * 4 <= (int)CTL_ZERO_BYTES && CW_DUMMY + M <= CW_RX, "ctl map");
constexpr size_t TAB_AB = 0;
constexpr size_t TAB_BBT = 64 * 1024;
constexpr size_t TAB_CQ = 512 * 1024;

constexpr int RING_OFF = 0, RING_BYTES = 131072;
constexpr int LDSCTL_OFF = RING_BYTES, MISC_OFF = LDSCTL_OFF + 320;
constexpr int LDS_BYTES = 147456;
static_assert(MISC_OFF + 128 <= LDS_BYTES, "LDS map");

#define GAS __attribute__((address_space(1)))
#define LAS __attribute__((address_space(3)))
typedef unsigned short bf16;
typedef unsigned v4u __attribute__((ext_vector_type(4)));
typedef unsigned v2u __attribute__((ext_vector_type(2)));
typedef float f32x4 __attribute__((ext_vector_type(4)));
typedef float f32x2 __attribute__((ext_vector_type(2)));
typedef float f32x16 __attribute__((ext_vector_type(16)));
typedef short bf16x8 __attribute__((ext_vector_type(8)));
typedef GAS unsigned gu32;
#define RLX_AGENT __ATOMIC_RELAXED, __HIP_MEMORY_SCOPE_AGENT
#define LDS_WAIT() asm volatile("s_waitcnt lgkmcnt(0)" ::: "memory")
#define VM_WAIT() asm volatile("s_waitcnt vmcnt(0)" ::: "memory")
__device__ __forceinline__ unsigned f2bf(float f) { unsigned u = __builtin_bit_cast(unsigned, f); return (u + 0x7fffu + ((u >> 16) & 1u)) >> 16; }
__device__ __forceinline__ unsigned pk2(float lo, float hi) { return f2bf(lo) | (f2bf(hi) << 16); }
__device__ __forceinline__ float bf_lo(unsigned w) { return __builtin_bit_cast(float, w << 16); }
__device__ __forceinline__ float bf_hi(unsigned w) { return __builtin_bit_cast(float, w & 0xffff0000u); }
__device__ __forceinline__ float wave_sum(float v) {
#pragma unroll
    for (int o = 1; o < 64; o <<= 1) v += __shfl_xor(v, o);
    return v;
}
__device__ __forceinline__ float fsigm(float x) { return __builtin_amdgcn_rcpf(1.0f + __builtin_amdgcn_exp2f(x * -1.4426950408889634f)); }
__device__ __forceinline__ float gelu_tanh_f(float x) {
    const float u2 = 1.5957691216057308f * (x + 0.044715f * x * x * x);
    return x * fsigm(u2);
}

#define XB_TMO      128
#define XB_XCNT(j)  (256  + 64 * (j))
#define XB_XSUB(j)  (1280 + 64 * (j))
#define XB_XGEN(j)  (2304 + 64 * (j))
#define XB_TOP      3328
#define XB_TOPGEN   3392
#define XCD_BAR_WORDS 3456
#define XB_SPIN_CAP (1u << 18)

__device__ __forceinline__ unsigned xb_ld(unsigned* p)              { return __hip_atomic_load(p, __ATOMIC_RELAXED, __HIP_MEMORY_SCOPE_AGENT); }
__device__ __forceinline__ unsigned xb_add(unsigned* p, unsigned v) { return __hip_atomic_fetch_add(p, v, __ATOMIC_RELAXED, __HIP_MEMORY_SCOPE_AGENT); }
__device__ __forceinline__ unsigned xb_xcc_id() { return (unsigned)__builtin_amdgcn_s_getreg((3 << 11) | 20) & 0xFu; }
#define XB_SPIN(cond, bar) do { unsigned _sp = 0; while (cond) { __builtin_amdgcn_s_sleep(1); \
    if ((++_sp & 255u) == 0u) { if (xb_ld(&(bar)[XB_TMO])) break; if (_sp > XB_SPIN_CAP) { atomicAdd(&(bar)[XB_TMO], 1u); break; } } } } while (0)

struct XcdBarrier {
    unsigned* bar; unsigned x;
    volatile LAS unsigned* st;
};

__device__ __forceinline__ XcdBarrier xcd_barrier_post(unsigned* bar, volatile LAS unsigned* st) {
    XcdBarrier b; b.bar = bar; b.x = xb_xcc_id(); b.st = st;
    if (threadIdx.x == 0) (void)xb_add(&bar[XB_XCNT(b.x)], 1u);
    return b;
}
__device__ __forceinline__ void xcd_barrier_complete(unsigned* bar, unsigned x, unsigned& nloc, unsigned& nx) {
    const unsigned G = gridDim.x * gridDim.y * gridDim.z;
    unsigned sum, cnt, mine, sp = 0u;
    for (;;) {
        sum = 0u; cnt = 0u; mine = 0u;
#pragma unroll
        for (unsigned j = 0; j < 16; ++j) { const unsigned c = xb_ld(&bar[XB_XCNT(j)]); sum += c; cnt += (c > 0u) ? 1u : 0u; mine = (j == x) ? c : mine; }
        if (sum == G) break;
        __builtin_amdgcn_s_sleep(1);
        if ((++sp & 255u) == 0u) { if (xb_ld(&bar[XB_TMO])) break; if (sp > XB_SPIN_CAP) { atomicAdd(&bar[XB_TMO], 1u); break; } }
    }
    nloc = mine > 0u ? mine : 1u; nx = cnt > 0u ? cnt : 1u;
}

__device__ __forceinline__ void xcd_barrier(const XcdBarrier& b) {
    asm volatile("s_waitcnt vmcnt(0)" ::: "memory");
    __syncthreads();
    if (threadIdx.x == 0) {
        unsigned* bar = b.bar;
        __builtin_amdgcn_s_waitcnt(0);
        unsigned nloc = b.st[0], nx = b.st[1];
        if (nloc == 0u) { xcd_barrier_complete(bar, b.x, nloc, nx); b.st[0] = nloc; b.st[1] = nx; }
        const unsigned old = xb_add(&bar[XB_XSUB(b.x)], 1u);
        const unsigned gen = old / nloc;
        if (old + 1u == (gen + 1u) * nloc) {
            __builtin_amdgcn_fence(__ATOMIC_RELEASE, "agent");
            asm volatile("s_waitcnt vmcnt(0)" ::: "memory");
            const unsigned og = xb_add(&bar[XB_TOP], 1u);
            const unsigned tg = og / nx;
            if (og + 1u == (tg + 1u) * nx) xb_add(&bar[XB_TOPGEN], 1u);
            else XB_SPIN(xb_ld(&bar[XB_TOPGEN]) == tg, bar);
            __builtin_amdgcn_fence(__ATOMIC_ACQUIRE, "agent");
            xb_add(&bar[XB_XGEN(b.x)], 1u);
            asm volatile("s_waitcnt vmcnt(0)" ::: "memory");
        } else {
            XB_SPIN(xb_ld(&bar[XB_XGEN(b.x)]) == gen, bar);
            __builtin_amdgcn_fence(__ATOMIC_ACQUIRE, "agent");
            asm volatile("s_waitcnt vmcnt(0)" ::: "memory");
        }
    }
    __syncthreads();
}

__device__ __forceinline__ void p0_transpose_item(const float* W, int N, const float* gain, bf16* WT, int K, int out_row0, LAS float* scr, int k0, int n0, int lane) {
    const int kr = lane >> 3, nq = lane & 7;
#pragma unroll
    for (int i = 0; i < 8; ++i) { const int kk = 8 * i + kr; const f32x4 v = *(const GAS f32x4*)(W + (size_t)(k0 + kk) * N + n0 + 4 * nq);
        const float gk = gain ? gain[k0 + kk] : 1.0f; LAS float* d = scr + kk * 33 + 4 * nq; d[0] = v.x * gk; d[1] = v.y * gk; d[2] = v.z * gk; d[3] = v.w * gk; }
    LDS_WAIT(); asm volatile("" ::: "memory");
    const int c = lane & 7;
#pragma unroll
    for (int j = 0; j < 4; ++j) { const int n = (lane >> 3) + 8 * j; const LAS float* s = scr + (8 * c) * 33 + n;
        v4u o; o.x = pk2(s[0 * 33], s[1 * 33]); o.y = pk2(s[2 * 33], s[3 * 33]); o.z = pk2(s[4 * 33], s[5 * 33]); o.w = pk2(s[6 * 33], s[7 * 33]);
        *(GAS v4u*)(WT + (size_t)(out_row0 + n) * K + k0 + 8 * c) = o; }
    LDS_WAIT(); asm volatile("" ::: "memory");
}

struct P0Args {
    const float *xp, *xs, *norm_mix, *w_in, *w_glu, *gn_conv, *gn_ssm, *w_out, *norm_ffn, *w_gate, *w_up, *w_down;
    const float *A_re, *A_im, *log_dt, *B_re, *B_im, *C_re, *C_im;
    bf16 *WIN, *WGL, *WOUT, *WGU, *WDN, *XB; float* rx; unsigned char* tab;
};
__device__ __forceinline__ void p0_prologue(const P0Args& a, LAS unsigned char* lds, int vcu, int G, int wave, int lane, int tid) {
    LAS float* scr = (LAS float*)(lds + RING_OFF + wave * 16384);
    const int gw = vcu * NWAVES + wave, NGW = G * NWAVES;
    { const int gt = vcu * (NWAVES * 64) + tid;
      if (gt < NG * NP) { const int g = gt >> 6, p = gt & 63;
        const float ar = a.A_re[gt], ai = a.A_im[gt], dt = expf(a.log_dt[g]);
        const float th = dt * ai, e1 = expm1f(dt * ar), sh = sinf(0.5f * th), cm1 = -2.0f * sh * sh, cs = 1.0f + cm1;
        const float nr = e1 * cs + cm1, ni = (1.0f + e1) * sinf(th);
        const float abr = 1.0f + nr, abi = ni, den = ar * ar + ai * ai;
        const float kr = (nr * ar + ni * ai) / den, ki = (ni * ar - nr * ai) / den;
        float* AB = (float*)(a.tab + TAB_AB); AB[gt * 2] = abr; AB[gt * 2 + 1] = abi;
        bf16* BBT = (bf16*)(a.tab + TAB_BBT); bf16* CQ = (bf16*)(a.tab + TAB_CQ);
#pragma unroll
        for (int c = 0; c < 16; ++c) { const float br = a.B_re[(size_t)gt * CH + c], bi = a.B_im[(size_t)gt * CH + c];
            BBT[((size_t)(g * 2 + 0) * NP + p) * CH + c] = (bf16)f2bf(kr * br - ki * bi);
            BBT[((size_t)(g * 2 + 1) * NP + p) * CH + c] = (bf16)f2bf(kr * bi + ki * br);
            CQ[((size_t)g * CH + c) * 128 + 2 * p] = (bf16)f2bf(a.C_re[((size_t)g * CH + c) * NP + p]);
            CQ[((size_t)g * CH + c) * 128 + 2 * p + 1] = (bf16)f2bf(-a.C_im[((size_t)g * CH + c) * NP + p]); }
      } }
    constexpr int I_IN = (D / 64) * (DIN / 32), I_GL = (DS / 64) * (DS / 32), I_OUT = (D / 64) * (D / 32), I_GA = (D / 64) * (DFF / 32), I_DN = (DFF / 64) * (D / 32);
    constexpr int NITEMS = I_IN + I_GL + I_OUT + 2 * I_GA + I_DN;
    for (int it = gw; it < NITEMS; it += NGW) {
        int r = it;
        if (r < I_IN) { const int nb = r % (DIN / 32), kb = r / (DIN / 32), n0 = 32 * nb;
            int orow; if (n0 < 2048) { const int bjv = n0 >> 10, ch = n0 & 1023; orow = 256 * (ch >> 7) + 128 * bjv + (ch & 127); } else orow = n0;
            p0_transpose_item(a.w_in, DIN, a.norm_mix, a.WIN, D, orow, scr, 64 * kb, n0, lane); continue; } r -= I_IN;
        if (r < I_GL) { const int nb = r % (DS / 32), kb = r / (DS / 32);
            p0_transpose_item(a.w_glu, DS, nullptr, a.WGL, DS, 32 * nb, scr, 64 * kb, 32 * nb, lane); continue; } r -= I_GL;
        if (r < I_OUT) { const int nb = r % (D / 32), kb = r / (D / 32), k0 = 64 * kb;
            p0_transpose_item(a.w_out, D, k0 < 1024 ? a.gn_conv : a.gn_ssm - 1024, a.WOUT, D, 32 * nb, scr, k0, 32 * nb, lane); continue; } r -= I_OUT;
        if (r < I_GA) { const int nb = r % (DFF / 32), kb = r / (DFF / 32), n0 = 32 * nb;
            p0_transpose_item(a.w_gate, DFF, a.norm_ffn, a.WGU, D, 256 * (n0 >> 7) + (n0 & 127), scr, 64 * kb, n0, lane); continue; } r -= I_GA;
        if (r < I_GA) { const int nb = r % (DFF / 32), kb = r / (DFF / 32), n0 = 32 * nb;
            p0_transpose_item(a.w_up, DFF, a.norm_ffn, a.WGU, D, 256 * (n0 >> 7) + 128 + (n0 & 127), scr, 64 * kb, n0, lane); continue; } r -= I_GA;
        { const int nb = r % (D / 32), kb = r / (D / 32);
            p0_transpose_item(a.w_down, D, nullptr, a.WDN, DFF, 32 * nb, scr, 64 * kb, 32 * nb, lane); }
    }
    for (int row = gw; row < M; row += NGW) {
        const float* x = row < MP ? a.xp + (size_t)row * D : a.xs + (size_t)(row - MP) * D;
        const GAS f32x4* xr = (const GAS f32x4*)x + lane;
        f32x4 v[8]; float s = 0.f;
#pragma unroll
        for (int j = 0; j < 8; ++j) { v[j] = xr[64 * j]; s += (v[j].x * v[j].x + v[j].y * v[j].y) + (v[j].z * v[j].z + v[j].w * v[j].w); }
        s = wave_sum(s);
        if (lane == 0) a.rx[row] = 1.0f / sqrtf(s * (1.0f / D) + 1e-6f);
        GAS v2u* o8 = (GAS v2u*)(a.XB + (size_t)row * D) + lane;
#pragma unroll
        for (int j = 0; j < 8; ++j) { v2u o; o.x = pk2(v[j].x, v[j].y); o.y = pk2(v[j].z, v[j].w); o8[64 * j] = o; }
    }
}

struct P2Args {
    const bf16* UC; const bf16* SI; bf16* G; bf16* MIX;
    const float *state_conv, *h0re, *h0im, *conv_w, *conv_b, *ln_g, *ln_b, *Dk;
    const unsigned char* tab;
    float *ncp, *nrp, *nip, *ncs, *nrs, *nis;
};
constexpr int P2_RED_OFF = 0, P2_TILE_OFF = 4096, P2_TILE_B = 4352, P2_TROW = 272, P2_UT_OFF = 73728, P2_SX_OFF = 81920;
__device__ __forceinline__ unsigned cvtpk(float lo, float hi) { unsigned r; asm("v_cvt_pk_bf16_f32 %0, %1, %2" : "=v"(r) : "v"(lo), "v"(hi)); return r; }

#define CONV_LOAD_ROWS(rows, it_) do { \
        int rowbase_, t0_; const float* hist_ = nullptr; \
        if ((it_) < 1024) { rowbase_ = ((it_) >> 8) * SEQ; t0_ = ((it_) & 255) * 8; } else { const int b_ = (it_) - 1024; rowbase_ = MP + b_ * DSQ; t0_ = 0; hist_ = a.state_conv + (size_t)b_ * (KW - 1) * DC; } \
        _Pragma("unroll") for (int r_ = 0; r_ < 8 + KW - 1; ++r_) { const int tt_ = t0_ - (KW - 1) + r_; \
            if (tt_ >= 0) rows[r_] = *(const GAS unsigned*)(a.UC + (size_t)(rowbase_ + tt_) * DC + c0); \
            else if (hist_) { const f32x2 hv_ = *(const GAS f32x2*)(hist_ + (size_t)(tt_ + KW - 1) * DC + c0); rows[r_] = cvtpk(hv_.x, hv_.y); } \
            else rows[r_] = 0u; } } while (0)

__device__ __forceinline__ void p2_conv(const P2Args& a, LAS unsigned char* lds, int vcu, int G, int wave, int lane, int tid) {
    LAS float* red = (LAS float*)(lds + P2_RED_OFF);
    LAS float* tot = red + 256;
    const int c0 = 2 * tid;
    f32x2 w[KW];
#pragma unroll
    for (int k = 0; k < KW; ++k) w[k] = *(const GAS f32x2*)(a.conv_w + k * DC + c0);
    const f32x2 bias = *(const GAS f32x2*)(a.conv_b + c0), lg = *(const GAS f32x2*)(a.ln_g + c0), lb = *(const GAS f32x2*)(a.ln_b + c0);
    unsigned rows[8 + KW - 1], rowsN[8 + KW - 1];
    if (vcu < 1024 + DB) CONV_LOAD_ROWS(rows, vcu);
    for (int it = vcu; it < 1024 + DB; it += G) {
        const int itn = it + G;
        if (itn < 1024 + DB) CONV_LOAD_ROWS(rowsN, itn);
        const int orow = it < 1024 ? (it >> 8) * SEQ + (it & 255) * 8 : MP + (it - 1024) * DSQ;
        f32x2 acc[8];
#pragma unroll
        for (int j = 0; j < 8; ++j) acc[j] = bias;
#pragma unroll
        for (int r = 0; r < 8 + KW - 1; ++r) {
            const f32x2 v = {bf_lo(rows[r]), bf_hi(rows[r])};
#pragma unroll
            for (int j = 0; j < 8; ++j) { const int k = r - j; if (k >= 0 && k < KW) acc[j] += w[k] * v; }
        }
        float st[16];
#pragma unroll
        for (int j = 0; j < 8; ++j) { st[j] = acc[j].x + acc[j].y; st[8 + j] = acc[j].x * acc[j].x + acc[j].y * acc[j].y; }
#pragma unroll
        for (int j = 0; j < 16; ++j) st[j] = wave_sum(st[j]);
        if (lane == 0) {
#pragma unroll
            for (int j = 0; j < 16; ++j) red[wave * 16 + j] = st[j]; }
        __syncthreads();
        if (tid < 16) { float s = 0.f;
#pragma unroll
            for (int wv = 0; wv < 8; ++wv) s += red[wv * 16 + tid];
            tot[tid] = s; }
        __syncthreads();
        float q[8];
#pragma unroll
        for (int j = 0; j < 8; ++j) { const float mu = tot[j] * (1.0f / DC), var = tot[8 + j] * (1.0f / DC) - mu * mu, rs = __builtin_amdgcn_rsqf(var + 1e-6f);
            f32x2 y = (acc[j] - mu) * rs * lg + lb; y.x = y.x * fsigm(y.x); y.y = y.y * fsigm(y.y); acc[j] = y; q[j] = y.x * y.x + y.y * y.y; }
#pragma unroll
        for (int j = 0; j < 8; ++j) q[j] = wave_sum(q[j]);
        if (lane == 0) {
#pragma unroll
            for (int j = 0; j < 8; ++j) red[128 + wave * 16 + j] = q[j]; }
        __syncthreads();
        if (tid < 8) { float s = 0.f;
#pragma unroll
            for (int wv = 0; wv < 8; ++wv) s += red[128 + wv * 16 + tid];
            tot[16 + tid] = s; }
        __syncthreads();
#pragma unroll
        for (int j = 0; j < 8; ++j) { const float r2 = __builtin_amdgcn_rsqf(tot[16 + j] * (1.0f / DC) + 1e-6f);
            *(GAS unsigned*)(a.MIX + (size_t)(orow + j) * D + c0) = cvtpk(acc[j].x * r2, acc[j].y * r2); }
#pragma unroll
        for (int r = 0; r < 8 + KW - 1; ++r) rows[r] = rowsN[r];
    }
    __syncthreads();
}

__device__ __forceinline__ void p2_newconv(const P2Args& a, int vcu, int G, int tid) {
    constexpr int NPV = BATCH * (KW - 1) * (DC / 4), NSV = DB * (KW - 1) * (DC / 4);
    for (int idx = vcu * (NWAVES * 64) + tid; idx < NPV + NSV; idx += G * NWAVES * 64) {
        if (idx < NPV) { const int c4 = idx & 255, j = (idx >> 8) % (KW - 1), b = idx / ((KW - 1) * 256);
            const v2u pk = *(const GAS v2u*)(a.UC + (size_t)(b * SEQ + SEQ - (KW - 1) + j) * DC + 4 * c4);
            const f32x4 v = {bf_lo(pk.x), bf_hi(pk.x), bf_lo(pk.y), bf_hi(pk.y)};
            *(GAS f32x4*)(a.ncp + (size_t)idx * 4) = v; }
        else { const int k = idx - NPV; const int c4 = k & 255, j = (k >> 8) % (KW - 1), b = k / ((KW - 1) * 256); const int id = j + DSQ; f32x4 v;
            if (id < KW - 1) v = *(const GAS f32x4*)(a.state_conv + ((size_t)b * (KW - 1) + id) * DC + 4 * c4);
            else { const v2u pk = *(const GAS v2u*)(a.UC + (size_t)(MP + b * DSQ + id - (KW - 1)) * DC + 4 * c4); v = (f32x4){bf_lo(pk.x), bf_hi(pk.x), bf_lo(pk.y), bf_hi(pk.y)}; }
            *(GAS f32x4*)(a.ncs + (size_t)k * 4) = v; }
    }
}

#define SSM_STEP(i) do { \
        const float nAr = __builtin_fmaf(aAr, hAr, __builtin_fmaf(-aAi, hAi, d00[i])), nAi = __builtin_fmaf(aAr, hAi, __builtin_fmaf(aAi, hAr, d01[i])); \
        const float nBr = __builtin_fmaf(aBr, hBr, __builtin_fmaf(-aBi, hBi, d10[i])), nBi = __builtin_fmaf(aBr, hBi, __builtin_fmaf(aBi, hBr, d11[i])); \
        hAr = nAr; hAi = nAi; hBr = nBr; hBi = nBi; } while (0)
#define SSM_MFMA(afrag) do { const f32x16 z16 = {0.f,0.f,0.f,0.f,0.f,0.f,0.f,0.f,0.f,0.f,0.f,0.f,0.f,0.f,0.f,0.f}; \
        d00 = __builtin_amdgcn_mfma_f32_32x32x16_bf16(afrag, bfr[0][0], z16, 0, 0, 0); d01 = __builtin_amdgcn_mfma_f32_32x32x16_bf16(afrag, bfr[0][1], z16, 0, 0, 0); \
        d10 = __builtin_amdgcn_mfma_f32_32x32x16_bf16(afrag, bfr[1][0], z16, 0, 0, 0); d11 = __builtin_amdgcn_mfma_f32_32x32x16_bf16(afrag, bfr[1][1], z16, 0, 0, 0); } while (0)
#define SSM_PUT_U(afrag) do { *(LAS bf16x8*)(utile + (s_r * 16 + i_r) * 32 + kc * 16) = afrag; } while (0)
#define SSM_EMIT(rowb0, rowb1) do { \
        LDS_WAIT(); __builtin_amdgcn_wave_barrier(); \
        _Pragma("unroll") for (int s_ = 0; s_ < 2; ++s_) { \
            f32x4 y_ = {0.f, 0.f, 0.f, 0.f}; \
            _Pragma("unroll") for (int ks = 0; ks < 4; ++ks) { const bf16x8 hf = *(const LAS bf16x8*)(tile + s_ * P2_TILE_B + (lane & 15) * P2_TROW + ks * 64 + (lane >> 4) * 16); \
                y_ = __builtin_amdgcn_mfma_f32_16x16x32_bf16(hf, cfr[ks], y_, 0, 0, 0); } \
            const int rb_ = s_ ? (rowb1) : (rowb0); float v_[4]; \
            _Pragma("unroll") for (int i_ = 0; i_ < 4; ++i_) { const unsigned short ub_ = *(const LAS unsigned short*)(utile + (s_ * 16 + 4 * (lane >> 4) + i_) * 32 + (lane & 15) * 2); \
                v_[i_] = gelu_tanh_f(y_[i_] + dsk * __builtin_bit_cast(float, (unsigned)ub_ << 16)); } \
            const unsigned w01_ = cvtpk(v_[0], v_[1]), w23_ = cvtpk(v_[2], v_[3]); \
            bf16* go_ = a.G + (size_t)(rb_ + 4 * (lane >> 4)) * DS + g * CH + (lane & 15); \
            go_[0] = (bf16)w01_; go_[DS] = (bf16)(w01_ >> 16); go_[2 * DS] = (bf16)w23_; go_[3 * DS] = (bf16)(w23_ >> 16); } \
        LDS_WAIT(); __builtin_amdgcn_wave_barrier(); } while (0)
#define SSM_TILE_ROW(i) do { v2u hw_; hw_.x = cvtpk(hAr, hAi); hw_.y = cvtpk(hBr, hBi); *(LAS v2u*)(mytile + (i) * P2_TROW) = hw_; } while (0)

__device__ __forceinline__ void p2_ssm(const P2Args& a, LAS unsigned char* lds, int vcu, int G, int wave, int lane, int tid) {
    const int col = lane & 31, half = lane >> 5;
    const int r = lane & 31, s_r = (r >> 2) & 1, i_r = (r & 3) + 4 * (r >> 3), kc = lane >> 5;
    LAS unsigned char* tile = lds + P2_TILE_OFF + wave * 2 * P2_TILE_B;
    LAS unsigned char* mytile = tile + half * P2_TILE_B + col * 8;
    LAS unsigned char* utile = lds + P2_UT_OFF + wave * 1024;
    LAS f32x4* SX = (LAS f32x4*)(lds + P2_SX_OFF);
    for (int it = vcu; it < BATCH * NG; it += G) {
        const int g = it & (NG - 1), pb = it >> 6;
        const float* AB = (const float*)(a.tab + TAB_AB) + (size_t)(g * NP + 2 * col) * 2;
        const f32x4 ab4 = *(const GAS f32x4*)AB;
        const float aAr = ab4.x, aAi = ab4.y, aBr = ab4.z, aBi = ab4.w;
        bf16x8 bfr[2][2], cfr[4];
#pragma unroll
        for (int pair = 0; pair < 2; ++pair)
#pragma unroll
            for (int ri = 0; ri < 2; ++ri) bfr[pair][ri] = *(const GAS bf16x8*)((const bf16*)(a.tab + TAB_BBT) + ((size_t)(g * 2 + ri) * NP + 2 * col + pair) * CH + 8 * kc);
#pragma unroll
        for (int ks = 0; ks < 4; ++ks) cfr[ks] = *(const GAS bf16x8*)((const bf16*)(a.tab + TAB_CQ) + ((size_t)g * CH + (lane & 15)) * 128 + 32 * ks + 8 * (lane >> 4));
        const float dsk = a.Dk[g * CH + (lane & 15)];
        f32x16 d00, d01, d10, d11;
        {
            const bf16* abase = a.SI + (size_t)(pb * SEQ + (2 * wave + s_r) * 128 + i_r) * DS + g * CH + 8 * kc;
            float hAr = 0.f, hAi = 0.f, hBr = 0.f, hBi = 0.f;
            bf16x8 a0 = *(const GAS bf16x8*)abase, a1 = *(const GAS bf16x8*)(abase + (size_t)1 * 16 * DS), a2 = *(const GAS bf16x8*)(abase + (size_t)2 * 16 * DS), a3 = *(const GAS bf16x8*)(abase + (size_t)3 * 16 * DS);
#pragma unroll 1
            for (int blk = 0; blk < 8; ++blk) {
                const bf16x8 an = *(const GAS bf16x8*)(abase + (size_t)((blk + 4) & 7) * 16 * DS);
                SSM_MFMA(a0);
#pragma unroll
                for (int i = 0; i < 16; ++i) SSM_STEP(i);
                a0 = a1; a1 = a2; a2 = a3; a3 = an;
            }
            __syncthreads();
            SX[(2 * wave + half) * 32 + col] = (f32x4){hAr, hAi, hBr, hBi};
            __syncthreads();
            float pAr = aAr, pAi = aAi, pBr = aBr, pBi = aBi;
#pragma unroll
            for (int sq = 0; sq < 7; ++sq) { const float t0 = pAr * pAr - pAi * pAi, t1 = 2.0f * pAr * pAi, t2 = pBr * pBr - pBi * pBi, t3 = 2.0f * pBr * pBi; pAr = t0; pAi = t1; pBr = t2; pBi = t3; }
            hAr = 0.f; hAi = 0.f; hBr = 0.f; hBi = 0.f;
            const int mine = 2 * wave + half;
            for (int s2 = 0; s2 < mine; ++s2) { const f32x4 sv = SX[s2 * 32 + col];
                const float nAr = pAr * hAr - pAi * hAi + sv.x, nAi = pAr * hAi + pAi * hAr + sv.y, nBr = pBr * hBr - pBi * hBi + sv.z, nBi = pBr * hBi + pBi * hBr + sv.w;
                hAr = nAr; hAi = nAi; hBr = nBr; hBi = nBi; }
#pragma unroll 1
            for (int blk = 0; blk < 8; ++blk) {
                const bf16x8 an = *(const GAS bf16x8*)(abase + (size_t)((blk + 4) & 7) * 16 * DS);
                SSM_MFMA(a0);
                SSM_PUT_U(a0);
#pragma unroll
                for (int i = 0; i < 16; ++i) { SSM_STEP(i); SSM_TILE_ROW(i); }
                const int rb = pb * SEQ + (2 * wave) * 128 + blk * 16;
                SSM_EMIT(rb, rb + 128);
                a0 = a1; a1 = a2; a2 = a3; a3 = an;
            }
            if (mine == 15) { const size_t o = ((size_t)pb * NG + g) * NP + 2 * col;
                *(GAS f32x2*)(a.nrp + o) = (f32x2){hAr, hBr}; *(GAS f32x2*)(a.nip + o) = (f32x2){hAi, hBi}; }
        }
        {
            const int bA_load = 32 * pb + 4 * wave + 2 * s_r, bA = 32 * pb + 4 * wave + 2 * half;
            const bf16x8 afS = *(const GAS bf16x8*)(a.SI + (size_t)(MP + bA_load * DSQ + i_r) * DS + g * CH + 8 * kc);
            size_t o = ((size_t)bA * NG + g) * NP + 2 * col;
            f32x2 t0 = *(const GAS f32x2*)(a.h0re + o), t1 = *(const GAS f32x2*)(a.h0im + o);
            SSM_MFMA(afS);
            SSM_PUT_U(afS);
            float hAr = t0.x, hBr = t0.y, hAi = t1.x, hBi = t1.y;
#pragma unroll
            for (int i = 0; i < 8; ++i) { SSM_STEP(i); SSM_TILE_ROW(i); }
            *(GAS f32x2*)(a.nrs + o) = (f32x2){hAr, hBr}; *(GAS f32x2*)(a.nis + o) = (f32x2){hAi, hBi};
            o += (size_t)NG * NP;
            t0 = *(const GAS f32x2*)(a.h0re + o); t1 = *(const GAS f32x2*)(a.h0im + o);
            hAr = t0.x; hBr = t0.y; hAi = t1.x; hBi = t1.y;
#pragma unroll
            for (int i = 8; i < 16; ++i) { SSM_STEP(i); SSM_TILE_ROW(i); }
            *(GAS f32x2*)(a.nrs + o) = (f32x2){hAr, hBr}; *(GAS f32x2*)(a.nis + o) = (f32x2){hAi, hBi};
            const int rb = MP + (32 * pb + 4 * wave) * DSQ;
            SSM_EMIT(rb, rb + 16);
        }
    }
    __syncthreads();
}

struct Args { const float* in[28]; float* out; unsigned char* ws; int lo, hi, dryk, li; };
__global__ void __launch_bounds__(NWAVES * 64, 2) mk_fwd(Args args) {
    __shared__ __attribute__((aligned(16))) unsigned char lds_raw[LDS_BYTES];
    LAS unsigned char* lds = (LAS unsigned char*)lds_raw;
    volatile LAS unsigned* MISC = (volatile LAS unsigned*)(lds + MISC_OFF);
    const int tid = threadIdx.x, lane = tid & 63, wave = __builtin_amdgcn_readfirstlane(tid >> 6);
    const int G = gridDim.x; const int bx = blockIdx.x; const int vcu = (G % 8 == 0) ? (bx % 8) * (G / 8) + bx / 8 : bx;
    unsigned char* ws = args.ws;
    gu32* ctl = (gu32*)(ws + WS_CTL);
    for (int u = tid; u < (LDS_BYTES - LDSCTL_OFF) / 4; u += NWAVES * 64) ((LAS unsigned*)(lds + LDSCTL_OFF))[u] = 0u;
    __syncthreads();
    XcdBarrier bar; bar.bar = (unsigned*)(ctl + CW_BAR) + args.li * XCD_BAR_WORDS; bar.x = 0; bar.st = nullptr;
    if (N_LAUNCHES != NPH) bar = xcd_barrier_post((unsigned*)(ctl + CW_BAR) + args.li * XCD_BAR_WORDS, MISC + 8);
#define GRID_BAR(seam) do { if (N_LAUNCHES == NPH) { if (tid == 0) __hip_atomic_store(ctl + CW_TMO, 0xBADBA0u | (unsigned)(seam), RLX_AGENT); } else { xcd_barrier(bar); } } while (0)
    const int lo = args.lo, hi = args.hi, dryk = args.dryk;
#define DRY(k) (dryk == (k))
#ifndef ONLY_PHASE
#define ONLY_PHASE -1
#endif
#define IN(k) (ONLY_PHASE < 0 ? (lo <= (k) && (k) < hi) : (k) == ONLY_PHASE)
#define BOTH(k) (IN(k) && IN((k) + 1))
    float* out = args.out;
    float* Y = out;
    float* ncp = out + (size_t)M * D;
    float* nrp = ncp + (size_t)BATCH * (KW - 1) * DC;
    float* nip = nrp + (size_t)BATCH * NG * NP;
    float* ncs = nip + (size_t)BATCH * NG * NP;
    float* nrs = ncs + (size_t)DB * (KW - 1) * DC;
    float* nis = nrs + (size_t)DB * NG * NP;
    bf16 *WGU = (bf16*)(ws + WS_WGU), *WDN = (bf16*)(ws + WS_WDN), *XB = (bf16*)(ws + WS_XB), *WIN = (bf16*)(ws + WS_WIN), *WGL = (bf16*)(ws + WS_WGL), *WOUT = (bf16*)(ws + WS_WOUT);
    bf16 *UC = (bf16*)(ws + WS_U), *SI = (bf16*)(ws + WS_S), *GB = (bf16*)(ws + WS_G), *MIX = (bf16*)(ws + WS_MIX), *ACT = (bf16*)(ws + WS_ACT);
    float* ssq_dummy = (float*)(ws + WS_CTL) + CW_DUMMY;
    float* ssq_s = (float*)(ws + WS_CTL) + CW_SSQ_S; float* ssq_h = (float*)(ws + WS_CTL) + CW_SSQ_H; float* ssq_o = (float*)(ws + WS_CTL) + CW_SSQ_O; float* rx = (float*)(ws + WS_CTL) + CW_RX;
    const int gw = vcu * NWAVES + wave, NGW = G * NWAVES;

    if (IN(0)) {
        P0Args a; a.xp = args.in[0]; a.xs = args.in[1]; a.norm_mix = args.in[5]; a.w_in = args.in[6]; a.w_glu = args.in[19]; a.gn_conv = args.in[20]; a.gn_ssm = args.in[21]; a.w_out = args.in[22];
        a.norm_ffn = args.in[23]; a.w_gate = args.in[24]; a.w_up = args.in[25]; a.w_down = args.in[26];
        a.A_re = args.in[11]; a.A_im = args.in[12]; a.log_dt = args.in[13]; a.B_re = args.in[14]; a.B_im = args.in[15]; a.C_re = args.in[16]; a.C_im = args.in[17];
        a.WIN = WIN; a.WGL = WGL; a.WOUT = WOUT; a.WGU = WGU; a.WDN = WDN; a.XB = XB; a.rx = rx; a.tab = ws + WS_TAB;
        p0_prologue(a, lds, vcu, G, wave, lane, tid);
        if (BOTH(0)) GRID_BAR(0);
    }
    if (IN(1)) {
        pg8::Gemm g{XB, WIN, M, DIN, D};
#define SCHED(slot, slabo, N_, K_) typedef pg8::HybridOrder<N_, K_> Sch; Sch S; S.init((int)blockIdx.x, ws + (slabo), (unsigned*)(ctl + CW_FLAGS + (slot) * FLAG_SLOT), (unsigned*)(ctl + CW_TMO))
        SCHED(0, SLAB_P1, DIN, D);
        pg8::EpiIn E{UC, SI, rx};
        pg8::gemm_phase<pg8::EpiIn, Sch, true, true>(lds + RING_OFF, g, S, E);
        if (BOTH(1)) GRID_BAR(1);
    }
    if (IN(2)) {
        P2Args a; a.UC = UC; a.SI = SI; a.G = GB; a.MIX = MIX; a.state_conv = args.in[2]; a.h0re = args.in[3]; a.h0im = args.in[4];
        a.conv_w = args.in[7]; a.conv_b = args.in[8]; a.ln_g = args.in[9]; a.ln_b = args.in[10]; a.Dk = args.in[18]; a.tab = ws + WS_TAB;
        a.ncp = ncp; a.nrp = nrp; a.nip = nip; a.ncs = ncs; a.nrs = nrs; a.nis = nis;
        p2_ssm(a, lds, vcu, G, wave, lane, tid);
        p2_conv(a, lds, vcu, G, wave, lane, tid);
        p2_newconv(a, vcu, G, tid);
        if (BOTH(2)) GRID_BAR(2);
    }
    if (IN(3)) {
        pg8::Gemm g{GB, WGL, M, DS, DS}; SCHED(1, SLAB_P3, DS, DS);
        pg8::EpiGlu E{GB, MIX, DRY(3) ? ssq_dummy : ssq_s};
        pg8::gemm_phase<pg8::EpiGlu, Sch, true, true>(lds + RING_OFF, g, S, E);
        if (BOTH(3)) GRID_BAR(3);
    }
    if (IN(4)) {
        for (int row = gw; row < M; row += NGW) {
            const float r = DRY(4) ? 1.0f : 1.0f / sqrtf(__hip_atomic_load(ssq_s + row, RLX_AGENT) * (1.0f / DS) + 1e-6f);
            GAS v4u* p = (GAS v4u*)(MIX + (size_t)row * D + DC) + 2 * lane;
#pragma unroll
            for (int j = 0; j < 2; ++j) { v4u w = p[j]; w.x = pk2(bf_lo(w.x) * r, bf_hi(w.x) * r); w.y = pk2(bf_lo(w.y) * r, bf_hi(w.y) * r); w.z = pk2(bf_lo(w.z) * r, bf_hi(w.z) * r); w.w = pk2(bf_lo(w.w) * r, bf_hi(w.w) * r); p[j] = w; }
        }
        if (BOTH(4)) GRID_BAR(4);
    }
    if (IN(5)) {
        pg8::Gemm g{MIX, WOUT, M, D, D}; SCHED(2, SLAB_P5, D, D);
        pg8::EpiOut E{args.in[0], args.in[1], Y, XB, DRY(5) ? ssq_dummy : ssq_h};
        pg8::gemm_phase<pg8::EpiOut, Sch, true, true>(lds + RING_OFF, g, S, E);
        if (BOTH(5)) GRID_BAR(5);
    }
    if (IN(6)) {
        pg8::Gemm g{XB, WGU, M, 2 * DFF, D}; SCHED(3, SLAB_P6, 2 * DFF, D);
        pg8::EpiUp E{ACT, ssq_h};
        pg8::gemm_phase<pg8::EpiUp, Sch, true, true>(lds + RING_OFF, g, S, E);
        if (BOTH(6)) GRID_BAR(6);
    }
    if (IN(7)) {
        pg8::Gemm g{ACT, WDN, M, D, DFF}; SCHED(4, SLAB_P7, D, DFF);
        pg8::EpiDown E{Y, DRY(7) ? ssq_dummy : ssq_o, DRY(7) ? 0.0f : 1.0f};
        pg8::gemm_phase<pg8::EpiDown, Sch, true, true>(lds + RING_OFF, g, S, E);
        if (BOTH(7)) GRID_BAR(7);
    }
    if (IN(8)) {
        const float* gfin = args.in[27];
        for (int row = gw; row < M; row += NGW) {
            const float r = DRY(8) ? 1.0f : 1.0f / sqrtf(__hip_atomic_load(ssq_o + row, RLX_AGENT) * (1.0f / D) + 1e-6f);
            GAS f32x4* p = (GAS f32x4*)(Y + (size_t)row * D) + lane; const GAS f32x4* gp = (const GAS f32x4*)gfin + lane;
#pragma unroll
            for (int j = 0; j < 8; ++j) p[64 * j] = p[64 * j] * r * (DRY(8) ? (f32x4){1.f, 1.f, 1.f, 1.f} : gp[64 * j]);
        }
    }
#undef DRY
#undef IN
#undef BOTH
#undef GRID_BAR
}

extern "C" void kernel_launch(void* const* d_in, const int* in_sizes, int n_in, void* d_out, int out_size, void* d_ws, size_t ws_size, hipStream_t stream) {
    static int grid = 0;
    if (grid == 0) {
        const long want_out = (long)M * D + (long)(BATCH + DB) * ((KW - 1) * DC + 2 * NG * NP);
        if (n_in != 28 || in_sizes[0] != MP * D || (long)out_size != want_out || ws_size < WS_END) {
            fprintf(stderr, "kernel_launch: unexpected shapes (n_in %d, in0 %d, out %d (want %ld), ws %zu (need %zu)); nothing launched\n", n_in, n_in > 0 ? in_sizes[0] : -1, out_size, want_out, ws_size, (size_t)WS_END); grid = -1; return; }
        int dev = 0, cus = 0;
        if (hipGetDevice(&dev) != hipSuccess || hipDeviceGetAttribute(&cus, hipDeviceAttributeMultiprocessorCount, dev) != hipSuccess) { fprintf(stderr, "kernel_launch: device query failed\n"); grid = -1; return; }
        if (cus != 256) fprintf(stderr, "kernel_launch: built for 256 CUs, device has %d\n", cus);
        grid = 256;
    }
    if (grid < 0) return;
    if (hipMemsetAsync((char*)d_ws + WS_CTL, 0, CTL_ZERO_BYTES, stream) != hipSuccess) { fprintf(stderr, "kernel_launch: memset failed\n"); return; }
    Args a{};
    for (int i = 0; i < 28; ++i) a.in[i] = (const float*)d_in[i];
    a.out = (float*)d_out; a.ws = (unsigned char*)d_ws;
#ifdef PROBE_PHASE
    constexpr int NL = 2;
#else
    constexpr int NL = N_LAUNCHES;
#endif
    for (int li = 0; li < NL; ++li) {
        a.dryk = -1;
        if (N_LAUNCHES == NPH) { a.lo = li; a.hi = li + 1; } else { a.lo = 0; a.hi = NPH; }
#ifdef PROBE_PHASE
        if (li == 0) { a.lo = 0; a.hi = PROBE_PHASE + 1; } else { a.lo = PROBE_PHASE; a.hi = NPH; a.dryk = PROBE_PHASE; }
#endif
        a.li = li;
        hipLaunchKernelGGL(mk_fwd, dim3(grid), dim3(NWAVES * 64), 0, stream, a);
        const hipError_t le = hipPeekAtLastError();
        if (le != hipSuccess) { fprintf(stderr, "kernel_launch: launch %d failed: %s\n", li, hipGetErrorName(le)); break; }
    }
}
```

```cpp
#include <hip/hip_runtime.h>
#include <cstdio>
#include <cstdint>
#define MK_N_LAUNCHES 1
namespace pg8 {
#define PG8_LAS __attribute__((address_space(3)))
typedef unsigned short bf16_t;
typedef short bf16x8 __attribute__((ext_vector_type(8)));
typedef float f32x4 __attribute__((ext_vector_type(4)));
typedef unsigned u32x4 __attribute__((ext_vector_type(4)));
constexpr int BM = 256, BK = 64, HALF = 128, HTB = HALF * BK * 2  , STAGE_BYTES = 8 * HTB, NXCD = 8, WGM = 8;

__host__ __device__ __forceinline__ int lds_byte(int r, int c) { const int st = (r >> 4) * 2 + (c >> 5), rr = r & 15, cc = c & 31, ob = rr * 64 + cc * 2; return st * 1024 + (ob ^ (((ob >> 9) & 1) << 5)); }
__host__ __device__ __forceinline__ void stage_rc(int b, int& R, int& C) { const int st = b / 1024, sb = b % 1024, swz = sb ^ (((sb >> 9) & 1) << 5); R = (st >> 1) * 16 + swz / 64; C = (st & 1) * 32 + (swz % 64) / 2; }
__host__ __device__ __forceinline__ int perm32(int rho) { const int n = rho >> 4, i = rho & 15; return 8 * (i >> 2) + 4 * n + (i & 3); }

struct Unit { int pm, pn, k0, nt, mode, need; };
struct Gemm { const bf16_t* A; const bf16_t* Bt; int M, N, K; };

__device__ __forceinline__ unsigned cvt_pk_bf16(float lo, float hi) { unsigned r; asm volatile("v_cvt_pk_bf16_f32 %0, %1, %2" : "=v"(r) : "v"(lo), "v"(hi)); return r; }
template <class Epi, class Sched, bool ALIGN_EPI = false, bool SP2 = false>
__device__ __forceinline__ void gemm_phase(PG8_LAS unsigned char* lds, const Gemm g, Sched& S, const Epi& E) {
    const int tid = threadIdx.x, wid = __builtin_amdgcn_readfirstlane(tid >> 6), lane = tid & 63, wr = wid >> 2, wc = wid & 3, fr = lane & 15, fq = lane >> 4;
    constexpr int K = Sched::KK;
    unsigned voffA[2], voffB[2];
#pragma unroll
    for (int i = 0; i < 2; ++i) { int R, C; stage_rc(tid * 16 + i * 8192, R, C); const int Rb = Epi::PERM ? ((R & ~31) + perm32(R & 31)) : R;
        voffA[i] = (unsigned)(R * K + C) * 2u; voffB[i] = (unsigned)(Rb * K + C) * 2u; }
    const size_t kstep = (size_t)(BK * 2);
    const size_t hstep = (size_t)HALF * K * 2;
    const size_t tstep = 2 * hstep;
    const unsigned ldsw = (unsigned)wid * 1024u;
    const int aoff = lds_byte(wr * 64 + fr, fq * 8), boff = lds_byte(wc * 32 + fr, fq * 8);
#define PG8_SA(b, h) (((b) * 2 + (h)) * HTB)
#define PG8_SB(b, h) ((4 + (b) * 2 + (h)) * HTB)
#define PG8_STAGE(bufoff, gbase, voff) do { _Pragma("unroll") for (int _i = 0; _i < 2; ++_i) \
        __builtin_amdgcn_global_load_lds((const unsigned*)((const char*)(gbase) + (voff)[_i]), (PG8_LAS unsigned*)(lds + (bufoff) + ldsw + _i * 8192), 16, 0, 0); } while (0)
#define PG8_LDA(dst, b, h) do { _Pragma("unroll") for (int m = 0; m < 4; ++m) _Pragma("unroll") for (int k = 0; k < 2; ++k) dst[m][k] = *(const PG8_LAS bf16x8*)(lds + PG8_SA(b, h) + aoff + m * 2048 + k * 1024); } while (0)
#define PG8_LDB(dst, b, h) do { _Pragma("unroll") for (int n = 0; n < 2; ++n) _Pragma("unroll") for (int k = 0; k < 2; ++k) dst[n][k] = *(const PG8_LAS bf16x8*)(lds + PG8_SB(b, h) + boff + n * 2048 + k * 1024); } while (0)
#define PG8_MMA(ai, bj, At, Bt) do { __builtin_amdgcn_s_setprio(1); _Pragma("unroll") for (int m = 0; m < 4; ++m) _Pragma("unroll") for (int n = 0; n < 2; ++n) _Pragma("unroll") for (int k = 0; k < 2; ++k) \
        acc[ai][bj][m][n] = __builtin_amdgcn_mfma_f32_16x16x32_bf16(Bt[n][k], At[m][k], acc[ai][bj][m][n], 0, 0, 0); __builtin_amdgcn_s_setprio(0); } while (0)
#define PG8_WAIT_V(n) asm volatile("s_waitcnt vmcnt(" #n ")" ::: "memory")
#define PG8_WAIT_L(n) asm volatile("s_waitcnt lgkmcnt(" #n ")" ::: "memory")
#define PG8_BAR __builtin_amdgcn_s_barrier()
#define PG8_SCHED __builtin_amdgcn_sched_barrier(0)
    Unit cur, nxt; int ui = 0;
    if (!S.next(0, cur)) return;
    f32x4 acc[2][2][4][2];
#pragma unroll
    for (int a = 0; a < 2; ++a)
#pragma unroll
        for (int b = 0; b < 2; ++b)
#pragma unroll
            for (int m = 0; m < 4; ++m)
#pragma unroll
                for (int n = 0; n < 2; ++n) acc[a][b][m][n] = (f32x4){0.f, 0.f, 0.f, 0.f};
    bf16x8 At[4][2], B0[2][2], B1[2][2];
    const char* cA = (const char*)g.A + (size_t)cur.pm * tstep + (size_t)cur.k0 * kstep; const char* cB = (const char*)g.Bt + (size_t)cur.pn * tstep + (size_t)cur.k0 * kstep;
    S.a_ready(cur);
    if constexpr (SP2) {
        PG8_STAGE(PG8_SB(0, 0), cB, voffB); PG8_STAGE(PG8_SB(0, 1), cB + hstep, voffB); PG8_STAGE(PG8_SA(0, 0), cA, voffA); PG8_STAGE(PG8_SA(0, 1), cA + hstep, voffA);
        if (wr == 1) PG8_BAR;
        PG8_WAIT_V(2); PG8_BAR;
        PG8_STAGE(PG8_SB(1, 0), cB + kstep, voffB); PG8_STAGE(PG8_SA(1, 0), cA + kstep, voffA); PG8_STAGE(PG8_SB(1, 1), cB + hstep + kstep, voffB);
        PG8_WAIT_V(6); PG8_BAR;
    } else {
        PG8_STAGE(PG8_SB(0, 0), cB, voffB); PG8_STAGE(PG8_SA(0, 0), cA, voffA); PG8_STAGE(PG8_SB(0, 1), cB + hstep, voffB); PG8_STAGE(PG8_SA(0, 1), cA + hstep, voffA);
        if (wr == 1) PG8_BAR;
        PG8_WAIT_V(4); PG8_BAR;
        PG8_STAGE(PG8_SB(1, 0), cB + kstep, voffB); PG8_STAGE(PG8_SA(1, 0), cA + kstep, voffA); PG8_STAGE(PG8_SB(1, 1), cB + hstep + kstep, voffB);
        PG8_WAIT_V(6); PG8_BAR;
    }
    for (;;) {
        const bool has_next = S.next(ui + 1, nxt);
        const char* nA = has_next ? (const char*)g.A + (size_t)nxt.pm * tstep + (size_t)nxt.k0 * kstep : cA; const char* nB = has_next ? (const char*)g.Bt + (size_t)nxt.pn * tstep + (size_t)nxt.k0 * kstep : cB;
        const int nt = cur.nt;
        for (int t = 0; t < nt; t += 2) {
            const bool last = (t == nt - 2);
            const char* a1 = cA + (size_t)(t + 1) * kstep;
            const char* a2 = last ? nA : cA + (size_t)(t + 2) * kstep; const char* b2 = last ? nB : cB + (size_t)(t + 2) * kstep;
            const char* a3 = a2 + kstep; const char* b3 = b2 + kstep;
            if (last && has_next) S.a_ready(nxt);
            if constexpr (SP2) {
            PG8_LDB(B0, 0, 0); PG8_LDB(B1, 0, 1); PG8_SCHED; PG8_LDA(At, 0, 0); PG8_STAGE(PG8_SA(1, 1), a1 + hstep, voffA);
            PG8_WAIT_V(8); PG8_WAIT_L(0); PG8_BAR; PG8_MMA(0, 0, At, B0); PG8_MMA(0, 1, At, B1); PG8_BAR; PG8_SCHED;
            PG8_LDA(At, 0, 1); PG8_STAGE(PG8_SB(0, 0), b2, voffB); PG8_STAGE(PG8_SB(0, 1), b2 + hstep, voffB); PG8_STAGE(PG8_SA(0, 0), a2, voffA);
            PG8_WAIT_V(8); PG8_WAIT_L(0); PG8_BAR; PG8_MMA(1, 0, At, B0); PG8_MMA(1, 1, At, B1); PG8_BAR; PG8_SCHED;
            PG8_LDB(B0, 1, 0); PG8_LDB(B1, 1, 1); PG8_SCHED; PG8_LDA(At, 1, 0); PG8_STAGE(PG8_SA(0, 1), a2 + hstep, voffA);
            PG8_WAIT_V(8); PG8_WAIT_L(0); PG8_BAR; PG8_MMA(0, 0, At, B0); PG8_MMA(0, 1, At, B1); PG8_BAR; PG8_SCHED;
            PG8_LDA(At, 1, 1); PG8_STAGE(PG8_SB(1, 0), b3, voffB); PG8_STAGE(PG8_SB(1, 1), b3 + hstep, voffB); PG8_STAGE(PG8_SA(1, 0), a3, voffA);
            PG8_WAIT_V(8); PG8_WAIT_L(0); PG8_BAR; PG8_MMA(1, 0, At, B0); PG8_MMA(1, 1, At, B1); PG8_BAR; PG8_SCHED;
            } else {
            PG8_LDB(B0, 0, 0); PG8_SCHED; PG8_LDA(At, 0, 0); PG8_STAGE(PG8_SA(1, 1), a1 + hstep, voffA);
            PG8_WAIT_L(8); PG8_BAR; PG8_WAIT_L(0); PG8_MMA(0, 0, At, B0); PG8_BAR; PG8_SCHED;
            PG8_LDB(B1, 0, 1); PG8_STAGE(PG8_SB(0, 0), b2, voffB);
            PG8_BAR; PG8_WAIT_L(0); PG8_MMA(0, 1, At, B1); PG8_BAR;
            PG8_LDA(At, 0, 1); PG8_STAGE(PG8_SA(0, 0), a2, voffA);
            PG8_BAR; PG8_WAIT_L(0); PG8_MMA(1, 0, At, B0); PG8_BAR; PG8_SCHED;
            PG8_STAGE(PG8_SB(0, 1), b2 + hstep, voffB);
            PG8_WAIT_V(6); PG8_BAR; PG8_MMA(1, 1, At, B1); PG8_BAR;
            PG8_LDB(B0, 1, 0); PG8_SCHED; PG8_LDA(At, 1, 0); PG8_STAGE(PG8_SA(0, 1), a2 + hstep, voffA);
            PG8_WAIT_L(8); PG8_BAR; PG8_WAIT_L(0); PG8_MMA(0, 0, At, B0); PG8_BAR; PG8_SCHED;
            PG8_LDB(B1, 1, 1); PG8_STAGE(PG8_SB(1, 0), b3, voffB);
            PG8_BAR; PG8_WAIT_L(0); PG8_MMA(0, 1, At, B1); PG8_BAR;
            PG8_LDA(At, 1, 1); PG8_STAGE(PG8_SA(1, 0), a3, voffA);
            PG8_BAR; PG8_WAIT_L(0); PG8_MMA(1, 0, At, B0); PG8_BAR; PG8_SCHED;
            PG8_STAGE(PG8_SB(1, 1), b3 + hstep, voffB);
            PG8_WAIT_V(6); PG8_BAR; PG8_MMA(1, 1, At, B1); PG8_BAR;
            }
        }
        if constexpr (ALIGN_EPI) { if (wr == 0) PG8_BAR; }
        static_assert(ALIGN_EPI && !Epi::AFTER_DRAIN, "the slab exchange needs both halves aligned in the epilogue");
        S.finish(acc, cur, E, tid, wid, wr, wc, fr, fq);
        if (!has_next) break;
#pragma unroll
        for (int a = 0; a < 2; ++a)
#pragma unroll
            for (int b = 0; b < 2; ++b)
#pragma unroll
                for (int m = 0; m < 4; ++m)
#pragma unroll
                    for (int n = 0; n < 2; ++n) acc[a][b][m][n] = (f32x4){0.f, 0.f, 0.f, 0.f};
        cur = nxt; cA = nA; cB = nB; ++ui;
        if constexpr (ALIGN_EPI) { if (wr == 1) PG8_BAR; }
    }
    PG8_WAIT_V(0);
    if constexpr (!ALIGN_EPI) { if (wr == 0) PG8_BAR; }
    PG8_BAR;
    S.finish_last(acc, cur, E, tid, wid, wr, wc, fr, fq);
#undef PG8_SA
#undef PG8_SB
#undef PG8_STAGE
#undef PG8_LDA
#undef PG8_LDB
#undef PG8_MMA
#undef PG8_WAIT_V
#undef PG8_WAIT_L
#undef PG8_BAR
#undef PG8_SCHED
}
}

namespace pg8 {
constexpr float RMS_EPS = 1e-6f;
__device__ __forceinline__ float fsig(float x) { return __builtin_amdgcn_rcpf(1.0f + __builtin_amdgcn_exp2f(x * -1.4426950408889634f)); }
__device__ __forceinline__ float bflo(unsigned w) { return __builtin_bit_cast(float, w << 16); }
__device__ __forceinline__ float bfhi(unsigned w) { return __builtin_bit_cast(float, w & 0xffff0000u); }
__device__ __forceinline__ u32x4 pack8(const f32x4& a, const f32x4& b) { u32x4 w; w.x = cvt_pk_bf16(a[0], a[1]); w.y = cvt_pk_bf16(a[2], a[3]); w.z = cvt_pk_bf16(b[0], b[1]); w.w = cvt_pk_bf16(b[2], b[3]); return w; }
__device__ __forceinline__ float sq4(const f32x4& a) { return (a[0] * a[0] + a[1] * a[1]) + (a[2] * a[2] + a[3] * a[3]); }
__device__ __forceinline__ void row_atomic(float* p, float q, int fq) { q += __shfl_xor(q, 16); q += __shfl_xor(q, 32); if (fq == 0) (void)__hip_atomic_fetch_add(p, q, __ATOMIC_RELAXED, __HIP_MEMORY_SCOPE_AGENT); }


#define PG8_EPI_ALL __device__ __forceinline__ void operator()(const f32x4 (&acc)[2][2][4][2], const Unit& u, int wr, int wc, int fr, int fq) const { \
        grp<0, 0>(acc, u, wr, wc, fr, fq); grp<0, 1>(acc, u, wr, wc, fr, fq); grp<0, 2>(acc, u, wr, wc, fr, fq); grp<0, 3>(acc, u, wr, wc, fr, fq); \
        grp<1, 0>(acc, u, wr, wc, fr, fq); grp<1, 1>(acc, u, wr, wc, fr, fq); grp<1, 2>(acc, u, wr, wc, fr, fq); grp<1, 3>(acc, u, wr, wc, fr, fq); }
template <int N_, int K_, int NP_ = 32, int RS_ = 0> struct HybridOrder {
    static constexpr size_t SLAB_BYTES = (size_t)BM * BM * 2;
    static constexpr int KK = K_, G = 256, nM = 9216 / BM, nN = N_ / BM, ntp = K_ / (2 * BK), nwg = nM * nN, per = G / 8, q = nwg / 8, R = NP_ > 0 ? q / per : (q + per - 1) / per, pairs = NP_ > 0 ? (q - R * per) * ntp : 0, np = NP_ <= 0 ? 1 : (NP_ < per ? NP_ : per), base = pairs / np, rem = pairs - base * np;
    static constexpr int Tr = q - R * per, S = RS_ > 0 ? RS_ : 1;
    static_assert(nwg % 8 == 0 && K_ % (2 * BK) == 0 && N_ % BM == 0 && (RS_ == 0 || (Tr * RS_ <= per && ntp >= RS_ && RS_ <= 8 && NP_ > 0)), "HybridOrder shapes");
    int x, j, rend, cur, vcu;
    unsigned char* slab; unsigned* flags; unsigned* tmo;
    __device__ __forceinline__ void init(int bx, unsigned char* slab_, unsigned* flags_, unsigned* tmo_) {
        x = bx & 7; j = bx >> 3;
        cur = j * base + (j < rem ? j : rem); rend = cur + base + (j < rem ? 1 : 0);
        if (j >= np) { cur = 0; rend = 0; }
        if (RS_ > 0) { cur = 0; rend = (j < Tr * S) ? 1 : 0; }
        vcu = x * per + j; slab = slab_; flags = flags_; tmo = tmo_;
    }
    __device__ __forceinline__ void tile_of(int wgid, Unit& u) const {
        constexpr int nig = WGM * nN; const int gid = wgid / nig, fm = gid * WGM, gsz = (nM - fm) < WGM ? (nM - fm) : WGM;
        u.pm = fm + ((wgid % nig) % gsz); u.pn = (wgid % nig) / gsz;
    }
    __device__ __forceinline__ bool next(int i, Unit& u) {
        if (i < R) { if (i * per + j >= q) return false; tile_of(x * q + i * per + j, u); u.k0 = 0; u.nt = 2 * ntp; u.mode = 0; u.need = 0; return true; }
        if (cur >= rend) return false;
        if (RS_ > 0) { const int t = j / S, p = j - t * S; constexpr int b = ntp / S, e = ntp - b * S;
            tile_of(x * q + R * per + t, u); u.k0 = 2 * (p * b + (p < e ? p : e)); u.nt = 2 * (b + (p < e ? 1 : 0)); u.mode = 3; u.need = p; cur = rend; return true; }
        const int t = cur / ntp, off = cur - t * ntp; int len = ntp - off; if (len > rend - cur) len = rend - cur;
        tile_of(x * q + R * per + t, u); u.k0 = 2 * off; u.nt = 2 * len; u.need = ntp - off - len;
        u.mode = off > 0 ? 1 : (u.need > 0 ? 2 : 0);
        cur += len; return true;
    }
    __device__ __forceinline__ void a_ready(const Unit&) const {}
    template <class Epi> __device__ __forceinline__ void finish(f32x4 (&acc)[2][2][4][2], const Unit& u, const Epi& E, int tid, int wid, int wr, int wc, int fr, int fq) const {
        asm volatile("" : "+v"(tid), "+v"(fr), "+v"(fq));
        if (u.mode == 1) {
            __amdgpu_buffer_rsrc_t rs = __builtin_amdgcn_make_buffer_rsrc(slab + (size_t)vcu * SLAB_BYTES, 0, (int)SLAB_BYTES, 0x00020000);
            const int vo = tid * 16;
#pragma unroll
            for (int ai = 0; ai < 2; ++ai)
#pragma unroll
                for (int bj = 0; bj < 2; ++bj)
#pragma unroll
                    for (int m = 0; m < 4; ++m) { __builtin_amdgcn_raw_buffer_store_b128(pack8(acc[ai][bj][m][0], acc[ai][bj][m][1]), rs, vo + (ai * 8 + bj * 4 + m) * 8192, 0, 16); asm volatile("" ::: "memory"); }
            asm volatile("s_waitcnt vmcnt(0)" ::: "memory");
            __builtin_amdgcn_s_barrier();
            if (tid == 0) __hip_atomic_store(flags + 64 * vcu, 1u, __ATOMIC_RELAXED, __HIP_MEMORY_SCOPE_AGENT);
            return;
        }
        if (u.mode >= 2) return;
        E(acc, u, wr, wc, fr, fq);
    }
    template <class Epi> __device__ __forceinline__ void finish_rs(f32x4 (&acc)[2][2][4][2], const Unit& u, const Epi& E, int tid, int wid, int wr, int wc, int fr, int fq) const {
        const int p = u.need, first = vcu - p;
        { __amdgpu_buffer_rsrc_t rs = __builtin_amdgcn_make_buffer_rsrc(slab + (size_t)vcu * SLAB_BYTES, 0, (int)SLAB_BYTES, 0x00020000);
          const int vo = tid * 16;
#pragma unroll
          for (int ai = 0; ai < 2; ++ai)
#pragma unroll
              for (int bj = 0; bj < 2; ++bj)
#pragma unroll
                  for (int m = 0; m < 4; ++m) { __builtin_amdgcn_raw_buffer_store_b128(pack8(acc[ai][bj][m][0], acc[ai][bj][m][1]), rs, vo + (ai * 8 + bj * 4 + m) * 8192, 0, 16); asm volatile("" ::: "memory"); }
          asm volatile("s_waitcnt vmcnt(0)" ::: "memory");
          __builtin_amdgcn_s_barrier();
          if (tid == 0) __hip_atomic_store(flags + 64 * vcu, 1u, __ATOMIC_RELAXED, __HIP_MEMORY_SCOPE_AGENT); }
        if (wid == 0) {
            for (int k = 0; k < S; ++k) { unsigned sp = 0;
                while (__hip_atomic_load(flags + 64 * (first + k), __ATOMIC_RELAXED, __HIP_MEMORY_SCOPE_AGENT) == 0u) { __builtin_amdgcn_s_sleep(2);
                    if (++sp > (1u << 20)) { if (tid == 0) __hip_atomic_store(tmo, 0x5AB3u, __ATOMIC_RELAXED, __HIP_MEMORY_SCOPE_AGENT); break; } } }
            __builtin_amdgcn_fence(__ATOMIC_ACQUIRE, "agent"); asm volatile("s_waitcnt vmcnt(0)" ::: "memory");
        }
        asm volatile("" ::: "memory"); __builtin_amdgcn_s_barrier(); asm volatile("" ::: "memory");
        const u32x4* sl0 = (const u32x4*)(slab + (size_t)first * SLAB_BYTES) + tid;
#define PG8_RS_GROUP(AI, MM) if ((AI * 4 + MM) % S == p) { u32x4 w0[S], w1[S]; \
            _Pragma("unroll") for (int k = 0; k < S; ++k) { const u32x4* sk = sl0 + (size_t)k * (SLAB_BYTES / 16); w0[k] = sk[(AI * 8 + MM) * 512]; w1[k] = sk[(AI * 8 + 4 + MM) * 512]; } \
            f32x4 a00 = {0.f, 0.f, 0.f, 0.f}, a01 = a00, a10 = a00, a11 = a00; \
            _Pragma("unroll") for (int k = 0; k < S; ++k) { a00 += (f32x4){bflo(w0[k].x), bfhi(w0[k].x), bflo(w0[k].y), bfhi(w0[k].y)}; a01 += (f32x4){bflo(w0[k].z), bfhi(w0[k].z), bflo(w0[k].w), bfhi(w0[k].w)}; \
                a10 += (f32x4){bflo(w1[k].x), bfhi(w1[k].x), bflo(w1[k].y), bfhi(w1[k].y)}; a11 += (f32x4){bflo(w1[k].z), bfhi(w1[k].z), bflo(w1[k].w), bfhi(w1[k].w)}; } \
            acc[AI][0][MM][0] = a00; acc[AI][0][MM][1] = a01; acc[AI][1][MM][0] = a10; acc[AI][1][MM][1] = a11; \
            E.template grp<AI, MM>(acc, u, wr, wc, fr, fq); }
        PG8_RS_GROUP(0, 0) PG8_RS_GROUP(0, 1) PG8_RS_GROUP(0, 2) PG8_RS_GROUP(0, 3) PG8_RS_GROUP(1, 0) PG8_RS_GROUP(1, 1) PG8_RS_GROUP(1, 2) PG8_RS_GROUP(1, 3)
#undef PG8_RS_GROUP
    }
    template <class Epi> __device__ __forceinline__ void finish_last(f32x4 (&acc)[2][2][4][2], const Unit& u, const Epi& E, int tid, int wid, int wr, int wc, int fr, int fq) const {
        if (u.mode == 3) { finish_rs(acc, u, E, tid, wid, wr, wc, fr, fq); return; }
        if (u.mode != 2) return;
        int ns = 0; { int need = u.need; for (int jj = j + 1; need > 0 && jj < np; ++jj) { const int len = base + (jj < rem ? 1 : 0); if (len == 0) break; need -= (len < need ? len : need); ++ns; } }
        if (wid == 0) {
            for (int k = 1; k <= ns; ++k) { unsigned sp = 0;
                while (__hip_atomic_load(flags + 64 * (vcu + k), __ATOMIC_RELAXED, __HIP_MEMORY_SCOPE_AGENT) == 0u) { __builtin_amdgcn_s_sleep(2);
                    if (++sp > (1u << 20)) { if (tid == 0) __hip_atomic_store(tmo, 0x5AB0u, __ATOMIC_RELAXED, __HIP_MEMORY_SCOPE_AGENT); break; } } }
            __builtin_amdgcn_fence(__ATOMIC_ACQUIRE, "agent"); asm volatile("s_waitcnt vmcnt(0)" ::: "memory");
        }
        asm volatile("" ::: "memory"); __builtin_amdgcn_s_barrier(); asm volatile("" ::: "memory");
        for (int k = 1; k <= ns; ++k) {
            const u32x4* sl = (const u32x4*)(slab + (size_t)(vcu + k) * SLAB_BYTES) + tid;
            u32x4 w[16];
#pragma unroll
            for (int i = 0; i < 16; ++i) w[i] = sl[i * 512];
#pragma unroll
            for (int ai = 0; ai < 2; ++ai)
#pragma unroll
                for (int bj = 0; bj < 2; ++bj)
#pragma unroll
                    for (int m = 0; m < 4; ++m) { const u32x4 v = w[ai * 8 + bj * 4 + m];
                        acc[ai][bj][m][0] += (f32x4){bflo(v.x), bfhi(v.x), bflo(v.y), bfhi(v.y)}; acc[ai][bj][m][1] += (f32x4){bflo(v.z), bfhi(v.z), bflo(v.w), bfhi(v.w)}; }
        }
        E(acc, u, wr, wc, fr, fq);
    }
};
struct EpiIn {
    static constexpr bool PERM = true, AFTER_DRAIN = false;
    bf16_t* U; bf16_t* S; const float* rx;
    template <int ai, int m> __device__ __forceinline__ void grp(const f32x4 (&acc)[2][2][4][2], const Unit& u, int wr, int wc, int fr, int fq) const {
        const int row = u.pm * BM + wr * 64 + fr + ai * HALF + m * 16; const float r = rx[row];
        if (u.pn < 8) {
            const int col0 = u.pn * 128 + wc * 32 + 8 * fq;
            f32x4 v0, v1;
#pragma unroll
            for (int j = 0; j < 4; ++j) { v0[j] = (acc[ai][0][m][0][j] * r) * fsig(acc[ai][1][m][0][j] * r); v1[j] = (acc[ai][0][m][1][j] * r) * fsig(acc[ai][1][m][1][j] * r); }
            *(u32x4*)(U + (size_t)row * 1024 + col0) = pack8(v0, v1);
        } else {
            const int col0 = (u.pn - 8) * 256 + wc * 32 + 8 * fq;
#pragma unroll
            for (int bj = 0; bj < 2; ++bj) *(u32x4*)(S + (size_t)row * 1024 + col0 + bj * HALF) = pack8(acc[ai][bj][m][0] * r, acc[ai][bj][m][1] * r);
        }
    }
    PG8_EPI_ALL
};
struct EpiGlu {
    static constexpr bool PERM = true, AFTER_DRAIN = false;
    const bf16_t* G; bf16_t* MIX; float* ssq;
    template <int ai, int m> __device__ __forceinline__ void grp(const f32x4 (&acc)[2][2][4][2], const Unit& u, int wr, int wc, int fr, int fq) const {
        const int row0 = u.pm * BM + wr * 64 + fr, col0 = u.pn * BM + wc * 32 + 8 * fq;
            { const int row = row0 + ai * HALF + m * 16; float q = 0.f;
#pragma unroll
                for (int bj = 0; bj < 2; ++bj) { const u32x4 gw = *(const u32x4*)(G + (size_t)row * 1024 + col0 + bj * HALF);
                    f32x4 g0 = {bflo(gw.x), bfhi(gw.x), bflo(gw.y), bfhi(gw.y)}, g1 = {bflo(gw.z), bfhi(gw.z), bflo(gw.w), bfhi(gw.w)}, y0, y1;
#pragma unroll
                    for (int j = 0; j < 4; ++j) { y0[j] = g0[j] * fsig(acc[ai][bj][m][0][j]); y1[j] = g1[j] * fsig(acc[ai][bj][m][1][j]); }
                    q += sq4(y0) + sq4(y1);
                    *(u32x4*)(MIX + (size_t)row * 2048 + 1024 + col0 + bj * HALF) = pack8(y0, y1); }
                row_atomic(ssq + row, q, fq); }
    }
    PG8_EPI_ALL
};
struct EpiOut {
    static constexpr bool PERM = true, AFTER_DRAIN = false;
    const float* xp; const float* xs; float* H; bf16_t* HB; float* ssq;
    template <int ai, int m> __device__ __forceinline__ void grp(const f32x4 (&acc)[2][2][4][2], const Unit& u, int wr, int wc, int fr, int fq) const {
        const int row0 = u.pm * BM + wr * 64 + fr, col0 = u.pn * BM + wc * 32 + 8 * fq;
        const float* xb = (u.pm < 32) ? xp : xs - (size_t)8192 * 2048;
            { const int row = row0 + ai * HALF + m * 16; float q = 0.f;
#pragma unroll
                for (int bj = 0; bj < 2; ++bj) { const size_t off = (size_t)row * 2048 + col0 + bj * HALF;
                    const f32x4 h0 = *(const f32x4*)(xb + off) + acc[ai][bj][m][0], h1 = *(const f32x4*)(xb + off + 4) + acc[ai][bj][m][1];
                    q += sq4(h0) + sq4(h1);
                    *(f32x4*)(H + off) = h0; *(f32x4*)(H + off + 4) = h1; *(u32x4*)(HB + off) = pack8(h0, h1); }
                row_atomic(ssq + row, q, fq); }
    }
    PG8_EPI_ALL
};
struct EpiUp {
    static constexpr bool PERM = true, AFTER_DRAIN = false;
    bf16_t* ACT; const float* ssq;
    template <int ai, int m> __device__ __forceinline__ void grp(const f32x4 (&acc)[2][2][4][2], const Unit& u, int wr, int wc, int fr, int fq) const {
        const int row0 = u.pm * BM + wr * 64 + fr, col0 = u.pn * 128 + wc * 32 + 8 * fq;
            { const int row = row0 + ai * HALF + m * 16; const float r = __builtin_amdgcn_rsqf(ssq[row] * (1.0f / 2048.0f) + RMS_EPS);
                f32x4 v0, v1;
#pragma unroll
                for (int j = 0; j < 4; ++j) { const float a0 = acc[ai][0][m][0][j] * r, a1 = acc[ai][0][m][1][j] * r;
                    v0[j] = a0 * fsig(a0) * (acc[ai][1][m][0][j] * r); v1[j] = a1 * fsig(a1) * (acc[ai][1][m][1][j] * r); }
                *(u32x4*)(ACT + (size_t)row * 5632 + col0) = pack8(v0, v1); }
    }
    PG8_EPI_ALL
};
struct EpiDown {
    static constexpr bool PERM = true, AFTER_DRAIN = false;
    float* H; float* ssq; float zmul;
    template <int ai, int m> __device__ __forceinline__ void grp(const f32x4 (&acc)[2][2][4][2], const Unit& u, int wr, int wc, int fr, int fq) const {
        const int row0 = u.pm * BM + wr * 64 + fr, col0 = u.pn * BM + wc * 32 + 8 * fq;
            { const int row = row0 + ai * HALF + m * 16; float q = 0.f;
#pragma unroll
                for (int bj = 0; bj < 2; ++bj) { float* p = H + (size_t)row * 2048 + col0 + bj * HALF;
                    const f32x4 o0 = *(const f32x4*)p + acc[ai][bj][m][0] * zmul, o1 = *(const f32x4*)(p + 4) + acc[ai][bj][m][1] * zmul;
                    q += sq4(o0) + sq4(o1);
                    *(f32x4*)p = o0; *(f32x4*)(p + 4) = o1; }
                row_atomic(ssq + row, q, fq); }
    }
    PG8_EPI_ALL
};
}

constexpr int NWAVES = 8;
#ifndef MK_N_LAUNCHES
#define MK_N_LAUNCHES 1
#endif
constexpr int NPH = 9;
constexpr int N_LAUNCHES = MK_N_LAUNCHES;

constexpr int D = 2048, DC = 1024, DS = 1024, DIN = 3072, DFF = 5632, NG = 64, NP = 64, CH = 16, KW = 31;
constexpr int BATCH = 4, SEQ = 2048, DB = 128, DSQ = 8;
constexpr int MP = BATCH * SEQ, MS = DB * DSQ, M = MP + MS;

constexpr size_t MiB = 1u << 20;
constexpr size_t WS_CTL = 0, CTL_ZERO_BYTES = 1 * MiB;
constexpr size_t WS_TAB = 1 * MiB;
constexpr size_t WS_WGU = 2 * MiB, WS_WDN = 46 * MiB, WS_XB = 68 * MiB;
constexpr size_t WS_WIN = 104 * MiB, WS_WGL = 116 * MiB, WS_WOUT = 118 * MiB;
constexpr size_t WS_U = 126 * MiB, WS_S = 144 * MiB, WS_G = 162 * MiB, WS_MIX = 180 * MiB;
constexpr size_t WS_ACT = 104 * MiB;
constexpr size_t WS_END = 235 * MiB;
constexpr size_t SLAB_P1 = 162 * MiB, SLAB_P3 = 126 * MiB, SLAB_P5 = 126 * MiB, SLAB_P6 = 203 * MiB, SLAB_P7 = 2 * MiB;
static_assert(WS_WGU + (size_t)2 * DFF * D * 2 <= WS_WDN && WS_WDN + (size_t)D * DFF * 2 <= WS_XB && WS_XB + (size_t)M * D * 2 <= WS_WIN, "ws map 1");
static_assert(WS_WIN + (size_t)DIN * D * 2 <= WS_WGL && WS_WGL + (size_t)DS * DS * 2 <= WS_WOUT && WS_WOUT + (size_t)D * D * 2 <= WS_U, "ws map 2");
static_assert(WS_U + (size_t)M * DC * 2 <= WS_S && WS_S + (size_t)M * DS * 2 <= WS_G && WS_G + (size_t)M * DS * 2 <= WS_MIX && WS_MIX + (size_t)M * D * 2 <= WS_END, "ws map 3");
static_assert(WS_ACT + (size_t)M * DFF * 2 <= SLAB_P6 && SLAB_P6 + 32 * MiB <= WS_END && WS_END <= 256 * MiB, "ws map 4");
constexpr int CW_TMO = 0, CW_CODE = 1;
constexpr int CW_BAR = 4096;
constexpr int CW_SSQ_S = 16384, CW_SSQ_H = CW_SSQ_S + M, CW_SSQ_O = CW_SSQ_H + M;
constexpr int CW_DUMMY = CW_SSQ_O + M;
constexpr int CW_FLAGS = 81920, FLAG_SLOT = 16384;
constexpr int CW_RX = 65536;
static_assert((CW_RX + M) * 4 <= (int)CTL_ZERO_BYTES && CW_DUMMY + M <= CW_RX, "ctl map");
constexpr size_t TAB_AB = 0;
constexpr size_t TAB_BBT = 64 * 1024;
constexpr size_t TAB_CQ = 512 * 1024;

constexpr int RING_OFF = 0, RING_BYTES = 131072;
constexpr int LDSCTL_OFF = RING_BYTES, MISC_OFF = LDSCTL_OFF + 320;
constexpr int LDS_BYTES = 147456;
static_assert(MISC_OFF + 128 <= LDS_BYTES, "LDS map");

#define GAS __attribute__((address_space(1)))
#define LAS __attribute__((address_space(3)))
typedef unsigned short bf16;
typedef unsigned v4u __attribute__((ext_vector_type(4)));
typedef unsigned v2u __attribute__((ext_vector_type(2)));
typedef float f32x4 __attribute__((ext_vector_type(4)));
typedef float f32x2 __attribute__((ext_vector_type(2)));
typedef float f32x16 __attribute__((ext_vector_type(16)));
typedef short bf16x8 __attribute__((ext_vector_type(8)));
typedef GAS unsigned gu32;
#define RLX_AGENT __ATOMIC_RELAXED, __HIP_MEMORY_SCOPE_AGENT
#define LDS_WAIT() asm volatile("s_waitcnt lgkmcnt(0)" ::: "memory")
#define VM_WAIT() asm volatile("s_waitcnt vmcnt(0)" ::: "memory")
__device__ __forceinline__ unsigned f2bf(float f) { unsigned u = __builtin_bit_cast(unsigned, f); return (u + 0x7fffu + ((u >> 16) & 1u)) >> 16; }
__device__ __forceinline__ unsigned pk2(float lo, float hi) { return f2bf(lo) | (f2bf(hi) << 16); }
__device__ __forceinline__ float bf_lo(unsigned w) { return __builtin_bit_cast(float, w << 16); }
__device__ __forceinline__ float bf_hi(unsigned w) { return __builtin_bit_cast(float, w & 0xffff0000u); }
__device__ __forceinline__ float wave_sum(float v) {
#pragma unroll
    for (int o = 1; o < 64; o <<= 1) v += __shfl_xor(v, o);
    return v;
}
__device__ __forceinline__ float fsigm(float x) { return __builtin_amdgcn_rcpf(1.0f + __builtin_amdgcn_exp2f(x * -1.4426950408889634f)); }
__device__ __forceinline__ float gelu_tanh_f(float x) {
    const float u2 = 1.5957691216057308f * (x + 0.044715f * x * x * x);
    return x * fsigm(u2);
}

#define XB_TMO      128
#define XB_XCNT(j)  (256  + 64 * (j))
#define XB_XSUB(j)  (1280 + 64 * (j))
#define XB_XGEN(j)  (2304 + 64 * (j))
#define XB_TOP      3328
#define XB_TOPGEN   3392
#define XCD_BAR_WORDS 3456
#define XB_SPIN_CAP (1u << 18)

__device__ __forceinline__ unsigned xb_ld(unsigned* p)              { return __hip_atomic_load(p, __ATOMIC_RELAXED, __HIP_MEMORY_SCOPE_AGENT); }
__device__ __forceinline__ unsigned xb_add(unsigned* p, unsigned v) { return __hip_atomic_fetch_add(p, v, __ATOMIC_RELAXED, __HIP_MEMORY_SCOPE_AGENT); }
__device__ __forceinline__ unsigned xb_xcc_id() { return (unsigned)__builtin_amdgcn_s_getreg((3 << 11) | 20) & 0xFu; }
#define XB_SPIN(cond, bar) do { unsigned _sp = 0; while (cond) { __builtin_amdgcn_s_sleep(1); \
    if ((++_sp & 255u) == 0u) { if (xb_ld(&(bar)[XB_TMO])) break; if (_sp > XB_SPIN_CAP) { atomicAdd(&(bar)[XB_TMO], 1u); break; } } } } while (0)

struct XcdBarrier {
    unsigned* bar; unsigned x;
    volatile LAS unsigned* st;
};

__device__ __forceinline__ XcdBarrier xcd_barrier_post(unsigned* bar, volatile LAS unsigned* st) {
    XcdBarrier b; b.bar = bar; b.x = xb_xcc_id(); b.st = st;
    if (threadIdx.x == 0) (void)xb_add(&bar[XB_XCNT(b.x)], 1u);
    return b;
}
__device__ __forceinline__ void xcd_barrier_complete(unsigned* bar, unsigned x, unsigned& nloc, unsigned& nx) {
    const unsigned G = gridDim.x * gridDim.y * gridDim.z;
    unsigned sum, cnt, mine, sp = 0u;
    for (;;) {
        sum = 0u; cnt = 0u; mine = 0u;
#pragma unroll
        for (unsigned j = 0; j < 16; ++j) { const unsigned c = xb_ld(&bar[XB_XCNT(j)]); sum += c; cnt += (c > 0u) ? 1u : 0u; mine = (j == x) ? c : mine; }
        if (sum == G) break;
        __builtin_amdgcn_s_sleep(1);
        if ((++sp & 255u) == 0u) { if (xb_ld(&bar[XB_TMO])) break; if (sp > XB_SPIN_CAP) { atomicAdd(&bar[XB_TMO], 1u); break; } }
    }
    nloc = mine > 0u ? mine : 1u; nx = cnt > 0u ? cnt : 1u;
}

__device__ __forceinline__ void xcd_barrier(const XcdBarrier& b) {
    asm volatile("s_waitcnt vmcnt(0)" ::: "memory");
    __syncthreads();
    if (threadIdx.x == 0) {
        unsigned* bar = b.bar;
        __builtin_amdgcn_s_waitcnt(0);
        unsigned nloc = b.st[0], nx = b.st[1];
        if (nloc == 0u) { xcd_barrier_complete(bar, b.x, nloc, nx); b.st[0] = nloc; b.st[1] = nx; }
        const unsigned old = xb_add(&bar[XB_XSUB(b.x)], 1u);
        const unsigned gen = old / nloc;
        if (old + 1u == (gen + 1u) * nloc) {
            __builtin_amdgcn_fence(__ATOMIC_RELEASE, "agent");
            asm volatile("s_waitcnt vmcnt(0)" ::: "memory");
            const unsigned og = xb_add(&bar[XB_TOP], 1u);
            const unsigned tg = og / nx;
            if (og + 1u == (tg + 1u) * nx) xb_add(&bar[XB_TOPGEN], 1u);
            else XB_SPIN(xb_ld(&bar[XB_TOPGEN]) == tg, bar);
            __builtin_amdgcn_fence(__ATOMIC_ACQUIRE, "agent");
            xb_add(&bar[XB_XGEN(b.x)], 1u);
            asm volatile("s_waitcnt vmcnt(0)" ::: "memory");
        } else {
            XB_SPIN(xb_ld(&bar[XB_XGEN(b.x)]) == gen, bar);
            __builtin_amdgcn_fence(__ATOMIC_ACQUIRE, "agent");
            asm volatile("s_waitcnt vmcnt(0)" ::: "memory");
        }
    }
    __syncthreads();
}
__device__ __forceinline__ unsigned cvtpk(float lo, float hi) { unsigned r; asm("v_cvt_pk_bf16_f32 %0, %1, %2" : "=v"(r) : "v"(lo), "v"(hi)); return r; }

struct P0Item { const float* W; const float* gp; bf16* WT; int N, K, orow, k0, n0, gain_on; };
__device__ __forceinline__ void p0_item_load(const P0Item& t, f32x4 (&v)[8], float (&gk)[8], int lane) {
    const int kr = lane >> 3, nq = lane & 7;
#pragma unroll
    for (int i = 0; i < 8; ++i) { const int kk = 8 * i + kr; v[i] = *(const GAS f32x4*)(t.W + (size_t)(t.k0 + kk) * t.N + t.n0 + 4 * nq);
        const float gl = t.gp[t.gain_on ? t.k0 + kk : 0]; gk[i] = t.gain_on ? gl : 1.0f; }
}
__device__ __forceinline__ void p0_item_finish(const P0Item& t, const f32x4 (&v)[8], const float (&gk)[8], LAS float* scr, int lane) {
    const int kr = lane >> 3, nq = lane & 7;
#pragma unroll
    for (int i = 0; i < 8; ++i) { const int kk = 8 * i + kr; LAS float* d = scr + kk * 33 + 4 * nq; d[0] = v[i].x * gk[i]; d[1] = v[i].y * gk[i]; d[2] = v[i].z * gk[i]; d[3] = v[i].w * gk[i]; }
    LDS_WAIT(); asm volatile("" ::: "memory");
    const int c = lane & 7;
#pragma unroll
    for (int j = 0; j < 4; ++j) { const int n = (lane >> 3) + 8 * j; const LAS float* s = scr + (8 * c) * 33 + n;
        v4u o; o.x = cvtpk(s[0 * 33], s[1 * 33]); o.y = cvtpk(s[2 * 33], s[3 * 33]); o.z = cvtpk(s[4 * 33], s[5 * 33]); o.w = cvtpk(s[6 * 33], s[7 * 33]);
        *(GAS v4u*)(t.WT + (size_t)(t.orow + n) * t.K + t.k0 + 8 * c) = o; }
    LDS_WAIT(); asm volatile("" ::: "memory");
}

struct P0Args {
    const float *xp, *xs, *norm_mix, *w_in, *w_glu, *gn_conv, *gn_ssm, *w_out, *norm_ffn, *w_gate, *w_up, *w_down;
    const float *A_re, *A_im, *log_dt, *B_re, *B_im, *C_re, *C_im;
    bf16 *WIN, *WGL, *WOUT, *WGU, *WDN, *XB; float* rx; unsigned char* tab;
};
__device__ __forceinline__ void p0_prologue(const P0Args& a, LAS unsigned char* lds, int vcu, int G, int wave, int lane, int tid) {
    LAS float* scr = (LAS float*)(lds + RING_OFF + wave * 16384);
    const int gw = vcu * NWAVES + wave, NGW = G * NWAVES;
    { const int gt = vcu * (NWAVES * 64) + tid;
      if (gt < NG * NP) { const int g = gt >> 6, p = gt & 63;
        const float ar = a.A_re[gt], ai = a.A_im[gt], dt = expf(a.log_dt[g]);
        const float th = dt * ai, e1 = expm1f(dt * ar), sh = sinf(0.5f * th), cm1 = -2.0f * sh * sh, cs = 1.0f + cm1;
        const float nr = e1 * cs + cm1, ni = (1.0f + e1) * sinf(th);
        const float abr = 1.0f + nr, abi = ni, den = ar * ar + ai * ai;
        const float kr = (nr * ar + ni * ai) / den, ki = (ni * ar - nr * ai) / den;
        float* AB = (float*)(a.tab + TAB_AB); AB[gt * 2] = abr; AB[gt * 2 + 1] = abi;
        bf16* BBT = (bf16*)(a.tab + TAB_BBT); bf16* CQ = (bf16*)(a.tab + TAB_CQ);
#pragma unroll
        for (int c = 0; c < 16; ++c) { const float br = a.B_re[(size_t)gt * CH + c], bi = a.B_im[(size_t)gt * CH + c];
            BBT[((size_t)(g * 2 + 0) * NP + p) * CH + c] = (bf16)f2bf(kr * br - ki * bi);
            BBT[((size_t)(g * 2 + 1) * NP + p) * CH + c] = (bf16)f2bf(kr * bi + ki * br);
            CQ[((size_t)g * CH + c) * 128 + 2 * p] = (bf16)f2bf(a.C_re[((size_t)g * CH + c) * NP + p]);
            CQ[((size_t)g * CH + c) * 128 + 2 * p + 1] = (bf16)f2bf(-a.C_im[((size_t)g * CH + c) * NP + p]); }
      } }
    constexpr int I_IN = (D / 64) * (DIN / 32), I_GL = (DS / 64) * (DS / 32), I_OUT = (D / 64) * (D / 32), I_GA = (D / 64) * (DFF / 32), I_DN = (DFF / 64) * (D / 32);
    constexpr int NITEMS = I_IN + I_GL + I_OUT + 2 * I_GA + I_DN;
#define P0_DECODE(t, it_) do { int r_ = (it_); \
        if (r_ < I_IN) { const int nb = r_ % (DIN / 32), kb = r_ / (DIN / 32), n0 = 32 * nb; \
            int orow; if (n0 < 2048) { const int bjv = n0 >> 10, ch = n0 & 1023; orow = 256 * (ch >> 7) + 128 * bjv + (ch & 127); } else orow = n0; \
            t.W = a.w_in; t.N = DIN; t.gp = a.norm_mix; t.gain_on = 1; t.WT = a.WIN; t.K = D; t.orow = orow; t.k0 = 64 * kb; t.n0 = n0; break; } r_ -= I_IN; \
        if (r_ < I_GL) { const int nb = r_ % (DS / 32), kb = r_ / (DS / 32); \
            t.W = a.w_glu; t.N = DS; t.gp = a.norm_mix; t.gain_on = 0; t.WT = a.WGL; t.K = DS; t.orow = 32 * nb; t.k0 = 64 * kb; t.n0 = 32 * nb; break; } r_ -= I_GL; \
        if (r_ < I_OUT) { const int nb = r_ % (D / 32), kb = r_ / (D / 32), k0 = 64 * kb; \
            t.W = a.w_out; t.N = D; t.gp = k0 < 1024 ? a.gn_conv : a.gn_ssm - 1024; t.gain_on = 1; t.WT = a.WOUT; t.K = D; t.orow = 32 * nb; t.k0 = k0; t.n0 = 32 * nb; break; } r_ -= I_OUT; \
        if (r_ < I_GA) { const int nb = r_ % (DFF / 32), kb = r_ / (DFF / 32), n0 = 32 * nb; \
            t.W = a.w_gate; t.N = DFF; t.gp = a.norm_ffn; t.gain_on = 1; t.WT = a.WGU; t.K = D; t.orow = 256 * (n0 >> 7) + (n0 & 127); t.k0 = 64 * kb; t.n0 = n0; break; } r_ -= I_GA; \
        if (r_ < I_GA) { const int nb = r_ % (DFF / 32), kb = r_ / (DFF / 32), n0 = 32 * nb; \
            t.W = a.w_up; t.N = DFF; t.gp = a.norm_ffn; t.gain_on = 1; t.WT = a.WGU; t.K = D; t.orow = 256 * (n0 >> 7) + 128 + (n0 & 127); t.k0 = 64 * kb; t.n0 = n0; break; } r_ -= I_GA; \
        { const int nb = r_ % (D / 32), kb = r_ / (D / 32); \
            t.W = a.w_down; t.N = D; t.gp = a.norm_mix; t.gain_on = 0; t.WT = a.WDN; t.K = DFF; t.orow = 32 * nb; t.k0 = 64 * kb; t.n0 = 32 * nb; } } while (0)
    {
        P0Item t0, t1; f32x4 va[8], vb[8]; float ga[8], gb[8];
        if (gw < NITEMS) { P0_DECODE(t0, gw); p0_item_load(t0, va, ga, lane); }
        for (int it = gw; it < NITEMS; it += NGW) {
            const int itn = it + NGW;
            if (itn < NITEMS) { P0_DECODE(t1, itn); p0_item_load(t1, vb, gb, lane); }
            p0_item_finish(t0, va, ga, scr, lane);
            t0 = t1;
#pragma unroll
            for (int i = 0; i < 8; ++i) { va[i] = vb[i]; ga[i] = gb[i]; }
        }
    }
#undef P0_DECODE
    {
        f32x4 v[8], vn[8];
        if (gw < M) { const GAS f32x4* xr = (const GAS f32x4*)(gw < MP ? a.xp + (size_t)gw * D : a.xs + (size_t)(gw - MP) * D) + lane;
#pragma unroll
            for (int j = 0; j < 8; ++j) v[j] = xr[64 * j]; }
        for (int row = gw; row < M; row += NGW) {
            const int rn = row + NGW;
            if (rn < M) { const GAS f32x4* xr = (const GAS f32x4*)(rn < MP ? a.xp + (size_t)rn * D : a.xs + (size_t)(rn - MP) * D) + lane;
#pragma unroll
                for (int j = 0; j < 8; ++j) vn[j] = xr[64 * j]; }
            float s = 0.f;
#pragma unroll
            for (int j = 0; j < 8; ++j) s += (v[j].x * v[j].x + v[j].y * v[j].y) + (v[j].z * v[j].z + v[j].w * v[j].w);
            s = wave_sum(s);
            if (lane == 0) a.rx[row] = 1.0f / sqrtf(s * (1.0f / D) + 1e-6f);
            GAS v2u* o8 = (GAS v2u*)(a.XB + (size_t)row * D) + lane;
#pragma unroll
            for (int j = 0; j < 8; ++j) { v2u o; o.x = cvtpk(v[j].x, v[j].y); o.y = cvtpk(v[j].z, v[j].w); o8[64 * j] = o; }
#pragma unroll
            for (int j = 0; j < 8; ++j) v[j] = vn[j];
        }
    }
}

struct P2Args {
    const bf16* UC; const bf16* SI; bf16* G; bf16* MIX;
    const float *state_conv, *h0re, *h0im, *conv_w, *conv_b, *ln_g, *ln_b, *Dk;
    const unsigned char* tab;
    float *ncp, *nrp, *nip, *ncs, *nrs, *nis;
};
constexpr int P2_RED_OFF = 0, P2_TILE_OFF = 4096, P2_TILE_B = 4352, P2_TROW = 272, P2_UT_OFF = 73728, P2_SX_OFF = 81920;

#define CONV_LOAD_ROWS(rows, it_) do { \
        int rowbase_, t0_; const float* hist_ = nullptr; \
        if ((it_) < 1024) { rowbase_ = ((it_) >> 8) * SEQ; t0_ = ((it_) & 255) * 8; } else { const int b_ = (it_) - 1024; rowbase_ = MP + b_ * DSQ; t0_ = 0; hist_ = a.state_conv + (size_t)b_ * (KW - 1) * DC; } \
        _Pragma("unroll") for (int r_ = 0; r_ < 8 + KW - 1; ++r_) { const int tt_ = t0_ - (KW - 1) + r_; \
            if (tt_ >= 0) rows[r_] = *(const GAS unsigned*)(a.UC + (size_t)(rowbase_ + tt_) * DC + c0); \
            else if (hist_) { const f32x2 hv_ = *(const GAS f32x2*)(hist_ + (size_t)(tt_ + KW - 1) * DC + c0); rows[r_] = cvtpk(hv_.x, hv_.y); } \
            else rows[r_] = 0u; } } while (0)

__device__ __forceinline__ void p2_conv(const P2Args& a, LAS unsigned char* lds, int vcu, int G, int wave, int lane, int tid) {
    LAS float* red = (LAS float*)(lds + P2_RED_OFF);
    LAS float* tot = red + 256;
    const int c0 = 2 * tid;
    f32x2 w[KW];
#pragma unroll
    for (int k = 0; k < KW; ++k) w[k] = *(const GAS f32x2*)(a.conv_w + k * DC + c0);
    const f32x2 bias = *(const GAS f32x2*)(a.conv_b + c0), lg = *(const GAS f32x2*)(a.ln_g + c0), lb = *(const GAS f32x2*)(a.ln_b + c0);
    unsigned rows[8 + KW - 1], rowsN[8 + KW - 1];
    if (vcu < 1024 + DB) CONV_LOAD_ROWS(rows, vcu);
    for (int it = vcu; it < 1024 + DB; it += G) {
        const int itn = it + G;
        if (itn < 1024 + DB) CONV_LOAD_ROWS(rowsN, itn);
        const int orow = it < 1024 ? (it >> 8) * SEQ + (it & 255) * 8 : MP + (it - 1024) * DSQ;
        f32x2 acc[8];
#pragma unroll
        for (int j = 0; j < 8; ++j) acc[j] = bias;
#pragma unroll
        for (int r = 0; r < 8 + KW - 1; ++r) {
            const f32x2 v = {bf_lo(rows[r]), bf_hi(rows[r])};
#pragma unroll
            for (int j = 0; j < 8; ++j) { const int k = r - j; if (k >= 0 && k < KW) acc[j] += w[k] * v; }
        }
        float st[16];
#pragma unroll
        for (int j = 0; j < 8; ++j) { st[j] = acc[j].x + acc[j].y; st[8 + j] = acc[j].x * acc[j].x + acc[j].y * acc[j].y; }
#pragma unroll
        for (int j = 0; j < 16; ++j) st[j] = wave_sum(st[j]);
        if (lane == 0) {
#pragma unroll
            for (int j = 0; j < 16; ++j) red[wave * 16 + j] = st[j]; }
        __syncthreads();
        if (tid < 16) { float s = 0.f;
#pragma unroll
            for (int wv = 0; wv < 8; ++wv) s += red[wv * 16 + tid];
            tot[tid] = s; }
        __syncthreads();
        float q[8];
#pragma unroll
        for (int j = 0; j < 8; ++j) { const float mu = tot[j] * (1.0f / DC), var = tot[8 + j] * (1.0f / DC) - mu * mu, rs = __builtin_amdgcn_rsqf(var + 1e-6f);
            f32x2 y = (acc[j] - mu) * rs * lg + lb; y.x = y.x * fsigm(y.x); y.y = y.y * fsigm(y.y); acc[j] = y; q[j] = y.x * y.x + y.y * y.y; }
#pragma unroll
        for (int j = 0; j < 8; ++j) q[j] = wave_sum(q[j]);
        if (lane == 0) {
#pragma unroll
            for (int j = 0; j < 8; ++j) red[128 + wave * 16 + j] = q[j]; }
        __syncthreads();
        if (tid < 8) { float s = 0.f;
#pragma unroll
            for (int wv = 0; wv < 8; ++wv) s += red[128 + wv * 16 + tid];
            tot[16 + tid] = s; }
        __syncthreads();
#pragma unroll
        for (int j = 0; j < 8; ++j) { const float r2 = __builtin_amdgcn_rsqf(tot[16 + j] * (1.0f / DC) + 1e-6f);
            *(GAS unsigned*)(a.MIX + (size_t)(orow + j) * D + c0) = cvtpk(acc[j].x * r2, acc[j].y * r2); }
#pragma unroll
        for (int r = 0; r < 8 + KW - 1; ++r) rows[r] = rowsN[r];
    }
    __syncthreads();
}

__device__ __forceinline__ void p2_newconv(const P2Args& a, int vcu, int G, int tid) {
    constexpr int NPV = BATCH * (KW - 1) * (DC / 4), NSV = DB * (KW - 1) * (DC / 4);
    for (int idx = vcu * (NWAVES * 64) + tid; idx < NPV + NSV; idx += G * NWAVES * 64) {
        if (idx < NPV) { const int c4 = idx & 255, j = (idx >> 8) % (KW - 1), b = idx / ((KW - 1) * 256);
            const v2u pk = *(const GAS v2u*)(a.UC + (size_t)(b * SEQ + SEQ - (KW - 1) + j) * DC + 4 * c4);
            const f32x4 v = {bf_lo(pk.x), bf_hi(pk.x), bf_lo(pk.y), bf_hi(pk.y)};
            *(GAS f32x4*)(a.ncp + (size_t)idx * 4) = v; }
        else { const int k = idx - NPV; const int c4 = k & 255, j = (k >> 8) % (KW - 1), b = k / ((KW - 1) * 256); const int id = j + DSQ; f32x4 v;
            if (id < KW - 1) v = *(const GAS f32x4*)(a.state_conv + ((size_t)b * (KW - 1) + id) * DC + 4 * c4);
            else { const v2u pk = *(const GAS v2u*)(a.UC + (size_t)(MP + b * DSQ + id - (KW - 1)) * DC + 4 * c4); v = (f32x4){bf_lo(pk.x), bf_hi(pk.x), bf_lo(pk.y), bf_hi(pk.y)}; }
            *(GAS f32x4*)(a.ncs + (size_t)k * 4) = v; }
    }
}

#define SSM_STEP(i) do { \
        const float nAr = __builtin_fmaf(aAr, hAr, __builtin_fmaf(-aAi, hAi, d00[i])), nAi = __builtin_fmaf(aAr, hAi, __builtin_fmaf(aAi, hAr, d01[i])); \
        const float nBr = __builtin_fmaf(aBr, hBr, __builtin_fmaf(-aBi, hBi, d10[i])), nBi = __builtin_fmaf(aBr, hBi, __builtin_fmaf(aBi, hBr, d11[i])); \
        hAr = nAr; hAi = nAi; hBr = nBr; hBi = nBi; } while (0)
#define SSM_MFMA(afrag) do { const f32x16 z16 = {0.f,0.f,0.f,0.f,0.f,0.f,0.f,0.f,0.f,0.f,0.f,0.f,0.f,0.f,0.f,0.f}; \
        d00 = __builtin_amdgcn_mfma_f32_32x32x16_bf16(afrag, bfr[0][0], z16, 0, 0, 0); d01 = __builtin_amdgcn_mfma_f32_32x32x16_bf16(afrag, bfr[0][1], z16, 0, 0, 0); \
        d10 = __builtin_amdgcn_mfma_f32_32x32x16_bf16(afrag, bfr[1][0], z16, 0, 0, 0); d11 = __builtin_amdgcn_mfma_f32_32x32x16_bf16(afrag, bfr[1][1], z16, 0, 0, 0); } while (0)
#define SSM_PUT_U(afrag) do { *(LAS bf16x8*)(utile + (s_r * 16 + i_r) * 32 + kc * 16) = afrag; } while (0)
#define SSM_EMIT(rowb0, rowb1) do { \
        LDS_WAIT(); __builtin_amdgcn_wave_barrier(); \
        _Pragma("unroll") for (int s_ = 0; s_ < 2; ++s_) { \
            f32x4 y_ = {0.f, 0.f, 0.f, 0.f}; \
            _Pragma("unroll") for (int ks = 0; ks < 4; ++ks) { const bf16x8 hf = *(const LAS bf16x8*)(tile + s_ * P2_TILE_B + (lane & 15) * P2_TROW + ks * 64 + (lane >> 4) * 16); \
                y_ = __builtin_amdgcn_mfma_f32_16x16x32_bf16(hf, cfr[ks], y_, 0, 0, 0); } \
            const int rb_ = s_ ? (rowb1) : (rowb0); float v_[4]; \
            _Pragma("unroll") for (int i_ = 0; i_ < 4; ++i_) { const unsigned short ub_ = *(const LAS unsigned short*)(utile + (s_ * 16 + 4 * (lane >> 4) + i_) * 32 + (lane & 15) * 2); \
                v_[i_] = gelu_tanh_f(y_[i_] + dsk * __builtin_bit_cast(float, (unsigned)ub_ << 16)); } \
            const unsigned w01_ = cvtpk(v_[0], v_[1]), w23_ = cvtpk(v_[2], v_[3]); \
            bf16* go_ = a.G + (size_t)(rb_ + 4 * (lane >> 4)) * DS + g * CH + (lane & 15); \
            go_[0] = (bf16)w01_; go_[DS] = (bf16)(w01_ >> 16); go_[2 * DS] = (bf16)w23_; go_[3 * DS] = (bf16)(w23_ >> 16); } \
        LDS_WAIT(); __builtin_amdgcn_wave_barrier(); } while (0)
#define SSM_TILE_ROW(i) do { v2u hw_; hw_.x = cvtpk(hAr, hAi); hw_.y = cvtpk(hBr, hBi); *(LAS v2u*)(mytile + (i) * P2_TROW) = hw_; } while (0)

__device__ __forceinline__ void p2_ssm(const P2Args& a, LAS unsigned char* lds, int vcu, int G, int wave, int lane, int tid) {
    const int col = lane & 31, half = lane >> 5;
    const int r = lane & 31, s_r = (r >> 2) & 1, i_r = (r & 3) + 4 * (r >> 3), kc = lane >> 5;
    LAS unsigned char* tile = lds + P2_TILE_OFF + wave * 2 * P2_TILE_B;
    LAS unsigned char* mytile = tile + half * P2_TILE_B + col * 8;
    LAS unsigned char* utile = lds + P2_UT_OFF + wave * 1024;
    LAS f32x4* SX = (LAS f32x4*)(lds + P2_SX_OFF);
    for (int it = vcu; it < BATCH * NG; it += G) {
        const int g = it & (NG - 1), pb = it >> 6;
        const float* AB = (const float*)(a.tab + TAB_AB) + (size_t)(g * NP + 2 * col) * 2;
        const f32x4 ab4 = *(const GAS f32x4*)AB;
        const float aAr = ab4.x, aAi = ab4.y, aBr = ab4.z, aBi = ab4.w;
        bf16x8 bfr[2][2], cfr[4];
#pragma unroll
        for (int pair = 0; pair < 2; ++pair)
#pragma unroll
            for (int ri = 0; ri < 2; ++ri) bfr[pair][ri] = *(const GAS bf16x8*)((const bf16*)(a.tab + TAB_BBT) + ((size_t)(g * 2 + ri) * NP + 2 * col + pair) * CH + 8 * kc);
#pragma unroll
        for (int ks = 0; ks < 4; ++ks) cfr[ks] = *(const GAS bf16x8*)((const bf16*)(a.tab + TAB_CQ) + ((size_t)g * CH + (lane & 15)) * 128 + 32 * ks + 8 * (lane >> 4));
        const float dsk = a.Dk[g * CH + (lane & 15)];
        f32x16 d00, d01, d10, d11;
        {
            const bf16* abase = a.SI + (size_t)(pb * SEQ + (2 * wave + s_r) * 128 + i_r) * DS + g * CH + 8 * kc;
            float hAr = 0.f, hAi = 0.f, hBr = 0.f, hBi = 0.f;
            bf16x8 a0 = *(const GAS bf16x8*)abase, a1 = *(const GAS bf16x8*)(abase + (size_t)1 * 16 * DS), a2 = *(const GAS bf16x8*)(abase + (size_t)2 * 16 * DS), a3 = *(const GAS bf16x8*)(abase + (size_t)3 * 16 * DS);
#pragma unroll 1
            for (int blk = 0; blk < 8; ++blk) {
                const bf16x8 an = *(const GAS bf16x8*)(abase + (size_t)((blk + 4) & 7) * 16 * DS);
                SSM_MFMA(a0);
#pragma unroll
                for (int i = 0; i < 16; ++i) SSM_STEP(i);
                a0 = a1; a1 = a2; a2 = a3; a3 = an;
            }
            __syncthreads();
            SX[(2 * wave + half) * 32 + col] = (f32x4){hAr, hAi, hBr, hBi};
            __syncthreads();
            float pAr = aAr, pAi = aAi, pBr = aBr, pBi = aBi;
#pragma unroll
            for (int sq = 0; sq < 7; ++sq) { const float t0 = pAr * pAr - pAi * pAi, t1 = 2.0f * pAr * pAi, t2 = pBr * pBr - pBi * pBi, t3 = 2.0f * pBr * pBi; pAr = t0; pAi = t1; pBr = t2; pBi = t3; }
            hAr = 0.f; hAi = 0.f; hBr = 0.f; hBi = 0.f;
            const int mine = 2 * wave + half;
            for (int s2 = 0; s2 < mine; ++s2) { const f32x4 sv = SX[s2 * 32 + col];
                const float nAr = pAr * hAr - pAi * hAi + sv.x, nAi = pAr * hAi + pAi * hAr + sv.y, nBr = pBr * hBr - pBi * hBi + sv.z, nBi = pBr * hBi + pBi * hBr + sv.w;
                hAr = nAr; hAi = nAi; hBr = nBr; hBi = nBi; }
#pragma unroll 1
            for (int blk = 0; blk < 8; ++blk) {
                const bf16x8 an = *(const GAS bf16x8*)(abase + (size_t)((blk + 4) & 7) * 16 * DS);
                SSM_MFMA(a0);
                SSM_PUT_U(a0);
#pragma unroll
                for (int i = 0; i < 16; ++i) { SSM_STEP(i); SSM_TILE_ROW(i); }
                const int rb = pb * SEQ + (2 * wave) * 128 + blk * 16;
                SSM_EMIT(rb, rb + 128);
                a0 = a1; a1 = a2; a2 = a3; a3 = an;
            }
            if (mine == 15) { const size_t o = ((size_t)pb * NG + g) * NP + 2 * col;
                *(GAS f32x2*)(a.nrp + o) = (f32x2){hAr, hBr}; *(GAS f32x2*)(a.nip + o) = (f32x2){hAi, hBi}; }
        }
        {
            const int bA_load = 32 * pb + 4 * wave + 2 * s_r, bA = 32 * pb + 4 * wave + 2 * half;
            const bf16x8 afS = *(const GAS bf16x8*)(a.SI + (size_t)(MP + bA_load * DSQ + i_r) * DS + g * CH + 8 * kc);
            size_t o = ((size_t)bA * NG + g) * NP + 2 * col;
            f32x2 t0 = *(const GAS f32x2*)(a.h0re + o), t1 = *(const GAS f32x2*)(a.h0im + o);
            SSM_MFMA(afS);
            SSM_PUT_U(afS);
            float hAr = t0.x, hBr = t0.y, hAi = t1.x, hBi = t1.y;
#pragma unroll
            for (int i = 0; i < 8; ++i) { SSM_STEP(i); SSM_TILE_ROW(i); }
            *(GAS f32x2*)(a.nrs + o) = (f32x2){hAr, hBr}; *(GAS f32x2*)(a.nis + o) = (f32x2){hAi, hBi};
            o += (size_t)NG * NP;
            t0 = *(const GAS f32x2*)(a.h0re + o); t1 = *(const GAS f32x2*)(a.h0im + o);
            hAr = t0.x; hBr = t0.y; hAi = t1.x; hBi = t1.y;
#pragma unroll
            for (int i = 8; i < 16; ++i) { SSM_STEP(i); SSM_TILE_ROW(i); }
            *(GAS f32x2*)(a.nrs + o) = (f32x2){hAr, hBr}; *(GAS f32x2*)(a.nis + o) = (f32x2){hAi, hBi};
            const int rb = MP + (32 * pb + 4 * wave) * DSQ;
            SSM_EMIT(rb, rb + 16);
        }
    }
    __syncthreads();
}

#ifndef NP_P1
#define NP_P1 32
#endif
#ifndef NP_P3
#define NP_P3 32
#endif
#ifndef NP_P5
#define NP_P5 16
#endif
#ifndef NP_P6
#define NP_P6 32
#endif
#ifndef NP_P7
#define NP_P7 16
#endif
struct Args { const float* in[28]; float* out; unsigned char* ws; int lo, hi, dryk, li; };
__global__ void __launch_bounds__(NWAVES * 64, 2) mk_fwd(Args args) {
    __shared__ __attribute__((aligned(16))) unsigned char lds_raw[LDS_BYTES];
    LAS unsigned char* lds = (LAS unsigned char*)lds_raw;
    volatile LAS unsigned* MISC = (volatile LAS unsigned*)(lds + MISC_OFF);
    const int tid = threadIdx.x, lane = tid & 63, wave = __builtin_amdgcn_readfirstlane(tid >> 6);
    const int G = gridDim.x; const int bx = blockIdx.x; const int vcu = (G % 8 == 0) ? (bx % 8) * (G / 8) + bx / 8 : bx;
    unsigned char* ws = args.ws;
    gu32* ctl = (gu32*)(ws + WS_CTL);
    for (int u = tid; u < (LDS_BYTES - LDSCTL_OFF) / 4; u += NWAVES * 64) ((LAS unsigned*)(lds + LDSCTL_OFF))[u] = 0u;
    __syncthreads();
    XcdBarrier bar; bar.bar = (unsigned*)(ctl + CW_BAR) + args.li * XCD_BAR_WORDS; bar.x = 0; bar.st = nullptr;
    if (N_LAUNCHES != NPH) bar = xcd_barrier_post((unsigned*)(ctl + CW_BAR) + args.li * XCD_BAR_WORDS, MISC + 8);
#define GRID_BAR(seam) do { if (N_LAUNCHES == NPH) { if (tid == 0) __hip_atomic_store(ctl + CW_TMO, 0xBADBA0u | (unsigned)(seam), RLX_AGENT); } else { xcd_barrier(bar); } } while (0)
    const int lo = args.lo, hi = args.hi, dryk = args.dryk;
#define DRY(k) (dryk == (k))
#ifndef ONLY_PHASE
#define ONLY_PHASE -1
#endif
#define IN(k) (ONLY_PHASE < 0 ? (lo <= (k) && (k) < hi) : (k) == ONLY_PHASE)
#define BOTH(k) (IN(k) && IN((k) + 1))
    float* out = args.out;
    float* Y = out;
    float* ncp = out + (size_t)M * D;
    float* nrp = ncp + (size_t)BATCH * (KW - 1) * DC;
    float* nip = nrp + (size_t)BATCH * NG * NP;
    float* ncs = nip + (size_t)BATCH * NG * NP;
    float* nrs = ncs + (size_t)DB * (KW - 1) * DC;
    float* nis = nrs + (size_t)DB * NG * NP;
    bf16 *WGU = (bf16*)(ws + WS_WGU), *WDN = (bf16*)(ws + WS_WDN), *XB = (bf16*)(ws + WS_XB), *WIN = (bf16*)(ws + WS_WIN), *WGL = (bf16*)(ws + WS_WGL), *WOUT = (bf16*)(ws + WS_WOUT);
    bf16 *UC = (bf16*)(ws + WS_U), *SI = (bf16*)(ws + WS_S), *GB = (bf16*)(ws + WS_G), *MIX = (bf16*)(ws + WS_MIX), *ACT = (bf16*)(ws + WS_ACT);
    float* ssq_dummy = (float*)(ws + WS_CTL) + CW_DUMMY;
    float* ssq_s = (float*)(ws + WS_CTL) + CW_SSQ_S; float* ssq_h = (float*)(ws + WS_CTL) + CW_SSQ_H; float* ssq_o = (float*)(ws + WS_CTL) + CW_SSQ_O; float* rx = (float*)(ws + WS_CTL) + CW_RX;
    const int gw = vcu * NWAVES + wave, NGW = G * NWAVES;

    if (IN(0)) {
        P0Args a; a.xp = args.in[0]; a.xs = args.in[1]; a.norm_mix = args.in[5]; a.w_in = args.in[6]; a.w_glu = args.in[19]; a.gn_conv = args.in[20]; a.gn_ssm = args.in[21]; a.w_out = args.in[22];
        a.norm_ffn = args.in[23]; a.w_gate = args.in[24]; a.w_up = args.in[25]; a.w_down = args.in[26];
        a.A_re = args.in[11]; a.A_im = args.in[12]; a.log_dt = args.in[13]; a.B_re = args.in[14]; a.B_im = args.in[15]; a.C_re = args.in[16]; a.C_im = args.in[17];
        a.WIN = WIN; a.WGL = WGL; a.WOUT = WOUT; a.WGU = WGU; a.WDN = WDN; a.XB = XB; a.rx = rx; a.tab = ws + WS_TAB;
        p0_prologue(a, lds, vcu, G, wave, lane, tid);
        if (BOTH(0)) GRID_BAR(0);
    }
    if (IN(1)) {
        pg8::Gemm g{XB, WIN, M, DIN, D};
#define SCHED(slot, slabo, N_, K_, NP_, RS_) typedef pg8::HybridOrder<N_, K_, NP_, RS_> Sch; Sch S; S.init((int)blockIdx.x, ws + (slabo), (unsigned*)(ctl + CW_FLAGS + (slot) * FLAG_SLOT), (unsigned*)(ctl + CW_TMO))
        SCHED(0, SLAB_P1, DIN, D, NP_P1, 0);
        pg8::EpiIn E{UC, SI, rx};
        pg8::gemm_phase<pg8::EpiIn, Sch, true, true>(lds + RING_OFF, g, S, E);
        if (BOTH(1)) GRID_BAR(1);
    }
    if (IN(2)) {
        P2Args a; a.UC = UC; a.SI = SI; a.G = GB; a.MIX = MIX; a.state_conv = args.in[2]; a.h0re = args.in[3]; a.h0im = args.in[4];
        a.conv_w = args.in[7]; a.conv_b = args.in[8]; a.ln_g = args.in[9]; a.ln_b = args.in[10]; a.Dk = args.in[18]; a.tab = ws + WS_TAB;
        a.ncp = ncp; a.nrp = nrp; a.nip = nip; a.ncs = ncs; a.nrs = nrs; a.nis = nis;
        p2_ssm(a, lds, vcu, G, wave, lane, tid);
        p2_conv(a, lds, vcu, G, wave, lane, tid);
        p2_newconv(a, vcu, G, tid);
        if (BOTH(2)) GRID_BAR(2);
    }
    if (IN(3)) {
        pg8::Gemm g{GB, WGL, M, DS, DS}; SCHED(1, SLAB_P3, DS, DS, NP_P3, 0);
        pg8::EpiGlu E{GB, MIX, DRY(3) ? ssq_dummy : ssq_s};
        pg8::gemm_phase<pg8::EpiGlu, Sch, true, true>(lds + RING_OFF, g, S, E);
        if (BOTH(3)) GRID_BAR(3);
    }
    if (IN(4)) {
        for (int row = gw; row < M; row += NGW) {
            const float r = DRY(4) ? 1.0f : 1.0f / sqrtf(__hip_atomic_load(ssq_s + row, RLX_AGENT) * (1.0f / DS) + 1e-6f);
            GAS v4u* p = (GAS v4u*)(MIX + (size_t)row * D + DC) + 2 * lane;
#pragma unroll
            for (int j = 0; j < 2; ++j) { v4u w = p[j]; w.x = pk2(bf_lo(w.x) * r, bf_hi(w.x) * r); w.y = pk2(bf_lo(w.y) * r, bf_hi(w.y) * r); w.z = pk2(bf_lo(w.z) * r, bf_hi(w.z) * r); w.w = pk2(bf_lo(w.w) * r, bf_hi(w.w) * r); p[j] = w; }
        }
        if (BOTH(4)) GRID_BAR(4);
    }
    if (IN(5)) {
        pg8::Gemm g{MIX, WOUT, M, D, D}; SCHED(2, SLAB_P5, D, D, NP_P5, 8);
        pg8::EpiOut E{args.in[0], args.in[1], Y, XB, DRY(5) ? ssq_dummy : ssq_h};
        pg8::gemm_phase<pg8::EpiOut, Sch, true, true>(lds + RING_OFF, g, S, E);
        if (BOTH(5)) GRID_BAR(5);
    }
    if (IN(6)) {
        pg8::Gemm g{XB, WGU, M, 2 * DFF, D}; SCHED(3, SLAB_P6, 2 * DFF, D, NP_P6, 5);
        pg8::EpiUp E{ACT, ssq_h};
        pg8::gemm_phase<pg8::EpiUp, Sch, true, true>(lds + RING_OFF, g, S, E);
        if (BOTH(6)) GRID_BAR(6);
    }
    if (IN(7)) {
        pg8::Gemm g{ACT, WDN, M, D, DFF}; SCHED(4, SLAB_P7, D, DFF, NP_P7, 8);
        pg8::EpiDown E{Y, DRY(7) ? ssq_dummy : ssq_o, DRY(7) ? 0.0f : 1.0f};
        pg8::gemm_phase<pg8::EpiDown, Sch, true, true>(lds + RING_OFF, g, S, E);
        if (BOTH(7)) GRID_BAR(7);
    }
    if (IN(8)) {
        const float* gfin = args.in[27];
        for (int row = gw; row < M; row += NGW) {
            const float r = DRY(8) ? 1.0f : 1.0f / sqrtf(__hip_atomic_load(ssq_o + row, RLX_AGENT) * (1.0f / D) + 1e-6f);
            GAS f32x4* p = (GAS f32x4*)(Y + (size_t)row * D) + lane; const GAS f32x4* gp = (const GAS f32x4*)gfin + lane;
#pragma unroll
            for (int j = 0; j < 8; ++j) p[64 * j] = p[64 * j] * r * (DRY(8) ? (f32x4){1.f, 1.f, 1.f, 1.f} : gp[64 * j]);
        }
    }
#undef DRY
#undef IN
#undef BOTH
#undef GRID_BAR
}

extern "C" void kernel_launch(void* const* d_in, const int* in_sizes, int n_in, void* d_out, int out_size, void* d_ws, size_t ws_size, hipStream_t stream) {
    static int grid = 0;
    if (grid == 0) {
        const long want_out = (long)M * D + (long)(BATCH + DB) * ((KW - 1) * DC + 2 * NG * NP);
        if (n_in != 28 || in_sizes[0] != MP * D || (long)out_size != want_out || ws_size < WS_END) {
            fprintf(stderr, "kernel_launch: unexpected shapes (n_in %d, in0 %d, out %d (want %ld), ws %zu (need %zu)); nothing launched\n", n_in, n_in > 0 ? in_sizes[0] : -1, out_size, want_out, ws_size, (size_t)WS_END); grid = -1; return; }
        int dev = 0, cus = 0;
        if (hipGetDevice(&dev) != hipSuccess || hipDeviceGetAttribute(&cus, hipDeviceAttributeMultiprocessorCount, dev) != hipSuccess) { fprintf(stderr, "kernel_launch: device query failed\n"); grid = -1; return; }
        if (cus != 256) fprintf(stderr, "kernel_launch: built for 256 CUs, device has %d\n", cus);
        grid = 256;
    }
    if (grid < 0) return;
    if (hipMemsetAsync((char*)d_ws + WS_CTL, 0, CTL_ZERO_BYTES, stream) != hipSuccess) { fprintf(stderr, "kernel_launch: memset failed\n"); return; }
    Args a{};
    for (int i = 0; i < 28; ++i) a.in[i] = (const float*)d_in[i];
    a.out = (float*)d_out; a.ws = (unsigned char*)d_ws;
#ifdef PROBE_PHASE
    constexpr int NL = 2;
#else
    constexpr int NL = N_LAUNCHES;
#endif
    for (int li = 0; li < NL; ++li) {
        a.dryk = -1;
        if (N_LAUNCHES == NPH) { a.lo = li; a.hi = li + 1; } else { a.lo = 0; a.hi = NPH; }
#ifdef PROBE_PHASE
        if (li == 0) { a.lo = 0; a.hi = PROBE_PHASE + 1; } else { a.lo = PROBE_PHASE; a.hi = NPH; a.dryk = PROBE_PHASE; }
#endif
        a.li = li;
        hipLaunchKernelGGL(mk_fwd, dim3(grid), dim3(NWAVES * 64), 0, stream, a);
        const hipError_t le = hipPeekAtLastError();
        if (le != hipSuccess) { fprintf(stderr, "kernel_launch: launch %d failed: %s\n", li, hipGetErrorName(le)); break; }
    }
}
```

```cpp
#include <hip/hip_runtime.h>
#include <cstdio>
#include <cstdint>
#define MK_N_LAUNCHES 1
namespace pg8 {
#define PG8_LAS __attribute__((address_space(3)))
typedef unsigned short bf16_t;
typedef short bf16x8 __attribute__((ext_vector_type(8)));
typedef float f32x4 __attribute__((ext_vector_type(4)));
typedef unsigned u32x4 __attribute__((ext_vector_type(4)));
constexpr int BM = 256, BK = 64, HALF = 128, HTB = HALF * BK * 2  , STAGE_BYTES = 8 * HTB, NXCD = 8, WGM = 4;

__host__ __device__ __forceinline__ int lds_byte(int r, int c) { const int st = (r >> 4) * 2 + (c >> 5), rr = r & 15, cc = c & 31, ob = rr * 64 + cc * 2; return st * 1024 + (ob ^ (((ob >> 9) & 1) << 5)); }
__host__ __device__ __forceinline__ void stage_rc(int b, int& R, int& C) { const int st = b / 1024, sb = b % 1024, swz = sb ^ (((sb >> 9) & 1) << 5); R = (st >> 1) * 16 + swz / 64; C = (st & 1) * 32 + (swz % 64) / 2; }
__host__ __device__ __forceinline__ int perm32(int rho) { const int n = rho >> 4, i = rho & 15; return 8 * (i >> 2) + 4 * n + (i & 3); }

struct Unit { int pm, pn, k0, nt, mode, need; };
struct Gemm { const bf16_t* A; const bf16_t* Bt; int M, N, K; };

__device__ __forceinline__ unsigned cvt_pk_bf16(float lo, float hi) { unsigned r; asm volatile("v_cvt_pk_bf16_f32 %0, %1, %2" : "=v"(r) : "v"(lo), "v"(hi)); return r; }
template <class Epi, class Sched, bool ALIGN_EPI = false, bool SP2 = false>
__device__ __forceinline__ void gemm_phase(PG8_LAS unsigned char* lds, const Gemm g, Sched& S, const Epi& E) {
    const int tid = threadIdx.x, wid = __builtin_amdgcn_readfirstlane(tid >> 6), lane = tid & 63, wr = wid >> 2, wc = wid & 3, fr = lane & 15, fq = lane >> 4;
    constexpr int K = Sched::KK;
    unsigned voffA[2], voffB[2];
#pragma unroll
    for (int i = 0; i < 2; ++i) { int R, C; stage_rc(tid * 16 + i * 8192, R, C); const int Rb = Epi::PERM ? ((R & ~31) + perm32(R & 31)) : R;
        voffA[i] = (unsigned)(R * K + C) * 2u; voffB[i] = (unsigned)(Rb * K + C) * 2u; }
    const size_t kstep = (size_t)(BK * 2);
    const size_t hstep = (size_t)HALF * K * 2;
    const size_t tstep = 2 * hstep;
    const unsigned ldsw = (unsigned)wid * 1024u;
    const int aoff = lds_byte(wr * 64 + fr, fq * 8), boff = lds_byte(wc * 32 + fr, fq * 8);
#define PG8_SA(b, h) (((b) * 2 + (h)) * HTB)
#define PG8_SB(b, h) ((4 + (b) * 2 + (h)) * HTB)
#define PG8_STAGE(bufoff, gbase, voff) do { _Pragma("unroll") for (int _i = 0; _i < 2; ++_i) \
        __builtin_amdgcn_global_load_lds((const unsigned*)((const char*)(gbase) + (voff)[_i]), (PG8_LAS unsigned*)(lds + (bufoff) + ldsw + _i * 8192), 16, 0, 0); } while (0)
#define PG8_LDA(dst, b, h) do { _Pragma("unroll") for (int m = 0; m < 4; ++m) _Pragma("unroll") for (int k = 0; k < 2; ++k) dst[m][k] = *(const PG8_LAS bf16x8*)(lds + PG8_SA(b, h) + aoff + m * 2048 + k * 1024); } while (0)
#define PG8_LDB(dst, b, h) do { _Pragma("unroll") for (int n = 0; n < 2; ++n) _Pragma("unroll") for (int k = 0; k < 2; ++k) dst[n][k] = *(const PG8_LAS bf16x8*)(lds + PG8_SB(b, h) + boff + n * 2048 + k * 1024); } while (0)
#define PG8_MMA(ai, bj, At, Bt) do { __builtin_amdgcn_s_setprio(1); _Pragma("unroll") for (int m = 0; m < 4; ++m) _Pragma("unroll") for (int n = 0; n < 2; ++n) _Pragma("unroll") for (int k = 0; k < 2; ++k) \
        acc[ai][bj][m][n] = __builtin_amdgcn_mfma_f32_16x16x32_bf16(Bt[n][k], At[m][k], acc[ai][bj][m][n], 0, 0, 0); __builtin_amdgcn_s_setprio(0); } while (0)
#define PG8_WAIT_V(n) asm volatile("s_waitcnt vmcnt(" #n ")" ::: "memory")
#define PG8_WAIT_L(n) asm volatile("s_waitcnt lgkmcnt(" #n ")" ::: "memory")
#define PG8_BAR __builtin_amdgcn_s_barrier()
#define PG8_SCHED __builtin_amdgcn_sched_barrier(0)
    Unit cur, nxt; int ui = 0;
    if (!S.next(0, cur)) return;
    f32x4 acc[2][2][4][2];
#pragma unroll
    for (int a = 0; a < 2; ++a)
#pragma unroll
        for (int b = 0; b < 2; ++b)
#pragma unroll
            for (int m = 0; m < 4; ++m)
#pragma unroll
                for (int n = 0; n < 2; ++n) acc[a][b][m][n] = (f32x4){0.f, 0.f, 0.f, 0.f};
    bf16x8 At[4][2], B0[2][2], B1[2][2];
    const char* cA = (const char*)g.A + (size_t)cur.pm * tstep + (size_t)cur.k0 * kstep; const char* cB = (const char*)g.Bt + (size_t)cur.pn * tstep + (size_t)cur.k0 * kstep;
    S.a_ready(cur);
    if constexpr (SP2) {
        PG8_STAGE(PG8_SB(0, 0), cB, voffB); PG8_STAGE(PG8_SB(0, 1), cB + hstep, voffB); PG8_STAGE(PG8_SA(0, 0), cA, voffA); PG8_STAGE(PG8_SA(0, 1), cA + hstep, voffA);
        if (wr == 1) PG8_BAR;
        PG8_WAIT_V(2); PG8_BAR;
        PG8_STAGE(PG8_SB(1, 0), cB + kstep, voffB); PG8_STAGE(PG8_SA(1, 0), cA + kstep, voffA); PG8_STAGE(PG8_SB(1, 1), cB + hstep + kstep, voffB);
        PG8_WAIT_V(6); PG8_BAR;
    } else {
        PG8_STAGE(PG8_SB(0, 0), cB, voffB); PG8_STAGE(PG8_SA(0, 0), cA, voffA); PG8_STAGE(PG8_SB(0, 1), cB + hstep, voffB); PG8_STAGE(PG8_SA(0, 1), cA + hstep, voffA);
        if (wr == 1) PG8_BAR;
        PG8_WAIT_V(4); PG8_BAR;
        PG8_STAGE(PG8_SB(1, 0), cB + kstep, voffB); PG8_STAGE(PG8_SA(1, 0), cA + kstep, voffA); PG8_STAGE(PG8_SB(1, 1), cB + hstep + kstep, voffB);
        PG8_WAIT_V(6); PG8_BAR;
    }
    for (;;) {
        const bool has_next = S.next(ui + 1, nxt);
        const char* nA = has_next ? (const char*)g.A + (size_t)nxt.pm * tstep + (size_t)nxt.k0 * kstep : cA; const char* nB = has_next ? (const char*)g.Bt + (size_t)nxt.pn * tstep + (size_t)nxt.k0 * kstep : cB;
        const int nt = cur.nt;
        for (int t = 0; t < nt; t += 2) {
            const bool last = (t == nt - 2);
            const char* a1 = cA + (size_t)(t + 1) * kstep;
            const char* a2 = last ? nA : cA + (size_t)(t + 2) * kstep; const char* b2 = last ? nB : cB + (size_t)(t + 2) * kstep;
            const char* a3 = a2 + kstep; const char* b3 = b2 + kstep;
            if (last && has_next) S.a_ready(nxt);
            if constexpr (SP2) {
            PG8_LDB(B0, 0, 0); PG8_LDB(B1, 0, 1); PG8_SCHED; PG8_LDA(At, 0, 0); PG8_STAGE(PG8_SA(1, 1), a1 + hstep, voffA);
            PG8_WAIT_V(8); PG8_WAIT_L(0); PG8_BAR; PG8_MMA(0, 0, At, B0); PG8_MMA(0, 1, At, B1); PG8_BAR; PG8_SCHED;
            PG8_LDA(At, 0, 1); PG8_STAGE(PG8_SB(0, 0), b2, voffB); PG8_STAGE(PG8_SB(0, 1), b2 + hstep, voffB); PG8_STAGE(PG8_SA(0, 0), a2, voffA);
            PG8_WAIT_V(8); PG8_WAIT_L(0); PG8_BAR; PG8_MMA(1, 0, At, B0); PG8_MMA(1, 1, At, B1); PG8_BAR; PG8_SCHED;
            PG8_LDB(B0, 1, 0); PG8_LDB(B1, 1, 1); PG8_SCHED; PG8_LDA(At, 1, 0); PG8_STAGE(PG8_SA(0, 1), a2 + hstep, voffA);
            PG8_WAIT_V(8); PG8_WAIT_L(0); PG8_BAR; PG8_MMA(0, 0, At, B0); PG8_MMA(0, 1, At, B1); PG8_BAR; PG8_SCHED;
            PG8_LDA(At, 1, 1); PG8_STAGE(PG8_SB(1, 0), b3, voffB); PG8_STAGE(PG8_SB(1, 1), b3 + hstep, voffB); PG8_STAGE(PG8_SA(1, 0), a3, voffA);
            PG8_WAIT_V(8); PG8_WAIT_L(0); PG8_BAR; PG8_MMA(1, 0, At, B0); PG8_MMA(1, 1, At, B1); PG8_BAR; PG8_SCHED;
            } else {
            PG8_LDB(B0, 0, 0); PG8_SCHED; PG8_LDA(At, 0, 0); PG8_STAGE(PG8_SA(1, 1), a1 + hstep, voffA);
            PG8_WAIT_L(8); PG8_BAR; PG8_WAIT_L(0); PG8_MMA(0, 0, At, B0); PG8_BAR; PG8_SCHED;
            PG8_LDB(B1, 0, 1); PG8_STAGE(PG8_SB(0, 0), b2, voffB);
            PG8_BAR; PG8_WAIT_L(0); PG8_MMA(0, 1, At, B1); PG8_BAR;
            PG8_LDA(At, 0, 1); PG8_STAGE(PG8_SA(0, 0), a2, voffA);
            PG8_BAR; PG8_WAIT_L(0); PG8_MMA(1, 0, At, B0); PG8_BAR; PG8_SCHED;
            PG8_STAGE(PG8_SB(0, 1), b2 + hstep, voffB);
            PG8_WAIT_V(6); PG8_BAR; PG8_MMA(1, 1, At, B1); PG8_BAR;
            PG8_LDB(B0, 1, 0); PG8_SCHED; PG8_LDA(At, 1, 0); PG8_STAGE(PG8_SA(0, 1), a2 + hstep, voffA);
            PG8_WAIT_L(8); PG8_BAR; PG8_WAIT_L(0); PG8_MMA(0, 0, At, B0); PG8_BAR; PG8_SCHED;
            PG8_LDB(B1, 1, 1); PG8_STAGE(PG8_SB(1, 0), b3, voffB);
            PG8_BAR; PG8_WAIT_L(0); PG8_MMA(0, 1, At, B1); PG8_BAR;
            PG8_LDA(At, 1, 1); PG8_STAGE(PG8_SA(1, 0), a3, voffA);
            PG8_BAR; PG8_WAIT_L(0); PG8_MMA(1, 0, At, B0); PG8_BAR; PG8_SCHED;
            PG8_STAGE(PG8_SB(1, 1), b3 + hstep, voffB);
            PG8_WAIT_V(6); PG8_BAR; PG8_MMA(1, 1, At, B1); PG8_BAR;
            }
        }
        if constexpr (ALIGN_EPI) { if (wr == 0) PG8_BAR; }
        static_assert(ALIGN_EPI && !Epi::AFTER_DRAIN, "the slab exchange needs both halves aligned in the epilogue");
        S.finish(acc, cur, E, tid, wid, wr, wc, fr, fq);
        if (!has_next) break;
        if (cur.mode != 4)
#pragma unroll
        for (int a = 0; a < 2; ++a)
#pragma unroll
            for (int b = 0; b < 2; ++b)
#pragma unroll
                for (int m = 0; m < 4; ++m)
#pragma unroll
                    for (int n = 0; n < 2; ++n) acc[a][b][m][n] = (f32x4){0.f, 0.f, 0.f, 0.f};
        cur = nxt; cA = nA; cB = nB; ++ui;
        if constexpr (ALIGN_EPI) { if (wr == 1) PG8_BAR; }
    }
    PG8_WAIT_V(0);
    if constexpr (!ALIGN_EPI) { if (wr == 0) PG8_BAR; }
    PG8_BAR;
    S.finish_last(acc, cur, E, tid, wid, wr, wc, fr, fq);
#undef PG8_SA
#undef PG8_SB
#undef PG8_STAGE
#undef PG8_LDA
#undef PG8_LDB
#undef PG8_MMA
#undef PG8_WAIT_V
#undef PG8_WAIT_L
#undef PG8_BAR
#undef PG8_SCHED
}
}

namespace pg8 {
constexpr float RMS_EPS = 1e-6f;
__device__ __forceinline__ float fsig(float x) { return __builtin_amdgcn_rcpf(1.0f + __builtin_amdgcn_exp2f(x * -1.4426950408889634f)); }
__device__ __forceinline__ float bflo(unsigned w) { return __builtin_bit_cast(float, w << 16); }
__device__ __forceinline__ float bfhi(unsigned w) { return __builtin_bit_cast(float, w & 0xffff0000u); }
__device__ __forceinline__ u32x4 pack8(const f32x4& a, const f32x4& b) { u32x4 w; w.x = cvt_pk_bf16(a[0], a[1]); w.y = cvt_pk_bf16(a[2], a[3]); w.z = cvt_pk_bf16(b[0], b[1]); w.w = cvt_pk_bf16(b[2], b[3]); return w; }
__device__ __forceinline__ float sq4(const f32x4& a) { return (a[0] * a[0] + a[1] * a[1]) + (a[2] * a[2] + a[3] * a[3]); }
__device__ __forceinline__ void row_atomic(float* p, float q, int fq) { q += __shfl_xor(q, 16); q += __shfl_xor(q, 32); if (fq == 0) (void)__hip_atomic_fetch_add(p, q, __ATOMIC_RELAXED, __HIP_MEMORY_SCOPE_AGENT); }


#define PG8_EPI_ALL __device__ __forceinline__ void operator()(const f32x4 (&acc)[2][2][4][2], const Unit& u, int wr, int wc, int fr, int fq) const { \
        grp<0, 0>(acc, u, wr, wc, fr, fq); grp<0, 1>(acc, u, wr, wc, fr, fq); grp<0, 2>(acc, u, wr, wc, fr, fq); grp<0, 3>(acc, u, wr, wc, fr, fq); \
        grp<1, 0>(acc, u, wr, wc, fr, fq); grp<1, 1>(acc, u, wr, wc, fr, fq); grp<1, 2>(acc, u, wr, wc, fr, fq); grp<1, 3>(acc, u, wr, wc, fr, fq); }
template <int N_, int K_, int NP_ = 32, int RS_ = 0, int MID_ = 0> struct HybridOrder {
    static constexpr size_t SLAB_BYTES = (size_t)BM * BM * 2;
    static constexpr int KK = K_, G = 256, nM = 9216 / BM, nN = N_ / BM, ntp = K_ / (2 * BK), nwg = nM * nN, per = G / 8, q = nwg / 8, R = NP_ > 0 ? q / per : (q + per - 1) / per, pairs = NP_ > 0 ? (q - R * per) * ntp : 0, np = NP_ <= 0 ? 1 : (NP_ < per ? NP_ : per), base = pairs / np, rem = pairs - base * np;
    static constexpr int Tr = q - R * per, S = RS_ > 0 ? RS_ : 1;
    static_assert(nwg % 8 == 0 && K_ % (2 * BK) == 0 && N_ % BM == 0 && (RS_ == 0 || (Tr * RS_ <= per && ntp >= RS_ && RS_ <= 8 && NP_ > 0)), "HybridOrder shapes");
    int x, j, rend, cur, vcu;
    unsigned char* slab; unsigned* flags; unsigned* tmo;
    __device__ __forceinline__ void init(int bx, unsigned char* slab_, unsigned* flags_, unsigned* tmo_) {
        x = bx & 7; j = bx >> 3;
        cur = j * base + (j < rem ? j : rem); rend = cur + base + (j < rem ? 1 : 0);
        if (j >= np) { cur = 0; rend = 0; }
        if (RS_ > 0) { cur = 0; rend = (j < Tr * S) ? 1 : 0; }
        vcu = x * per + j; slab = slab_; flags = flags_; tmo = tmo_;
    }
    __device__ __forceinline__ void tile_of(int wgid, Unit& u) const {
        constexpr int nig = WGM * nN; const int gid = wgid / nig, fm = gid * WGM, gsz = (nM - fm) < WGM ? (nM - fm) : WGM;
        u.pm = fm + ((wgid % nig) % gsz); u.pn = (wgid % nig) / gsz;
    }
    __device__ __forceinline__ bool next(int i, Unit& u) {
        if (MID_ > 0) { if (i < 2 * R) { const int ii = i >> 1; tile_of(x * q + ii * per + j, u); u.need = 0;
                if (i & 1) { u.k0 = MID_; u.nt = 2 * ntp - MID_; u.mode = 0; } else { u.k0 = 0; u.nt = MID_; u.mode = 4; } return true; } }
        else if (i < R) { if (i * per + j >= q) return false; tile_of(x * q + i * per + j, u); u.k0 = 0; u.nt = 2 * ntp; u.mode = 0; u.need = 0; return true; }
        if (cur >= rend) return false;
        if (RS_ > 0) { const int t = j / S, p = j - t * S; constexpr int b = ntp / S, e = ntp - b * S;
            tile_of(x * q + R * per + t, u); u.k0 = 2 * (p * b + (p < e ? p : e)); u.nt = 2 * (b + (p < e ? 1 : 0)); u.mode = 3; u.need = p; cur = rend; return true; }
        const int t = cur / ntp, off = cur - t * ntp; int len = ntp - off; if (len > rend - cur) len = rend - cur;
        tile_of(x * q + R * per + t, u); u.k0 = 2 * off; u.nt = 2 * len; u.need = ntp - off - len;
        u.mode = off > 0 ? 1 : (u.need > 0 ? 2 : 0);
        cur += len; return true;
    }
    __device__ __forceinline__ void a_ready(const Unit&) const {}
    template <class Epi> __device__ __forceinline__ void finish(f32x4 (&acc)[2][2][4][2], const Unit& u, const Epi& E, int tid, int wid, int wr, int wc, int fr, int fq) const {
        asm volatile("" : "+v"(tid), "+v"(fr), "+v"(fq));
        if constexpr (RS_ == 0 && NP_ > 0) if (u.mode == 1) {
            __amdgpu_buffer_rsrc_t rs = __builtin_amdgcn_make_buffer_rsrc(slab + (size_t)vcu * SLAB_BYTES, 0, (int)SLAB_BYTES, 0x00020000);
            const int vo = tid * 16;
#pragma unroll
            for (int ai = 0; ai < 2; ++ai)
#pragma unroll
                for (int bj = 0; bj < 2; ++bj)
#pragma unroll
                    for (int m = 0; m < 4; ++m) { __builtin_amdgcn_raw_buffer_store_b128(pack8(acc[ai][bj][m][0], acc[ai][bj][m][1]), rs, vo + (ai * 8 + bj * 4 + m) * 8192, 0, 16); asm volatile("" ::: "memory"); }
            asm volatile("s_waitcnt vmcnt(0)" ::: "memory");
            __builtin_amdgcn_s_barrier();
            if (tid == 0) __hip_atomic_store(flags + 64 * vcu, 1u, __ATOMIC_RELAXED, __HIP_MEMORY_SCOPE_AGENT);
            return;
        }
        if constexpr (Epi::MIDK > 0) { if (u.mode == 4) { E.midscale(acc, u, wr, fr); return; } }
        if (u.mode >= 2) return;
        E(acc, u, wr, wc, fr, fq);
    }
    template <class Epi> __device__ __forceinline__ void finish_rs(f32x4 (&acc)[2][2][4][2], const Unit& u, const Epi& E, int tid, int wid, int wr, int wc, int fr, int fq) const {
        const int p = u.need, first = vcu - p;
        if constexpr (Epi::MIDK > 0) { if (u.k0 + u.nt <= Epi::MIDK) E.midscale(acc, u, wr, fr); }
        { __amdgpu_buffer_rsrc_t rs = __builtin_amdgcn_make_buffer_rsrc(slab + (size_t)vcu * SLAB_BYTES, 0, (int)SLAB_BYTES, 0x00020000);
          const int vo = tid * 16;
#pragma unroll
          for (int ai = 0; ai < 2; ++ai)
#pragma unroll
              for (int bj = 0; bj < 2; ++bj)
#pragma unroll
                  for (int m = 0; m < 4; ++m) { __builtin_amdgcn_raw_buffer_store_b128(pack8(acc[ai][bj][m][0], acc[ai][bj][m][1]), rs, vo + (ai * 8 + bj * 4 + m) * 8192, 0, 16); asm volatile("" ::: "memory"); }
          asm volatile("s_waitcnt vmcnt(0)" ::: "memory");
          __builtin_amdgcn_s_barrier();
          if (tid == 0) __hip_atomic_store(flags + 64 * vcu, 1u, __ATOMIC_RELAXED, __HIP_MEMORY_SCOPE_AGENT); }
        if (wid == 0) {
            for (int k = 0; k < S; ++k) { unsigned sp = 0;
                while (__hip_atomic_load(flags + 64 * (first + k), __ATOMIC_RELAXED, __HIP_MEMORY_SCOPE_AGENT) == 0u) { __builtin_amdgcn_s_sleep(2);
                    if (++sp > (1u << 20)) { if (tid == 0) __hip_atomic_store(tmo, 0x5AB3u, __ATOMIC_RELAXED, __HIP_MEMORY_SCOPE_AGENT); break; } } }
            __builtin_amdgcn_fence(__ATOMIC_ACQUIRE, "agent"); asm volatile("s_waitcnt vmcnt(0)" ::: "memory");
        }
        asm volatile("" ::: "memory"); __builtin_amdgcn_s_barrier(); asm volatile("" ::: "memory");
        const u32x4* sl0 = (const u32x4*)(slab + (size_t)first * SLAB_BYTES) + tid;
#define PG8_RS_GROUP(AI, MM) if ((AI * 4 + MM) % S == p) { u32x4 w0[S], w1[S]; \
            _Pragma("unroll") for (int k = 0; k < S; ++k) { const u32x4* sk = sl0 + (size_t)k * (SLAB_BYTES / 16); w0[k] = sk[(AI * 8 + MM) * 512]; w1[k] = sk[(AI * 8 + 4 + MM) * 512]; } \
            f32x4 a00 = {0.f, 0.f, 0.f, 0.f}, a01 = a00, a10 = a00, a11 = a00; \
            _Pragma("unroll") for (int k = 0; k < S; ++k) { a00 += (f32x4){bflo(w0[k].x), bfhi(w0[k].x), bflo(w0[k].y), bfhi(w0[k].y)}; a01 += (f32x4){bflo(w0[k].z), bfhi(w0[k].z), bflo(w0[k].w), bfhi(w0[k].w)}; \
                a10 += (f32x4){bflo(w1[k].x), bfhi(w1[k].x), bflo(w1[k].y), bfhi(w1[k].y)}; a11 += (f32x4){bflo(w1[k].z), bfhi(w1[k].z), bflo(w1[k].w), bfhi(w1[k].w)}; } \
            acc[AI][0][MM][0] = a00; acc[AI][0][MM][1] = a01; acc[AI][1][MM][0] = a10; acc[AI][1][MM][1] = a11; \
            E.template grp<AI, MM>(acc, u, wr, wc, fr, fq); }
        PG8_RS_GROUP(0, 0) PG8_RS_GROUP(0, 1) PG8_RS_GROUP(0, 2) PG8_RS_GROUP(0, 3) PG8_RS_GROUP(1, 0) PG8_RS_GROUP(1, 1) PG8_RS_GROUP(1, 2) PG8_RS_GROUP(1, 3)
#undef PG8_RS_GROUP
    }
    template <class Epi> __device__ __forceinline__ void finish_last(f32x4 (&acc)[2][2][4][2], const Unit& u, const Epi& E, int tid, int wid, int wr, int wc, int fr, int fq) const {
        if constexpr (RS_ > 0) { if (u.mode == 3) finish_rs(acc, u, E, tid, wid, wr, wc, fr, fq); return; }
        if constexpr (NP_ <= 0) return;
        if (u.mode != 2) return;
        int ns = 0; { int need = u.need; for (int jj = j + 1; need > 0 && jj < np; ++jj) { const int len = base + (jj < rem ? 1 : 0); if (len == 0) break; need -= (len < need ? len : need); ++ns; } }
        if (wid == 0) {
            for (int k = 1; k <= ns; ++k) { unsigned sp = 0;
                while (__hip_atomic_load(flags + 64 * (vcu + k), __ATOMIC_RELAXED, __HIP_MEMORY_SCOPE_AGENT) == 0u) { __builtin_amdgcn_s_sleep(2);
                    if (++sp > (1u << 20)) { if (tid == 0) __hip_atomic_store(tmo, 0x5AB0u, __ATOMIC_RELAXED, __HIP_MEMORY_SCOPE_AGENT); break; } } }
            __builtin_amdgcn_fence(__ATOMIC_ACQUIRE, "agent"); asm volatile("s_waitcnt vmcnt(0)" ::: "memory");
        }
        asm volatile("" ::: "memory"); __builtin_amdgcn_s_barrier(); asm volatile("" ::: "memory");
        for (int k = 1; k <= ns; ++k) {
            const u32x4* sl = (const u32x4*)(slab + (size_t)(vcu + k) * SLAB_BYTES) + tid;
            u32x4 w[16];
#pragma unroll
            for (int i = 0; i < 16; ++i) w[i] = sl[i * 512];
#pragma unroll
            for (int ai = 0; ai < 2; ++ai)
#pragma unroll
                for (int bj = 0; bj < 2; ++bj)
#pragma unroll
                    for (int m = 0; m < 4; ++m) { const u32x4 v = w[ai * 8 + bj * 4 + m];
                        acc[ai][bj][m][0] += (f32x4){bflo(v.x), bfhi(v.x), bflo(v.y), bfhi(v.y)}; acc[ai][bj][m][1] += (f32x4){bflo(v.z), bfhi(v.z), bflo(v.w), bfhi(v.w)}; }
        }
        E(acc, u, wr, wc, fr, fq);
    }
};
struct EpiIn {
    static constexpr bool PERM = true, AFTER_DRAIN = false; static constexpr int MIDK = 0;
    bf16_t* U; bf16_t* S; const float* rx;
    template <int ai, int m> __device__ __forceinline__ void grp(const f32x4 (&acc)[2][2][4][2], const Unit& u, int wr, int wc, int fr, int fq) const {
        const int row = u.pm * BM + wr * 64 + fr + ai * HALF + m * 16; const float r = rx[row];
        if (u.pn < 8) {
            const int col0 = u.pn * 128 + wc * 32 + 8 * fq;
            f32x4 v0, v1;
#pragma unroll
            for (int j = 0; j < 4; ++j) { v0[j] = (acc[ai][0][m][0][j] * r) * fsig(acc[ai][1][m][0][j] * r); v1[j] = (acc[ai][0][m][1][j] * r) * fsig(acc[ai][1][m][1][j] * r); }
            *(u32x4*)(U + (size_t)row * 1024 + col0) = pack8(v0, v1);
        } else {
            const int col0 = (u.pn - 8) * 256 + wc * 32 + 8 * fq;
#pragma unroll
            for (int bj = 0; bj < 2; ++bj) *(u32x4*)(S + (size_t)row * 1024 + col0 + bj * HALF) = pack8(acc[ai][bj][m][0] * r, acc[ai][bj][m][1] * r);
        }
    }
    PG8_EPI_ALL
};
struct EpiGlu {
    static constexpr bool PERM = true, AFTER_DRAIN = false; static constexpr int MIDK = 0;
    const bf16_t* G; bf16_t* MIX; float* ssq;
    template <int ai, int m> __device__ __forceinline__ void grp(const f32x4 (&acc)[2][2][4][2], const Unit& u, int wr, int wc, int fr, int fq) const {
        const int row0 = u.pm * BM + wr * 64 + fr, col0 = u.pn * BM + wc * 32 + 8 * fq;
            { const int row = row0 + ai * HALF + m * 16; float q = 0.f;
#pragma unroll
                for (int bj = 0; bj < 2; ++bj) { const u32x4 gw = *(const u32x4*)(G + (size_t)row * 1024 + col0 + bj * HALF);
                    f32x4 g0 = {bflo(gw.x), bfhi(gw.x), bflo(gw.y), bfhi(gw.y)}, g1 = {bflo(gw.z), bfhi(gw.z), bflo(gw.w), bfhi(gw.w)}, y0, y1;
#pragma unroll
                    for (int j = 0; j < 4; ++j) { y0[j] = g0[j] * fsig(acc[ai][bj][m][0][j]); y1[j] = g1[j] * fsig(acc[ai][bj][m][1][j]); }
                    q += sq4(y0) + sq4(y1);
                    *(u32x4*)(MIX + (size_t)row * 2048 + col0 + bj * HALF) = pack8(y0, y1); }
                row_atomic(ssq + row, q, fq); }
    }
    PG8_EPI_ALL
};
struct EpiOut {
    static constexpr bool PERM = true, AFTER_DRAIN = false; static constexpr int MIDK = 16;
    bf16_t* HB; float* ssq; const float* ssqs;
    __device__ __forceinline__ void midscale(f32x4 (&acc)[2][2][4][2], const Unit& u, int wr, int fr) const {
        const int row0 = u.pm * BM + wr * 64 + fr;
#pragma unroll
        for (int ai = 0; ai < 2; ++ai)
#pragma unroll
            for (int m = 0; m < 4; ++m) { const float r = __builtin_amdgcn_rsqf(ssqs[row0 + ai * HALF + m * 16] * (1.0f / 1024.0f) + RMS_EPS);
#pragma unroll
                for (int bj = 0; bj < 2; ++bj) { acc[ai][bj][m][0] *= r; acc[ai][bj][m][1] *= r; } }
    }
    template <int ai, int m> __device__ __forceinline__ void grp(const f32x4 (&acc)[2][2][4][2], const Unit& u, int wr, int wc, int fr, int fq) const {
        const int row0 = u.pm * BM + wr * 64 + fr, col0 = u.pn * BM + wc * 32 + 8 * fq;
            { const int row = row0 + ai * HALF + m * 16; float q = 0.f;
#pragma unroll
                for (int bj = 0; bj < 2; ++bj) { const size_t off = (size_t)row * 2048 + col0 + bj * HALF;
                    const u32x4 xw = *(const u32x4*)(HB + off);
                    const f32x4 h0 = (f32x4){bflo(xw.x), bfhi(xw.x), bflo(xw.y), bfhi(xw.y)} + acc[ai][bj][m][0], h1 = (f32x4){bflo(xw.z), bfhi(xw.z), bflo(xw.w), bfhi(xw.w)} + acc[ai][bj][m][1];
                    q += sq4(h0) + sq4(h1);
                    *(u32x4*)(HB + off) = pack8(h0, h1); }
                row_atomic(ssq + row, q, fq); }
    }
    PG8_EPI_ALL
};
struct EpiUp {
    static constexpr bool PERM = true, AFTER_DRAIN = false; static constexpr int MIDK = 0;
    bf16_t* ACT; const float* ssq;
    template <int ai, int m> __device__ __forceinline__ void grp(const f32x4 (&acc)[2][2][4][2], const Unit& u, int wr, int wc, int fr, int fq) const {
        const int row0 = u.pm * BM + wr * 64 + fr, col0 = u.pn * 128 + wc * 32 + 8 * fq;
            { const int row = row0 + ai * HALF + m * 16; const float r = __builtin_amdgcn_rsqf(ssq[row] * (1.0f / 2048.0f) + RMS_EPS);
                f32x4 v0, v1;
#pragma unroll
                for (int j = 0; j < 4; ++j) { const float a0 = acc[ai][0][m][0][j] * r, a1 = acc[ai][0][m][1][j] * r;
                    v0[j] = a0 * fsig(a0) * (acc[ai][1][m][0][j] * r); v1[j] = a1 * fsig(a1) * (acc[ai][1][m][1][j] * r); }
                *(u32x4*)(ACT + (size_t)row * 5632 + col0) = pack8(v0, v1); }
    }
    PG8_EPI_ALL
};
struct EpiDown {
    static constexpr bool PERM = true, AFTER_DRAIN = false; static constexpr int MIDK = 0;
    bf16_t* HB; float* ssq; float zmul;
    template <int ai, int m> __device__ __forceinline__ void grp(const f32x4 (&acc)[2][2][4][2], const Unit& u, int wr, int wc, int fr, int fq) const {
        const int row0 = u.pm * BM + wr * 64 + fr, col0 = u.pn * BM + wc * 32 + 8 * fq;
            { const int row = row0 + ai * HALF + m * 16; float q = 0.f;
#pragma unroll
                for (int bj = 0; bj < 2; ++bj) { bf16_t* p = HB + (size_t)row * 2048 + col0 + bj * HALF; const u32x4 hw = *(const u32x4*)p;
                    const f32x4 o0 = (f32x4){bflo(hw.x), bfhi(hw.x), bflo(hw.y), bfhi(hw.y)} + acc[ai][bj][m][0] * zmul, o1 = (f32x4){bflo(hw.z), bfhi(hw.z), bflo(hw.w), bfhi(hw.w)} + acc[ai][bj][m][1] * zmul;
                    q += sq4(o0) + sq4(o1);
                    *(u32x4*)p = pack8(o0, o1); }
                row_atomic(ssq + row, q, fq); }
    }
    PG8_EPI_ALL
};
}

constexpr int NWAVES = 8;
#ifndef MK_N_LAUNCHES
#define MK_N_LAUNCHES 1
#endif
constexpr int NPH = 9;
constexpr int N_LAUNCHES = MK_N_LAUNCHES;

constexpr int D = 2048, DC = 1024, DS = 1024, DIN = 3072, DFF = 5632, NG = 64, NP = 64, CH = 16, KW = 31;
constexpr int BATCH = 4, SEQ = 2048, DB = 128, DSQ = 8;
constexpr int MP = BATCH * SEQ, MS = DB * DSQ, M = MP + MS;

constexpr size_t MiB = 1u << 20;
constexpr size_t WS_CTL = 0, CTL_ZERO_BYTES = 1 * MiB;
constexpr size_t WS_TAB = 1 * MiB;
constexpr size_t WS_WGU = 2 * MiB, WS_WDN = 46 * MiB, WS_XB = 68 * MiB;
constexpr size_t WS_WIN = 104 * MiB, WS_WGL = 116 * MiB, WS_WOUT = 118 * MiB;
constexpr size_t WS_U = 126 * MiB, WS_S = 144 * MiB, WS_G = 162 * MiB, WS_MIX = 180 * MiB;
constexpr size_t WS_ACT = 104 * MiB;
constexpr size_t WS_END = 235 * MiB;
constexpr size_t SLAB_P1 = 162 * MiB, SLAB_P3 = 126 * MiB, SLAB_P5 = 126 * MiB, SLAB_P6 = 203 * MiB, SLAB_P7 = 2 * MiB;
static_assert(WS_WGU + (size_t)2 * DFF * D * 2 <= WS_WDN && WS_WDN + (size_t)D * DFF * 2 <= WS_XB && WS_XB + (size_t)M * D * 2 <= WS_WIN, "ws map 1");
static_assert(WS_WIN + (size_t)DIN * D * 2 <= WS_WGL && WS_WGL + (size_t)DS * DS * 2 <= WS_WOUT && WS_WOUT + (size_t)D * D * 2 <= WS_U, "ws map 2");
static_assert(WS_U + (size_t)M * DC * 2 <= WS_S && WS_S + (size_t)M * DS * 2 <= WS_G && WS_G + (size_t)M * DS * 2 <= WS_MIX && WS_MIX + (size_t)M * D * 2 <= WS_END, "ws map 3");
static_assert(WS_ACT + (size_t)M * DFF * 2 <= SLAB_P6 && SLAB_P6 + 32 * MiB <= WS_END && WS_END <= 256 * MiB, "ws map 4");
constexpr int CW_TMO = 0, CW_CODE = 1;
constexpr int CW_BAR = 4096;
constexpr int CW_SSQ_S = 16384, CW_SSQ_H = CW_SSQ_S + M, CW_SSQ_O = CW_SSQ_H + M;
constexpr int CW_DUMMY = CW_SSQ_O + M;
constexpr int CW_FLAGS = 81920, FLAG_SLOT = 16384;
constexpr int CW_RX = 65536;
static_assert((CW_RX + M) * 4 <= (int)CTL_ZERO_BYTES && CW_DUMMY + M <= CW_RX, "ctl map");
constexpr size_t TAB_AB = 0;
constexpr size_t TAB_BBT = 64 * 1024;
constexpr size_t TAB_CQ = 512 * 1024;

constexpr int RING_OFF = 0, RING_BYTES = 131072;
constexpr int LDSCTL_OFF = RING_BYTES, MISC_OFF = LDSCTL_OFF + 320;
constexpr int LDS_BYTES = 147456;
static_assert(MISC_OFF + 128 <= LDS_BYTES, "LDS map");

#define GAS __attribute__((address_space(1)))
#define LAS __attribute__((address_space(3)))
typedef unsigned short bf16;
typedef unsigned v4u __attribute__((ext_vector_type(4)));
typedef unsigned v2u __attribute__((ext_vector_type(2)));
typedef float f32x4 __attribute__((ext_vector_type(4)));
typedef float f32x2 __attribute__((ext_vector_type(2)));
typedef float f32x16 __attribute__((ext_vector_type(16)));
typedef short bf16x8 __attribute__((ext_vector_type(8)));
typedef GAS unsigned gu32;
#define RLX_AGENT __ATOMIC_RELAXED, __HIP_MEMORY_SCOPE_AGENT
#define LDS_WAIT() asm volatile("s_waitcnt lgkmcnt(0)" ::: "memory")
#define VM_WAIT() asm volatile("s_waitcnt vmcnt(0)" ::: "memory")
__device__ __forceinline__ unsigned f2bf(float f) { unsigned u = __builtin_bit_cast(unsigned, f); return (u + 0x7fffu + ((u >> 16) & 1u)) >> 16; }
__device__ __forceinline__ unsigned pk2(float lo, float hi) { return f2bf(lo) | (f2bf(hi) << 16); }
__device__ __forceinline__ float bf_lo(unsigned w) { return __builtin_bit_cast(float, w << 16); }
__device__ __forceinline__ float bf_hi(unsigned w) { return __builtin_bit_cast(float, w & 0xffff0000u); }
#define WS_DPP(v, ctrl, rm) ((v) + __builtin_bit_cast(float, __builtin_amdgcn_update_dpp(0, __builtin_bit_cast(int, (v)), (ctrl), (rm), 0xF, true)))
__device__ __forceinline__ float wave_sum63(float v) {
    v = WS_DPP(v, 0xB1, 0xF); v = WS_DPP(v, 0x4E, 0xF); v = WS_DPP(v, 0x141, 0xF); v = WS_DPP(v, 0x140, 0xF); v = WS_DPP(v, 0x142, 0xA); v = WS_DPP(v, 0x143, 0xC);
    return v;
}
__device__ __forceinline__ float fsigm(float x) { return __builtin_amdgcn_rcpf(1.0f + __builtin_amdgcn_exp2f(x * -1.4426950408889634f)); }
__device__ __forceinline__ float gelu_tanh_f(float x) {
    const float u2 = 1.5957691216057308f * (x + 0.044715f * x * x * x);
    return x * fsigm(u2);
}

#define XB_TMO      128
#define XB_XCNT(j)  (256  + 64 * (j))
#define XB_XSUB(j)  (1280 + 64 * (j))
#define XB_XGEN(j)  (2304 + 64 * (j))
#define XB_TOP      3328
#define XB_TOPGEN   3392
#define XCD_BAR_WORDS 3456
#define XB_SPIN_CAP (1u << 18)

__device__ __forceinline__ unsigned xb_ld(unsigned* p)              { return __hip_atomic_load(p, __ATOMIC_RELAXED, __HIP_MEMORY_SCOPE_AGENT); }
__device__ __forceinline__ unsigned xb_add(unsigned* p, unsigned v) { return __hip_atomic_fetch_add(p, v, __ATOMIC_RELAXED, __HIP_MEMORY_SCOPE_AGENT); }
__device__ __forceinline__ unsigned xb_xcc_id() { return (unsigned)__builtin_amdgcn_s_getreg((3 << 11) | 20) & 0xFu; }
#define XB_SPIN(cond, bar) do { unsigned _sp = 0; while (cond) { __builtin_amdgcn_s_sleep(1); \
    if ((++_sp & 255u) == 0u) { if (xb_ld(&(bar)[XB_TMO])) break; if (_sp > XB_SPIN_CAP) { atomicAdd(&(bar)[XB_TMO], 1u); break; } } } } while (0)

struct XcdBarrier {
    unsigned* bar; unsigned x;
    volatile LAS unsigned* st;
};

__device__ __forceinline__ XcdBarrier xcd_barrier_post(unsigned* bar, volatile LAS unsigned* st) {
    XcdBarrier b; b.bar = bar; b.x = xb_xcc_id(); b.st = st;
    if (threadIdx.x == 0) (void)xb_add(&bar[XB_XCNT(b.x)], 1u);
    return b;
}
__device__ __forceinline__ void xcd_barrier_complete(unsigned* bar, unsigned x, unsigned& nloc, unsigned& nx) {
    const unsigned G = gridDim.x * gridDim.y * gridDim.z;
    unsigned sum, cnt, mine, sp = 0u;
    for (;;) {
        sum = 0u; cnt = 0u; mine = 0u;
#pragma unroll
        for (unsigned j = 0; j < 16; ++j) { const unsigned c = xb_ld(&bar[XB_XCNT(j)]); sum += c; cnt += (c > 0u) ? 1u : 0u; mine = (j == x) ? c : mine; }
        if (sum == G) break;
        __builtin_amdgcn_s_sleep(1);
        if ((++sp & 255u) == 0u) { if (xb_ld(&bar[XB_TMO])) break; if (sp > XB_SPIN_CAP) { atomicAdd(&bar[XB_TMO], 1u); break; } }
    }
    nloc = mine > 0u ? mine : 1u; nx = cnt > 0u ? cnt : 1u;
}

__device__ __forceinline__ void xcd_barrier(const XcdBarrier& b) {
    asm volatile("s_waitcnt vmcnt(0)" ::: "memory");
    __syncthreads();
    if (threadIdx.x == 0) {
        unsigned* bar = b.bar;
        __builtin_amdgcn_s_waitcnt(0);
        unsigned nloc = b.st[0], nx = b.st[1];
        if (nloc == 0u) { xcd_barrier_complete(bar, b.x, nloc, nx); b.st[0] = nloc; b.st[1] = nx; }
        const unsigned old = xb_add(&bar[XB_XSUB(b.x)], 1u);
        const unsigned gen = old / nloc;
        if (old + 1u == (gen + 1u) * nloc) {
            __builtin_amdgcn_fence(__ATOMIC_RELEASE, "agent");
            asm volatile("s_waitcnt vmcnt(0)" ::: "memory");
            const unsigned og = xb_add(&bar[XB_TOP], 1u);
            const unsigned tg = og / nx;
            if (og + 1u == (tg + 1u) * nx) xb_add(&bar[XB_TOPGEN], 1u);
            else XB_SPIN(xb_ld(&bar[XB_TOPGEN]) == tg, bar);
            __builtin_amdgcn_fence(__ATOMIC_ACQUIRE, "agent");
            xb_add(&bar[XB_XGEN(b.x)], 1u);
            asm volatile("s_waitcnt vmcnt(0)" ::: "memory");
        } else {
            XB_SPIN(xb_ld(&bar[XB_XGEN(b.x)]) == gen, bar);
            __builtin_amdgcn_fence(__ATOMIC_ACQUIRE, "agent");
            asm volatile("s_waitcnt vmcnt(0)" ::: "memory");
        }
    }
    __syncthreads();
}
__device__ __forceinline__ unsigned cvtpk(float lo, float hi) { unsigned r; asm("v_cvt_pk_bf16_f32 %0, %1, %2" : "=v"(r) : "v"(lo), "v"(hi)); return r; }

struct P0Item { const float* W; const float* gp; bf16* WT; int N, K, orow, k0, n0, gain_on, kdst; };
__device__ __forceinline__ void p0_item_load(const P0Item& t, f32x4 (&v)[8], float (&gk)[8], int lane) {
    const int kr = lane >> 3, nq = lane & 7;
#pragma unroll
    for (int i = 0; i < 8; ++i) { const int kk = 8 * i + kr; v[i] = __builtin_nontemporal_load((const GAS f32x4*)(t.W + (size_t)(t.k0 + kk) * t.N + t.n0 + 4 * nq));
        const float gl = t.gp[t.gain_on ? t.k0 + kk : 0]; gk[i] = t.gain_on ? gl : 1.0f; }
}
__device__ __forceinline__ void p0_item_finish(const P0Item& t, const f32x4 (&v)[8], const float (&gk)[8], LAS float* scr, int lane) {
    const int kr = lane >> 3, nq = lane & 7;
#pragma unroll
    for (int i = 0; i < 8; ++i) { const int kk = 8 * i + kr; LAS float* d = scr + kk * 33 + 4 * nq; d[0] = v[i].x * gk[i]; d[1] = v[i].y * gk[i]; d[2] = v[i].z * gk[i]; d[3] = v[i].w * gk[i]; }
    LDS_WAIT(); asm volatile("" ::: "memory");
    const int c = lane & 7;
#pragma unroll
    for (int j = 0; j < 4; ++j) { const int n = (lane >> 3) + 8 * j; const LAS float* s = scr + (8 * c) * 33 + n;
        v4u o; o.x = cvtpk(s[0 * 33], s[1 * 33]); o.y = cvtpk(s[2 * 33], s[3 * 33]); o.z = cvtpk(s[4 * 33], s[5 * 33]); o.w = cvtpk(s[6 * 33], s[7 * 33]);
        *(GAS v4u*)(t.WT + (size_t)(t.orow + n) * t.K + t.kdst + 8 * c) = o; }
    LDS_WAIT(); asm volatile("" ::: "memory");
}

struct P0Args {
    const float *xp, *xs, *norm_mix, *w_in, *w_glu, *gn_conv, *gn_ssm, *w_out, *norm_ffn, *w_gate, *w_up, *w_down;
    const float *A_re, *A_im, *log_dt, *B_re, *B_im, *C_re, *C_im;
    bf16 *WIN, *WGL, *WOUT, *WGU, *WDN, *XB; float* rx; unsigned char* tab;
};
__device__ __forceinline__ void p0_convert(const P0Args& a, LAS unsigned char* lds, int first, int stride, int lo, int hi, int wave, int lane) {
    LAS float* scr = (LAS float*)(lds + RING_OFF + wave * 16384);
    constexpr int I_IN = (D / 64) * (DIN / 32), I_GL = (DS / 64) * (DS / 32), I_OUT = (D / 64) * (D / 32), I_GA = (D / 64) * (DFF / 32), I_DN = (DFF / 64) * (D / 32);
    constexpr int NITEMS = I_IN + I_GL + I_OUT + 2 * I_GA + I_DN;
#define P0_DECODE(t, it_) do { int r_ = (it_); \
        if (r_ < I_IN) { const int nb = r_ % (DIN / 32), kb = r_ / (DIN / 32), n0 = 32 * nb; \
            int orow; if (n0 < 2048) { const int bjv = n0 >> 10, ch = n0 & 1023; orow = 256 * (ch >> 7) + 128 * bjv + (ch & 127); } else orow = n0; \
            t.W = a.w_in; t.N = DIN; t.gp = a.norm_mix; t.gain_on = 1; t.WT = a.WIN; t.K = D; t.orow = orow; t.k0 = 64 * kb; t.kdst = 64 * kb; t.n0 = n0; break; } r_ -= I_IN; \
        if (r_ < I_GL) { const int nb = r_ % (DS / 32), kb = r_ / (DS / 32); \
            t.W = a.w_glu; t.N = DS; t.gp = a.norm_mix; t.gain_on = 0; t.WT = a.WGL; t.K = DS; t.orow = 32 * nb; t.k0 = 64 * kb; t.kdst = 64 * kb; t.n0 = 32 * nb; break; } r_ -= I_GL; \
        if (r_ < I_OUT) { const int nb = r_ % (D / 32), kb = r_ / (D / 32), k0 = 64 * kb; \
            t.W = a.w_out; t.N = D; t.gp = k0 < 1024 ? a.gn_conv : a.gn_ssm - 1024; t.gain_on = 1; t.WT = a.WOUT; t.K = D; t.orow = 32 * nb; t.k0 = k0; t.kdst = k0 ^ 1024; t.n0 = 32 * nb; break; }     r_ -= I_OUT; \
        if (r_ < I_GA) { const int nb = r_ % (DFF / 32), kb = r_ / (DFF / 32), n0 = 32 * nb; \
            t.W = a.w_gate; t.N = DFF; t.gp = a.norm_ffn; t.gain_on = 1; t.WT = a.WGU; t.K = D; t.orow = 256 * (n0 >> 7) + (n0 & 127); t.k0 = 64 * kb; t.kdst = 64 * kb; t.n0 = n0; break; } r_ -= I_GA; \
        if (r_ < I_GA) { const int nb = r_ % (DFF / 32), kb = r_ / (DFF / 32), n0 = 32 * nb; \
            t.W = a.w_up; t.N = DFF; t.gp = a.norm_ffn; t.gain_on = 1; t.WT = a.WGU; t.K = D; t.orow = 256 * (n0 >> 7) + 128 + (n0 & 127); t.k0 = 64 * kb; t.kdst = 64 * kb; t.n0 = n0; break; } r_ -= I_GA; \
        { const int nb = r_ % (D / 32), kb = r_ / (D / 32); \
            t.W = a.w_down; t.N = D; t.gp = a.norm_mix; t.gain_on = 0; t.WT = a.WDN; t.K = DFF; t.orow = 32 * nb; t.k0 = 64 * kb; t.kdst = 64 * kb; t.n0 = 32 * nb; } } while (0)
    {
        P0Item t0, t1, t2; f32x4 va[8], vb[8], vc[8]; float ga[8], gb[8], gc[8];
        if (lo + first < hi) { P0_DECODE(t0, lo + first); p0_item_load(t0, va, ga, lane); }
        if (lo + first + stride < hi) { P0_DECODE(t1, lo + first + stride); p0_item_load(t1, vb, gb, lane); }
        for (int it = lo + first; it < hi; it += stride) {
            const int itn = it + 2 * stride;
            if (itn < hi) { P0_DECODE(t2, itn); p0_item_load(t2, vc, gc, lane); }
            p0_item_finish(t0, va, ga, scr, lane);
            t0 = t1; t1 = t2;
#pragma unroll
            for (int i = 0; i < 8; ++i) { va[i] = vb[i]; ga[i] = gb[i]; vb[i] = vc[i]; gb[i] = gc[i]; }
        }
    }
#undef P0_DECODE
}
__device__ __forceinline__ void p0_tables(const P0Args& a, int gt) {
    {
      if (gt < NG * NP) { const int g = gt >> 6, p = gt & 63;
        const float ar = a.A_re[gt], ai = a.A_im[gt], dt = expf(a.log_dt[g]);
        const float th = dt * ai, e1 = expm1f(dt * ar), sh = sinf(0.5f * th), cm1 = -2.0f * sh * sh, cs = 1.0f + cm1;
        const float nr = e1 * cs + cm1, ni = (1.0f + e1) * sinf(th);
        const float abr = 1.0f + nr, abi = ni, den = ar * ar + ai * ai;
        const float kr = (nr * ar + ni * ai) / den, ki = (ni * ar - nr * ai) / den;
        float* AB = (float*)(a.tab + TAB_AB); AB[gt * 2] = abr; AB[gt * 2 + 1] = abi;
        bf16* BBT = (bf16*)(a.tab + TAB_BBT); bf16* CQ = (bf16*)(a.tab + TAB_CQ);
#pragma unroll
        for (int c = 0; c < 16; ++c) { const float br = a.B_re[(size_t)gt * CH + c], bi = a.B_im[(size_t)gt * CH + c];
            BBT[((size_t)(g * 2 + 0) * NP + p) * CH + c] = (bf16)f2bf(kr * br - ki * bi);
            BBT[((size_t)(g * 2 + 1) * NP + p) * CH + c] = (bf16)f2bf(kr * bi + ki * br);
            CQ[((size_t)g * CH + c) * 128 + 2 * p] = (bf16)f2bf(a.C_re[((size_t)g * CH + c) * NP + p]);
            CQ[((size_t)g * CH + c) * 128 + 2 * p + 1] = (bf16)f2bf(-a.C_im[((size_t)g * CH + c) * NP + p]); }
      } }
}
constexpr int P0_ITEMS_P3 = 7552;
constexpr int P0_ITEMS_B = (D / 64) * (DIN / 32) + (DS / 64) * (DS / 32) + (D / 64) * (D / 32) + 2 * (D / 64) * (DFF / 32), P0_ITEMS_A = P0_ITEMS_B - P0_ITEMS_P3;
constexpr int P0_ITEMS_ALL = P0_ITEMS_B + (DFF / 64) * (D / 32);
__device__ __forceinline__ void p0_prologue(const P0Args& a, LAS unsigned char* lds, int vcu, int G, int wave, int lane, int tid) {
    const int gw = vcu * NWAVES + wave, NGW = G * NWAVES;
    p0_convert(a, lds, gw, NGW, 0, P0_ITEMS_A, wave, lane);
#ifdef STAMP_A
    __syncthreads(); if (blockIdx.x == 0 && tid == 0) { const unsigned long long t_ = __builtin_amdgcn_s_memrealtime(); volatile LAS unsigned* M_ = (volatile LAS unsigned*)(lds + MISC_OFF); M_[12 + 2 * 15] = (unsigned)t_; M_[13 + 2 * 15] = (unsigned)(t_ >> 32); }
#endif
    {
        f32x4 v[8], vn[8];
        if (gw < M) { const GAS f32x4* xr = (const GAS f32x4*)(gw < MP ? a.xp + (size_t)gw * D : a.xs + (size_t)(gw - MP) * D) + lane;
#pragma unroll
            for (int j = 0; j < 8; ++j) v[j] = xr[64 * j]; }
        for (int row = gw; row < M; row += NGW) {
            const int rn = row + NGW;
            if (rn < M) { const GAS f32x4* xr = (const GAS f32x4*)(rn < MP ? a.xp + (size_t)rn * D : a.xs + (size_t)(rn - MP) * D) + lane;
#pragma unroll
                for (int j = 0; j < 8; ++j) vn[j] = xr[64 * j]; }
            float s = 0.f;
#pragma unroll
            for (int j = 0; j < 8; ++j) s += (v[j].x * v[j].x + v[j].y * v[j].y) + (v[j].z * v[j].z + v[j].w * v[j].w);
            s = wave_sum63(s);
            if (lane == 63) a.rx[row] = 1.0f / sqrtf(s * (1.0f / D) + 1e-6f);
            GAS v2u* o8 = (GAS v2u*)(a.XB + (size_t)row * D) + lane;
#pragma unroll
            for (int j = 0; j < 8; ++j) { v2u o; o.x = cvtpk(v[j].x, v[j].y); o.y = cvtpk(v[j].z, v[j].w); o8[64 * j] = o; }
#pragma unroll
            for (int j = 0; j < 8; ++j) v[j] = vn[j];
        }
    }
}

struct P2Args {
    const bf16* UC; const bf16* SI; bf16* G; bf16* MIX;
    const float *state_conv, *h0re, *h0im, *conv_w, *conv_b, *ln_g, *ln_b, *Dk;
    const unsigned char* tab;
    float *ncp, *nrp, *nip, *ncs, *nrs, *nis;
};
constexpr int P2_RED_OFF = 0, P2_TILE_OFF = 4096, P2_TILE_B = 4352, P2_TROW = 272, P2_UT_OFF = 73728, P2_SX_OFF = 81920;

#define CONV_LOAD_ROWS(rows, it_) do { \
        if ((it_) < 1024) { const int t0_ = ((it_) & 255) * 8, neg_ = (KW - 1) - t0_; const bf16* ub_ = a.UC + (size_t)(((it_) >> 8) * SEQ) * DC + c0; \
            _Pragma("unroll") for (int r_ = 0; r_ < 8 + KW - 1; ++r_) { const int tt_ = t0_ - (KW - 1) + r_; \
                const unsigned ld_ = *(const GAS unsigned*)(ub_ + (size_t)(tt_ > 0 ? tt_ : 0) * DC); rows[r_] = ld_ & (r_ >= neg_ ? 0xffffffffu : 0u); } } \
        else { const int b_ = (it_) - 1024; const float* hist_ = a.state_conv + (size_t)b_ * (KW - 1) * DC + c0; const bf16* ub_ = a.UC + (size_t)(MP + b_ * DSQ) * DC + c0; \
            _Pragma("unroll") for (int r_ = 0; r_ < KW - 1; ++r_) { const f32x2 hv_ = *(const GAS f32x2*)(hist_ + (size_t)r_ * DC); rows[r_] = cvtpk(hv_.x, hv_.y); } \
            _Pragma("unroll") for (int r_ = 0; r_ < 8; ++r_) rows[KW - 1 + r_] = *(const GAS unsigned*)(ub_ + (size_t)r_ * DC); } } while (0)

#define CONV_COMPUTE(rows, orow) do { \
        float ax_[8], ay_[8]; \
        _Pragma("unroll") for (int j = 0; j < 8; ++j) { ax_[j] = bias.x; ay_[j] = bias.y; } \
        _Pragma("unroll") for (int r = 0; r < 8 + KW - 1; ++r) { const float vx_ = bf_lo(rows[r]), vy_ = bf_hi(rows[r]); \
            _Pragma("unroll") for (int j = 0; j < 8; ++j) { const int k = r - j; if (k >= 0 && k < KW) { \
                asm("v_fmac_f32 %0, %1, %2" : "+v"(ax_[j]) : "v"(w[k].x), "v"(vx_)); asm("v_fmac_f32 %0, %1, %2" : "+v"(ay_[j]) : "v"(w[k].y), "v"(vy_)); } } }     \
        f32x2 acc[8]; \
        _Pragma("unroll") for (int j = 0; j < 8; ++j) acc[j] = (f32x2){ax_[j], ay_[j]}; \
        float st[16]; \
        _Pragma("unroll") for (int j = 0; j < 8; ++j) { st[j] = acc[j].x + acc[j].y; st[8 + j] = acc[j].x * acc[j].x + acc[j].y * acc[j].y; } \
        _Pragma("unroll") for (int j = 0; j < 16; ++j) st[j] = wave_sum63(st[j]); \
        if (lane == 63) { _Pragma("unroll") for (int j = 0; j < 16; ++j) red[wave * 16 + j] = st[j]; } \
        __syncthreads(); \
        if (tid < 16) { float s = 0.f; _Pragma("unroll") for (int wv = 0; wv < 8; ++wv) s += red[wv * 16 + tid]; tot[tid] = s; } \
        __syncthreads(); \
        float q[8]; \
        _Pragma("unroll") for (int j = 0; j < 8; ++j) { const float mu = tot[j] * (1.0f / DC), var = __builtin_fmaxf(tot[8 + j] * (1.0f / DC) - mu * mu, 0.0f), rs = __builtin_amdgcn_rsqf(var + 1e-6f); \
            f32x2 y = (acc[j] - mu) * rs * lg + lb; y.x = y.x * fsigm(y.x); y.y = y.y * fsigm(y.y); acc[j] = y; q[j] = y.x * y.x + y.y * y.y; } \
        _Pragma("unroll") for (int j = 0; j < 8; ++j) q[j] = wave_sum63(q[j]); \
        if (lane == 63) { _Pragma("unroll") for (int j = 0; j < 8; ++j) red[128 + wave * 16 + j] = q[j]; } \
        __syncthreads(); \
        if (tid < 8) { float s = 0.f; _Pragma("unroll") for (int wv = 0; wv < 8; ++wv) s += red[128 + wv * 16 + tid]; tot[16 + tid] = s; } \
        __syncthreads(); \
        _Pragma("unroll") for (int j = 0; j < 8; ++j) { const float r2 = __builtin_amdgcn_rsqf(tot[16 + j] * (1.0f / DC) + 1e-6f); \
            *(GAS unsigned*)(a.MIX + (size_t)((orow) + j) * D + DC + c0) = cvtpk(acc[j].x * r2, acc[j].y * r2); } } while (0)

__device__ __forceinline__ void p2_conv(const P2Args& a, LAS unsigned char* lds, int idx, int cnt, int ibeg, int iend, int wave, int lane, int tid) {
    LAS float* red = (LAS float*)(lds + P2_RED_OFF);
    LAS float* tot = red + 256;
    const int c0 = 2 * tid;
    f32x2 w[KW];
#pragma unroll
    for (int k = 0; k < KW; ++k) w[k] = *(const GAS f32x2*)(a.conv_w + k * DC + c0);
    const f32x2 bias = *(const GAS f32x2*)(a.conv_b + c0), lg = *(const GAS f32x2*)(a.ln_g + c0), lb = *(const GAS f32x2*)(a.ln_b + c0);
    unsigned rows[8 + KW - 1], rowsN[8 + KW - 1];
    if (ibeg + idx < iend) CONV_LOAD_ROWS(rows, ibeg + idx);
    for (int it = ibeg + idx; it < iend; it += cnt) {
        const int itn = it + cnt;
        if (itn < iend) CONV_LOAD_ROWS(rowsN, itn);
        const int orow = it < 1024 ? (it >> 8) * SEQ + (it & 255) * 8 : MP + (it - 1024) * DSQ;
        CONV_COMPUTE(rows, orow);
#pragma unroll
        for (int r = 0; r < 8 + KW - 1; ++r) rows[r] = rowsN[r];
    }
    __syncthreads();
}
__device__ __forceinline__ void p2_conv_runs(const P2Args& a, LAS unsigned char* lds, int ci, int wave, int lane, int tid) {
    LAS float* red = (LAS float*)(lds + P2_RED_OFF);
    LAS float* tot = red + 256;
    const int c0 = 2 * tid;
    f32x2 w[KW];
#pragma unroll
    for (int k = 0; k < KW; ++k) w[k] = *(const GAS f32x2*)(a.conv_w + k * DC + c0);
    const f32x2 bias = *(const GAS f32x2*)(a.conv_b + c0), lg = *(const GAS f32x2*)(a.ln_g + c0), lb = *(const GAS f32x2*)(a.ln_b + c0);
    const int b = ci / 28, k28 = ci - b * 28, len = k28 < 4 ? 10 : 9, start = b * 256 + (k28 < 4 ? k28 * 10 : 40 + (k28 - 4) * 9);
    unsigned rows[8 + KW - 1], rowsS[8 + KW - 1], pfA[8], pfB[8];
    CONV_LOAD_ROWS(rows, start);
    { const int its = 1024 + ci; CONV_LOAD_ROWS(rowsS, its); }
    const bf16* ub = a.UC + (size_t)(b * SEQ) * DC + c0;
    const int t0s = (start & 255) * 8;
#pragma unroll
    for (int i = 0; i < 8; ++i) { pfA[i] = *(const GAS unsigned*)(ub + (size_t)(t0s + 8 + i) * DC); pfB[i] = *(const GAS unsigned*)(ub + (size_t)(t0s + 16 + i) * DC); }
    for (int n = 0; n < len; ++n) {
        const int t0 = t0s + 8 * n;
        unsigned pfC[8];
        { const int tn = t0 + 24; const int tc = tn + 7 < SEQ ? tn : SEQ - 8;
#pragma unroll
          for (int i = 0; i < 8; ++i) pfC[i] = *(const GAS unsigned*)(ub + (size_t)(tc + i) * DC); }
        CONV_COMPUTE(rows, b * SEQ + t0);
#pragma unroll
        for (int r = 0; r < KW - 1; ++r) rows[r] = rows[r + 8];
#pragma unroll
        for (int i = 0; i < 8; ++i) { rows[KW - 1 + i] = pfA[i]; pfA[i] = pfB[i]; pfB[i] = pfC[i]; }
    }
    CONV_COMPUTE(rowsS, MP + ci * DSQ);
    if (ci >= 4 && ci < 20) { const int its = 1024 + 112 + (ci - 4); CONV_LOAD_ROWS(rowsS, its); CONV_COMPUTE(rowsS, MP + (112 + ci - 4) * DSQ); }
    __syncthreads();
}

__device__ __forceinline__ void p2_newconv(const P2Args& a, int vcu, int G, int tid) {
    constexpr int NPV = BATCH * (KW - 1) * (DC / 4), NSV = DB * (KW - 1) * (DC / 4);
    for (int idx = vcu * (NWAVES * 64) + tid; idx < NPV + NSV; idx += G * NWAVES * 64) {
        if (idx < NPV) { const int c4 = idx & 255, j = (idx >> 8) % (KW - 1), b = idx / ((KW - 1) * 256);
            const v2u pk = *(const GAS v2u*)(a.UC + (size_t)(b * SEQ + SEQ - (KW - 1) + j) * DC + 4 * c4);
            const f32x4 v = {bf_lo(pk.x), bf_hi(pk.x), bf_lo(pk.y), bf_hi(pk.y)};
            *(GAS f32x4*)(a.ncp + (size_t)idx * 4) = v; }
        else { const int k = idx - NPV; const int c4 = k & 255, j = (k >> 8) % (KW - 1), b = k / ((KW - 1) * 256); const int id = j + DSQ; f32x4 v;
            if (id < KW - 1) v = *(const GAS f32x4*)(a.state_conv + ((size_t)b * (KW - 1) + id) * DC + 4 * c4);
            else { const v2u pk = *(const GAS v2u*)(a.UC + (size_t)(MP + b * DSQ + id - (KW - 1)) * DC + 4 * c4); v = (f32x4){bf_lo(pk.x), bf_hi(pk.x), bf_lo(pk.y), bf_hi(pk.y)}; }
            *(GAS f32x4*)(a.ncs + (size_t)k * 4) = v; }
    }
}

#define SSM_STEP(i) do { \
        const float nAr = __builtin_fmaf(aAr, hAr, __builtin_fmaf(-aAi, hAi, d00[i])), nAi = __builtin_fmaf(aAr, hAi, __builtin_fmaf(aAi, hAr, d01[i])); \
        const float nBr = __builtin_fmaf(aBr, hBr, __builtin_fmaf(-aBi, hBi, d10[i])), nBi = __builtin_fmaf(aBr, hBi, __builtin_fmaf(aBi, hBr, d11[i])); \
        hAr = nAr; hAi = nAi; hBr = nBr; hBi = nBi; } while (0)
#define SSM_MFMA(afrag) do { const f32x16 z16 = {0.f,0.f,0.f,0.f,0.f,0.f,0.f,0.f,0.f,0.f,0.f,0.f,0.f,0.f,0.f,0.f}; \
        d00 = __builtin_amdgcn_mfma_f32_32x32x16_bf16(afrag, bfr[0][0], z16, 0, 0, 0); d01 = __builtin_amdgcn_mfma_f32_32x32x16_bf16(afrag, bfr[0][1], z16, 0, 0, 0); \
        d10 = __builtin_amdgcn_mfma_f32_32x32x16_bf16(afrag, bfr[1][0], z16, 0, 0, 0); d11 = __builtin_amdgcn_mfma_f32_32x32x16_bf16(afrag, bfr[1][1], z16, 0, 0, 0); } while (0)
#define SSM_PUT_U(afrag) do { *(LAS bf16x8*)(utile + (s_r * 16 + i_r) * 32 + kc * 16) = afrag; } while (0)
#define SSM_EMIT(rowb0, rowb1) do { \
        LDS_WAIT(); __builtin_amdgcn_wave_barrier(); \
        _Pragma("unroll") for (int s_ = 0; s_ < 2; ++s_) { \
            f32x4 y_ = {0.f, 0.f, 0.f, 0.f}; \
            _Pragma("unroll") for (int ks = 0; ks < 4; ++ks) { const bf16x8 hf = *(const LAS bf16x8*)(tile + s_ * P2_TILE_B + (lane & 15) * P2_TROW + ks * 64 + (lane >> 4) * 16); \
                y_ = __builtin_amdgcn_mfma_f32_16x16x32_bf16(hf, cfr[ks], y_, 0, 0, 0); } \
            const int rb_ = s_ ? (rowb1) : (rowb0); float v_[4]; \
            _Pragma("unroll") for (int i_ = 0; i_ < 4; ++i_) { const unsigned short ub_ = *(const LAS unsigned short*)(utile + (s_ * 16 + 4 * (lane >> 4) + i_) * 32 + (lane & 15) * 2); \
                v_[i_] = gelu_tanh_f(y_[i_] + dsk * __builtin_bit_cast(float, (unsigned)ub_ << 16)); } \
            const unsigned w01_ = cvtpk(v_[0], v_[1]), w23_ = cvtpk(v_[2], v_[3]); \
            bf16* go_ = a.G + (size_t)(rb_ + 4 * (lane >> 4)) * DS + g * CH + (lane & 15); \
            go_[0] = (bf16)w01_; go_[DS] = (bf16)(w01_ >> 16); go_[2 * DS] = (bf16)w23_; go_[3 * DS] = (bf16)(w23_ >> 16); } \
        LDS_WAIT(); __builtin_amdgcn_wave_barrier(); } while (0)
#define SSM_TILE_ROW(i) do { v2u hw_; hw_.x = cvtpk(hAr, hAi); hw_.y = cvtpk(hBr, hBi); *(LAS v2u*)(mytile + (i) * P2_TROW) = hw_; } while (0)

__device__ __forceinline__ void p2_ssm(const P2Args& a, LAS unsigned char* lds, int vcu, int G, int wave, int lane, int tid) {
    const int col = lane & 31, half = lane >> 5;
    const int r = lane & 31, s_r = (r >> 2) & 1, i_r = (r & 3) + 4 * (r >> 3), kc = lane >> 5;
    LAS unsigned char* tile = lds + P2_TILE_OFF + wave * 2 * P2_TILE_B;
    LAS unsigned char* mytile = tile + half * P2_TILE_B + col * 8;
    LAS unsigned char* utile = lds + P2_UT_OFF + wave * 1024;
    LAS f32x4* SX = (LAS f32x4*)(lds + P2_SX_OFF);
    for (int it = vcu; it < BATCH * NG; it += G) {
        const int g = it & (NG - 1), pb = it >> 6;
        const float* AB = (const float*)(a.tab + TAB_AB) + (size_t)(g * NP + 2 * col) * 2;
        const f32x4 ab4 = *(const GAS f32x4*)AB;
        const float aAr = ab4.x, aAi = ab4.y, aBr = ab4.z, aBi = ab4.w;
        bf16x8 bfr[2][2], cfr[4];
#pragma unroll
        for (int pair = 0; pair < 2; ++pair)
#pragma unroll
            for (int ri = 0; ri < 2; ++ri) bfr[pair][ri] = *(const GAS bf16x8*)((const bf16*)(a.tab + TAB_BBT) + ((size_t)(g * 2 + ri) * NP + 2 * col + pair) * CH + 8 * kc);
#pragma unroll
        for (int ks = 0; ks < 4; ++ks) cfr[ks] = *(const GAS bf16x8*)((const bf16*)(a.tab + TAB_CQ) + ((size_t)g * CH + (lane & 15)) * 128 + 32 * ks + 8 * (lane >> 4));
        const float dsk = a.Dk[g * CH + (lane & 15)];
        f32x16 d00, d01, d10, d11;
        {
            const bf16* abase = a.SI + (size_t)(pb * SEQ + (2 * wave + s_r) * 128 + i_r) * DS + g * CH + 8 * kc;
            float hAr = 0.f, hAi = 0.f, hBr = 0.f, hBi = 0.f;
            bf16x8 a0 = *(const GAS bf16x8*)abase, a1 = *(const GAS bf16x8*)(abase + (size_t)1 * 16 * DS), a2 = *(const GAS bf16x8*)(abase + (size_t)2 * 16 * DS), a3 = *(const GAS bf16x8*)(abase + (size_t)3 * 16 * DS);
#pragma unroll 1
            for (int blk = 0; blk < 8; ++blk) {
                const bf16x8 an = *(const GAS bf16x8*)(abase + (size_t)((blk + 4) & 7) * 16 * DS);
                SSM_MFMA(a0);
#pragma unroll
                for (int i = 0; i < 16; ++i) SSM_STEP(i);
                a0 = a1; a1 = a2; a2 = a3; a3 = an;
            }
            __syncthreads();
            SX[(2 * wave + half) * 32 + col] = (f32x4){hAr, hAi, hBr, hBi};
            __syncthreads();
            float pAr = aAr, pAi = aAi, pBr = aBr, pBi = aBi;
#pragma unroll
            for (int sq = 0; sq < 7; ++sq) { const float t0 = pAr * pAr - pAi * pAi, t1 = 2.0f * pAr * pAi, t2 = pBr * pBr - pBi * pBi, t3 = 2.0f * pBr * pBi; pAr = t0; pAi = t1; pBr = t2; pBi = t3; }
            hAr = 0.f; hAi = 0.f; hBr = 0.f; hBi = 0.f;
            const int mine = 2 * wave + half;
            for (int s2 = 0; s2 < mine; ++s2) { const f32x4 sv = SX[s2 * 32 + col];
                const float nAr = pAr * hAr - pAi * hAi + sv.x, nAi = pAr * hAi + pAi * hAr + sv.y, nBr = pBr * hBr - pBi * hBi + sv.z, nBi = pBr * hBi + pBi * hBr + sv.w;
                hAr = nAr; hAi = nAi; hBr = nBr; hBi = nBi; }
#pragma unroll 1
            for (int blk = 0; blk < 8; ++blk) {
                const bf16x8 an = *(const GAS bf16x8*)(abase + (size_t)((blk + 4) & 7) * 16 * DS);
                SSM_MFMA(a0);
                SSM_PUT_U(a0);
#pragma unroll
                for (int i = 0; i < 16; ++i) { SSM_STEP(i); SSM_TILE_ROW(i); }
                const int rb = pb * SEQ + (2 * wave) * 128 + blk * 16;
                SSM_EMIT(rb, rb + 128);
                a0 = a1; a1 = a2; a2 = a3; a3 = an;
            }
            if (mine == 15) { const size_t o = ((size_t)pb * NG + g) * NP + 2 * col;
                *(GAS f32x2*)(a.nrp + o) = (f32x2){hAr, hBr}; *(GAS f32x2*)(a.nip + o) = (f32x2){hAi, hBi}; }
        }
        {
            const int bA_load = 32 * pb + 4 * wave + 2 * s_r, bA = 32 * pb + 4 * wave + 2 * half;
            const bf16x8 afS = *(const GAS bf16x8*)(a.SI + (size_t)(MP + bA_load * DSQ + i_r) * DS + g * CH + 8 * kc);
            size_t o = ((size_t)bA * NG + g) * NP + 2 * col;
            f32x2 t0 = *(const GAS f32x2*)(a.h0re + o), t1 = *(const GAS f32x2*)(a.h0im + o);
            SSM_MFMA(afS);
            SSM_PUT_U(afS);
            float hAr = t0.x, hBr = t0.y, hAi = t1.x, hBi = t1.y;
#pragma unroll
            for (int i = 0; i < 8; ++i) { SSM_STEP(i); SSM_TILE_ROW(i); }
            *(GAS f32x2*)(a.nrs + o) = (f32x2){hAr, hBr}; *(GAS f32x2*)(a.nis + o) = (f32x2){hAi, hBi};
            o += (size_t)NG * NP;
            t0 = *(const GAS f32x2*)(a.h0re + o); t1 = *(const GAS f32x2*)(a.h0im + o);
            hAr = t0.x; hBr = t0.y; hAi = t1.x; hBi = t1.y;
#pragma unroll
            for (int i = 8; i < 16; ++i) { SSM_STEP(i); SSM_TILE_ROW(i); }
            *(GAS f32x2*)(a.nrs + o) = (f32x2){hAr, hBr}; *(GAS f32x2*)(a.nis + o) = (f32x2){hAi, hBi};
            const int rb = MP + (32 * pb + 4 * wave) * DSQ;
            SSM_EMIT(rb, rb + 16);
        }
    }
    __syncthreads();
}

#ifndef NP_P1
#define NP_P1 0
#endif
#ifndef NP_P3
#define NP_P3 0
#endif
#ifndef NP_P5
#define NP_P5 16
#endif
#ifndef NP_P6
#define NP_P6 32
#endif
#ifndef NP_P7
#define NP_P7 16
#endif
struct Args { const float* in[28]; float* out; unsigned char* ws; int lo, hi, dryk, li; };
__global__ void __launch_bounds__(NWAVES * 64, 2) mk_fwd(Args args) {
    __shared__ __attribute__((aligned(16))) unsigned char lds_raw[LDS_BYTES];
    LAS unsigned char* lds = (LAS unsigned char*)lds_raw;
    volatile LAS unsigned* MISC = (volatile LAS unsigned*)(lds + MISC_OFF);
    const int tid = threadIdx.x, lane = tid & 63, wave = __builtin_amdgcn_readfirstlane(tid >> 6);
    const int G = gridDim.x; const int bx = blockIdx.x; const int vcu = (G % 8 == 0) ? (bx % 8) * (G / 8) + bx / 8 : bx;
    unsigned char* ws = args.ws;
    gu32* ctl = (gu32*)(ws + WS_CTL);
    for (int u = tid; u < (LDS_BYTES - LDSCTL_OFF) / 4; u += NWAVES * 64) ((LAS unsigned*)(lds + LDSCTL_OFF))[u] = 0u;
    __syncthreads();
    XcdBarrier bar; bar.bar = (unsigned*)(ctl + CW_BAR) + args.li * XCD_BAR_WORDS; bar.x = 0; bar.st = nullptr;
    if (N_LAUNCHES != NPH) bar = xcd_barrier_post((unsigned*)(ctl + CW_BAR) + args.li * XCD_BAR_WORDS, MISC + 8);
#ifndef STAMP_BX
#define STAMP_BX 0
#endif
#ifdef STAMP_A
#define STAMP(i) do { if (blockIdx.x == STAMP_BX && tid == 0) { const unsigned long long t_ = __builtin_amdgcn_s_memrealtime(); MISC[12 + 2 * (i)] = (unsigned)t_; MISC[13 + 2 * (i)] = (unsigned)(t_ >> 32); } } while (0)
#else
#define STAMP(i) do { } while (0)
#endif
    STAMP(0);
#define GRID_BAR(seam) do { GRID_BAR_(seam); STAMP((seam) + 1); } while (0)
#define GRID_BAR_(seam) do { if (N_LAUNCHES == NPH) { if (tid == 0) __hip_atomic_store(ctl + CW_TMO, 0xBADBA0u | (unsigned)(seam), RLX_AGENT); } else { xcd_barrier(bar); } } while (0)
    const int lo = args.lo, hi = args.hi, dryk = args.dryk;
#define DRY(k) (dryk == (k))
#ifndef ONLY_PHASE
#define ONLY_PHASE -1
#endif
#define IN(k) (ONLY_PHASE < 0 ? (lo <= (k) && (k) < hi) : (k) == ONLY_PHASE)
#define BOTH(k) (IN(k) && IN((k) + 1))
    float* out = args.out;
    float* Y = out;
    float* ncp = out + (size_t)M * D;
    float* nrp = ncp + (size_t)BATCH * (KW - 1) * DC;
    float* nip = nrp + (size_t)BATCH * NG * NP;
    float* ncs = nip + (size_t)BATCH * NG * NP;
    float* nrs = ncs + (size_t)DB * (KW - 1) * DC;
    float* nis = nrs + (size_t)DB * NG * NP;
    bf16 *WGU = (bf16*)(ws + WS_WGU), *WDN = (bf16*)(ws + WS_WDN), *XB = (bf16*)(ws + WS_XB), *WIN = (bf16*)(ws + WS_WIN), *WGL = (bf16*)(ws + WS_WGL), *WOUT = (bf16*)(ws + WS_WOUT);
    bf16 *UC = (bf16*)(ws + WS_U), *SI = (bf16*)(ws + WS_S), *GB = (bf16*)(ws + WS_G), *MIX = (bf16*)(ws + WS_MIX), *ACT = (bf16*)(ws + WS_ACT);
    float* ssq_dummy = (float*)(ws + WS_CTL) + CW_DUMMY;
    float* ssq_s = (float*)(ws + WS_CTL) + CW_SSQ_S; float* ssq_h = (float*)(ws + WS_CTL) + CW_SSQ_H; float* ssq_o = (float*)(ws + WS_CTL) + CW_SSQ_O; float* rx = (float*)(ws + WS_CTL) + CW_RX;
    const int gw = vcu * NWAVES + wave, NGW = G * NWAVES;

    if (IN(0)) {
        P0Args a; a.xp = args.in[0]; a.xs = args.in[1]; a.norm_mix = args.in[5]; a.w_in = args.in[6]; a.w_glu = args.in[19]; a.gn_conv = args.in[20]; a.gn_ssm = args.in[21]; a.w_out = args.in[22];
        a.norm_ffn = args.in[23]; a.w_gate = args.in[24]; a.w_up = args.in[25]; a.w_down = args.in[26];
        a.A_re = args.in[11]; a.A_im = args.in[12]; a.log_dt = args.in[13]; a.B_re = args.in[14]; a.B_im = args.in[15]; a.C_re = args.in[16]; a.C_im = args.in[17];
        a.WIN = WIN; a.WGL = WGL; a.WOUT = WOUT; a.WGU = WGU; a.WDN = WDN; a.XB = XB; a.rx = rx; a.tab = ws + WS_TAB;
        STAMP(13);
        p0_prologue(a, lds, vcu, G, wave, lane, tid); STAMP(14);
        if (BOTH(0)) GRID_BAR(0);
    }
    if (IN(1)) {
        pg8::Gemm g{XB, WIN, M, DIN, D};
#define SCHED(slot, slabo, N_, K_, NP_, RS_, MID_) typedef pg8::HybridOrder<N_, K_, NP_, RS_, MID_> Sch; Sch S; S.init((int)blockIdx.x, ws + (slabo), (unsigned*)(ctl + CW_FLAGS + (slot) * FLAG_SLOT), (unsigned*)(ctl + CW_TMO))
        SCHED(0, SLAB_P1, DIN, D, NP_P1, 0, 0);
        pg8::EpiIn E{UC, SI, rx};
        pg8::gemm_phase<pg8::EpiIn, Sch, true, true>(lds + RING_OFF, g, S, E);
        {
            static_assert(Sch::R == 2 && Sch::np == 1, "P1 runs two static rounds");
            constexpr int BUSY = Sch::q - Sch::per, IDLE = Sch::per - BUSY;
            const int jx = (int)blockIdx.x >> 3, xx = (int)blockIdx.x & 7;
            P0Args a; a.xp = args.in[0]; a.xs = args.in[1]; a.norm_mix = args.in[5]; a.w_in = args.in[6]; a.w_glu = args.in[19]; a.gn_conv = args.in[20]; a.gn_ssm = args.in[21]; a.w_out = args.in[22];
            a.norm_ffn = args.in[23]; a.w_gate = args.in[24]; a.w_up = args.in[25]; a.w_down = args.in[26];
            a.A_re = args.in[11]; a.A_im = args.in[12]; a.log_dt = args.in[13]; a.B_re = args.in[14]; a.B_im = args.in[15]; a.C_re = args.in[16]; a.C_im = args.in[17];
            a.WIN = WIN; a.WGL = WGL; a.WOUT = WOUT; a.WGU = WGU; a.WDN = WDN; a.XB = XB; a.rx = rx; a.tab = ws + WS_TAB;
            if (G != 256) p0_convert(a, lds, vcu * NWAVES + wave, G * NWAVES, P0_ITEMS_B, P0_ITEMS_ALL, wave, lane);
            if (G != 256) p0_tables(a, vcu * (NWAVES * 64) + tid); else if (jx >= BUSY) p0_tables(a, (xx * IDLE + (jx - BUSY)) * (NWAVES * 64) + tid);
            if (G == 256 && jx >= BUSY) p0_convert(a, lds, (xx * IDLE + (jx - BUSY)) * NWAVES + wave, 8 * IDLE * NWAVES, P0_ITEMS_B, P0_ITEMS_ALL, wave, lane);
        }
        if (BOTH(1)) GRID_BAR(1);
    }
    if (IN(2)) {
        P2Args a; a.UC = UC; a.SI = SI; a.G = GB; a.MIX = MIX; a.state_conv = args.in[2]; a.h0re = args.in[3]; a.h0im = args.in[4];
        a.conv_w = args.in[7]; a.conv_b = args.in[8]; a.ln_g = args.in[9]; a.ln_b = args.in[10]; a.Dk = args.in[18]; a.tab = ws + WS_TAB;
        a.ncp = ncp; a.nrp = nrp; a.nip = nip; a.ncs = ncs; a.nrs = nrs; a.nis = nis;
        p2_ssm(a, lds, vcu, G, wave, lane, tid); STAMP(10);
        if (BOTH(2)) GRID_BAR(2);
    }
    if (IN(3)) {
        constexpr int P3_OWNERS = (M / 256) * (DS / 256) / 8;
        const int jx = (int)blockIdx.x >> 3, xx = (int)blockIdx.x & 7;
        P2Args a; a.UC = UC; a.SI = SI; a.G = GB; a.MIX = MIX; a.state_conv = args.in[2]; a.h0re = args.in[3]; a.h0im = args.in[4];
        a.conv_w = args.in[7]; a.conv_b = args.in[8]; a.ln_g = args.in[9]; a.ln_b = args.in[10]; a.Dk = args.in[18]; a.tab = ws + WS_TAB;
        a.ncp = ncp; a.nrp = nrp; a.nip = nip; a.ncs = ncs; a.nrs = nrs; a.nis = nis;
        constexpr int NCW = 8 * (32 - P3_OWNERS), CONV_A = 1024 + DB;
        if (G != 256) { p2_conv(a, lds, vcu, G, 0, 1024 + DB, wave, lane, tid); p2_newconv(a, vcu, G, tid);
            { P0Args pa; pa.xp = args.in[0]; pa.xs = args.in[1]; pa.norm_mix = args.in[5]; pa.w_in = args.in[6]; pa.w_glu = args.in[19]; pa.gn_conv = args.in[20]; pa.gn_ssm = args.in[21]; pa.w_out = args.in[22];
              pa.norm_ffn = args.in[23]; pa.w_gate = args.in[24]; pa.w_up = args.in[25]; pa.w_down = args.in[26];
              pa.A_re = args.in[11]; pa.A_im = args.in[12]; pa.log_dt = args.in[13]; pa.B_re = args.in[14]; pa.B_im = args.in[15]; pa.C_re = args.in[16]; pa.C_im = args.in[17];
              pa.WIN = WIN; pa.WGL = WGL; pa.WOUT = WOUT; pa.WGU = WGU; pa.WDN = WDN; pa.XB = XB; pa.rx = rx; pa.tab = ws + WS_TAB;
              __syncthreads(); p0_convert(pa, lds, vcu * NWAVES + wave, G * NWAVES, P0_ITEMS_A, P0_ITEMS_B, wave, lane); __syncthreads(); }
            pg8::Gemm g{GB, WGL, M, DS, DS}; SCHED(1, SLAB_P3, DS, DS, NP_P3, 0, 0); pg8::EpiGlu E{GB, MIX, DRY(3) ? ssq_dummy : ssq_s};
            pg8::gemm_phase<pg8::EpiGlu, Sch, true, true>(lds + RING_OFF, g, S, E); }
        else if (jx < P3_OWNERS) {
            pg8::Gemm g{GB, WGL, M, DS, DS}; SCHED(1, SLAB_P3, DS, DS, NP_P3, 0, 0);
            pg8::EpiGlu E{GB, MIX, DRY(3) ? ssq_dummy : ssq_s};
            pg8::gemm_phase<pg8::EpiGlu, Sch, true, true>(lds + RING_OFF, g, S, E);
            __syncthreads();
            { P0Args pa; pa.xp = args.in[0]; pa.xs = args.in[1]; pa.norm_mix = args.in[5]; pa.w_in = args.in[6]; pa.w_glu = args.in[19]; pa.gn_conv = args.in[20]; pa.gn_ssm = args.in[21]; pa.w_out = args.in[22];
              pa.norm_ffn = args.in[23]; pa.w_gate = args.in[24]; pa.w_up = args.in[25]; pa.w_down = args.in[26];
              pa.A_re = args.in[11]; pa.A_im = args.in[12]; pa.log_dt = args.in[13]; pa.B_re = args.in[14]; pa.B_im = args.in[15]; pa.C_re = args.in[16]; pa.C_im = args.in[17];
              pa.WIN = WIN; pa.WGL = WGL; pa.WOUT = WOUT; pa.WGU = WGU; pa.WDN = WDN; pa.XB = XB; pa.rx = rx; pa.tab = ws + WS_TAB;
              p0_convert(pa, lds, (xx * P3_OWNERS + jx) * NWAVES + wave, 8 * P3_OWNERS * NWAVES, P0_ITEMS_A, P0_ITEMS_B, wave, lane); }
        } else {
            const int ci = xx * (32 - P3_OWNERS) + (jx - P3_OWNERS);
            static_assert(NCW == 112, "p2_conv_runs: 28 workgroups per prompt batch");
            p2_conv_runs(a, lds, ci, wave, lane, tid); STAMP(11);
            p2_newconv(a, ci, NCW, tid); STAMP(12);
        }
        if (BOTH(3)) GRID_BAR(3);
    }
    if (IN(5)) {
        pg8::Gemm g{MIX, WOUT, M, D, D}; SCHED(2, SLAB_P5, D, D, NP_P5, 8, 16);
        pg8::EpiOut E{XB, DRY(5) ? ssq_dummy : ssq_h, ssq_s};
        static_assert(Sch::S == 8 && Sch::ntp == 16, "remainder segments of 2 K-tile pairs never straddle K-tile 16");
        pg8::gemm_phase<pg8::EpiOut, Sch, true, true>(lds + RING_OFF, g, S, E);
        if (BOTH(5)) GRID_BAR(5);
    }
    if (IN(6)) {
        pg8::Gemm g{XB, WGU, M, 2 * DFF, D}; SCHED(3, SLAB_P6, 2 * DFF, D, NP_P6, 5, 0);
        pg8::EpiUp E{ACT, ssq_h};
        pg8::gemm_phase<pg8::EpiUp, Sch, true, true>(lds + RING_OFF, g, S, E);
        if (BOTH(6)) GRID_BAR(6);
    }
    if (IN(7)) {
        pg8::Gemm g{ACT, WDN, M, D, DFF}; SCHED(4, SLAB_P7, D, DFF, NP_P7, 8, 0);
        pg8::EpiDown E{XB, DRY(7) ? ssq_dummy : ssq_o, DRY(7) ? 0.0f : 1.0f};
        pg8::gemm_phase<pg8::EpiDown, Sch, true, true>(lds + RING_OFF, g, S, E);
        if (BOTH(7)) GRID_BAR(7);
    }
    if (IN(8)) {
        const float* gfin = args.in[27];
        for (int row = gw; row < M; row += NGW) {
            const float r = 1.0f / sqrtf(__hip_atomic_load(ssq_o + row, RLX_AGENT) * (1.0f / D) + 1e-6f);
            const GAS v4u* ob = (const GAS v4u*)(XB + (size_t)row * D) + lane; GAS f32x4* p = (GAS f32x4*)(Y + (size_t)row * D) + 2 * lane; const GAS f32x4* gp = (const GAS f32x4*)gfin + 2 * lane;
#pragma unroll
            for (int j = 0; j < 4; ++j) { const v4u w = ob[64 * j];
                p[128 * j] = (f32x4){bf_lo(w.x), bf_hi(w.x), bf_lo(w.y), bf_hi(w.y)} * r * gp[128 * j];
                p[128 * j + 1] = (f32x4){bf_lo(w.z), bf_hi(w.z), bf_lo(w.w), bf_hi(w.w)} * r * gp[128 * j + 1]; }
        }
    }
#ifdef STAMP_A
    STAMP(9);
    if (blockIdx.x == STAMP_BX && tid == 0) {
        const unsigned long long ta = ((unsigned long long)MISC[13 + 2 * STAMP_A] << 32) | MISC[12 + 2 * STAMP_A], tb = ((unsigned long long)MISC[13 + 2 * STAMP_B] << 32) | MISC[12 + 2 * STAMP_B];
        const unsigned long long d = tb - ta, t0 = __builtin_amdgcn_s_memrealtime();
        while (__builtin_amdgcn_s_memrealtime() - t0 < d) __builtin_amdgcn_s_sleep(8);
    }
#endif
#undef DRY
#undef IN
#undef BOTH
#undef GRID_BAR
#undef GRID_BAR_
#undef STAMP
}

extern "C" void kernel_launch(void* const* d_in, const int* in_sizes, int n_in, void* d_out, int out_size, void* d_ws, size_t ws_size, hipStream_t stream) {
    static int grid = 0;
    if (grid == 0) {
        const long want_out = (long)M * D + (long)(BATCH + DB) * ((KW - 1) * DC + 2 * NG * NP);
        if (n_in != 28 || in_sizes[0] != MP * D || (long)out_size != want_out || ws_size < WS_END) {
            fprintf(stderr, "kernel_launch: unexpected shapes (n_in %d, in0 %d, out %d (want %ld), ws %zu (need %zu)); nothing launched\n", n_in, n_in > 0 ? in_sizes[0] : -1, out_size, want_out, ws_size, (size_t)WS_END); grid = -1; return; }
        int dev = 0, cus = 0;
        if (hipGetDevice(&dev) != hipSuccess || hipDeviceGetAttribute(&cus, hipDeviceAttributeMultiprocessorCount, dev) != hipSuccess) { fprintf(stderr, "kernel_launch: device query failed\n"); grid = -1; return; }
        if (cus != 256) fprintf(stderr, "kernel_launch: built for 256 CUs, device has %d\n", cus);
        grid = 256;
    }
    if (grid < 0) return;
    if (hipMemsetAsync((char*)d_ws + WS_CTL, 0, CTL_ZERO_BYTES, stream) != hipSuccess) { fprintf(stderr, "kernel_launch: memset failed\n"); return; }
    Args a{};
    for (int i = 0; i < 28; ++i) a.in[i] = (const float*)d_in[i];
    a.out = (float*)d_out; a.ws = (unsigned char*)d_ws;
#ifdef PROBE_PHASE
    constexpr int NL = 2;
#else
    constexpr int NL = N_LAUNCHES;
#endif
    for (int li = 0; li < NL; ++li) {
        a.dryk = -1;
        if (N_LAUNCHES == NPH) { a.lo = li; a.hi = li + 1; } else { a.lo = 0; a.hi = NPH; }
#ifdef PROBE_PHASE
        if (li == 0) { a.lo = 0; a.hi = PROBE_PHASE + 1; } else { a.lo = PROBE_PHASE; a.hi = NPH; a.dryk = PROBE_PHASE; }
#endif
        a.li = li;
        hipLaunchKernelGGL(mk_fwd, dim3(grid), dim3(NWAVES * 64), 0, stream, a);
        const hipError_t le = hipPeekAtLastError();
        if (le != hipSuccess) { fprintf(stderr, "kernel_launch: launch %d failed: %s\n", li, hipGetErrorName(le)); break; }
    }
}
```

```cpp
#include <hip/hip_runtime.h>
#include <cstdio>
#include <cstdint>
#define MK_N_LAUNCHES 1
namespace pg8 {
#define PG8_LAS __attribute__((address_space(3)))
typedef unsigned short bf16_t;
typedef short bf16x8 __attribute__((ext_vector_type(8)));
typedef float f32x4 __attribute__((ext_vector_type(4)));
typedef unsigned u32x4 __attribute__((ext_vector_type(4)));
constexpr int BM = 256, BK = 64, HALF = 128, HTB = HALF * BK * 2  , STAGE_BYTES = 8 * HTB, NXCD = 8, WGM = 4;

__host__ __device__ __forceinline__ int lds_byte(int r, int c) { const int st = (r >> 4) * 2 + (c >> 5), rr = r & 15, cc = c & 31, ob = rr * 64 + cc * 2; return st * 1024 + (ob ^ (((ob >> 9) & 1) << 5)); }
__host__ __device__ __forceinline__ void stage_rc(int b, int& R, int& C) { const int st = b / 1024, sb = b % 1024, swz = sb ^ (((sb >> 9) & 1) << 5); R = (st >> 1) * 16 + swz / 64; C = (st & 1) * 32 + (swz % 64) / 2; }
__host__ __device__ __forceinline__ int perm32(int rho) { const int n = rho >> 4, i = rho & 15; return 8 * (i >> 2) + 4 * n + (i & 3); }

struct Unit { int pm, pn, k0, nt, mode, need; };
struct Gemm { const bf16_t* A; const bf16_t* Bt; int M, N, K; };

__device__ __forceinline__ unsigned cvt_pk_bf16(float lo, float hi) { unsigned r; asm volatile("v_cvt_pk_bf16_f32 %0, %1, %2" : "=v"(r) : "v"(lo), "v"(hi)); return r; }
template <class Epi, class Sched, bool ALIGN_EPI = false, bool SP2 = false>
__device__ __forceinline__ void gemm_phase(PG8_LAS unsigned char* lds, const Gemm g, Sched& S, const Epi& E) {
    const int tid = threadIdx.x, wid = __builtin_amdgcn_readfirstlane(tid >> 6), lane = tid & 63, wr = wid >> 2, wc = wid & 3, fr = lane & 15, fq = lane >> 4;
    constexpr int K = Sched::KK;
    unsigned voffA[2], voffB[2];
#pragma unroll
    for (int i = 0; i < 2; ++i) { int R, C; stage_rc(tid * 16 + i * 8192, R, C); const int Rb = Epi::PERM ? ((R & ~31) + perm32(R & 31)) : R;
        voffA[i] = (unsigned)(R * K + C) * 2u; voffB[i] = (unsigned)(Rb * K + C) * 2u; }
    const size_t kstep = (size_t)(BK * 2);
    const size_t hstep = (size_t)HALF * K * 2;
    const size_t tstep = 2 * hstep;
    const unsigned ldsw = (unsigned)wid * 1024u;
    const int aoff = lds_byte(wr * 64 + fr, fq * 8), boff = lds_byte(wc * 32 + fr, fq * 8);
#define PG8_SA(b, h) (((b) * 2 + (h)) * HTB)
#define PG8_SB(b, h) ((4 + (b) * 2 + (h)) * HTB)
#define PG8_STAGE(bufoff, gbase, voff) do { _Pragma("unroll") for (int _i = 0; _i < 2; ++_i) \
        __builtin_amdgcn_global_load_lds((const unsigned*)((const char*)(gbase) + (voff)[_i]), (PG8_LAS unsigned*)(lds + (bufoff) + ldsw + _i * 8192), 16, 0, 0); } while (0)
#define PG8_LDA(dst, b, h) do { _Pragma("unroll") for (int m = 0; m < 4; ++m) _Pragma("unroll") for (int k = 0; k < 2; ++k) dst[m][k] = *(const PG8_LAS bf16x8*)(lds + PG8_SA(b, h) + aoff + m * 2048 + k * 1024); } while (0)
#define PG8_LDB(dst, b, h) do { _Pragma("unroll") for (int n = 0; n < 2; ++n) _Pragma("unroll") for (int k = 0; k < 2; ++k) dst[n][k] = *(const PG8_LAS bf16x8*)(lds + PG8_SB(b, h) + boff + n * 2048 + k * 1024); } while (0)
#define PG8_MMA(ai, bj, At, Bt) do { __builtin_amdgcn_s_setprio(1); _Pragma("unroll") for (int m = 0; m < 4; ++m) _Pragma("unroll") for (int n = 0; n < 2; ++n) _Pragma("unroll") for (int k = 0; k < 2; ++k) \
        acc[ai][bj][m][n] = __builtin_amdgcn_mfma_f32_16x16x32_bf16(Bt[n][k], At[m][k], acc[ai][bj][m][n], 0, 0, 0); __builtin_amdgcn_s_setprio(0); } while (0)
#define PG8_WAIT_V(n) asm volatile("s_waitcnt vmcnt(" #n ")" ::: "memory")
#define PG8_WAIT_L(n) asm volatile("s_waitcnt lgkmcnt(" #n ")" ::: "memory")
#define PG8_BAR __builtin_amdgcn_s_barrier()
#define PG8_SCHED __builtin_amdgcn_sched_barrier(0)
    Unit cur, nxt; int ui = 0;
    if (!S.next(0, cur)) return;
    f32x4 acc[2][2][4][2];
#pragma unroll
    for (int a = 0; a < 2; ++a)
#pragma unroll
        for (int b = 0; b < 2; ++b)
#pragma unroll
            for (int m = 0; m < 4; ++m)
#pragma unroll
                for (int n = 0; n < 2; ++n) acc[a][b][m][n] = (f32x4){0.f, 0.f, 0.f, 0.f};
    bf16x8 At[4][2], B0[2][2], B1[2][2];
    const char* cA = (const char*)g.A + (size_t)cur.pm * tstep + (size_t)cur.k0 * kstep; const char* cB = (const char*)g.Bt + (size_t)cur.pn * tstep + (size_t)cur.k0 * kstep;
    S.a_ready(cur);
    if constexpr (SP2) {
        PG8_STAGE(PG8_SB(0, 0), cB, voffB); PG8_STAGE(PG8_SB(0, 1), cB + hstep, voffB); PG8_STAGE(PG8_SA(0, 0), cA, voffA); PG8_STAGE(PG8_SA(0, 1), cA + hstep, voffA);
        if (wr == 1) PG8_BAR;
        PG8_WAIT_V(2); PG8_BAR;
        PG8_STAGE(PG8_SB(1, 0), cB + kstep, voffB); PG8_STAGE(PG8_SA(1, 0), cA + kstep, voffA); PG8_STAGE(PG8_SB(1, 1), cB + hstep + kstep, voffB);
        PG8_WAIT_V(6); PG8_BAR;
    } else {
        PG8_STAGE(PG8_SB(0, 0), cB, voffB); PG8_STAGE(PG8_SA(0, 0), cA, voffA); PG8_STAGE(PG8_SB(0, 1), cB + hstep, voffB); PG8_STAGE(PG8_SA(0, 1), cA + hstep, voffA);
        if (wr == 1) PG8_BAR;
        PG8_WAIT_V(4); PG8_BAR;
        PG8_STAGE(PG8_SB(1, 0), cB + kstep, voffB); PG8_STAGE(PG8_SA(1, 0), cA + kstep, voffA); PG8_STAGE(PG8_SB(1, 1), cB + hstep + kstep, voffB);
        PG8_WAIT_V(6); PG8_BAR;
    }
    for (;;) {
        const bool has_next = S.next(ui + 1, nxt);
        const char* nA = has_next ? (const char*)g.A + (size_t)nxt.pm * tstep + (size_t)nxt.k0 * kstep : cA; const char* nB = has_next ? (const char*)g.Bt + (size_t)nxt.pn * tstep + (size_t)nxt.k0 * kstep : cB;
        const int nt = cur.nt;
        for (int t = 0; t < nt; t += 2) {
            const bool last = (t == nt - 2);
            const char* a1 = cA + (size_t)(t + 1) * kstep;
            const char* a2 = last ? nA : cA + (size_t)(t + 2) * kstep; const char* b2 = last ? nB : cB + (size_t)(t + 2) * kstep;
            const char* a3 = a2 + kstep; const char* b3 = b2 + kstep;
            if (last && has_next) S.a_ready(nxt);
            if constexpr (SP2) {
            PG8_LDB(B0, 0, 0); PG8_LDB(B1, 0, 1); PG8_SCHED; PG8_LDA(At, 0, 0); PG8_STAGE(PG8_SA(1, 1), a1 + hstep, voffA);
            PG8_WAIT_V(8); PG8_WAIT_L(0); PG8_BAR; PG8_MMA(0, 0, At, B0); PG8_MMA(0, 1, At, B1); PG8_BAR; PG8_SCHED;
            PG8_LDA(At, 0, 1); PG8_STAGE(PG8_SB(0, 0), b2, voffB); PG8_STAGE(PG8_SB(0, 1), b2 + hstep, voffB); PG8_STAGE(PG8_SA(0, 0), a2, voffA);
            PG8_WAIT_V(8); PG8_WAIT_L(0); PG8_BAR; PG8_MMA(1, 0, At, B0); PG8_MMA(1, 1, At, B1); PG8_BAR; PG8_SCHED;
            PG8_LDB(B0, 1, 0); PG8_LDB(B1, 1, 1); PG8_SCHED; PG8_LDA(At, 1, 0); PG8_STAGE(PG8_SA(0, 1), a2 + hstep, voffA);
            PG8_WAIT_V(8); PG8_WAIT_L(0); PG8_BAR; PG8_MMA(0, 0, At, B0); PG8_MMA(0, 1, At, B1); PG8_BAR; PG8_SCHED;
            PG8_LDA(At, 1, 1); PG8_STAGE(PG8_SB(1, 0), b3, voffB); PG8_STAGE(PG8_SB(1, 1), b3 + hstep, voffB); PG8_STAGE(PG8_SA(1, 0), a3, voffA);
            PG8_WAIT_V(8); PG8_WAIT_L(0); PG8_BAR; PG8_MMA(1, 0, At, B0); PG8_MMA(1, 1, At, B1); PG8_BAR; PG8_SCHED;
            } else {
            PG8_LDB(B0, 0, 0); PG8_SCHED; PG8_LDA(At, 0, 0); PG8_STAGE(PG8_SA(1, 1), a1 + hstep, voffA);
            PG8_WAIT_L(8); PG8_BAR; PG8_WAIT_L(0); PG8_MMA(0, 0, At, B0); PG8_BAR; PG8_SCHED;
            PG8_LDB(B1, 0, 1); PG8_STAGE(PG8_SB(0, 0), b2, voffB);
            PG8_BAR; PG8_WAIT_L(0); PG8_MMA(0, 1, At, B1); PG8_BAR;
            PG8_LDA(At, 0, 1); PG8_STAGE(PG8_SA(0, 0), a2, voffA);
            PG8_BAR; PG8_WAIT_L(0); PG8_MMA(1, 0, At, B0); PG8_BAR; PG8_SCHED;
            PG8_STAGE(PG8_SB(0, 1), b2 + hstep, voffB);
            PG8_WAIT_V(6); PG8_BAR; PG8_MMA(1, 1, At, B1); PG8_BAR;
            PG8_LDB(B0, 1, 0); PG8_SCHED; PG8_LDA(At, 1, 0); PG8_STAGE(PG8_SA(0, 1), a2 + hstep, voffA);
            PG8_WAIT_L(8); PG8_BAR; PG8_WAIT_L(0); PG8_MMA(0, 0, At, B0); PG8_BAR; PG8_SCHED;
            PG8_LDB(B1, 1, 1); PG8_STAGE(PG8_SB(1, 0), b3, voffB);
            PG8_BAR; PG8_WAIT_L(0); PG8_MMA(0, 1, At, B1); PG8_BAR;
            PG8_LDA(At, 1, 1); PG8_STAGE(PG8_SA(1, 0), a3, voffA);
            PG8_BAR; PG8_WAIT_L(0); PG8_MMA(1, 0, At, B0); PG8_BAR; PG8_SCHED;
            PG8_STAGE(PG8_SB(1, 1), b3 + hstep, voffB);
            PG8_WAIT_V(6); PG8_BAR; PG8_MMA(1, 1, At, B1); PG8_BAR;
            }
        }
        if constexpr (ALIGN_EPI) { if (wr == 0) PG8_BAR; }
        static_assert(ALIGN_EPI && !Epi::AFTER_DRAIN, "the slab exchange needs both halves aligned in the epilogue");
        S.finish(acc, cur, E, tid, wid, wr, wc, fr, fq);
        if (!has_next) break;
        if (cur.mode != 4)
#pragma unroll
        for (int a = 0; a < 2; ++a)
#pragma unroll
            for (int b = 0; b < 2; ++b)
#pragma unroll
                for (int m = 0; m < 4; ++m)
#pragma unroll
                    for (int n = 0; n < 2; ++n) acc[a][b][m][n] = (f32x4){0.f, 0.f, 0.f, 0.f};
        cur = nxt; cA = nA; cB = nB; ++ui;
        if constexpr (ALIGN_EPI) { if (wr == 1) PG8_BAR; }
    }
    PG8_WAIT_V(0);
    if constexpr (!ALIGN_EPI) { if (wr == 0) PG8_BAR; }
    PG8_BAR;
    S.finish_last(acc, cur, E, tid, wid, wr, wc, fr, fq);
#undef PG8_SA
#undef PG8_SB
#undef PG8_STAGE
#undef PG8_LDA
#undef PG8_LDB
#undef PG8_MMA
#undef PG8_WAIT_V
#undef PG8_WAIT_L
#undef PG8_BAR
#undef PG8_SCHED
}
}

namespace pg8 {
constexpr float RMS_EPS = 1e-6f;
__device__ __forceinline__ float fsig(float x) { return __builtin_amdgcn_rcpf(1.0f + __builtin_amdgcn_exp2f(x * -1.4426950408889634f)); }
__device__ __forceinline__ float bflo(unsigned w) { return __builtin_bit_cast(float, w << 16); }
__device__ __forceinline__ float bfhi(unsigned w) { return __builtin_bit_cast(float, w & 0xffff0000u); }
__device__ __forceinline__ u32x4 pack8(const f32x4& a, const f32x4& b) { u32x4 w; w.x = cvt_pk_bf16(a[0], a[1]); w.y = cvt_pk_bf16(a[2], a[3]); w.z = cvt_pk_bf16(b[0], b[1]); w.w = cvt_pk_bf16(b[2], b[3]); return w; }
__device__ __forceinline__ float sq4(const f32x4& a) { return (a[0] * a[0] + a[1] * a[1]) + (a[2] * a[2] + a[3] * a[3]); }
__device__ __forceinline__ void row_atomic(float* p, float q, int fq) { q += __shfl_xor(q, 16); q += __shfl_xor(q, 32); if (fq == 0) (void)__hip_atomic_fetch_add(p, q, __ATOMIC_RELAXED, __HIP_MEMORY_SCOPE_AGENT); }


#define PG8_EPI_ALL __device__ __forceinline__ void operator()(const f32x4 (&acc)[2][2][4][2], const Unit& u, int wr, int wc, int fr, int fq) const { \
        grp<0, 0>(acc, u, wr, wc, fr, fq); grp<0, 1>(acc, u, wr, wc, fr, fq); grp<0, 2>(acc, u, wr, wc, fr, fq); grp<0, 3>(acc, u, wr, wc, fr, fq); \
        grp<1, 0>(acc, u, wr, wc, fr, fq); grp<1, 1>(acc, u, wr, wc, fr, fq); grp<1, 2>(acc, u, wr, wc, fr, fq); grp<1, 3>(acc, u, wr, wc, fr, fq); }
template <int N_, int K_, int NP_ = 32, int RS_ = 0, int MID_ = 0> struct HybridOrder {
    static constexpr size_t SLAB_BYTES = (size_t)BM * BM * 2;
    static constexpr int KK = K_, G = 256, nM = 9216 / BM, nN = N_ / BM, ntp = K_ / (2 * BK), nwg = nM * nN, per = G / 8, q = nwg / 8, R = NP_ > 0 ? q / per : (q + per - 1) / per, pairs = NP_ > 0 ? (q - R * per) * ntp : 0, np = NP_ <= 0 ? 1 : (NP_ < per ? NP_ : per), base = pairs / np, rem = pairs - base * np;
    static constexpr int Tr = q - R * per, S = RS_ > 0 ? RS_ : 1;
    static_assert(nwg % 8 == 0 && K_ % (2 * BK) == 0 && N_ % BM == 0 && (RS_ == 0 || (Tr * RS_ <= per && ntp >= RS_ && RS_ <= 8 && NP_ > 0)), "HybridOrder shapes");
    int x, j, rend, cur, vcu;
    unsigned char* slab; unsigned* flags; unsigned* tmo;
    __device__ __forceinline__ void init(int bx, unsigned char* slab_, unsigned* flags_, unsigned* tmo_) {
        x = bx & 7; j = bx >> 3;
        cur = j * base + (j < rem ? j : rem); rend = cur + base + (j < rem ? 1 : 0);
        if (j >= np) { cur = 0; rend = 0; }
        if (RS_ > 0) { cur = 0; rend = (j < Tr * S) ? 1 : 0; }
        vcu = x * per + j; slab = slab_; flags = flags_; tmo = tmo_;
    }
    __device__ __forceinline__ void tile_of(int wgid, Unit& u) const {
        constexpr int nig = WGM * nN; const int gid = wgid / nig, fm = gid * WGM, gsz = (nM - fm) < WGM ? (nM - fm) : WGM;
        u.pm = fm + ((wgid % nig) % gsz); u.pn = (wgid % nig) / gsz;
    }
    __device__ __forceinline__ bool next(int i, Unit& u) {
        if (MID_ > 0) { if (i < 2 * R) { const int ii = i >> 1; tile_of(x * q + ii * per + j, u); u.need = 0;
                if (i & 1) { u.k0 = MID_; u.nt = 2 * ntp - MID_; u.mode = 0; } else { u.k0 = 0; u.nt = MID_; u.mode = 4; } return true; } }
        else if (i < R) { if (i * per + j >= q) return false; tile_of(x * q + i * per + j, u); u.k0 = 0; u.nt = 2 * ntp; u.mode = 0; u.need = 0; return true; }
        if (cur >= rend) return false;
        if (RS_ > 0) { const int t = j / S, p = j - t * S; constexpr int b = ntp / S, e = ntp - b * S;
            tile_of(x * q + R * per + t, u); u.k0 = 2 * (p * b + (p < e ? p : e)); u.nt = 2 * (b + (p < e ? 1 : 0)); u.mode = 3; u.need = p; cur = rend; return true; }
        const int t = cur / ntp, off = cur - t * ntp; int len = ntp - off; if (len > rend - cur) len = rend - cur;
        tile_of(x * q + R * per + t, u); u.k0 = 2 * off; u.nt = 2 * len; u.need = ntp - off - len;
        u.mode = off > 0 ? 1 : (u.need > 0 ? 2 : 0);
        cur += len; return true;
    }
    __device__ __forceinline__ void a_ready(const Unit&) const {}
    template <class Epi> __device__ __forceinline__ void finish(f32x4 (&acc)[2][2][4][2], const Unit& u, const Epi& E, int tid, int wid, int wr, int wc, int fr, int fq) const {
        asm volatile("" : "+v"(tid), "+v"(fr), "+v"(fq));
        if constexpr (RS_ == 0 && NP_ > 0) if (u.mode == 1) {
            __amdgpu_buffer_rsrc_t rs = __builtin_amdgcn_make_buffer_rsrc(slab + (size_t)vcu * SLAB_BYTES, 0, (int)SLAB_BYTES, 0x00020000);
            const int vo = tid * 16;
#pragma unroll
            for (int ai = 0; ai < 2; ++ai)
#pragma unroll
                for (int bj = 0; bj < 2; ++bj)
#pragma unroll
                    for (int m = 0; m < 4; ++m) { __builtin_amdgcn_raw_buffer_store_b128(pack8(acc[ai][bj][m][0], acc[ai][bj][m][1]), rs, vo + (ai * 8 + bj * 4 + m) * 8192, 0, 16); asm volatile("" ::: "memory"); }
            asm volatile("s_waitcnt vmcnt(0)" ::: "memory");
            __builtin_amdgcn_s_barrier();
            if (tid == 0) __hip_atomic_store(flags + 64 * vcu, 1u, __ATOMIC_RELAXED, __HIP_MEMORY_SCOPE_AGENT);
            return;
        }
        if constexpr (Epi::MIDK > 0) { if (u.mode == 4) { E.midscale(acc, u, wr, fr); return; } }
        if (u.mode >= 2) return;
        E(acc, u, wr, wc, fr, fq);
    }
    template <class Epi> __device__ __forceinline__ void finish_rs(f32x4 (&acc)[2][2][4][2], const Unit& u, const Epi& E, int tid, int wid, int wr, int wc, int fr, int fq) const {
        const int p = u.need, first = vcu - p;
        if constexpr (Epi::MIDK > 0) { if (u.k0 + u.nt <= Epi::MIDK) E.midscale(acc, u, wr, fr); }
        { __amdgpu_buffer_rsrc_t rs = __builtin_amdgcn_make_buffer_rsrc(slab + (size_t)vcu * SLAB_BYTES, 0, (int)SLAB_BYTES, 0x00020000);
          const int vo = tid * 16;
#pragma unroll
          for (int ai = 0; ai < 2; ++ai)
#pragma unroll
              for (int bj = 0; bj < 2; ++bj)
#pragma unroll
                  for (int m = 0; m < 4; ++m) { __builtin_amdgcn_raw_buffer_store_b128(pack8(acc[ai][bj][m][0], acc[ai][bj][m][1]), rs, vo + (ai * 8 + bj * 4 + m) * 8192, 0, 16); asm volatile("" ::: "memory"); }
          asm volatile("s_waitcnt vmcnt(0)" ::: "memory");
          __builtin_amdgcn_s_barrier();
          if (tid == 0) __hip_atomic_store(flags + 64 * vcu, 1u, __ATOMIC_RELAXED, __HIP_MEMORY_SCOPE_AGENT); }
        if (wid == 0) {
            for (int k = 0; k < S; ++k) { unsigned sp = 0;
                while (__hip_atomic_load(flags + 64 * (first + k), __ATOMIC_RELAXED, __HIP_MEMORY_SCOPE_AGENT) == 0u) { __builtin_amdgcn_s_sleep(2);
                    if (++sp > (1u << 20)) { if (tid == 0) __hip_atomic_store(tmo, 0x5AB3u, __ATOMIC_RELAXED, __HIP_MEMORY_SCOPE_AGENT); break; } } }
            __builtin_amdgcn_fence(__ATOMIC_ACQUIRE, "agent"); asm volatile("s_waitcnt vmcnt(0)" ::: "memory");
        }
        asm volatile("" ::: "memory"); __builtin_amdgcn_s_barrier(); asm volatile("" ::: "memory");
        const u32x4* sl0 = (const u32x4*)(slab + (size_t)first * SLAB_BYTES) + tid;
#define PG8_RS_GROUP(AI, MM) if ((AI * 4 + MM) % S == p) { u32x4 w0[S], w1[S]; \
            _Pragma("unroll") for (int k = 0; k < S; ++k) { const u32x4* sk = sl0 + (size_t)k * (SLAB_BYTES / 16); w0[k] = sk[(AI * 8 + MM) * 512]; w1[k] = sk[(AI * 8 + 4 + MM) * 512]; } \
            f32x4 a00 = {0.f, 0.f, 0.f, 0.f}, a01 = a00, a10 = a00, a11 = a00; \
            _Pragma("unroll") for (int k = 0; k < S; ++k) { a00 += (f32x4){bflo(w0[k].x), bfhi(w0[k].x), bflo(w0[k].y), bfhi(w0[k].y)}; a01 += (f32x4){bflo(w0[k].z), bfhi(w0[k].z), bflo(w0[k].w), bfhi(w0[k].w)}; \
                a10 += (f32x4){bflo(w1[k].x), bfhi(w1[k].x), bflo(w1[k].y), bfhi(w1[k].y)}; a11 += (f32x4){bflo(w1[k].z), bfhi(w1[k].z), bflo(w1[k].w), bfhi(w1[k].w)}; } \
            acc[AI][0][MM][0] = a00; acc[AI][0][MM][1] = a01; acc[AI][1][MM][0] = a10; acc[AI][1][MM][1] = a11; \
            E.template grp<AI, MM>(acc, u, wr, wc, fr, fq); }
        PG8_RS_GROUP(0, 0) PG8_RS_GROUP(0, 1) PG8_RS_GROUP(0, 2) PG8_RS_GROUP(0, 3) PG8_RS_GROUP(1, 0) PG8_RS_GROUP(1, 1) PG8_RS_GROUP(1, 2) PG8_RS_GROUP(1, 3)
#undef PG8_RS_GROUP
    }
    template <class Epi> __device__ __forceinline__ void finish_last(f32x4 (&acc)[2][2][4][2], const Unit& u, const Epi& E, int tid, int wid, int wr, int wc, int fr, int fq) const {
        if constexpr (RS_ > 0) { if (u.mode == 3) finish_rs(acc, u, E, tid, wid, wr, wc, fr, fq); return; }
        if constexpr (NP_ <= 0) return;
        if (u.mode != 2) return;
        int ns = 0; { int need = u.need; for (int jj = j + 1; need > 0 && jj < np; ++jj) { const int len = base + (jj < rem ? 1 : 0); if (len == 0) break; need -= (len < need ? len : need); ++ns; } }
        if (wid == 0) {
            for (int k = 1; k <= ns; ++k) { unsigned sp = 0;
                while (__hip_atomic_load(flags + 64 * (vcu + k), __ATOMIC_RELAXED, __HIP_MEMORY_SCOPE_AGENT) == 0u) { __builtin_amdgcn_s_sleep(2);
                    if (++sp > (1u << 20)) { if (tid == 0) __hip_atomic_store(tmo, 0x5AB0u, __ATOMIC_RELAXED, __HIP_MEMORY_SCOPE_AGENT); break; } } }
            __builtin_amdgcn_fence(__ATOMIC_ACQUIRE, "agent"); asm volatile("s_waitcnt vmcnt(0)" ::: "memory");
        }
        asm volatile("" ::: "memory"); __builtin_amdgcn_s_barrier(); asm volatile("" ::: "memory");
        for (int k = 1; k <= ns; ++k) {
            const u32x4* sl = (const u32x4*)(slab + (size_t)(vcu + k) * SLAB_BYTES) + tid;
            u32x4 w[16];
#pragma unroll
            for (int i = 0; i < 16; ++i) w[i] = sl[i * 512];
#pragma unroll
            for (int ai = 0; ai < 2; ++ai)
#pragma unroll
                for (int bj = 0; bj < 2; ++bj)
#pragma unroll
                    for (int m = 0; m < 4; ++m) { const u32x4 v = w[ai * 8 + bj * 4 + m];
                        acc[ai][bj][m][0] += (f32x4){bflo(v.x), bfhi(v.x), bflo(v.y), bfhi(v.y)}; acc[ai][bj][m][1] += (f32x4){bflo(v.z), bfhi(v.z), bflo(v.w), bfhi(v.w)}; }
        }
        E(acc, u, wr, wc, fr, fq);
    }
};
struct EpiIn {
    static constexpr bool PERM = true, AFTER_DRAIN = false; static constexpr int MIDK = 0;
    bf16_t* U; bf16_t* S; const float* rx;
    template <int ai, int m> __device__ __forceinline__ void grp(const f32x4 (&acc)[2][2][4][2], const Unit& u, int wr, int wc, int fr, int fq) const {
        const int row = u.pm * BM + wr * 64 + fr + ai * HALF + m * 16; const float r = rx[row];
        if (u.pn < 8) {
            const int col0 = u.pn * 128 + wc * 32 + 8 * fq;
            f32x4 v0, v1;
#pragma unroll
            for (int j = 0; j < 4; ++j) { v0[j] = (acc[ai][0][m][0][j] * r) * fsig(acc[ai][1][m][0][j] * r); v1[j] = (acc[ai][0][m][1][j] * r) * fsig(acc[ai][1][m][1][j] * r); }
            *(u32x4*)(U + (size_t)row * 1024 + col0) = pack8(v0, v1);
        } else {
            const int col0 = (u.pn - 8) * 256 + wc * 32 + 8 * fq;
#pragma unroll
            for (int bj = 0; bj < 2; ++bj) *(u32x4*)(S + (size_t)row * 1024 + col0 + bj * HALF) = pack8(acc[ai][bj][m][0] * r, acc[ai][bj][m][1] * r);
        }
    }
    PG8_EPI_ALL
};
struct EpiGlu {
    static constexpr bool PERM = true, AFTER_DRAIN = false; static constexpr int MIDK = 0;
    const bf16_t* G; bf16_t* MIX; float* ssq;
    template <int ai, int m> __device__ __forceinline__ void grp(const f32x4 (&acc)[2][2][4][2], const Unit& u, int wr, int wc, int fr, int fq) const {
        const int row0 = u.pm * BM + wr * 64 + fr, col0 = u.pn * BM + wc * 32 + 8 * fq;
            { const int row = row0 + ai * HALF + m * 16; float q = 0.f;
#pragma unroll
                for (int bj = 0; bj < 2; ++bj) { const u32x4 gw = *(const u32x4*)(G + (size_t)row * 1024 + col0 + bj * HALF);
                    f32x4 g0 = {bflo(gw.x), bfhi(gw.x), bflo(gw.y), bfhi(gw.y)}, g1 = {bflo(gw.z), bfhi(gw.z), bflo(gw.w), bfhi(gw.w)}, y0, y1;
#pragma unroll
                    for (int j = 0; j < 4; ++j) { y0[j] = g0[j] * fsig(acc[ai][bj][m][0][j]); y1[j] = g1[j] * fsig(acc[ai][bj][m][1][j]); }
                    q += sq4(y0) + sq4(y1);
                    *(u32x4*)(MIX + (size_t)row * 2048 + col0 + bj * HALF) = pack8(y0, y1); }
                row_atomic(ssq + row, q, fq); }
    }
    PG8_EPI_ALL
};
struct EpiOut {
    static constexpr bool PERM = true, AFTER_DRAIN = false; static constexpr int MIDK = 16;
    bf16_t* HB; float* ssq; const float* ssqs;
    __device__ __forceinline__ void midscale(f32x4 (&acc)[2][2][4][2], const Unit& u, int wr, int fr) const {
        const int row0 = u.pm * BM + wr * 64 + fr;
#pragma unroll
        for (int ai = 0; ai < 2; ++ai)
#pragma unroll
            for (int m = 0; m < 4; ++m) { const float r = __builtin_amdgcn_rsqf(ssqs[row0 + ai * HALF + m * 16] * (1.0f / 1024.0f) + RMS_EPS);
#pragma unroll
                for (int bj = 0; bj < 2; ++bj) { acc[ai][bj][m][0] *= r; acc[ai][bj][m][1] *= r; } }
    }
    template <int ai, int m> __device__ __forceinline__ void grp(const f32x4 (&acc)[2][2][4][2], const Unit& u, int wr, int wc, int fr, int fq) const {
        const int row0 = u.pm * BM + wr * 64 + fr, col0 = u.pn * BM + wc * 32 + 8 * fq;
            { const int row = row0 + ai * HALF + m * 16; float q = 0.f;
#pragma unroll
                for (int bj = 0; bj < 2; ++bj) { const size_t off = (size_t)row * 2048 + col0 + bj * HALF;
                    const u32x4 xw = *(const u32x4*)(HB + off);
                    const f32x4 h0 = (f32x4){bflo(xw.x), bfhi(xw.x), bflo(xw.y), bfhi(xw.y)} + acc[ai][bj][m][0], h1 = (f32x4){bflo(xw.z), bfhi(xw.z), bflo(xw.w), bfhi(xw.w)} + acc[ai][bj][m][1];
                    q += sq4(h0) + sq4(h1);
                    *(u32x4*)(HB + off) = pack8(h0, h1); }
                row_atomic(ssq + row, q, fq); }
    }
    PG8_EPI_ALL
};
struct EpiUp {
    static constexpr bool PERM = true, AFTER_DRAIN = false; static constexpr int MIDK = 0;
    bf16_t* ACT; const float* ssq;
    template <int ai, int m> __device__ __forceinline__ void grp(const f32x4 (&acc)[2][2][4][2], const Unit& u, int wr, int wc, int fr, int fq) const {
        const int row0 = u.pm * BM + wr * 64 + fr, col0 = u.pn * 128 + wc * 32 + 8 * fq;
            { const int row = row0 + ai * HALF + m * 16; const float r = __builtin_amdgcn_rsqf(ssq[row] * (1.0f / 2048.0f) + RMS_EPS);
                f32x4 v0, v1;
#pragma unroll
                for (int j = 0; j < 4; ++j) { const float a0 = acc[ai][0][m][0][j] * r, a1 = acc[ai][0][m][1][j] * r;
                    v0[j] = a0 * fsig(a0) * (acc[ai][1][m][0][j] * r); v1[j] = a1 * fsig(a1) * (acc[ai][1][m][1][j] * r); }
                *(u32x4*)(ACT + (size_t)row * 5632 + col0) = pack8(v0, v1); }
    }
    PG8_EPI_ALL
};
struct EpiDown {
    static constexpr bool PERM = true, AFTER_DRAIN = false; static constexpr int MIDK = 0;
    bf16_t* HB; float* ssq; float zmul;
    template <int ai, int m> __device__ __forceinline__ void grp(const f32x4 (&acc)[2][2][4][2], const Unit& u, int wr, int wc, int fr, int fq) const {
        const int row0 = u.pm * BM + wr * 64 + fr, col0 = u.pn * BM + wc * 32 + 8 * fq;
            { const int row = row0 + ai * HALF + m * 16; float q = 0.f;
#pragma unroll
                for (int bj = 0; bj < 2; ++bj) { bf16_t* p = HB + (size_t)row * 2048 + col0 + bj * HALF; const u32x4 hw = *(const u32x4*)p;
                    const f32x4 o0 = (f32x4){bflo(hw.x), bfhi(hw.x), bflo(hw.y), bfhi(hw.y)} + acc[ai][bj][m][0] * zmul, o1 = (f32x4){bflo(hw.z), bfhi(hw.z), bflo(hw.w), bfhi(hw.w)} + acc[ai][bj][m][1] * zmul;
                    q += sq4(o0) + sq4(o1);
                    *(u32x4*)p = pack8(o0, o1); }
                row_atomic(ssq + row, q, fq); }
    }
    PG8_EPI_ALL
};
}

constexpr int NWAVES = 8;
#ifndef MK_N_LAUNCHES
#define MK_N_LAUNCHES 1
#endif
constexpr int NPH = 9;
constexpr int N_LAUNCHES = MK_N_LAUNCHES;

constexpr int D = 2048, DC = 1024, DS = 1024, DIN = 3072, DFF = 5632, NG = 64, NP = 64, CH = 16, KW = 31;
constexpr int BATCH = 4, SEQ = 2048, DB = 128, DSQ = 8;
constexpr int MP = BATCH * SEQ, MS = DB * DSQ, M = MP + MS;

constexpr size_t MiB = 1u << 20;
constexpr size_t WS_CTL = 0, CTL_ZERO_BYTES = 1 * MiB;
constexpr size_t WS_TAB = 1 * MiB;
constexpr size_t WS_WGU = 2 * MiB, WS_WDN = 46 * MiB, WS_XB = 68 * MiB;
constexpr size_t WS_WIN = 104 * MiB, WS_WGL = 116 * MiB, WS_WOUT = 118 * MiB;
constexpr size_t WS_U = 126 * MiB, WS_S = 144 * MiB, WS_G = 162 * MiB, WS_MIX = 180 * MiB;
constexpr size_t WS_ACT = 104 * MiB;
constexpr size_t WS_END = 235 * MiB;
constexpr size_t SLAB_P1 = 162 * MiB, SLAB_P3 = 126 * MiB, SLAB_P5 = 126 * MiB, SLAB_P6 = 203 * MiB, SLAB_P7 = 2 * MiB;
static_assert(WS_WGU + (size_t)2 * DFF * D * 2 <= WS_WDN && WS_WDN + (size_t)D * DFF * 2 <= WS_XB && WS_XB + (size_t)M * D * 2 <= WS_WIN, "ws map 1");
static_assert(WS_WIN + (size_t)DIN * D * 2 <= WS_WGL && WS_WGL + (size_t)DS * DS * 2 <= WS_WOUT && WS_WOUT + (size_t)D * D * 2 <= WS_U, "ws map 2");
static_assert(WS_U + (size_t)M * DC * 2 <= WS_S && WS_S + (size_t)M * DS * 2 <= WS_G && WS_G + (size_t)M * DS * 2 <= WS_MIX && WS_MIX + (size_t)M * D * 2 <= WS_END, "ws map 3");
static_assert(WS_ACT + (size_t)M * DFF * 2 <= SLAB_P6 && SLAB_P6 + 32 * MiB <= WS_END && WS_END <= 256 * MiB, "ws map 4");
constexpr int CW_TMO = 0, CW_CODE = 1;
constexpr int CW_BAR = 4096;
constexpr int CW_SSQ_S = 16384, CW_SSQ_H = CW_SSQ_S + M, CW_SSQ_O = CW_SSQ_H + M;
constexpr int CW_DUMMY = CW_SSQ_O + M;
constexpr int CW_FLAGS = 81920, FLAG_SLOT = 16384;
constexpr int CW_RX = 65536;
static_assert((CW_RX + M) * 4 <= (int)CTL_ZERO_BYTES && CW_DUMMY + M <= CW_RX, "ctl map");
constexpr size_t TAB_AB = 0;
constexpr size_t TAB_BBT = 64 * 1024;
constexpr size_t TAB_CQ = 512 * 1024;

constexpr int RING_OFF = 0, RING_BYTES = 131072;
constexpr int LDSCTL_OFF = RING_BYTES, MISC_OFF = LDSCTL_OFF + 320;
constexpr int LDS_BYTES = 147456;
static_assert(MISC_OFF + 128 <= LDS_BYTES, "LDS map");

#define GAS __attribute__((address_space(1)))
#define LAS __attribute__((address_space(3)))
typedef unsigned short bf16;
typedef unsigned v4u __attribute__((ext_vector_type(4)));
typedef unsigned v2u __attribute__((ext_vector_type(2)));
typedef float f32x4 __attribute__((ext_vector_type(4)));
typedef float f32x2 __attribute__((ext_vector_type(2)));
typedef float f32x16 __attribute__((ext_vector_type(16)));
typedef short bf16x8 __attribute__((ext_vector_type(8)));
typedef GAS unsigned gu32;
#define RLX_AGENT __ATOMIC_RELAXED, __HIP_MEMORY_SCOPE_AGENT
#define LDS_WAIT() asm volatile("s_waitcnt lgkmcnt(0)" ::: "memory")
#define VM_WAIT() asm volatile("s_waitcnt vmcnt(0)" ::: "memory")
__device__ __forceinline__ unsigned f2bf(float f) { unsigned u = __builtin_bit_cast(unsigned, f); return (u + 0x7fffu + ((u >> 16) & 1u)) >> 16; }
__device__ __forceinline__ unsigned pk2(float lo, float hi) { return f2bf(lo) | (f2bf(hi) << 16); }
__device__ __forceinline__ float bf_lo(unsigned w) { return __builtin_bit_cast(float, w << 16); }
__device__ __forceinline__ float bf_hi(unsigned w) { return __builtin_bit_cast(float, w & 0xffff0000u); }
#define WS_DPP(v, ctrl, rm) ((v) + __builtin_bit_cast(float, __builtin_amdgcn_update_dpp(0, __builtin_bit_cast(int, (v)), (ctrl), (rm), 0xF, true)))
__device__ __forceinline__ float wave_sum63(float v) {
    v = WS_DPP(v, 0xB1, 0xF); v = WS_DPP(v, 0x4E, 0xF); v = WS_DPP(v, 0x141, 0xF); v = WS_DPP(v, 0x140, 0xF); v = WS_DPP(v, 0x142, 0xA); v = WS_DPP(v, 0x143, 0xC);
    return v;
}
__device__ __forceinline__ float fsigm(float x) { return __builtin_amdgcn_rcpf(1.0f + __builtin_amdgcn_exp2f(x * -1.4426950408889634f)); }
__device__ __forceinline__ float gelu_tanh_f(float x) {
    const float u2 = 1.5957691216057308f * (x + 0.044715f * x * x * x);
    return x * fsigm(u2);
}

#define XB_TMO      128
#define XB_XCNT(j)  (256  + 64 * (j))
#define XB_XSUB(j)  (1280 + 64 * (j))
#define XB_XGEN(j)  (2304 + 64 * (j))
#define XB_TOP      3328
#define XB_TOPGEN   3392
#define XCD_BAR_WORDS 3456
#define XB_SPIN_CAP (1u << 18)

__device__ __forceinline__ unsigned xb_ld(unsigned* p)              { return __hip_atomic_load(p, __ATOMIC_RELAXED, __HIP_MEMORY_SCOPE_AGENT); }
__device__ __forceinline__ unsigned xb_add(unsigned* p, unsigned v) { return __hip_atomic_fetch_add(p, v, __ATOMIC_RELAXED, __HIP_MEMORY_SCOPE_AGENT); }
__device__ __forceinline__ unsigned xb_xcc_id() { return (unsigned)__builtin_amdgcn_s_getreg((3 << 11) | 20) & 0xFu; }
#define XB_SPIN(cond, bar) do { unsigned _sp = 0; while (cond) { __builtin_amdgcn_s_sleep(1); \
    if ((++_sp & 255u) == 0u) { if (xb_ld(&(bar)[XB_TMO])) break; if (_sp > XB_SPIN_CAP) { atomicAdd(&(bar)[XB_TMO], 1u); break; } } } } while (0)

struct XcdBarrier {
    unsigned* bar; unsigned x;
    volatile LAS unsigned* st;
};

__device__ __forceinline__ XcdBarrier xcd_barrier_post(unsigned* bar, volatile LAS unsigned* st) {
    XcdBarrier b; b.bar = bar; b.x = xb_xcc_id(); b.st = st;
    if (threadIdx.x == 0) (void)xb_add(&bar[XB_XCNT(b.x)], 1u);
    return b;
}
__device__ __forceinline__ void xcd_barrier_complete(unsigned* bar, unsigned x, unsigned& nloc, unsigned& nx) {
    const unsigned G = gridDim.x * gridDim.y * gridDim.z;
    unsigned sum, cnt, mine, sp = 0u;
    for (;;) {
        sum = 0u; cnt = 0u; mine = 0u;
#pragma unroll
        for (unsigned j = 0; j < 16; ++j) { const unsigned c = xb_ld(&bar[XB_XCNT(j)]); sum += c; cnt += (c > 0u) ? 1u : 0u; mine = (j == x) ? c : mine; }
        if (sum == G) break;
        __builtin_amdgcn_s_sleep(1);
        if ((++sp & 255u) == 0u) { if (xb_ld(&bar[XB_TMO])) break; if (sp > XB_SPIN_CAP) { atomicAdd(&bar[XB_TMO], 1u); break; } }
    }
    nloc = mine > 0u ? mine : 1u; nx = cnt > 0u ? cnt : 1u;
}

__device__ __forceinline__ void xcd_barrier(const XcdBarrier& b) {
    asm volatile("s_waitcnt vmcnt(0)" ::: "memory");
    __syncthreads();
    if (threadIdx.x == 0) {
        unsigned* bar = b.bar;
        __builtin_amdgcn_s_waitcnt(0);
        unsigned nloc = b.st[0], nx = b.st[1];
        if (nloc == 0u) { xcd_barrier_complete(bar, b.x, nloc, nx); b.st[0] = nloc; b.st[1] = nx; }
        const unsigned old = xb_add(&bar[XB_XSUB(b.x)], 1u);
        const unsigned gen = old / nloc;
        if (old + 1u == (gen + 1u) * nloc) {
            __builtin_amdgcn_fence(__ATOMIC_RELEASE, "agent");
            asm volatile("s_waitcnt vmcnt(0)" ::: "memory");
            const unsigned og = xb_add(&bar[XB_TOP], 1u);
            const unsigned tg = og / nx;
            if (og + 1u == (tg + 1u) * nx) xb_add(&bar[XB_TOPGEN], 1u);
            else XB_SPIN(xb_ld(&bar[XB_TOPGEN]) == tg, bar);
            __builtin_amdgcn_fence(__ATOMIC_ACQUIRE, "agent");
            xb_add(&bar[XB_XGEN(b.x)], 1u);
            asm volatile("s_waitcnt vmcnt(0)" ::: "memory");
        } else {
            XB_SPIN(xb_ld(&bar[XB_XGEN(b.x)]) == gen, bar);
            __builtin_amdgcn_fence(__ATOMIC_ACQUIRE, "agent");
            asm volatile("s_waitcnt vmcnt(0)" ::: "memory");
        }
    }
    __syncthreads();
}
__device__ __forceinline__ unsigned cvtpk(float lo, float hi) { unsigned r; asm("v_cvt_pk_bf16_f32 %0, %1, %2" : "=v"(r) : "v"(lo), "v"(hi)); return r; }

struct P0Item { const float* W; const float* gp; bf16* WT; int N, K, orow, k0, n0, gain_on, kdst; };
__device__ __forceinline__ void p0_item_load(const P0Item& t, f32x4 (&v)[8], float (&gk)[8], int lane) {
    const int kr = lane >> 3, nq = lane & 7;
#pragma unroll
    for (int i = 0; i < 8; ++i) { const int kk = 8 * i + kr; v[i] = __builtin_nontemporal_load((const GAS f32x4*)(t.W + (size_t)(t.k0 + kk) * t.N + t.n0 + 4 * nq));
        const float gl = t.gp[t.gain_on ? t.k0 + kk : 0]; gk[i] = t.gain_on ? gl : 1.0f; }
}
__device__ __forceinline__ void p0_item_finish(const P0Item& t, const f32x4 (&v)[8], const float (&gk)[8], LAS float* scr, int lane) {
    const int kr = lane >> 3, nq = lane & 7;
#pragma unroll
    for (int i = 0; i < 8; ++i) { const int kk = 8 * i + kr; LAS float* d = scr + kk * 33 + 4 * nq; d[0] = v[i].x * gk[i]; d[1] = v[i].y * gk[i]; d[2] = v[i].z * gk[i]; d[3] = v[i].w * gk[i]; }
    LDS_WAIT(); asm volatile("" ::: "memory");
    const int c = lane & 7;
#pragma unroll
    for (int j = 0; j < 4; ++j) { const int n = (lane >> 3) + 8 * j; const LAS float* s = scr + (8 * c) * 33 + n;
        v4u o; o.x = cvtpk(s[0 * 33], s[1 * 33]); o.y = cvtpk(s[2 * 33], s[3 * 33]); o.z = cvtpk(s[4 * 33], s[5 * 33]); o.w = cvtpk(s[6 * 33], s[7 * 33]);
        *(GAS v4u*)(t.WT + (size_t)(t.orow + n) * t.K + t.kdst + 8 * c) = o; }
    LDS_WAIT(); asm volatile("" ::: "memory");
}

struct P0Args {
    const float *xp, *xs, *norm_mix, *w_in, *w_glu, *gn_conv, *gn_ssm, *w_out, *norm_ffn, *w_gate, *w_up, *w_down;
    const float *A_re, *A_im, *log_dt, *B_re, *B_im, *C_re, *C_im;
    bf16 *WIN, *WGL, *WOUT, *WGU, *WDN, *XB; float* rx; unsigned char* tab;
};
__device__ __forceinline__ void p0_convert(const P0Args& a, LAS unsigned char* lds, int first, int stride, int lo, int hi, int wave, int lane) {
    LAS float* scr = (LAS float*)(lds + RING_OFF + wave * 16384);
    constexpr int I_IN = (D / 64) * (DIN / 32), I_GL = (DS / 64) * (DS / 32), I_OUT = (D / 64) * (D / 32), I_GA = (D / 64) * (DFF / 32), I_DN = (DFF / 64) * (D / 32);
    constexpr int NITEMS = I_IN + I_GL + I_OUT + 2 * I_GA + I_DN;
#define P0_DECODE(t, it_) do { int r_ = (it_); \
        if (r_ < I_IN) { const int nb = r_ % (DIN / 32), kb = r_ / (DIN / 32), n0 = 32 * nb; \
            int orow; if (n0 < 2048) { const int bjv = n0 >> 10, ch = n0 & 1023; orow = 256 * (ch >> 7) + 128 * bjv + (ch & 127); } else orow = n0; \
            t.W = a.w_in; t.N = DIN; t.gp = a.norm_mix; t.gain_on = 1; t.WT = a.WIN; t.K = D; t.orow = orow; t.k0 = 64 * kb; t.kdst = 64 * kb; t.n0 = n0; break; } r_ -= I_IN; \
        if (r_ < I_GL) { const int nb = r_ % (DS / 32), kb = r_ / (DS / 32); \
            t.W = a.w_glu; t.N = DS; t.gp = a.norm_mix; t.gain_on = 0; t.WT = a.WGL; t.K = DS; t.orow = 32 * nb; t.k0 = 64 * kb; t.kdst = 64 * kb; t.n0 = 32 * nb; break; } r_ -= I_GL; \
        if (r_ < I_OUT) { const int nb = r_ % (D / 32), kb = r_ / (D / 32), k0 = 64 * kb; \
            t.W = a.w_out; t.N = D; t.gp = k0 < 1024 ? a.gn_conv : a.gn_ssm - 1024; t.gain_on = 1; t.WT = a.WOUT; t.K = D; t.orow = 32 * nb; t.k0 = k0; t.kdst = k0 ^ 1024; t.n0 = 32 * nb; break; }     r_ -= I_OUT; \
        if (r_ < I_GA) { const int nb = r_ % (DFF / 32), kb = r_ / (DFF / 32), n0 = 32 * nb; \
            t.W = a.w_gate; t.N = DFF; t.gp = a.norm_ffn; t.gain_on = 1; t.WT = a.WGU; t.K = D; t.orow = 256 * (n0 >> 7) + (n0 & 127); t.k0 = 64 * kb; t.kdst = 64 * kb; t.n0 = n0; break; } r_ -= I_GA; \
        if (r_ < I_GA) { const int nb = r_ % (DFF / 32), kb = r_ / (DFF / 32), n0 = 32 * nb; \
            t.W = a.w_up; t.N = DFF; t.gp = a.norm_ffn; t.gain_on = 1; t.WT = a.WGU; t.K = D; t.orow = 256 * (n0 >> 7) + 128 + (n0 & 127); t.k0 = 64 * kb; t.kdst = 64 * kb; t.n0 = n0; break; } r_ -= I_GA; \
        { const int nb = r_ % (D / 32), kb = r_ / (D / 32); \
            t.W = a.w_down; t.N = D; t.gp = a.norm_mix; t.gain_on = 0; t.WT = a.WDN; t.K = DFF; t.orow = 32 * nb; t.k0 = 64 * kb; t.kdst = 64 * kb; t.n0 = 32 * nb; } } while (0)
    {
        P0Item t0, t1, t2; f32x4 va[8], vb[8], vc[8]; float ga[8], gb[8], gc[8];
        if (lo + first < hi) { P0_DECODE(t0, lo + first); p0_item_load(t0, va, ga, lane); }
        if (lo + first + stride < hi) { P0_DECODE(t1, lo + first + stride); p0_item_load(t1, vb, gb, lane); }
        for (int it = lo + first; it < hi; it += stride) {
            const int itn = it + 2 * stride;
            if (itn < hi) { P0_DECODE(t2, itn); p0_item_load(t2, vc, gc, lane); }
            p0_item_finish(t0, va, ga, scr, lane);
            t0 = t1; t1 = t2;
#pragma unroll
            for (int i = 0; i < 8; ++i) { va[i] = vb[i]; ga[i] = gb[i]; vb[i] = vc[i]; gb[i] = gc[i]; }
        }
    }
#undef P0_DECODE
}
__device__ __forceinline__ void p0_tables(const P0Args& a, int gt) {
    {
      if (gt < NG * NP) { const int g = gt >> 6, p = gt & 63;
        const float ar = a.A_re[gt], ai = a.A_im[gt], dt = expf(a.log_dt[g]);
        const float th = dt * ai, e1 = expm1f(dt * ar), sh = sinf(0.5f * th), cm1 = -2.0f * sh * sh, cs = 1.0f + cm1;
        const float nr = e1 * cs + cm1, ni = (1.0f + e1) * sinf(th);
        const float abr = 1.0f + nr, abi = ni, den = ar * ar + ai * ai;
        const float kr = (nr * ar + ni * ai) / den, ki = (ni * ar - nr * ai) / den;
        float* AB = (float*)(a.tab + TAB_AB); AB[gt * 2] = abr; AB[gt * 2 + 1] = abi;
        bf16* BBT = (bf16*)(a.tab + TAB_BBT); bf16* CQ = (bf16*)(a.tab + TAB_CQ);
#pragma unroll
        for (int c = 0; c < 16; ++c) { const float br = a.B_re[(size_t)gt * CH + c], bi = a.B_im[(size_t)gt * CH + c];
            BBT[((size_t)(g * 2 + 0) * NP + p) * CH + c] = (bf16)f2bf(kr * br - ki * bi);
            BBT[((size_t)(g * 2 + 1) * NP + p) * CH + c] = (bf16)f2bf(kr * bi + ki * br);
            CQ[((size_t)g * CH + c) * 128 + 2 * p] = (bf16)f2bf(a.C_re[((size_t)g * CH + c) * NP + p]);
            CQ[((size_t)g * CH + c) * 128 + 2 * p + 1] = (bf16)f2bf(-a.C_im[((size_t)g * CH + c) * NP + p]); }
      } }
}
constexpr int P0_ITEMS_P3 = 8704;
constexpr int P0_ITEMS_B = (D / 64) * (DIN / 32) + (DS / 64) * (DS / 32) + (D / 64) * (D / 32) + 2 * (D / 64) * (DFF / 32), P0_ITEMS_A = P0_ITEMS_B - P0_ITEMS_P3;
constexpr int P0_ITEMS_ALL = P0_ITEMS_B + (DFF / 64) * (D / 32);
__device__ __forceinline__ void p0_prologue(const P0Args& a, LAS unsigned char* lds, int vcu, int G, int wave, int lane, int tid) {
    const int gw = vcu * NWAVES + wave, NGW = G * NWAVES;
    p0_convert(a, lds, gw, NGW, 0, P0_ITEMS_A, wave, lane);
#ifdef STAMP_A
    __syncthreads(); if (blockIdx.x == 0 && tid == 0) { const unsigned long long t_ = __builtin_amdgcn_s_memrealtime(); volatile LAS unsigned* M_ = (volatile LAS unsigned*)(lds + MISC_OFF); M_[12 + 2 * 15] = (unsigned)t_; M_[13 + 2 * 15] = (unsigned)(t_ >> 32); }
#endif
    {
        f32x4 v[8], vn[8];
        if (gw < M) { const GAS f32x4* xr = (const GAS f32x4*)(gw < MP ? a.xp + (size_t)gw * D : a.xs + (size_t)(gw - MP) * D) + lane;
#pragma unroll
            for (int j = 0; j < 8; ++j) v[j] = xr[64 * j]; }
        for (int row = gw; row < M; row += NGW) {
            const int rn = row + NGW;
            if (rn < M) { const GAS f32x4* xr = (const GAS f32x4*)(rn < MP ? a.xp + (size_t)rn * D : a.xs + (size_t)(rn - MP) * D) + lane;
#pragma unroll
                for (int j = 0; j < 8; ++j) vn[j] = xr[64 * j]; }
            float s = 0.f;
#pragma unroll
            for (int j = 0; j < 8; ++j) s += (v[j].x * v[j].x + v[j].y * v[j].y) + (v[j].z * v[j].z + v[j].w * v[j].w);
            s = wave_sum63(s);
            if (lane == 63) a.rx[row] = 1.0f / sqrtf(s * (1.0f / D) + 1e-6f);
            GAS v2u* o8 = (GAS v2u*)(a.XB + (size_t)row * D) + lane;
#pragma unroll
            for (int j = 0; j < 8; ++j) { v2u o; o.x = cvtpk(v[j].x, v[j].y); o.y = cvtpk(v[j].z, v[j].w); o8[64 * j] = o; }
#pragma unroll
            for (int j = 0; j < 8; ++j) v[j] = vn[j];
        }
    }
}

struct P2Args {
    const bf16* UC; const bf16* SI; bf16* G; bf16* MIX;
    const float *state_conv, *h0re, *h0im, *conv_w, *conv_b, *ln_g, *ln_b, *Dk;
    const unsigned char* tab;
    float *ncp, *nrp, *nip, *ncs, *nrs, *nis;
};
constexpr int P2_RED_OFF = 0, P2_TILE_OFF = 4096, P2_TILE_B = 4352, P2_TROW = 272, P2_UT_OFF = 73728, P2_SX_OFF = 81920;

#define CONV_LOAD_ROWS(rows, it_) do { \
        if ((it_) < 1024) { const int t0_ = ((it_) & 255) * 8, neg_ = (KW - 1) - t0_; const bf16* ub_ = a.UC + (size_t)(((it_) >> 8) * SEQ) * DC + c0; \
            _Pragma("unroll") for (int r_ = 0; r_ < 8 + KW - 1; ++r_) { const int tt_ = t0_ - (KW - 1) + r_; \
                const unsigned ld_ = *(const GAS unsigned*)(ub_ + (size_t)(tt_ > 0 ? tt_ : 0) * DC); rows[r_] = ld_ & (r_ >= neg_ ? 0xffffffffu : 0u); } } \
        else { const int b_ = (it_) - 1024; const float* hist_ = a.state_conv + (size_t)b_ * (KW - 1) * DC + c0; const bf16* ub_ = a.UC + (size_t)(MP + b_ * DSQ) * DC + c0; \
            _Pragma("unroll") for (int r_ = 0; r_ < KW - 1; ++r_) { const f32x2 hv_ = *(const GAS f32x2*)(hist_ + (size_t)r_ * DC); rows[r_] = cvtpk(hv_.x, hv_.y); } \
            _Pragma("unroll") for (int r_ = 0; r_ < 8; ++r_) rows[KW - 1 + r_] = *(const GAS unsigned*)(ub_ + (size_t)r_ * DC); } } while (0)

#define CONV_COMPUTE(rows, orow) do { \
        float ax_[8], ay_[8]; \
        _Pragma("unroll") for (int j = 0; j < 8; ++j) { ax_[j] = bias.x; ay_[j] = bias.y; } \
        _Pragma("unroll") for (int r = 0; r < 8 + KW - 1; ++r) { const float vx_ = bf_lo(rows[r]), vy_ = bf_hi(rows[r]); \
            _Pragma("unroll") for (int j = 0; j < 8; ++j) { const int k = r - j; if (k >= 0 && k < KW) { \
                asm("v_fmac_f32 %0, %1, %2" : "+v"(ax_[j]) : "v"(w[k].x), "v"(vx_)); asm("v_fmac_f32 %0, %1, %2" : "+v"(ay_[j]) : "v"(w[k].y), "v"(vy_)); } } }     \
        f32x2 acc[8]; \
        _Pragma("unroll") for (int j = 0; j < 8; ++j) acc[j] = (f32x2){ax_[j], ay_[j]}; \
        float st[16]; \
        _Pragma("unroll") for (int j = 0; j < 8; ++j) { st[j] = acc[j].x + acc[j].y; st[8 + j] = acc[j].x * acc[j].x + acc[j].y * acc[j].y; } \
        _Pragma("unroll") for (int j = 0; j < 16; ++j) st[j] = wave_sum63(st[j]); \
        if (lane == 63) { _Pragma("unroll") for (int j = 0; j < 16; ++j) red[wave * 16 + j] = st[j]; } \
        __syncthreads(); \
        if (tid < 16) { float s = 0.f; _Pragma("unroll") for (int wv = 0; wv < 8; ++wv) s += red[wv * 16 + tid]; tot[tid] = s; } \
        __syncthreads(); \
        float q[8]; \
        _Pragma("unroll") for (int j = 0; j < 8; ++j) { const float mu = tot[j] * (1.0f / DC), var = __builtin_fmaxf(tot[8 + j] * (1.0f / DC) - mu * mu, 0.0f), rs = __builtin_amdgcn_rsqf(var + 1e-6f); \
            f32x2 y = (acc[j] - mu) * rs * lg + lb; y.x = y.x * fsigm(y.x); y.y = y.y * fsigm(y.y); acc[j] = y; q[j] = y.x * y.x + y.y * y.y; } \
        _Pragma("unroll") for (int j = 0; j < 8; ++j) q[j] = wave_sum63(q[j]); \
        if (lane == 63) { _Pragma("unroll") for (int j = 0; j < 8; ++j) red[128 + wave * 16 + j] = q[j]; } \
        __syncthreads(); \
        if (tid < 8) { float s = 0.f; _Pragma("unroll") for (int wv = 0; wv < 8; ++wv) s += red[128 + wv * 16 + tid]; tot[16 + tid] = s; } \
        __syncthreads(); \
        _Pragma("unroll") for (int j = 0; j < 8; ++j) { const float r2 = __builtin_amdgcn_rsqf(tot[16 + j] * (1.0f / DC) + 1e-6f); \
            *(GAS unsigned*)(a.MIX + (size_t)((orow) + j) * D + DC + c0) = cvtpk(acc[j].x * r2, acc[j].y * r2); } } while (0)

__device__ __forceinline__ void p2_conv(const P2Args& a, LAS unsigned char* lds, int idx, int cnt, int ibeg, int iend, int wave, int lane, int tid) {
    LAS float* red = (LAS float*)(lds + P2_RED_OFF);
    LAS float* tot = red + 256;
    const int c0 = 2 * tid;
    f32x2 w[KW];
#pragma unroll
    for (int k = 0; k < KW; ++k) w[k] = *(const GAS f32x2*)(a.conv_w + k * DC + c0);
    const f32x2 bias = *(const GAS f32x2*)(a.conv_b + c0), lg = *(const GAS f32x2*)(a.ln_g + c0), lb = *(const GAS f32x2*)(a.ln_b + c0);
    unsigned rows[8 + KW - 1], rowsN[8 + KW - 1];
    if (ibeg + idx < iend) CONV_LOAD_ROWS(rows, ibeg + idx);
    for (int it = ibeg + idx; it < iend; it += cnt) {
        const int itn = it + cnt;
        if (itn < iend) CONV_LOAD_ROWS(rowsN, itn);
        const int orow = it < 1024 ? (it >> 8) * SEQ + (it & 255) * 8 : MP + (it - 1024) * DSQ;
        CONV_COMPUTE(rows, orow);
#pragma unroll
        for (int r = 0; r < 8 + KW - 1; ++r) rows[r] = rowsN[r];
    }
    __syncthreads();
}
__device__ __forceinline__ void p2_conv_runs(const P2Args& a, LAS unsigned char* lds, int ci, int wave, int lane, int tid) {
    LAS float* red = (LAS float*)(lds + P2_RED_OFF);
    LAS float* tot = red + 256;
    const int c0 = 2 * tid;
    f32x2 w[KW];
#pragma unroll
    for (int k = 0; k < KW; ++k) w[k] = *(const GAS f32x2*)(a.conv_w + k * DC + c0);
    const f32x2 bias = *(const GAS f32x2*)(a.conv_b + c0), lg = *(const GAS f32x2*)(a.ln_g + c0), lb = *(const GAS f32x2*)(a.ln_b + c0);
    const int b = ci / 28, k28 = ci - b * 28, len = k28 < 4 ? 10 : 9, start = b * 256 + (k28 < 4 ? k28 * 10 : 40 + (k28 - 4) * 9);
    unsigned rows[8 + KW - 1], rowsS[8 + KW - 1], pfA[8], pfB[8];
    CONV_LOAD_ROWS(rows, start);
    { const int its = 1024 + ci; CONV_LOAD_ROWS(rowsS, its); }
    const bf16* ub = a.UC + (size_t)(b * SEQ) * DC + c0;
    const int t0s = (start & 255) * 8;
#pragma unroll
    for (int i = 0; i < 8; ++i) { pfA[i] = *(const GAS unsigned*)(ub + (size_t)(t0s + 8 + i) * DC); pfB[i] = *(const GAS unsigned*)(ub + (size_t)(t0s + 16 + i) * DC); }
    for (int n = 0; n < len; ++n) {
        const int t0 = t0s + 8 * n;
        unsigned pfC[8];
        { const int tn = t0 + 24; const int tc = tn + 7 < SEQ ? tn : SEQ - 8;
#pragma unroll
          for (int i = 0; i < 8; ++i) pfC[i] = *(const GAS unsigned*)(ub + (size_t)(tc + i) * DC); }
        CONV_COMPUTE(rows, b * SEQ + t0);
#pragma unroll
        for (int r = 0; r < KW - 1; ++r) rows[r] = rows[r + 8];
#pragma unroll
        for (int i = 0; i < 8; ++i) { rows[KW - 1 + i] = pfA[i]; pfA[i] = pfB[i]; pfB[i] = pfC[i]; }
    }
    CONV_COMPUTE(rowsS, MP + ci * DSQ);
    if (ci >= 4 && ci < 20) { const int its = 1024 + 112 + (ci - 4); CONV_LOAD_ROWS(rowsS, its); CONV_COMPUTE(rowsS, MP + (112 + ci - 4) * DSQ); }
    __syncthreads();
}

__device__ __forceinline__ void p2_newconv(const P2Args& a, int vcu, int G, int tid) {
    constexpr int NPV = BATCH * (KW - 1) * (DC / 4), NSV = DB * (KW - 1) * (DC / 4);
    for (int idx = vcu * (NWAVES * 64) + tid; idx < NPV + NSV; idx += G * NWAVES * 64) {
        if (idx < NPV) { const int c4 = idx & 255, j = (idx >> 8) % (KW - 1), b = idx / ((KW - 1) * 256);
            const v2u pk = *(const GAS v2u*)(a.UC + (size_t)(b * SEQ + SEQ - (KW - 1) + j) * DC + 4 * c4);
            const f32x4 v = {bf_lo(pk.x), bf_hi(pk.x), bf_lo(pk.y), bf_hi(pk.y)};
            *(GAS f32x4*)(a.ncp + (size_t)idx * 4) = v; }
        else { const int k = idx - NPV; const int c4 = k & 255, j = (k >> 8) % (KW - 1), b = k / ((KW - 1) * 256); const int id = j + DSQ; f32x4 v;
            if (id < KW - 1) v = *(const GAS f32x4*)(a.state_conv + ((size_t)b * (KW - 1) + id) * DC + 4 * c4);
            else { const v2u pk = *(const GAS v2u*)(a.UC + (size_t)(MP + b * DSQ + id - (KW - 1)) * DC + 4 * c4); v = (f32x4){bf_lo(pk.x), bf_hi(pk.x), bf_lo(pk.y), bf_hi(pk.y)}; }
            *(GAS f32x4*)(a.ncs + (size_t)k * 4) = v; }
    }
}

#define SSM_STEP(i) do { \
        const float nAr = __builtin_fmaf(aAr, hAr, __builtin_fmaf(-aAi, hAi, d00[i])), nAi = __builtin_fmaf(aAr, hAi, __builtin_fmaf(aAi, hAr, d01[i])); \
        const float nBr = __builtin_fmaf(aBr, hBr, __builtin_fmaf(-aBi, hBi, d10[i])), nBi = __builtin_fmaf(aBr, hBi, __builtin_fmaf(aBi, hBr, d11[i])); \
        hAr = nAr; hAi = nAi; hBr = nBr; hBi = nBi; } while (0)
#define SSM_MFMA(afrag) do { const f32x16 z16 = {0.f,0.f,0.f,0.f,0.f,0.f,0.f,0.f,0.f,0.f,0.f,0.f,0.f,0.f,0.f,0.f}; \
        d00 = __builtin_amdgcn_mfma_f32_32x32x16_bf16(afrag, bfr[0][0], z16, 0, 0, 0); d01 = __builtin_amdgcn_mfma_f32_32x32x16_bf16(afrag, bfr[0][1], z16, 0, 0, 0); \
        d10 = __builtin_amdgcn_mfma_f32_32x32x16_bf16(afrag, bfr[1][0], z16, 0, 0, 0); d11 = __builtin_amdgcn_mfma_f32_32x32x16_bf16(afrag, bfr[1][1], z16, 0, 0, 0); } while (0)
#define SSM_PUT_U(afrag) do { *(LAS bf16x8*)(utile + (s_r * 16 + i_r) * 32 + kc * 16) = afrag; } while (0)
#define SSM_EMIT(rowb0, rowb1) do { \
        LDS_WAIT(); __builtin_amdgcn_wave_barrier(); \
        _Pragma("unroll") for (int s_ = 0; s_ < 2; ++s_) { \
            f32x4 y_ = {0.f, 0.f, 0.f, 0.f}; \
            _Pragma("unroll") for (int ks = 0; ks < 4; ++ks) { const bf16x8 hf = *(const LAS bf16x8*)(tile + s_ * P2_TILE_B + (lane & 15) * P2_TROW + ks * 64 + (lane >> 4) * 16); \
                y_ = __builtin_amdgcn_mfma_f32_16x16x32_bf16(hf, cfr[ks], y_, 0, 0, 0); } \
            const int rb_ = s_ ? (rowb1) : (rowb0); float v_[4]; \
            _Pragma("unroll") for (int i_ = 0; i_ < 4; ++i_) { const unsigned short ub_ = *(const LAS unsigned short*)(utile + (s_ * 16 + 4 * (lane >> 4) + i_) * 32 + (lane & 15) * 2); \
                v_[i_] = gelu_tanh_f(y_[i_] + dsk * __builtin_bit_cast(float, (unsigned)ub_ << 16)); } \
            const unsigned w01_ = cvtpk(v_[0], v_[1]), w23_ = cvtpk(v_[2], v_[3]); \
            bf16* go_ = a.G + (size_t)(rb_ + 4 * (lane >> 4)) * DS + g * CH + (lane & 15); \
            go_[0] = (bf16)w01_; go_[DS] = (bf16)(w01_ >> 16); go_[2 * DS] = (bf16)w23_; go_[3 * DS] = (bf16)(w23_ >> 16); } \
        LDS_WAIT(); __builtin_amdgcn_wave_barrier(); } while (0)
#define SSM_TILE_ROW(i) do { v2u hw_; hw_.x = cvtpk(hAr, hAi); hw_.y = cvtpk(hBr, hBi); *(LAS v2u*)(mytile + (i) * P2_TROW) = hw_; } while (0)

__device__ __forceinline__ void p2_ssm(const P2Args& a, LAS unsigned char* lds, int vcu, int G, int wave, int lane, int tid) {
    const int col = lane & 31, half = lane >> 5;
    const int r = lane & 31, s_r = (r >> 2) & 1, i_r = (r & 3) + 4 * (r >> 3), kc = lane >> 5;
    LAS unsigned char* tile = lds + P2_TILE_OFF + wave * 2 * P2_TILE_B;
    LAS unsigned char* mytile = tile + half * P2_TILE_B + col * 8;
    LAS unsigned char* utile = lds + P2_UT_OFF + wave * 1024;
    LAS f32x4* SX = (LAS f32x4*)(lds + P2_SX_OFF);
    for (int it = vcu; it < BATCH * NG; it += G) {
        const int g = it & (NG - 1), pb = it >> 6;
        const float* AB = (const float*)(a.tab + TAB_AB) + (size_t)(g * NP + 2 * col) * 2;
        const f32x4 ab4 = *(const GAS f32x4*)AB;
        const float aAr = ab4.x, aAi = ab4.y, aBr = ab4.z, aBi = ab4.w;
        bf16x8 bfr[2][2], cfr[4];
#pragma unroll
        for (int pair = 0; pair < 2; ++pair)
#pragma unroll
            for (int ri = 0; ri < 2; ++ri) bfr[pair][ri] = *(const GAS bf16x8*)((const bf16*)(a.tab + TAB_BBT) + ((size_t)(g * 2 + ri) * NP + 2 * col + pair) * CH + 8 * kc);
#pragma unroll
        for (int ks = 0; ks < 4; ++ks) cfr[ks] = *(const GAS bf16x8*)((const bf16*)(a.tab + TAB_CQ) + ((size_t)g * CH + (lane & 15)) * 128 + 32 * ks + 8 * (lane >> 4));
        const float dsk = a.Dk[g * CH + (lane & 15)];
        f32x16 d00, d01, d10, d11;
        {
            const bf16* abase = a.SI + (size_t)(pb * SEQ + (2 * wave + s_r) * 128 + i_r) * DS + g * CH + 8 * kc;
            float hAr = 0.f, hAi = 0.f, hBr = 0.f, hBi = 0.f;
            bf16x8 a0 = *(const GAS bf16x8*)abase, a1 = *(const GAS bf16x8*)(abase + (size_t)1 * 16 * DS), a2 = *(const GAS bf16x8*)(abase + (size_t)2 * 16 * DS), a3 = *(const GAS bf16x8*)(abase + (size_t)3 * 16 * DS);
#pragma unroll 1
            for (int blk = 0; blk < 8; ++blk) {
                const bf16x8 an = *(const GAS bf16x8*)(abase + (size_t)((blk + 4) & 7) * 16 * DS);
                SSM_MFMA(a0);
#pragma unroll
                for (int i = 0; i < 16; ++i) SSM_STEP(i);
                a0 = a1; a1 = a2; a2 = a3; a3 = an;
            }
            __syncthreads();
            SX[(2 * wave + half) * 32 + col] = (f32x4){hAr, hAi, hBr, hBi};
            __syncthreads();
            float pAr = aAr, pAi = aAi, pBr = aBr, pBi = aBi;
#pragma unroll
            for (int sq = 0; sq < 7; ++sq) { const float t0 = pAr * pAr - pAi * pAi, t1 = 2.0f * pAr * pAi, t2 = pBr * pBr - pBi * pBi, t3 = 2.0f * pBr * pBi; pAr = t0; pAi = t1; pBr = t2; pBi = t3; }
            hAr = 0.f; hAi = 0.f; hBr = 0.f; hBi = 0.f;
            const int mine = 2 * wave + half;
            for (int s2 = 0; s2 < mine; ++s2) { const f32x4 sv = SX[s2 * 32 + col];
                const float nAr = pAr * hAr - pAi * hAi + sv.x, nAi = pAr * hAi + pAi * hAr + sv.y, nBr = pBr * hBr - pBi * hBi + sv.z, nBi = pBr * hBi + pBi * hBr + sv.w;
                hAr = nAr; hAi = nAi; hBr = nBr; hBi = nBi; }
#pragma unroll 1
            for (int blk = 0; blk < 8; ++blk) {
                const bf16x8 an = *(const GAS bf16x8*)(abase + (size_t)((blk + 4) & 7) * 16 * DS);
                SSM_MFMA(a0);
                SSM_PUT_U(a0);
#pragma unroll
                for (int i = 0; i < 16; ++i) { SSM_STEP(i); SSM_TILE_ROW(i); }
                const int rb = pb * SEQ + (2 * wave) * 128 + blk * 16;
                SSM_EMIT(rb, rb + 128);
                a0 = a1; a1 = a2; a2 = a3; a3 = an;
            }
            if (mine == 15) { const size_t o = ((size_t)pb * NG + g) * NP + 2 * col;
                *(GAS f32x2*)(a.nrp + o) = (f32x2){hAr, hBr}; *(GAS f32x2*)(a.nip + o) = (f32x2){hAi, hBi}; }
        }
        {
            const int bA_load = 32 * pb + 4 * wave + 2 * s_r, bA = 32 * pb + 4 * wave + 2 * half;
            const bf16x8 afS = *(const GAS bf16x8*)(a.SI + (size_t)(MP + bA_load * DSQ + i_r) * DS + g * CH + 8 * kc);
            size_t o = ((size_t)bA * NG + g) * NP + 2 * col;
            f32x2 t0 = *(const GAS f32x2*)(a.h0re + o), t1 = *(const GAS f32x2*)(a.h0im + o);
            SSM_MFMA(afS);
            SSM_PUT_U(afS);
            float hAr = t0.x, hBr = t0.y, hAi = t1.x, hBi = t1.y;
#pragma unroll
            for (int i = 0; i < 8; ++i) { SSM_STEP(i); SSM_TILE_ROW(i); }
            *(GAS f32x2*)(a.nrs + o) = (f32x2){hAr, hBr}; *(GAS f32x2*)(a.nis + o) = (f32x2){hAi, hBi};
            o += (size_t)NG * NP;
            t0 = *(const GAS f32x2*)(a.h0re + o); t1 = *(const GAS f32x2*)(a.h0im + o);
            hAr = t0.x; hBr = t0.y; hAi = t1.x; hBi = t1.y;
#pragma unroll
            for (int i = 8; i < 16; ++i) { SSM_STEP(i); SSM_TILE_ROW(i); }
            *(GAS f32x2*)(a.nrs + o) = (f32x2){hAr, hBr}; *(GAS f32x2*)(a.nis + o) = (f32x2){hAi, hBi};
            const int rb = MP + (32 * pb + 4 * wave) * DSQ;
            SSM_EMIT(rb, rb + 16);
        }
    }
    __syncthreads();
}

#ifndef NP_P1
#define NP_P1 0
#endif
#ifndef NP_P3
#define NP_P3 0
#endif
#ifndef NP_P5
#define NP_P5 16
#endif
#ifndef NP_P6
#define NP_P6 32
#endif
#ifndef NP_P7
#define NP_P7 16
#endif
struct Args { const float* in[28]; float* out; unsigned char* ws; int lo, hi, dryk, li; };
__global__ void __launch_bounds__(NWAVES * 64, 2) mk_fwd(Args args) {
    __shared__ __attribute__((aligned(16))) unsigned char lds_raw[LDS_BYTES];
    LAS unsigned char* lds = (LAS unsigned char*)lds_raw;
    volatile LAS unsigned* MISC = (volatile LAS unsigned*)(lds + MISC_OFF);
    const int tid = threadIdx.x, lane = tid & 63, wave = __builtin_amdgcn_readfirstlane(tid >> 6);
    const int G = gridDim.x; const int bx = blockIdx.x; const int vcu = (G % 8 == 0) ? (bx % 8) * (G / 8) + bx / 8 : bx;
    unsigned char* ws = args.ws;
    gu32* ctl = (gu32*)(ws + WS_CTL);
    for (int u = tid; u < (LDS_BYTES - LDSCTL_OFF) / 4; u += NWAVES * 64) ((LAS unsigned*)(lds + LDSCTL_OFF))[u] = 0u;
    __syncthreads();
    XcdBarrier bar; bar.bar = (unsigned*)(ctl + CW_BAR) + args.li * XCD_BAR_WORDS; bar.x = 0; bar.st = nullptr;
    if (N_LAUNCHES != NPH) bar = xcd_barrier_post((unsigned*)(ctl + CW_BAR) + args.li * XCD_BAR_WORDS, MISC + 8);
#ifndef STAMP_BX
#define STAMP_BX 0
#endif
#ifdef STAMP_A
#define STAMP(i) do { if (blockIdx.x == STAMP_BX && tid == 0) { const unsigned long long t_ = __builtin_amdgcn_s_memrealtime(); MISC[12 + 2 * (i)] = (unsigned)t_; MISC[13 + 2 * (i)] = (unsigned)(t_ >> 32); } } while (0)
#else
#define STAMP(i) do { } while (0)
#endif
    STAMP(0);
#define GRID_BAR(seam) do { GRID_BAR_(seam); STAMP((seam) + 1); } while (0)
#define GRID_BAR_(seam) do { if (N_LAUNCHES == NPH) { if (tid == 0) __hip_atomic_store(ctl + CW_TMO, 0xBADBA0u | (unsigned)(seam), RLX_AGENT); } else { xcd_barrier(bar); } } while (0)
    const int lo = args.lo, hi = args.hi, dryk = args.dryk;
#define DRY(k) (dryk == (k))
#ifndef ONLY_PHASE
#define ONLY_PHASE -1
#endif
#define IN(k) (ONLY_PHASE < 0 ? (lo <= (k) && (k) < hi) : (k) == ONLY_PHASE)
#define BOTH(k) (IN(k) && IN((k) + 1))
    float* out = args.out;
    float* Y = out;
    float* ncp = out + (size_t)M * D;
    float* nrp = ncp + (size_t)BATCH * (KW - 1) * DC;
    float* nip = nrp + (size_t)BATCH * NG * NP;
    float* ncs = nip + (size_t)BATCH * NG * NP;
    float* nrs = ncs + (size_t)DB * (KW - 1) * DC;
    float* nis = nrs + (size_t)DB * NG * NP;
    bf16 *WGU = (bf16*)(ws + WS_WGU), *WDN = (bf16*)(ws + WS_WDN), *XB = (bf16*)(ws + WS_XB), *WIN = (bf16*)(ws + WS_WIN), *WGL = (bf16*)(ws + WS_WGL), *WOUT = (bf16*)(ws + WS_WOUT);
    bf16 *UC = (bf16*)(ws + WS_U), *SI = (bf16*)(ws + WS_S), *GB = (bf16*)(ws + WS_G), *MIX = (bf16*)(ws + WS_MIX), *ACT = (bf16*)(ws + WS_ACT);
    float* ssq_dummy = (float*)(ws + WS_CTL) + CW_DUMMY;
    float* ssq_s = (float*)(ws + WS_CTL) + CW_SSQ_S; float* ssq_h = (float*)(ws + WS_CTL) + CW_SSQ_H; float* ssq_o = (float*)(ws + WS_CTL) + CW_SSQ_O; float* rx = (float*)(ws + WS_CTL) + CW_RX;
    const int gw = vcu * NWAVES + wave, NGW = G * NWAVES;

    if (IN(0)) {
        P0Args a; a.xp = args.in[0]; a.xs = args.in[1]; a.norm_mix = args.in[5]; a.w_in = args.in[6]; a.w_glu = args.in[19]; a.gn_conv = args.in[20]; a.gn_ssm = args.in[21]; a.w_out = args.in[22];
        a.norm_ffn = args.in[23]; a.w_gate = args.in[24]; a.w_up = args.in[25]; a.w_down = args.in[26];
        a.A_re = args.in[11]; a.A_im = args.in[12]; a.log_dt = args.in[13]; a.B_re = args.in[14]; a.B_im = args.in[15]; a.C_re = args.in[16]; a.C_im = args.in[17];
        a.WIN = WIN; a.WGL = WGL; a.WOUT = WOUT; a.WGU = WGU; a.WDN = WDN; a.XB = XB; a.rx = rx; a.tab = ws + WS_TAB;
        STAMP(13);
        p0_prologue(a, lds, vcu, G, wave, lane, tid); STAMP(14);
        if (BOTH(0)) GRID_BAR(0);
    }
    if (IN(1)) {
        pg8::Gemm g{XB, WIN, M, DIN, D};
#define SCHED(slot, slabo, N_, K_, NP_, RS_, MID_) typedef pg8::HybridOrder<N_, K_, NP_, RS_, MID_> Sch; Sch S; S.init((int)blockIdx.x, ws + (slabo), (unsigned*)(ctl + CW_FLAGS + (slot) * FLAG_SLOT), (unsigned*)(ctl + CW_TMO))
        SCHED(0, SLAB_P1, DIN, D, NP_P1, 0, 0);
        pg8::EpiIn E{UC, SI, rx};
        pg8::gemm_phase<pg8::EpiIn, Sch, true, true>(lds + RING_OFF, g, S, E);
        {
            static_assert(Sch::R == 2 && Sch::np == 1, "P1 runs two static rounds");
            constexpr int BUSY = Sch::q - Sch::per, IDLE = Sch::per - BUSY;
            const int jx = (int)blockIdx.x >> 3, xx = (int)blockIdx.x & 7;
            P0Args a; a.xp = args.in[0]; a.xs = args.in[1]; a.norm_mix = args.in[5]; a.w_in = args.in[6]; a.w_glu = args.in[19]; a.gn_conv = args.in[20]; a.gn_ssm = args.in[21]; a.w_out = args.in[22];
            a.norm_ffn = args.in[23]; a.w_gate = args.in[24]; a.w_up = args.in[25]; a.w_down = args.in[26];
            a.A_re = args.in[11]; a.A_im = args.in[12]; a.log_dt = args.in[13]; a.B_re = args.in[14]; a.B_im = args.in[15]; a.C_re = args.in[16]; a.C_im = args.in[17];
            a.WIN = WIN; a.WGL = WGL; a.WOUT = WOUT; a.WGU = WGU; a.WDN = WDN; a.XB = XB; a.rx = rx; a.tab = ws + WS_TAB;
            if (G != 256) p0_convert(a, lds, vcu * NWAVES + wave, G * NWAVES, P0_ITEMS_B, P0_ITEMS_ALL, wave, lane);
            if (G != 256) p0_tables(a, vcu * (NWAVES * 64) + tid); else if (jx >= BUSY) p0_tables(a, (xx * IDLE + (jx - BUSY)) * (NWAVES * 64) + tid);
            if (G == 256 && jx >= BUSY) p0_convert(a, lds, (xx * IDLE + (jx - BUSY)) * NWAVES + wave, 8 * IDLE * NWAVES, P0_ITEMS_B, P0_ITEMS_ALL, wave, lane);
        }
        if (BOTH(1)) GRID_BAR(1);
    }
    if (IN(2)) {
        P2Args a; a.UC = UC; a.SI = SI; a.G = GB; a.MIX = MIX; a.state_conv = args.in[2]; a.h0re = args.in[3]; a.h0im = args.in[4];
        a.conv_w = args.in[7]; a.conv_b = args.in[8]; a.ln_g = args.in[9]; a.ln_b = args.in[10]; a.Dk = args.in[18]; a.tab = ws + WS_TAB;
        a.ncp = ncp; a.nrp = nrp; a.nip = nip; a.ncs = ncs; a.nrs = nrs; a.nis = nis;
        p2_ssm(a, lds, vcu, G, wave, lane, tid); STAMP(10);
        if (BOTH(2)) GRID_BAR(2);
    }
    if (IN(3)) {
        constexpr int P3_OWNERS = (M / 256) * (DS / 256) / 8;
        const int jx = (int)blockIdx.x >> 3, xx = (int)blockIdx.x & 7;
        P2Args a; a.UC = UC; a.SI = SI; a.G = GB; a.MIX = MIX; a.state_conv = args.in[2]; a.h0re = args.in[3]; a.h0im = args.in[4];
        a.conv_w = args.in[7]; a.conv_b = args.in[8]; a.ln_g = args.in[9]; a.ln_b = args.in[10]; a.Dk = args.in[18]; a.tab = ws + WS_TAB;
        a.ncp = ncp; a.nrp = nrp; a.nip = nip; a.ncs = ncs; a.nrs = nrs; a.nis = nis;
        constexpr int NCW = 8 * (32 - P3_OWNERS), CONV_A = 1024 + DB;
        if (G != 256) { p2_conv(a, lds, vcu, G, 0, 1024 + DB, wave, lane, tid); p2_newconv(a, vcu, G, tid);
            { P0Args pa; pa.xp = args.in[0]; pa.xs = args.in[1]; pa.norm_mix = args.in[5]; pa.w_in = args.in[6]; pa.w_glu = args.in[19]; pa.gn_conv = args.in[20]; pa.gn_ssm = args.in[21]; pa.w_out = args.in[22];
              pa.norm_ffn = args.in[23]; pa.w_gate = args.in[24]; pa.w_up = args.in[25]; pa.w_down = args.in[26];
              pa.A_re = args.in[11]; pa.A_im = args.in[12]; pa.log_dt = args.in[13]; pa.B_re = args.in[14]; pa.B_im = args.in[15]; pa.C_re = args.in[16]; pa.C_im = args.in[17];
              pa.WIN = WIN; pa.WGL = WGL; pa.WOUT = WOUT; pa.WGU = WGU; pa.WDN = WDN; pa.XB = XB; pa.rx = rx; pa.tab = ws + WS_TAB;
              __syncthreads(); p0_convert(pa, lds, vcu * NWAVES + wave, G * NWAVES, P0_ITEMS_A, P0_ITEMS_B, wave, lane); __syncthreads(); }
            pg8::Gemm g{GB, WGL, M, DS, DS}; SCHED(1, SLAB_P3, DS, DS, NP_P3, 0, 0); pg8::EpiGlu E{GB, MIX, DRY(3) ? ssq_dummy : ssq_s};
            pg8::gemm_phase<pg8::EpiGlu, Sch, true, true>(lds + RING_OFF, g, S, E); }
        else if (jx < P3_OWNERS) {
            pg8::Gemm g{GB, WGL, M, DS, DS}; SCHED(1, SLAB_P3, DS, DS, NP_P3, 0, 0);
            pg8::EpiGlu E{GB, MIX, DRY(3) ? ssq_dummy : ssq_s};
            pg8::gemm_phase<pg8::EpiGlu, Sch, true, true>(lds + RING_OFF, g, S, E);
            __syncthreads();
            { P0Args pa; pa.xp = args.in[0]; pa.xs = args.in[1]; pa.norm_mix = args.in[5]; pa.w_in = args.in[6]; pa.w_glu = args.in[19]; pa.gn_conv = args.in[20]; pa.gn_ssm = args.in[21]; pa.w_out = args.in[22];
              pa.norm_ffn = args.in[23]; pa.w_gate = args.in[24]; pa.w_up = args.in[25]; pa.w_down = args.in[26];
              pa.A_re = args.in[11]; pa.A_im = args.in[12]; pa.log_dt = args.in[13]; pa.B_re = args.in[14]; pa.B_im = args.in[15]; pa.C_re = args.in[16]; pa.C_im = args.in[17];
              pa.WIN = WIN; pa.WGL = WGL; pa.WOUT = WOUT; pa.WGU = WGU; pa.WDN = WDN; pa.XB = XB; pa.rx = rx; pa.tab = ws + WS_TAB;
              p0_convert(pa, lds, (xx * P3_OWNERS + jx) * NWAVES + wave, 8 * P3_OWNERS * NWAVES, P0_ITEMS_A, P0_ITEMS_B, wave, lane); }
        } else {
            const int ci = xx * (32 - P3_OWNERS) + (jx - P3_OWNERS);
            static_assert(NCW == 112, "p2_conv_runs: 28 workgroups per prompt batch");
            p2_conv_runs(a, lds, ci, wave, lane, tid); STAMP(11);
            p2_newconv(a, ci, NCW, tid); STAMP(12);
        }
        if (BOTH(3)) GRID_BAR(3);
    }
    if (IN(5)) {
        pg8::Gemm g{MIX, WOUT, M, D, D}; SCHED(2, SLAB_P5, D, D, NP_P5, 8, 16);
        pg8::EpiOut E{XB, DRY(5) ? ssq_dummy : ssq_h, ssq_s};
        static_assert(Sch::S == 8 && Sch::ntp == 16, "remainder segments of 2 K-tile pairs never straddle K-tile 16");
        pg8::gemm_phase<pg8::EpiOut, Sch, true, true>(lds + RING_OFF, g, S, E);
        if (BOTH(5)) GRID_BAR(5);
    }
    if (IN(6)) {
        pg8::Gemm g{XB, WGU, M, 2 * DFF, D}; SCHED(3, SLAB_P6, 2 * DFF, D, NP_P6, 5, 0);
        pg8::EpiUp E{ACT, ssq_h};
        pg8::gemm_phase<pg8::EpiUp, Sch, true, true>(lds + RING_OFF, g, S, E);
        if (BOTH(6)) GRID_BAR(6);
    }
    if (IN(7)) {
        pg8::Gemm g{ACT, WDN, M, D, DFF}; SCHED(4, SLAB_P7, D, DFF, NP_P7, 8, 0);
        pg8::EpiDown E{XB, DRY(7) ? ssq_dummy : ssq_o, DRY(7) ? 0.0f : 1.0f};
        pg8::gemm_phase<pg8::EpiDown, Sch, true, true>(lds + RING_OFF, g, S, E);
        if (BOTH(7)) GRID_BAR(7);
    }
    if (IN(8)) {
        const float* gfin = args.in[27];
        for (int row = gw; row < M; row += NGW) {
            const float r = 1.0f / sqrtf(__hip_atomic_load(ssq_o + row, RLX_AGENT) * (1.0f / D) + 1e-6f);
            const GAS v4u* ob = (const GAS v4u*)(XB + (size_t)row * D) + lane; GAS f32x4* p = (GAS f32x4*)(Y + (size_t)row * D) + 2 * lane; const GAS f32x4* gp = (const GAS f32x4*)gfin + 2 * lane;
#pragma unroll
            for (int j = 0; j < 4; ++j) { const v4u w = ob[64 * j];
                p[128 * j] = (f32x4){bf_lo(w.x), bf_hi(w.x), bf_lo(w.y), bf_hi(w.y)} * r * gp[128 * j];
                p[128 * j + 1] = (f32x4){bf_lo(w.z), bf_hi(w.z), bf_lo(w.w), bf_hi(w.w)} * r * gp[128 * j + 1]; }
        }
    }
#ifdef STAMP_A
    STAMP(9);
    if (blockIdx.x == STAMP_BX && tid == 0) {
        const unsigned long long ta = ((unsigned long long)MISC[13 + 2 * STAMP_A] << 32) | MISC[12 + 2 * STAMP_A], tb = ((unsigned long long)MISC[13 + 2 * STAMP_B] << 32) | MISC[12 + 2 * STAMP_B];
        const unsigned long long d = tb - ta, t0 = __builtin_amdgcn_s_memrealtime();
        while (__builtin_amdgcn_s_memrealtime() - t0 < d) __builtin_amdgcn_s_sleep(8);
    }
#endif
#undef DRY
#undef IN
#undef BOTH
#undef GRID_BAR
#undef GRID_BAR_
#undef STAMP
}

extern "C" void kernel_launch(void* const* d_in, const int* in_sizes, int n_in, void* d_out, int out_size, void* d_ws, size_t ws_size, hipStream_t stream) {
    static int grid = 0;
    if (grid == 0) {
        const long want_out = (long)M * D + (long)(BATCH + DB) * ((KW - 1) * DC + 2 * NG * NP);
        if (n_in != 28 || in_sizes[0] != MP * D || (long)out_size != want_out || ws_size < WS_END) {
            fprintf(stderr, "kernel_launch: unexpected shapes (n_in %d, in0 %d, out %d (want %ld), ws %zu (need %zu)); nothing launched\n", n_in, n_in > 0 ? in_sizes[0] : -1, out_size, want_out, ws_size, (size_t)WS_END); grid = -1; return; }
        int dev = 0, cus = 0;
        if (hipGetDevice(&dev) != hipSuccess || hipDeviceGetAttribute(&cus, hipDeviceAttributeMultiprocessorCount, dev) != hipSuccess) { fprintf(stderr, "kernel_launch: device query failed\n"); grid = -1; return; }
        if (cus != 256) fprintf(stderr, "kernel_launch: built for 256 CUs, device has %d\n", cus);
        grid = 256;
    }
    if (grid < 0) return;
    if (hipMemsetAsync((char*)d_ws + WS_CTL, 0, CTL_ZERO_BYTES, stream) != hipSuccess) { fprintf(stderr, "kernel_launch: memset failed\n"); return; }
    Args a{};
    for (int i = 0; i < 28; ++i) a.in[i] = (const float*)d_in[i];
    a.out = (float*)d_out; a.ws = (unsigned char*)d_ws;
#ifdef PROBE_PHASE
    constexpr int NL = 2;
#else
    constexpr int NL = N_LAUNCHES;
#endif
    for (int li = 0; li < NL; ++li) {
        a.dryk = -1;
        if (N_LAUNCHES == NPH) { a.lo = li; a.hi = li + 1; } else { a.lo = 0; a.hi = NPH; }
#ifdef PROBE_PHASE
        if (li == 0) { a.lo = 0; a.hi = PROBE_PHASE + 1; } else { a.lo = PROBE_PHASE; a.hi = NPH; a.dryk = PROBE_PHASE; }
#endif
        a.li = li;
        hipLaunchKernelGGL(mk_fwd, dim3(grid), dim3(NWAVES * 64), 0, stream, a);
        const hipError_t le = hipPeekAtLastError();
        if (le != hipSuccess) { fprintf(stderr, "kernel_launch: launch %d failed: %s\n", li, hipGetErrorName(le)); break; }
    }
}
```

```cpp
#include <hip/hip_runtime.h>
#include <cstdio>
#include <cstdint>
#define MK_N_LAUNCHES 1
namespace pg8 {
#define PG8_LAS __attribute__((address_space(3)))
typedef unsigned short bf16_t;
typedef short bf16x8 __attribute__((ext_vector_type(8)));
typedef float f32x4 __attribute__((ext_vector_type(4)));
typedef unsigned u32x4 __attribute__((ext_vector_type(4)));
constexpr int BM = 256, BK = 64, HALF = 128, HTB = HALF * BK * 2  , STAGE_BYTES = 8 * HTB, NXCD = 8, WGM = 4;

__host__ __device__ __forceinline__ int lds_byte(int r, int c) { const int st = (r >> 4) * 2 + (c >> 5), rr = r & 15, cc = c & 31, ob = rr * 64 + cc * 2; return st * 1024 + (ob ^ (((ob >> 9) & 1) << 5)); }
__host__ __device__ __forceinline__ void stage_rc(int b, int& R, int& C) { const int st = b / 1024, sb = b % 1024, swz = sb ^ (((sb >> 9) & 1) << 5); R = (st >> 1) * 16 + swz / 64; C = (st & 1) * 32 + (swz % 64) / 2; }
__host__ __device__ __forceinline__ int perm32(int rho) { const int n = rho >> 4, i = rho & 15; return 8 * (i >> 2) + 4 * n + (i & 3); }

struct Unit { int pm, pn, k0, nt, mode, need; };
struct Gemm { const bf16_t* A; const bf16_t* Bt; int M, N, K; };

__device__ __forceinline__ unsigned cvt_pk_bf16(float lo, float hi) { unsigned r; asm volatile("v_cvt_pk_bf16_f32 %0, %1, %2" : "=v"(r) : "v"(lo), "v"(hi)); return r; }
template <class Epi, class Sched, bool ALIGN_EPI = false, bool SP2 = false>
__device__ __forceinline__ void gemm_phase(PG8_LAS unsigned char* lds, const Gemm g, Sched& S, const Epi& E) {
    const int tid = threadIdx.x, wid = __builtin_amdgcn_readfirstlane(tid >> 6), lane = tid & 63, wr = wid >> 2, wc = wid & 3, fr = lane & 15, fq = lane >> 4;
    constexpr int K = Sched::KK;
    unsigned voffA[2], voffB[2];
#pragma unroll
    for (int i = 0; i < 2; ++i) { int R, C; stage_rc(tid * 16 + i * 8192, R, C); const int Rb = Epi::PERM ? ((R & ~31) + perm32(R & 31)) : R;
        voffA[i] = (unsigned)(R * K + C) * 2u; voffB[i] = (unsigned)(Rb * K + C) * 2u; }
    const size_t kstep = (size_t)(BK * 2);
    const size_t hstep = (size_t)HALF * K * 2;
    const size_t tstep = 2 * hstep;
    const unsigned ldsw = (unsigned)wid * 1024u;
    const int aoff = lds_byte(wr * 64 + fr, fq * 8), boff = lds_byte(wc * 32 + fr, fq * 8);
#define PG8_SA(b, h) (((b) * 2 + (h)) * HTB)
#define PG8_SB(b, h) ((4 + (b) * 2 + (h)) * HTB)
#define PG8_STAGE(bufoff, gbase, voff) do { _Pragma("unroll") for (int _i = 0; _i < 2; ++_i) \
        __builtin_amdgcn_global_load_lds((const unsigned*)((const char*)(gbase) + (voff)[_i]), (PG8_LAS unsigned*)(lds + (bufoff) + ldsw + _i * 8192), 16, 0, 0); } while (0)
#define PG8_LDA(dst, b, h) do { _Pragma("unroll") for (int m = 0; m < 4; ++m) _Pragma("unroll") for (int k = 0; k < 2; ++k) dst[m][k] = *(const PG8_LAS bf16x8*)(lds + PG8_SA(b, h) + aoff + m * 2048 + k * 1024); } while (0)
#define PG8_LDB(dst, b, h) do { _Pragma("unroll") for (int n = 0; n < 2; ++n) _Pragma("unroll") for (int k = 0; k < 2; ++k) dst[n][k] = *(const PG8_LAS bf16x8*)(lds + PG8_SB(b, h) + boff + n * 2048 + k * 1024); } while (0)
#define PG8_MMA(ai, bj, At, Bt) do { __builtin_amdgcn_s_setprio(1); _Pragma("unroll") for (int m = 0; m < 4; ++m) _Pragma("unroll") for (int n = 0; n < 2; ++n) _Pragma("unroll") for (int k = 0; k < 2; ++k) \
        acc[ai][bj][m][n] = __builtin_amdgcn_mfma_f32_16x16x32_bf16(Bt[n][k], At[m][k], acc[ai][bj][m][n], 0, 0, 0); __builtin_amdgcn_s_setprio(0); } while (0)
#define PG8_WAIT_V(n) asm volatile("s_waitcnt vmcnt(" #n ")" ::: "memory")
#define PG8_WAIT_L(n) asm volatile("s_waitcnt lgkmcnt(" #n ")" ::: "memory")
#define PG8_BAR __builtin_amdgcn_s_barrier()
#define PG8_SCHED __builtin_amdgcn_sched_barrier(0)
    Unit cur, nxt; int ui = 0;
    if (!S.next(0, cur)) return;
    f32x4 acc[2][2][4][2];
#pragma unroll
    for (int a = 0; a < 2; ++a)
#pragma unroll
        for (int b = 0; b < 2; ++b)
#pragma unroll
            for (int m = 0; m < 4; ++m)
#pragma unroll
                for (int n = 0; n < 2; ++n) acc[a][b][m][n] = (f32x4){0.f, 0.f, 0.f, 0.f};
    bf16x8 At[4][2], B0[2][2], B1[2][2];
    const char* cA = (const char*)g.A + (size_t)cur.pm * tstep + (size_t)cur.k0 * kstep; const char* cB = (const char*)g.Bt + (size_t)cur.pn * tstep + (size_t)cur.k0 * kstep;
    S.a_ready(cur);
    if constexpr (SP2) {
        PG8_STAGE(PG8_SB(0, 0), cB, voffB); PG8_STAGE(PG8_SB(0, 1), cB + hstep, voffB); PG8_STAGE(PG8_SA(0, 0), cA, voffA); PG8_STAGE(PG8_SA(0, 1), cA + hstep, voffA);
        if (wr == 1) PG8_BAR;
        PG8_WAIT_V(2); PG8_BAR;
        PG8_STAGE(PG8_SB(1, 0), cB + kstep, voffB); PG8_STAGE(PG8_SA(1, 0), cA + kstep, voffA); PG8_STAGE(PG8_SB(1, 1), cB + hstep + kstep, voffB);
        PG8_WAIT_V(6); PG8_BAR;
    } else {
        PG8_STAGE(PG8_SB(0, 0), cB, voffB); PG8_STAGE(PG8_SA(0, 0), cA, voffA); PG8_STAGE(PG8_SB(0, 1), cB + hstep, voffB); PG8_STAGE(PG8_SA(0, 1), cA + hstep, voffA);
        if (wr == 1) PG8_BAR;
        PG8_WAIT_V(4); PG8_BAR;
        PG8_STAGE(PG8_SB(1, 0), cB + kstep, voffB); PG8_STAGE(PG8_SA(1, 0), cA + kstep, voffA); PG8_STAGE(PG8_SB(1, 1), cB + hstep + kstep, voffB);
        PG8_WAIT_V(6); PG8_BAR;
    }
    for (;;) {
        const bool has_next = S.next(ui + 1, nxt);
        const char* nA = has_next ? (const char*)g.A + (size_t)nxt.pm * tstep + (size_t)nxt.k0 * kstep : cA; const char* nB = has_next ? (const char*)g.Bt + (size_t)nxt.pn * tstep + (size_t)nxt.k0 * kstep : cB;
        const int nt = cur.nt;
        for (int t = 0; t < nt; t += 2) {
            const bool last = (t == nt - 2);
            const char* a1 = cA + (size_t)(t + 1) * kstep;
            const char* a2 = last ? nA : cA + (size_t)(t + 2) * kstep; const char* b2 = last ? nB : cB + (size_t)(t + 2) * kstep;
            const char* a3 = a2 + kstep; const char* b3 = b2 + kstep;
            if (last && has_next) S.a_ready(nxt);
            if constexpr (SP2) {
            PG8_LDB(B0, 0, 0); PG8_LDB(B1, 0, 1); PG8_SCHED; PG8_LDA(At, 0, 0); PG8_STAGE(PG8_SA(1, 1), a1 + hstep, voffA);
            PG8_WAIT_V(8); PG8_WAIT_L(0); PG8_BAR; PG8_MMA(0, 0, At, B0); PG8_MMA(0, 1, At, B1); PG8_BAR; PG8_SCHED;
            PG8_LDA(At, 0, 1); PG8_STAGE(PG8_SB(0, 0), b2, voffB); PG8_STAGE(PG8_SB(0, 1), b2 + hstep, voffB); PG8_STAGE(PG8_SA(0, 0), a2, voffA);
            PG8_WAIT_V(8); PG8_WAIT_L(0); PG8_BAR; PG8_MMA(1, 0, At, B0); PG8_MMA(1, 1, At, B1); PG8_BAR; PG8_SCHED;
            PG8_LDB(B0, 1, 0); PG8_LDB(B1, 1, 1); PG8_SCHED; PG8_LDA(At, 1, 0); PG8_STAGE(PG8_SA(0, 1), a2 + hstep, voffA);
            PG8_WAIT_V(8); PG8_WAIT_L(0); PG8_BAR; PG8_MMA(0, 0, At, B0); PG8_MMA(0, 1, At, B1); PG8_BAR; PG8_SCHED;
            PG8_LDA(At, 1, 1); PG8_STAGE(PG8_SB(1, 0), b3, voffB); PG8_STAGE(PG8_SB(1, 1), b3 + hstep, voffB); PG8_STAGE(PG8_SA(1, 0), a3, voffA);
            PG8_WAIT_V(8); PG8_WAIT_L(0); PG8_BAR; PG8_MMA(1, 0, At, B0); PG8_MMA(1, 1, At, B1); PG8_BAR; PG8_SCHED;
            } else {
            PG8_LDB(B0, 0, 0); PG8_SCHED; PG8_LDA(At, 0, 0); PG8_STAGE(PG8_SA(1, 1), a1 + hstep, voffA);
            PG8_WAIT_L(8); PG8_BAR; PG8_WAIT_L(0); PG8_MMA(0, 0, At, B0); PG8_BAR; PG8_SCHED;
            PG8_LDB(B1, 0, 1); PG8_STAGE(PG8_SB(0, 0), b2, voffB);
            PG8_BAR; PG8_WAIT_L(0); PG8_MMA(0, 1, At, B1); PG8_BAR;
            PG8_LDA(At, 0, 1); PG8_STAGE(PG8_SA(0, 0), a2, voffA);
            PG8_BAR; PG8_WAIT_L(0); PG8_MMA(1, 0, At, B0); PG8_BAR; PG8_SCHED;
            PG8_STAGE(PG8_SB(0, 1), b2 + hstep, voffB);
            PG8_WAIT_V(6); PG8_BAR; PG8_MMA(1, 1, At, B1); PG8_BAR;
            PG8_LDB(B0, 1, 0); PG8_SCHED; PG8_LDA(At, 1, 0); PG8_STAGE(PG8_SA(0, 1), a2 + hstep, voffA);
            PG8_WAIT_L(8); PG8_BAR; PG8_WAIT_L(0); PG8_MMA(0, 0, At, B0); PG8_BAR; PG8_SCHED;
            PG8_LDB(B1, 1, 1); PG8_STAGE(PG8_SB(1, 0), b3, voffB);
            PG8_BAR; PG8_WAIT_L(0); PG8_MMA(0, 1, At, B1); PG8_BAR;
            PG8_LDA(At, 1, 1); PG8_STAGE(PG8_SA(1, 0), a3, voffA);
            PG8_BAR; PG8_WAIT_L(0); PG8_MMA(1, 0, At, B0); PG8_BAR; PG8_SCHED;
            PG8_STAGE(PG8_SB(1, 1), b3 + hstep, voffB);
            PG8_WAIT_V(6); PG8_BAR; PG8_MMA(1, 1, At, B1); PG8_BAR;
            }
        }
        if constexpr (ALIGN_EPI) { if (wr == 0) PG8_BAR; }
        static_assert(ALIGN_EPI && !Epi::AFTER_DRAIN, "the slab exchange needs both halves aligned in the epilogue");
        S.finish(acc, cur, E, tid, wid, wr, wc, fr, fq);
        if (!has_next) break;
        if (cur.mode != 4)
#pragma unroll
        for (int a = 0; a < 2; ++a)
#pragma unroll
            for (int b = 0; b < 2; ++b)
#pragma unroll
                for (int m = 0; m < 4; ++m)
#pragma unroll
                    for (int n = 0; n < 2; ++n) acc[a][b][m][n] = (f32x4){0.f, 0.f, 0.f, 0.f};
        cur = nxt; cA = nA; cB = nB; ++ui;
        if constexpr (ALIGN_EPI) { if (wr == 1) PG8_BAR; }
    }
    PG8_WAIT_V(0);
    if constexpr (!ALIGN_EPI) { if (wr == 0) PG8_BAR; }
    PG8_BAR;
    S.finish_last(acc, cur, E, tid, wid, wr, wc, fr, fq);
#undef PG8_SA
#undef PG8_SB
#undef PG8_STAGE
#undef PG8_LDA
#undef PG8_LDB
#undef PG8_MMA
#undef PG8_WAIT_V
#undef PG8_WAIT_L
#undef PG8_BAR
#undef PG8_SCHED
}
}

namespace pg8 {
constexpr float RMS_EPS = 1e-6f;
__device__ __forceinline__ float fsig(float x) { return __builtin_amdgcn_rcpf(1.0f + __builtin_amdgcn_exp2f(x * -1.4426950408889634f)); }
typedef float f32x2 __attribute__((ext_vector_type(2)));
__device__ __forceinline__ f32x2 sig_arg2(f32x2 e) { e.x = __builtin_amdgcn_exp2f(e.x); e.y = __builtin_amdgcn_exp2f(e.y); e += 1.0f; e.x = __builtin_amdgcn_rcpf(e.x); e.y = __builtin_amdgcn_rcpf(e.y); return e; }
__device__ __forceinline__ float bflo(unsigned w) { return __builtin_bit_cast(float, w << 16); }
__device__ __forceinline__ float bfhi(unsigned w) { return __builtin_bit_cast(float, w & 0xffff0000u); }
__device__ __forceinline__ u32x4 pack8(const f32x4& a, const f32x4& b) { u32x4 w; w.x = cvt_pk_bf16(a[0], a[1]); w.y = cvt_pk_bf16(a[2], a[3]); w.z = cvt_pk_bf16(b[0], b[1]); w.w = cvt_pk_bf16(b[2], b[3]); return w; }
__device__ __forceinline__ float sq4(const f32x4& a) { return (a[0] * a[0] + a[1] * a[1]) + (a[2] * a[2] + a[3] * a[3]); }
__device__ __forceinline__ void row_atomic(float* p, float q, int fq) { q += __shfl_xor(q, 16); q += __shfl_xor(q, 32); if (fq == 0) (void)__hip_atomic_fetch_add(p, q, __ATOMIC_RELAXED, __HIP_MEMORY_SCOPE_AGENT); }


#define PG8_EPI_ALL __device__ __forceinline__ void operator()(const f32x4 (&acc)[2][2][4][2], const Unit& u, int wr, int wc, int fr, int fq) const { \
        grp<0, 0>(acc, u, wr, wc, fr, fq); grp<0, 1>(acc, u, wr, wc, fr, fq); grp<0, 2>(acc, u, wr, wc, fr, fq); grp<0, 3>(acc, u, wr, wc, fr, fq); \
        grp<1, 0>(acc, u, wr, wc, fr, fq); grp<1, 1>(acc, u, wr, wc, fr, fq); grp<1, 2>(acc, u, wr, wc, fr, fq); grp<1, 3>(acc, u, wr, wc, fr, fq); }
template <int N_, int K_, int NP_ = 32, int RS_ = 0, int MID_ = 0> struct HybridOrder {
    static constexpr size_t SLAB_BYTES = (size_t)BM * BM * 2;
    static constexpr int KK = K_, G = 256, nM = 9216 / BM, nN = N_ / BM, ntp = K_ / (2 * BK), nwg = nM * nN, per = G / 8, q = nwg / 8, R = NP_ > 0 ? q / per : (q + per - 1) / per, pairs = NP_ > 0 ? (q - R * per) * ntp : 0, np = NP_ <= 0 ? 1 : (NP_ < per ? NP_ : per), base = pairs / np, rem = pairs - base * np;
    static constexpr int Tr = q - R * per, S = RS_ > 0 ? RS_ : 1;
    static_assert(nwg % 8 == 0 && K_ % (2 * BK) == 0 && N_ % BM == 0 && (RS_ == 0 || (Tr * RS_ <= per && ntp >= RS_ && RS_ <= 8 && NP_ > 0)), "HybridOrder shapes");
    int x, j, rend, cur, vcu;
    unsigned char* slab; unsigned* flags; unsigned* tmo;
    __device__ __forceinline__ void init(int bx, unsigned char* slab_, unsigned* flags_, unsigned* tmo_) {
        x = bx & 7; j = bx >> 3;
        cur = j * base + (j < rem ? j : rem); rend = cur + base + (j < rem ? 1 : 0);
        if (j >= np) { cur = 0; rend = 0; }
        if (RS_ > 0) { cur = 0; rend = (j < Tr * S) ? 1 : 0; }
        vcu = x * per + j; slab = slab_; flags = flags_; tmo = tmo_;
    }
    __device__ __forceinline__ void tile_of(int wgid, Unit& u) const {
        constexpr int nig = WGM * nN; const int gid = wgid / nig, fm = gid * WGM, gsz = (nM - fm) < WGM ? (nM - fm) : WGM;
        u.pm = fm + ((wgid % nig) % gsz); u.pn = (wgid % nig) / gsz;
    }
    __device__ __forceinline__ bool next(int i, Unit& u) {
        if (MID_ > 0) { if (i < 2 * R) { const int ii = i >> 1; tile_of(x * q + ii * per + j, u); u.need = 0;
                if (i & 1) { u.k0 = MID_; u.nt = 2 * ntp - MID_; u.mode = 0; } else { u.k0 = 0; u.nt = MID_; u.mode = 4; } return true; } }
        else if (i < R) { if (i * per + j >= q) return false; tile_of(x * q + i * per + j, u); u.k0 = 0; u.nt = 2 * ntp; u.mode = 0; u.need = 0; return true; }
        if (cur >= rend) return false;
        if (RS_ > 0) { const int t = j / S, p = j - t * S; constexpr int b = ntp / S, e = ntp - b * S;
            tile_of(x * q + R * per + t, u); u.k0 = 2 * (p * b + (p < e ? p : e)); u.nt = 2 * (b + (p < e ? 1 : 0)); u.mode = 3; u.need = p; cur = rend; return true; }
        const int t = cur / ntp, off = cur - t * ntp; int len = ntp - off; if (len > rend - cur) len = rend - cur;
        tile_of(x * q + R * per + t, u); u.k0 = 2 * off; u.nt = 2 * len; u.need = ntp - off - len;
        u.mode = off > 0 ? 1 : (u.need > 0 ? 2 : 0);
        cur += len; return true;
    }
    __device__ __forceinline__ void a_ready(const Unit&) const {}
    template <class Epi> __device__ __forceinline__ void finish(f32x4 (&acc)[2][2][4][2], const Unit& u, const Epi& E, int tid, int wid, int wr, int wc, int fr, int fq) const {
        asm volatile("" : "+v"(tid), "+v"(fr), "+v"(fq));
        if constexpr (RS_ == 0 && NP_ > 0) if (u.mode == 1) {
            __amdgpu_buffer_rsrc_t rs = __builtin_amdgcn_make_buffer_rsrc(slab + (size_t)vcu * SLAB_BYTES, 0, (int)SLAB_BYTES, 0x00020000);
            const int vo = tid * 16;
#pragma unroll
            for (int ai = 0; ai < 2; ++ai)
#pragma unroll
                for (int bj = 0; bj < 2; ++bj)
#pragma unroll
                    for (int m = 0; m < 4; ++m) { __builtin_amdgcn_raw_buffer_store_b128(pack8(acc[ai][bj][m][0], acc[ai][bj][m][1]), rs, vo + (ai * 8 + bj * 4 + m) * 8192, 0, 16); asm volatile("" ::: "memory"); }
            asm volatile("s_waitcnt vmcnt(0)" ::: "memory");
            __builtin_amdgcn_s_barrier();
            if (tid == 0) __hip_atomic_store(flags + 64 * vcu, 1u, __ATOMIC_RELAXED, __HIP_MEMORY_SCOPE_AGENT);
            return;
        }
        if constexpr (Epi::MIDK > 0) { if (u.mode == 4) { E.midscale(acc, u, wr, fr); return; } }
        if (u.mode >= 2) return;
        E(acc, u, wr, wc, fr, fq);
    }
    template <class Epi> __device__ __forceinline__ void finish_rs(f32x4 (&acc)[2][2][4][2], const Unit& u, const Epi& E, int tid, int wid, int wr, int wc, int fr, int fq) const {
        const int p = u.need, first = vcu - p;
        if constexpr (Epi::MIDK > 0) { if (u.k0 + u.nt <= Epi::MIDK) E.midscale(acc, u, wr, fr); }
        { __amdgpu_buffer_rsrc_t rs = __builtin_amdgcn_make_buffer_rsrc(slab + (size_t)vcu * SLAB_BYTES, 0, (int)SLAB_BYTES, 0x00020000);
          const int vo = tid * 16;
#pragma unroll
          for (int ai = 0; ai < 2; ++ai)
#pragma unroll
              for (int bj = 0; bj < 2; ++bj)
#pragma unroll
                  for (int m = 0; m < 4; ++m) { __builtin_amdgcn_raw_buffer_store_b128(pack8(acc[ai][bj][m][0], acc[ai][bj][m][1]), rs, vo + (ai * 8 + bj * 4 + m) * 8192, 0, 16); asm volatile("" ::: "memory"); }
          asm volatile("s_waitcnt vmcnt(0)" ::: "memory");
          __builtin_amdgcn_s_barrier();
          if (tid == 0) __hip_atomic_store(flags + 64 * vcu, 1u, __ATOMIC_RELAXED, __HIP_MEMORY_SCOPE_AGENT); }
        if (wid == 0) {
            for (int k = 0; k < S; ++k) { unsigned sp = 0;
                while (__hip_atomic_load(flags + 64 * (first + k), __ATOMIC_RELAXED, __HIP_MEMORY_SCOPE_AGENT) == 0u) { __builtin_amdgcn_s_sleep(2);
                    if (++sp > (1u << 20)) { if (tid == 0) __hip_atomic_store(tmo, 0x5AB3u, __ATOMIC_RELAXED, __HIP_MEMORY_SCOPE_AGENT); break; } } }
            __builtin_amdgcn_fence(__ATOMIC_ACQUIRE, "agent"); asm volatile("s_waitcnt vmcnt(0)" ::: "memory");
        }
        asm volatile("" ::: "memory"); __builtin_amdgcn_s_barrier(); asm volatile("" ::: "memory");
        const u32x4* sl0 = (const u32x4*)(slab + (size_t)first * SLAB_BYTES) + tid;
#define PG8_RS_GROUP(AI, MM) if ((AI * 4 + MM) % S == p) { u32x4 w0[S], w1[S]; \
            _Pragma("unroll") for (int k = 0; k < S; ++k) { const u32x4* sk = sl0 + (size_t)k * (SLAB_BYTES / 16); w0[k] = sk[(AI * 8 + MM) * 512]; w1[k] = sk[(AI * 8 + 4 + MM) * 512]; } \
            f32x4 a00 = {0.f, 0.f, 0.f, 0.f}, a01 = a00, a10 = a00, a11 = a00; \
            _Pragma("unroll") for (int k = 0; k < S; ++k) { a00 += (f32x4){bflo(w0[k].x), bfhi(w0[k].x), bflo(w0[k].y), bfhi(w0[k].y)}; a01 += (f32x4){bflo(w0[k].z), bfhi(w0[k].z), bflo(w0[k].w), bfhi(w0[k].w)}; \
                a10 += (f32x4){bflo(w1[k].x), bfhi(w1[k].x), bflo(w1[k].y), bfhi(w1[k].y)}; a11 += (f32x4){bflo(w1[k].z), bfhi(w1[k].z), bflo(w1[k].w), bfhi(w1[k].w)}; } \
            acc[AI][0][MM][0] = a00; acc[AI][0][MM][1] = a01; acc[AI][1][MM][0] = a10; acc[AI][1][MM][1] = a11; \
            E.template grp<AI, MM>(acc, u, wr, wc, fr, fq); }
        PG8_RS_GROUP(0, 0) PG8_RS_GROUP(0, 1) PG8_RS_GROUP(0, 2) PG8_RS_GROUP(0, 3) PG8_RS_GROUP(1, 0) PG8_RS_GROUP(1, 1) PG8_RS_GROUP(1, 2) PG8_RS_GROUP(1, 3)
#undef PG8_RS_GROUP
    }
    template <class Epi> __device__ __forceinline__ void finish_last(f32x4 (&acc)[2][2][4][2], const Unit& u, const Epi& E, int tid, int wid, int wr, int wc, int fr, int fq) const {
        if constexpr (RS_ > 0) { if (u.mode == 3) finish_rs(acc, u, E, tid, wid, wr, wc, fr, fq); return; }
        if constexpr (NP_ <= 0) return;
        if (u.mode != 2) return;
        int ns = 0; { int need = u.need; for (int jj = j + 1; need > 0 && jj < np; ++jj) { const int len = base + (jj < rem ? 1 : 0); if (len == 0) break; need -= (len < need ? len : need); ++ns; } }
        if (wid == 0) {
            for (int k = 1; k <= ns; ++k) { unsigned sp = 0;
                while (__hip_atomic_load(flags + 64 * (vcu + k), __ATOMIC_RELAXED, __HIP_MEMORY_SCOPE_AGENT) == 0u) { __builtin_amdgcn_s_sleep(2);
                    if (++sp > (1u << 20)) { if (tid == 0) __hip_atomic_store(tmo, 0x5AB0u, __ATOMIC_RELAXED, __HIP_MEMORY_SCOPE_AGENT); break; } } }
            __builtin_amdgcn_fence(__ATOMIC_ACQUIRE, "agent"); asm volatile("s_waitcnt vmcnt(0)" ::: "memory");
        }
        asm volatile("" ::: "memory"); __builtin_amdgcn_s_barrier(); asm volatile("" ::: "memory");
        for (int k = 1; k <= ns; ++k) {
            const u32x4* sl = (const u32x4*)(slab + (size_t)(vcu + k) * SLAB_BYTES) + tid;
            u32x4 w[16];
#pragma unroll
            for (int i = 0; i < 16; ++i) w[i] = sl[i * 512];
#pragma unroll
            for (int ai = 0; ai < 2; ++ai)
#pragma unroll
                for (int bj = 0; bj < 2; ++bj)
#pragma unroll
                    for (int m = 0; m < 4; ++m) { const u32x4 v = w[ai * 8 + bj * 4 + m];
                        acc[ai][bj][m][0] += (f32x4){bflo(v.x), bfhi(v.x), bflo(v.y), bfhi(v.y)}; acc[ai][bj][m][1] += (f32x4){bflo(v.z), bfhi(v.z), bflo(v.w), bfhi(v.w)}; }
        }
        E(acc, u, wr, wc, fr, fq);
    }
};
struct EpiIn {
    static constexpr bool PERM = true, AFTER_DRAIN = false; static constexpr int MIDK = 0;
    bf16_t* U; bf16_t* S; const float* rx;
    template <int ai, int m> __device__ __forceinline__ void grp_r(const f32x4 (&acc)[2][2][4][2], const Unit& u, int wr, int wc, int fr, int fq, float r) const {
        const int row = u.pm * BM + wr * 64 + fr + ai * HALF + m * 16;
        if (u.pn < 8) {
            const int col0 = u.pn * 128 + wc * 32 + 8 * fq; const float rn = r * -1.4426950408889634f;
            u32x4 w;
#pragma unroll
            for (int n = 0; n < 2; ++n)
#pragma unroll
                for (int jp = 0; jp < 2; ++jp) { const f32x2 v = {acc[ai][0][m][n][2 * jp], acc[ai][0][m][n][2 * jp + 1]}, gt = {acc[ai][1][m][n][2 * jp], acc[ai][1][m][n][2 * jp + 1]};
                    const f32x2 o = (v * r) * sig_arg2(gt * rn);
                    w[n * 2 + jp] = cvt_pk_bf16(o.x, o.y); }
            *(u32x4*)(U + (size_t)row * 1024 + col0) = w;
        } else {
            const int col0 = (u.pn - 8) * 256 + wc * 32 + 8 * fq;
#pragma unroll
            for (int bj = 0; bj < 2; ++bj) *(u32x4*)(S + (size_t)row * 1024 + col0 + bj * HALF) = pack8(acc[ai][bj][m][0] * r, acc[ai][bj][m][1] * r);
        }
    }
    template <int ai, int m> __device__ __forceinline__ void grp(const f32x4 (&acc)[2][2][4][2], const Unit& u, int wr, int wc, int fr, int fq) const {
        grp_r<ai, m>(acc, u, wr, wc, fr, fq, rx[u.pm * BM + wr * 64 + fr + ai * HALF + m * 16]); }
    __device__ __forceinline__ void operator()(const f32x4 (&acc)[2][2][4][2], const Unit& u, int wr, int wc, int fr, int fq) const {
        const float* sp = rx + u.pm * BM + wr * 64 + fr;
        const float s00 = sp[0], s01 = sp[16], s02 = sp[32], s03 = sp[48], s10 = sp[HALF], s11 = sp[HALF + 16], s12 = sp[HALF + 32], s13 = sp[HALF + 48];
        grp_r<0, 0>(acc, u, wr, wc, fr, fq, s00); grp_r<0, 1>(acc, u, wr, wc, fr, fq, s01); grp_r<0, 2>(acc, u, wr, wc, fr, fq, s02); grp_r<0, 3>(acc, u, wr, wc, fr, fq, s03);
        grp_r<1, 0>(acc, u, wr, wc, fr, fq, s10); grp_r<1, 1>(acc, u, wr, wc, fr, fq, s11); grp_r<1, 2>(acc, u, wr, wc, fr, fq, s12); grp_r<1, 3>(acc, u, wr, wc, fr, fq, s13);
    }
};
struct EpiGlu {
    static constexpr bool PERM = true, AFTER_DRAIN = false; static constexpr int MIDK = 0;
    const bf16_t* G; bf16_t* MIX; float* ssq;
    template <int ai, int m> __device__ __forceinline__ void grp(const f32x4 (&acc)[2][2][4][2], const Unit& u, int wr, int wc, int fr, int fq) const {
        const int row0 = u.pm * BM + wr * 64 + fr, col0 = u.pn * BM + wc * 32 + 8 * fq;
            { const int row = row0 + ai * HALF + m * 16; float q = 0.f;
#pragma unroll
                for (int bj = 0; bj < 2; ++bj) { const u32x4 gw = *(const u32x4*)(G + (size_t)row * 1024 + col0 + bj * HALF);
                    f32x4 g0 = {bflo(gw.x), bfhi(gw.x), bflo(gw.y), bfhi(gw.y)}, g1 = {bflo(gw.z), bfhi(gw.z), bflo(gw.w), bfhi(gw.w)}, y0, y1;
#pragma unroll
                    for (int j = 0; j < 4; ++j) { y0[j] = g0[j] * fsig(acc[ai][bj][m][0][j]); y1[j] = g1[j] * fsig(acc[ai][bj][m][1][j]); }
                    q += sq4(y0) + sq4(y1);
                    *(u32x4*)(MIX + (size_t)row * 2048 + col0 + bj * HALF) = pack8(y0, y1); }
                row_atomic(ssq + row, q, fq); }
    }
    PG8_EPI_ALL
};
struct EpiOut {
    static constexpr bool PERM = true, AFTER_DRAIN = false; static constexpr int MIDK = 16;
    bf16_t* HB; float* ssq; const float* ssqs;
    __device__ __forceinline__ void midscale(f32x4 (&acc)[2][2][4][2], const Unit& u, int wr, int fr) const {
        const int row0 = u.pm * BM + wr * 64 + fr;
#pragma unroll
        for (int ai = 0; ai < 2; ++ai)
#pragma unroll
            for (int m = 0; m < 4; ++m) { const float r = __builtin_amdgcn_rsqf(ssqs[row0 + ai * HALF + m * 16] * (1.0f / 1024.0f) + RMS_EPS);
#pragma unroll
                for (int bj = 0; bj < 2; ++bj) { acc[ai][bj][m][0] *= r; acc[ai][bj][m][1] *= r; } }
    }
    template <int ai, int m> __device__ __forceinline__ void grp(const f32x4 (&acc)[2][2][4][2], const Unit& u, int wr, int wc, int fr, int fq) const {
        const int row0 = u.pm * BM + wr * 64 + fr, col0 = u.pn * BM + wc * 32 + 8 * fq;
            { const int row = row0 + ai * HALF + m * 16; float q = 0.f;
#pragma unroll
                for (int bj = 0; bj < 2; ++bj) { const size_t off = (size_t)row * 2048 + col0 + bj * HALF;
                    const u32x4 xw = *(const u32x4*)(HB + off);
                    const f32x4 h0 = (f32x4){bflo(xw.x), bfhi(xw.x), bflo(xw.y), bfhi(xw.y)} + acc[ai][bj][m][0], h1 = (f32x4){bflo(xw.z), bfhi(xw.z), bflo(xw.w), bfhi(xw.w)} + acc[ai][bj][m][1];
                    q += sq4(h0) + sq4(h1);
                    *(u32x4*)(HB + off) = pack8(h0, h1); }
                row_atomic(ssq + row, q, fq); }
    }
    PG8_EPI_ALL
};
struct EpiUp {
    static constexpr bool PERM = true, AFTER_DRAIN = false; static constexpr int MIDK = 0;
    bf16_t* ACT; const float* ssq;
    template <int ai, int m> __device__ __forceinline__ void grp_r(const f32x4 (&acc)[2][2][4][2], const Unit& u, int wr, int wc, int fr, int fq, float ss) const {
        const int row = u.pm * BM + wr * 64 + fr + ai * HALF + m * 16, col0 = u.pn * 128 + wc * 32 + 8 * fq;
        const float r = __builtin_amdgcn_rsqf(ss * (1.0f / 2048.0f) + RMS_EPS), rn = r * -1.4426950408889634f, r2 = r * r;
        u32x4 w;
#pragma unroll
        for (int n = 0; n < 2; ++n)
#pragma unroll
            for (int jp = 0; jp < 2; ++jp) { const f32x2 g = {acc[ai][0][m][n][2 * jp], acc[ai][0][m][n][2 * jp + 1]}, up = {acc[ai][1][m][n][2 * jp], acc[ai][1][m][n][2 * jp + 1]};
                const f32x2 o = (g * up) * (sig_arg2(g * rn) * r2);
                w[n * 2 + jp] = cvt_pk_bf16(o.x, o.y); }
        *(u32x4*)(ACT + (size_t)row * 5632 + col0) = w;
    }
    template <int ai, int m> __device__ __forceinline__ void grp(const f32x4 (&acc)[2][2][4][2], const Unit& u, int wr, int wc, int fr, int fq) const {
        grp_r<ai, m>(acc, u, wr, wc, fr, fq, ssq[u.pm * BM + wr * 64 + fr + ai * HALF + m * 16]); }
    __device__ __forceinline__ void operator()(const f32x4 (&acc)[2][2][4][2], const Unit& u, int wr, int wc, int fr, int fq) const {
        const float* sp = ssq + u.pm * BM + wr * 64 + fr;
        const float s00 = sp[0], s01 = sp[16], s02 = sp[32], s03 = sp[48], s10 = sp[HALF], s11 = sp[HALF + 16], s12 = sp[HALF + 32], s13 = sp[HALF + 48];
        grp_r<0, 0>(acc, u, wr, wc, fr, fq, s00); grp_r<0, 1>(acc, u, wr, wc, fr, fq, s01); grp_r<0, 2>(acc, u, wr, wc, fr, fq, s02); grp_r<0, 3>(acc, u, wr, wc, fr, fq, s03);
        grp_r<1, 0>(acc, u, wr, wc, fr, fq, s10); grp_r<1, 1>(acc, u, wr, wc, fr, fq, s11); grp_r<1, 2>(acc, u, wr, wc, fr, fq, s12); grp_r<1, 3>(acc, u, wr, wc, fr, fq, s13);
    }
};
struct EpiDown {
    static constexpr bool PERM = true, AFTER_DRAIN = false; static constexpr int MIDK = 0;
    bf16_t* HB; float* ssq; float zmul;
    template <int ai, int m> __device__ __forceinline__ void grp(const f32x4 (&acc)[2][2][4][2], const Unit& u, int wr, int wc, int fr, int fq) const {
        const int row0 = u.pm * BM + wr * 64 + fr, col0 = u.pn * BM + wc * 32 + 8 * fq;
            { const int row = row0 + ai * HALF + m * 16; float q = 0.f;
#pragma unroll
                for (int bj = 0; bj < 2; ++bj) { bf16_t* p = HB + (size_t)row * 2048 + col0 + bj * HALF; const u32x4 hw = *(const u32x4*)p;
                    const f32x4 o0 = (f32x4){bflo(hw.x), bfhi(hw.x), bflo(hw.y), bfhi(hw.y)} + acc[ai][bj][m][0] * zmul, o1 = (f32x4){bflo(hw.z), bfhi(hw.z), bflo(hw.w), bfhi(hw.w)} + acc[ai][bj][m][1] * zmul;
                    q += sq4(o0) + sq4(o1);
                    *(u32x4*)p = pack8(o0, o1); }
                row_atomic(ssq + row, q, fq); }
    }
    PG8_EPI_ALL
};
}
typedef pg8::f32x2 f32x2;

constexpr int NWAVES = 8;
#ifndef MK_N_LAUNCHES
#define MK_N_LAUNCHES 1
#endif
constexpr int NPH = 9;
constexpr int N_LAUNCHES = MK_N_LAUNCHES;

constexpr int D = 2048, DC = 1024, DS = 1024, DIN = 3072, DFF = 5632, NG = 64, NP = 64, CH = 16, KW = 31;
constexpr int BATCH = 4, SEQ = 2048, DB = 128, DSQ = 8;
constexpr int MP = BATCH * SEQ, MS = DB * DSQ, M = MP + MS;

constexpr size_t MiB = 1u << 20;
constexpr size_t WS_CTL = 0, CTL_ZERO_BYTES = 1 * MiB;
constexpr size_t WS_TAB = 1 * MiB;
constexpr size_t WS_WGU = 2 * MiB, WS_WDN = 46 * MiB, WS_XB = 68 * MiB;
constexpr size_t WS_WIN = 104 * MiB, WS_WGL = 116 * MiB, WS_WOUT = 118 * MiB;
constexpr size_t WS_U = 126 * MiB, WS_S = 144 * MiB, WS_G = 162 * MiB, WS_MIX = 180 * MiB;
constexpr size_t WS_ACT = 104 * MiB;
constexpr size_t WS_END = 235 * MiB;
constexpr size_t SLAB_P1 = 162 * MiB, SLAB_P3 = 126 * MiB, SLAB_P5 = 126 * MiB, SLAB_P6 = 203 * MiB, SLAB_P7 = 2 * MiB;
static_assert(WS_WGU + (size_t)2 * DFF * D * 2 <= WS_WDN && WS_WDN + (size_t)D * DFF * 2 <= WS_XB && WS_XB + (size_t)M * D * 2 <= WS_WIN, "ws map 1");
static_assert(WS_WIN + (size_t)DIN * D * 2 <= WS_WGL && WS_WGL + (size_t)DS * DS * 2 <= WS_WOUT && WS_WOUT + (size_t)D * D * 2 <= WS_U, "ws map 2");
static_assert(WS_U + (size_t)M * DC * 2 <= WS_S && WS_S + (size_t)M * DS * 2 <= WS_G && WS_G + (size_t)M * DS * 2 <= WS_MIX && WS_MIX + (size_t)M * D * 2 <= WS_END, "ws map 3");
static_assert(WS_ACT + (size_t)M * DFF * 2 <= SLAB_P6 && SLAB_P6 + 32 * MiB <= WS_END && WS_END <= 256 * MiB, "ws map 4");
constexpr int CW_TMO = 0, CW_CODE = 1;
constexpr int CW_BAR = 4096;
constexpr int CW_SSQ_S = 16384, CW_SSQ_H = CW_SSQ_S + M, CW_SSQ_O = CW_SSQ_H + M;
constexpr int CW_DUMMY = CW_SSQ_O + M;
constexpr int CW_FLAGS = 81920, FLAG_SLOT = 16384;
constexpr int CW_RX = 65536;
static_assert((CW_RX + M) * 4 <= (int)CTL_ZERO_BYTES && CW_DUMMY + M <= CW_RX, "ctl map");
constexpr size_t TAB_AB = 0;
constexpr size_t TAB_BBT = 64 * 1024;
constexpr size_t TAB_CQ = 512 * 1024;

constexpr int RING_OFF = 0, RING_BYTES = 131072;
constexpr int LDSCTL_OFF = RING_BYTES, MISC_OFF = LDSCTL_OFF + 320;
constexpr int LDS_BYTES = 147456;
static_assert(MISC_OFF + 128 <= LDS_BYTES, "LDS map");

#define GAS __attribute__((address_space(1)))
#define LAS __attribute__((address_space(3)))
typedef unsigned short bf16;
typedef unsigned v4u __attribute__((ext_vector_type(4)));
typedef unsigned v2u __attribute__((ext_vector_type(2)));
typedef float f32x4 __attribute__((ext_vector_type(4)));

typedef float f32x16 __attribute__((ext_vector_type(16)));
typedef short bf16x8 __attribute__((ext_vector_type(8)));
typedef GAS unsigned gu32;
#define RLX_AGENT __ATOMIC_RELAXED, __HIP_MEMORY_SCOPE_AGENT
#define LDS_WAIT() asm volatile("s_waitcnt lgkmcnt(0)" ::: "memory")
#define VM_WAIT() asm volatile("s_waitcnt vmcnt(0)" ::: "memory")
__device__ __forceinline__ unsigned f2bf(float f) { unsigned u = __builtin_bit_cast(unsigned, f); return (u + 0x7fffu + ((u >> 16) & 1u)) >> 16; }
__device__ __forceinline__ unsigned pk2(float lo, float hi) { return f2bf(lo) | (f2bf(hi) << 16); }
__device__ __forceinline__ float bf_lo(unsigned w) { return __builtin_bit_cast(float, w << 16); }
__device__ __forceinline__ float bf_hi(unsigned w) { return __builtin_bit_cast(float, w & 0xffff0000u); }
#define WS_DPP(v, ctrl, rm) ((v) + __builtin_bit_cast(float, __builtin_amdgcn_update_dpp(0, __builtin_bit_cast(int, (v)), (ctrl), (rm), 0xF, true)))
__device__ __forceinline__ float wave_sum63(float v) {
    v = WS_DPP(v, 0xB1, 0xF); v = WS_DPP(v, 0x4E, 0xF); v = WS_DPP(v, 0x141, 0xF); v = WS_DPP(v, 0x140, 0xF); v = WS_DPP(v, 0x142, 0xA); v = WS_DPP(v, 0x143, 0xC);
    return v;
}
__device__ __forceinline__ float fsigm(float x) { return __builtin_amdgcn_rcpf(1.0f + __builtin_amdgcn_exp2f(x * -1.4426950408889634f)); }
__device__ __forceinline__ float gelu_tanh_f(float x) {
    const float u2 = 1.5957691216057308f * (x + 0.044715f * x * x * x);
    return x * fsigm(u2);
}

#define XB_TMO      128
#define XB_XCNT(j)  (256  + 64 * (j))
#define XB_XSUB(j)  (1280 + 64 * (j))
#define XB_XGEN(j)  (2304 + 64 * (j))
#define XB_TOP      3328
#define XB_TOPGEN   3392
#define XCD_BAR_WORDS 3456
#define XB_SPIN_CAP (1u << 18)

__device__ __forceinline__ unsigned xb_ld(unsigned* p)              { return __hip_atomic_load(p, __ATOMIC_RELAXED, __HIP_MEMORY_SCOPE_AGENT); }
__device__ __forceinline__ unsigned xb_add(unsigned* p, unsigned v) { return __hip_atomic_fetch_add(p, v, __ATOMIC_RELAXED, __HIP_MEMORY_SCOPE_AGENT); }
__device__ __forceinline__ unsigned xb_xcc_id() { return (unsigned)__builtin_amdgcn_s_getreg((3 << 11) | 20) & 0xFu; }
#define XB_SPIN(cond, bar) do { unsigned _sp = 0; while (cond) { __builtin_amdgcn_s_sleep(1); \
    if ((++_sp & 255u) == 0u) { if (xb_ld(&(bar)[XB_TMO])) break; if (_sp > XB_SPIN_CAP) { atomicAdd(&(bar)[XB_TMO], 1u); break; } } } } while (0)

struct XcdBarrier {
    unsigned* bar; unsigned x;
    volatile LAS unsigned* st;
};

__device__ __forceinline__ XcdBarrier xcd_barrier_post(unsigned* bar, volatile LAS unsigned* st) {
    XcdBarrier b; b.bar = bar; b.x = xb_xcc_id(); b.st = st;
    if (threadIdx.x == 0) (void)xb_add(&bar[XB_XCNT(b.x)], 1u);
    return b;
}
__device__ __forceinline__ void xcd_barrier_complete(unsigned* bar, unsigned x, unsigned& nloc, unsigned& nx) {
    const unsigned G = gridDim.x * gridDim.y * gridDim.z;
    unsigned sum, cnt, mine, sp = 0u;
    for (;;) {
        sum = 0u; cnt = 0u; mine = 0u;
#pragma unroll
        for (unsigned j = 0; j < 16; ++j) { const unsigned c = xb_ld(&bar[XB_XCNT(j)]); sum += c; cnt += (c > 0u) ? 1u : 0u; mine = (j == x) ? c : mine; }
        if (sum == G) break;
        __builtin_amdgcn_s_sleep(1);
        if ((++sp & 255u) == 0u) { if (xb_ld(&bar[XB_TMO])) break; if (sp > XB_SPIN_CAP) { atomicAdd(&bar[XB_TMO], 1u); break; } }
    }
    nloc = mine > 0u ? mine : 1u; nx = cnt > 0u ? cnt : 1u;
}

__device__ __forceinline__ void xcd_barrier(const XcdBarrier& b) {
    asm volatile("s_waitcnt vmcnt(0)" ::: "memory");
    __syncthreads();
    if (threadIdx.x == 0) {
        unsigned* bar = b.bar;
        __builtin_amdgcn_s_waitcnt(0);
        unsigned nloc = b.st[0], nx = b.st[1];
        if (nloc == 0u) { xcd_barrier_complete(bar, b.x, nloc, nx); b.st[0] = nloc; b.st[1] = nx; }
        const unsigned old = xb_add(&bar[XB_XSUB(b.x)], 1u);
        const unsigned gen = old / nloc;
        if (old + 1u == (gen + 1u) * nloc) {
            __builtin_amdgcn_fence(__ATOMIC_RELEASE, "agent");
            asm volatile("s_waitcnt vmcnt(0)" ::: "memory");
            const unsigned og = xb_add(&bar[XB_TOP], 1u);
            const unsigned tg = og / nx;
            if (og + 1u == (tg + 1u) * nx) xb_add(&bar[XB_TOPGEN], 1u);
            else XB_SPIN(xb_ld(&bar[XB_TOPGEN]) == tg, bar);
            __builtin_amdgcn_fence(__ATOMIC_ACQUIRE, "agent");
            xb_add(&bar[XB_XGEN(b.x)], 1u);
            asm volatile("s_waitcnt vmcnt(0)" ::: "memory");
        } else {
            XB_SPIN(xb_ld(&bar[XB_XGEN(b.x)]) == gen, bar);
            __builtin_amdgcn_fence(__ATOMIC_ACQUIRE, "agent");
            asm volatile("s_waitcnt vmcnt(0)" ::: "memory");
        }
    }
    __syncthreads();
}
__device__ __forceinline__ unsigned cvtpk(float lo, float hi) { unsigned r; asm("v_cvt_pk_bf16_f32 %0, %1, %2" : "=v"(r) : "v"(lo), "v"(hi)); return r; }

struct P0Item { const float* W; const float* gp; bf16* WT; int N, K, orow, k0, n0, gain_on, kdst; };
__device__ __forceinline__ void p0_item_load(const P0Item& t, f32x4 (&v)[8], float (&gk)[8], int lane) {
    const int kr = lane >> 3, nq = lane & 7;
#pragma unroll
    for (int i = 0; i < 8; ++i) { const int kk = 8 * i + kr; v[i] = __builtin_nontemporal_load((const GAS f32x4*)(t.W + (size_t)(t.k0 + kk) * t.N + t.n0 + 4 * nq));
        const float gl = t.gp[t.gain_on ? t.k0 + kk : 0]; gk[i] = t.gain_on ? gl : 1.0f; }
}
__device__ __forceinline__ void p0_item_finish(const P0Item& t, const f32x4 (&v)[8], const float (&gk)[8], LAS float* scr, int lane) {
    const int kr = lane >> 3, nq = lane & 7;
#pragma unroll
    for (int i = 0; i < 8; ++i) { const int kk = 8 * i + kr; LAS float* d = scr + kk * 33 + 4 * nq; d[0] = v[i].x * gk[i]; d[1] = v[i].y * gk[i]; d[2] = v[i].z * gk[i]; d[3] = v[i].w * gk[i]; }
    LDS_WAIT(); asm volatile("" ::: "memory");
    const int c = lane & 7;
#pragma unroll
    for (int j = 0; j < 4; ++j) { const int n = (lane >> 3) + 8 * j; const LAS float* s = scr + (8 * c) * 33 + n;
        v4u o; o.x = cvtpk(s[0 * 33], s[1 * 33]); o.y = cvtpk(s[2 * 33], s[3 * 33]); o.z = cvtpk(s[4 * 33], s[5 * 33]); o.w = cvtpk(s[6 * 33], s[7 * 33]);
        *(GAS v4u*)(t.WT + (size_t)(t.orow + n) * t.K + t.kdst + 8 * c) = o; }
    LDS_WAIT(); asm volatile("" ::: "memory");
}

struct P0Args {
    const float *xp, *xs, *norm_mix, *w_in, *w_glu, *gn_conv, *gn_ssm, *w_out, *norm_ffn, *w_gate, *w_up, *w_down;
    const float *A_re, *A_im, *log_dt, *B_re, *B_im, *C_re, *C_im;
    bf16 *WIN, *WGL, *WOUT, *WGU, *WDN, *XB; float* rx; unsigned char* tab;
};
__device__ __forceinline__ void p0_convert(const P0Args& a, LAS unsigned char* lds, int first, int stride, int lo, int hi, int wave, int lane) {
    LAS float* scr = (LAS float*)(lds + RING_OFF + wave * 16384);
    constexpr int I_IN = (D / 64) * (DIN / 32), I_GL = (DS / 64) * (DS / 32), I_OUT = (D / 64) * (D / 32), I_GA = (D / 64) * (DFF / 32), I_DN = (DFF / 64) * (D / 32);
    constexpr int NITEMS = I_IN + I_GL + I_OUT + 2 * I_GA + I_DN;
#define P0_DECODE(t, it_) do { int r_ = (it_); \
        if (r_ < I_IN) { const int nb = r_ % (DIN / 32), kb = r_ / (DIN / 32), n0 = 32 * nb; \
            int orow; if (n0 < 2048) { const int bjv = n0 >> 10, ch = n0 & 1023; orow = 256 * (ch >> 7) + 128 * bjv + (ch & 127); } else orow = n0; \
            t.W = a.w_in; t.N = DIN; t.gp = a.norm_mix; t.gain_on = 1; t.WT = a.WIN; t.K = D; t.orow = orow; t.k0 = 64 * kb; t.kdst = 64 * kb; t.n0 = n0; break; } r_ -= I_IN; \
        if (r_ < I_GL) { const int nb = r_ % (DS / 32), kb = r_ / (DS / 32); \
            t.W = a.w_glu; t.N = DS; t.gp = a.norm_mix; t.gain_on = 0; t.WT = a.WGL; t.K = DS; t.orow = 32 * nb; t.k0 = 64 * kb; t.kdst = 64 * kb; t.n0 = 32 * nb; break; } r_ -= I_GL; \
        if (r_ < I_OUT) { const int nb = r_ % (D / 32), kb = r_ / (D / 32), k0 = 64 * kb; \
            t.W = a.w_out; t.N = D; t.gp = k0 < 1024 ? a.gn_conv : a.gn_ssm - 1024; t.gain_on = 1; t.WT = a.WOUT; t.K = D; t.orow = 32 * nb; t.k0 = k0; t.kdst = k0 ^ 1024; t.n0 = 32 * nb; break; }     r_ -= I_OUT; \
        if (r_ < I_GA) { const int nb = r_ % (DFF / 32), kb = r_ / (DFF / 32), n0 = 32 * nb; \
            t.W = a.w_gate; t.N = DFF; t.gp = a.norm_ffn; t.gain_on = 1; t.WT = a.WGU; t.K = D; t.orow = 256 * (n0 >> 7) + (n0 & 127); t.k0 = 64 * kb; t.kdst = 64 * kb; t.n0 = n0; break; } r_ -= I_GA; \
        if (r_ < I_GA) { const int nb = r_ % (DFF / 32), kb = r_ / (DFF / 32), n0 = 32 * nb; \
            t.W = a.w_up; t.N = DFF; t.gp = a.norm_ffn; t.gain_on = 1; t.WT = a.WGU; t.K = D; t.orow = 256 * (n0 >> 7) + 128 + (n0 & 127); t.k0 = 64 * kb; t.kdst = 64 * kb; t.n0 = n0; break; } r_ -= I_GA; \
        { const int nb = r_ % (D / 32), kb = r_ / (D / 32); \
            t.W = a.w_down; t.N = D; t.gp = a.norm_mix; t.gain_on = 0; t.WT = a.WDN; t.K = DFF; t.orow = 32 * nb; t.k0 = 64 * kb; t.kdst = 64 * kb; t.n0 = 32 * nb; } } while (0)
    {
        P0Item t0, t1, t2; f32x4 va[8], vb[8], vc[8]; float ga[8], gb[8], gc[8];
        if (lo + first < hi) { P0_DECODE(t0, lo + first); p0_item_load(t0, va, ga, lane); }
        if (lo + first + stride < hi) { P0_DECODE(t1, lo + first + stride); p0_item_load(t1, vb, gb, lane); }
        for (int it = lo + first; it < hi; it += stride) {
            const int itn = it + 2 * stride;
            if (itn < hi) { P0_DECODE(t2, itn); p0_item_load(t2, vc, gc, lane); }
            p0_item_finish(t0, va, ga, scr, lane);
            t0 = t1; t1 = t2;
#pragma unroll
            for (int i = 0; i < 8; ++i) { va[i] = vb[i]; ga[i] = gb[i]; vb[i] = vc[i]; gb[i] = gc[i]; }
        }
    }
#undef P0_DECODE
}
__device__ __forceinline__ void p0_tables(const P0Args& a, int gt) {
    {
      if (gt < NG * NP) { const int g = gt >> 6, p = gt & 63;
        const float ar = a.A_re[gt], ai = a.A_im[gt], dt = expf(a.log_dt[g]);
        const float th = dt * ai, e1 = expm1f(dt * ar), sh = sinf(0.5f * th), cm1 = -2.0f * sh * sh, cs = 1.0f + cm1;
        const float nr = e1 * cs + cm1, ni = (1.0f + e1) * sinf(th);
        const float abr = 1.0f + nr, abi = ni, den = ar * ar + ai * ai;
        const float kr = (nr * ar + ni * ai) / den, ki = (ni * ar - nr * ai) / den;
        float* AB = (float*)(a.tab + TAB_AB); AB[gt * 2] = abr; AB[gt * 2 + 1] = abi;
        bf16* BBT = (bf16*)(a.tab + TAB_BBT); bf16* CQ = (bf16*)(a.tab + TAB_CQ);
#pragma unroll
        for (int c = 0; c < 16; ++c) { const float br = a.B_re[(size_t)gt * CH + c], bi = a.B_im[(size_t)gt * CH + c];
            BBT[((size_t)(g * 2 + 0) * NP + p) * CH + c] = (bf16)f2bf(kr * br - ki * bi);
            BBT[((size_t)(g * 2 + 1) * NP + p) * CH + c] = (bf16)f2bf(kr * bi + ki * br);
            CQ[((size_t)g * CH + c) * 128 + 2 * p] = (bf16)f2bf(a.C_re[((size_t)g * CH + c) * NP + p]);
            CQ[((size_t)g * CH + c) * 128 + 2 * p + 1] = (bf16)f2bf(-a.C_im[((size_t)g * CH + c) * NP + p]); }
      } }
}
constexpr int P0_ITEMS_P3 = 8704;
constexpr int P0_ITEMS_B = (D / 64) * (DIN / 32) + (DS / 64) * (DS / 32) + (D / 64) * (D / 32) + 2 * (D / 64) * (DFF / 32), P0_ITEMS_A = P0_ITEMS_B - P0_ITEMS_P3;
constexpr int P0_ITEMS_ALL = P0_ITEMS_B + (DFF / 64) * (D / 32);
__device__ __forceinline__ void p0_prologue(const P0Args& a, LAS unsigned char* lds, int vcu, int G, int wave, int lane, int tid) {
    const int gw = vcu * NWAVES + wave, NGW = G * NWAVES;
    p0_convert(a, lds, gw, NGW, 0, P0_ITEMS_A, wave, lane);
#ifdef STAMP_A
    __syncthreads(); if (blockIdx.x == 0 && tid == 0) { const unsigned long long t_ = __builtin_amdgcn_s_memrealtime(); volatile LAS unsigned* M_ = (volatile LAS unsigned*)(lds + MISC_OFF); M_[12 + 2 * 15] = (unsigned)t_; M_[13 + 2 * 15] = (unsigned)(t_ >> 32); }
#endif
    {
        f32x4 v[8], vn[8];
        if (gw < M) { const GAS f32x4* xr = (const GAS f32x4*)(gw < MP ? a.xp + (size_t)gw * D : a.xs + (size_t)(gw - MP) * D) + lane;
#pragma unroll
            for (int j = 0; j < 8; ++j) v[j] = xr[64 * j]; }
        for (int row = gw; row < M; row += NGW) {
            const int rn = row + NGW;
            if (rn < M) { const GAS f32x4* xr = (const GAS f32x4*)(rn < MP ? a.xp + (size_t)rn * D : a.xs + (size_t)(rn - MP) * D) + lane;
#pragma unroll
                for (int j = 0; j < 8; ++j) vn[j] = xr[64 * j]; }
            float s = 0.f;
#pragma unroll
            for (int j = 0; j < 8; ++j) s += (v[j].x * v[j].x + v[j].y * v[j].y) + (v[j].z * v[j].z + v[j].w * v[j].w);
            s = wave_sum63(s);
            if (lane == 63) a.rx[row] = 1.0f / sqrtf(s * (1.0f / D) + 1e-6f);
            GAS v2u* o8 = (GAS v2u*)(a.XB + (size_t)row * D) + lane;
#pragma unroll
            for (int j = 0; j < 8; ++j) { v2u o; o.x = cvtpk(v[j].x, v[j].y); o.y = cvtpk(v[j].z, v[j].w); o8[64 * j] = o; }
#pragma unroll
            for (int j = 0; j < 8; ++j) v[j] = vn[j];
        }
    }
}

struct P2Args {
    const bf16* UC; const bf16* SI; bf16* G; bf16* MIX;
    const float *state_conv, *h0re, *h0im, *conv_w, *conv_b, *ln_g, *ln_b, *Dk;
    const unsigned char* tab;
    float *ncp, *nrp, *nip, *ncs, *nrs, *nis;
};
constexpr int P2_RED_OFF = 0, P2_TILE_OFF = 4096, P2_TILE_B = 4352, P2_TROW = 272, P2_UT_OFF = 73728, P2_SX_OFF = 81920;

#define CONV_LOAD_ROWS(rows, it_) do { \
        if ((it_) < 1024) { const int t0_ = ((it_) & 255) * 8, neg_ = (KW - 1) - t0_; const bf16* ub_ = a.UC + (size_t)(((it_) >> 8) * SEQ) * DC + c0; \
            _Pragma("unroll") for (int r_ = 0; r_ < 8 + KW - 1; ++r_) { const int tt_ = t0_ - (KW - 1) + r_; \
                const unsigned ld_ = *(const GAS unsigned*)(ub_ + (size_t)(tt_ > 0 ? tt_ : 0) * DC); rows[r_] = ld_ & (r_ >= neg_ ? 0xffffffffu : 0u); } } \
        else { const int b_ = (it_) - 1024; const float* hist_ = a.state_conv + (size_t)b_ * (KW - 1) * DC + c0; const bf16* ub_ = a.UC + (size_t)(MP + b_ * DSQ) * DC + c0; \
            _Pragma("unroll") for (int r_ = 0; r_ < KW - 1; ++r_) { const f32x2 hv_ = *(const GAS f32x2*)(hist_ + (size_t)r_ * DC); rows[r_] = cvtpk(hv_.x, hv_.y); } \
            _Pragma("unroll") for (int r_ = 0; r_ < 8; ++r_) rows[KW - 1 + r_] = *(const GAS unsigned*)(ub_ + (size_t)r_ * DC); } } while (0)

#define CONV_COMPUTE(rows, orow) do { \
        float ax_[8], ay_[8]; \
        _Pragma("unroll") for (int j = 0; j < 8; ++j) { ax_[j] = bias.x; ay_[j] = bias.y; } \
        _Pragma("unroll") for (int r = 0; r < 8 + KW - 1; ++r) { const float vx_ = bf_lo(rows[r]), vy_ = bf_hi(rows[r]); \
            _Pragma("unroll") for (int j = 0; j < 8; ++j) { const int k = r - j; if (k >= 0 && k < KW) { \
                asm("v_fmac_f32 %0, %1, %2" : "+v"(ax_[j]) : "v"(w[k].x), "v"(vx_)); asm("v_fmac_f32 %0, %1, %2" : "+v"(ay_[j]) : "v"(w[k].y), "v"(vy_)); } } }     \
        f32x2 acc[8]; \
        _Pragma("unroll") for (int j = 0; j < 8; ++j) acc[j] = (f32x2){ax_[j], ay_[j]}; \
        float st[16]; \
        _Pragma("unroll") for (int j = 0; j < 8; ++j) { st[j] = acc[j].x + acc[j].y; st[8 + j] = acc[j].x * acc[j].x + acc[j].y * acc[j].y; } \
        _Pragma("unroll") for (int j = 0; j < 16; ++j) st[j] = wave_sum63(st[j]); \
        if (lane == 63) { _Pragma("unroll") for (int j = 0; j < 16; ++j) red[wave * 16 + j] = st[j]; } \
        __syncthreads(); \
        if (tid < 16) { float s = 0.f; _Pragma("unroll") for (int wv = 0; wv < 8; ++wv) s += red[wv * 16 + tid]; tot[tid] = s; } \
        __syncthreads(); \
        float q[8]; \
        _Pragma("unroll") for (int j = 0; j < 8; ++j) { const float mu = tot[j] * (1.0f / DC), var = __builtin_fmaxf(tot[8 + j] * (1.0f / DC) - mu * mu, 0.0f), rs = __builtin_amdgcn_rsqf(var + 1e-6f); \
            f32x2 y = (acc[j] - mu) * rs * lg + lb; y.x = y.x * fsigm(y.x); y.y = y.y * fsigm(y.y); acc[j] = y; q[j] = y.x * y.x + y.y * y.y; } \
        _Pragma("unroll") for (int j = 0; j < 8; ++j) q[j] = wave_sum63(q[j]); \
        if (lane == 63) { _Pragma("unroll") for (int j = 0; j < 8; ++j) red[128 + wave * 16 + j] = q[j]; } \
        __syncthreads(); \
        if (tid < 8) { float s = 0.f; _Pragma("unroll") for (int wv = 0; wv < 8; ++wv) s += red[128 + wv * 16 + tid]; tot[16 + tid] = s; } \
        __syncthreads(); \
        _Pragma("unroll") for (int j = 0; j < 8; ++j) { const float r2 = __builtin_amdgcn_rsqf(tot[16 + j] * (1.0f / DC) + 1e-6f); \
            *(GAS unsigned*)(a.MIX + (size_t)((orow) + j) * D + DC + c0) = cvtpk(acc[j].x * r2, acc[j].y * r2); } } while (0)

__device__ __forceinline__ void p2_conv(const P2Args& a, LAS unsigned char* lds, int idx, int cnt, int ibeg, int iend, int wave, int lane, int tid) {
    LAS float* red = (LAS float*)(lds + P2_RED_OFF);
    LAS float* tot = red + 256;
    const int c0 = 2 * tid;
    f32x2 w[KW];
#pragma unroll
    for (int k = 0; k < KW; ++k) w[k] = *(const GAS f32x2*)(a.conv_w + k * DC + c0);
    const f32x2 bias = *(const GAS f32x2*)(a.conv_b + c0), lg = *(const GAS f32x2*)(a.ln_g + c0), lb = *(const GAS f32x2*)(a.ln_b + c0);
    unsigned rows[8 + KW - 1], rowsN[8 + KW - 1];
    if (ibeg + idx < iend) CONV_LOAD_ROWS(rows, ibeg + idx);
    for (int it = ibeg + idx; it < iend; it += cnt) {
        const int itn = it + cnt;
        if (itn < iend) CONV_LOAD_ROWS(rowsN, itn);
        const int orow = it < 1024 ? (it >> 8) * SEQ + (it & 255) * 8 : MP + (it - 1024) * DSQ;
        CONV_COMPUTE(rows, orow);
#pragma unroll
        for (int r = 0; r < 8 + KW - 1; ++r) rows[r] = rowsN[r];
    }
    __syncthreads();
}
__device__ __forceinline__ void p2_conv_runs(const P2Args& a, LAS unsigned char* lds, int ci, int wave, int lane, int tid) {
    LAS float* red = (LAS float*)(lds + P2_RED_OFF);
    LAS float* tot = red + 256;
    const int c0 = 2 * tid;
    f32x2 w[KW];
#pragma unroll
    for (int k = 0; k < KW; ++k) w[k] = *(const GAS f32x2*)(a.conv_w + k * DC + c0);
    const f32x2 bias = *(const GAS f32x2*)(a.conv_b + c0), lg = *(const GAS f32x2*)(a.ln_g + c0), lb = *(const GAS f32x2*)(a.ln_b + c0);
    const int b = ci / 28, k28 = ci - b * 28, len = k28 < 4 ? 10 : 9, start = b * 256 + (k28 < 4 ? k28 * 10 : 40 + (k28 - 4) * 9);
    unsigned rows[8 + KW - 1], rowsS[8 + KW - 1], pfA[8], pfB[8];
    CONV_LOAD_ROWS(rows, start);
    { const int its = 1024 + ci; CONV_LOAD_ROWS(rowsS, its); }
    const bf16* ub = a.UC + (size_t)(b * SEQ) * DC + c0;
    const int t0s = (start & 255) * 8;
#pragma unroll
    for (int i = 0; i < 8; ++i) { pfA[i] = *(const GAS unsigned*)(ub + (size_t)(t0s + 8 + i) * DC); pfB[i] = *(const GAS unsigned*)(ub + (size_t)(t0s + 16 + i) * DC); }
    for (int n = 0; n < len; ++n) {
        const int t0 = t0s + 8 * n;
        unsigned pfC[8];
        { const int tn = t0 + 24; const int tc = tn + 7 < SEQ ? tn : SEQ - 8;
#pragma unroll
          for (int i = 0; i < 8; ++i) pfC[i] = *(const GAS unsigned*)(ub + (size_t)(tc + i) * DC); }
        CONV_COMPUTE(rows, b * SEQ + t0);
#pragma unroll
        for (int r = 0; r < KW - 1; ++r) rows[r] = rows[r + 8];
#pragma unroll
        for (int i = 0; i < 8; ++i) { rows[KW - 1 + i] = pfA[i]; pfA[i] = pfB[i]; pfB[i] = pfC[i]; }
    }
    CONV_COMPUTE(rowsS, MP + ci * DSQ);
    if (ci >= 4 && ci < 20) { const int its = 1024 + 112 + (ci - 4); CONV_LOAD_ROWS(rowsS, its); CONV_COMPUTE(rowsS, MP + (112 + ci - 4) * DSQ); }
    __syncthreads();
}

__device__ __forceinline__ void p2_newconv(const P2Args& a, int vcu, int G, int tid) {
    constexpr int NPV = BATCH * (KW - 1) * (DC / 4), NSV = DB * (KW - 1) * (DC / 4);
    for (int idx = vcu * (NWAVES * 64) + tid; idx < NPV + NSV; idx += G * NWAVES * 64) {
        if (idx < NPV) { const int c4 = idx & 255, j = (idx >> 8) % (KW - 1), b = idx / ((KW - 1) * 256);
            const v2u pk = *(const GAS v2u*)(a.UC + (size_t)(b * SEQ + SEQ - (KW - 1) + j) * DC + 4 * c4);
            const f32x4 v = {bf_lo(pk.x), bf_hi(pk.x), bf_lo(pk.y), bf_hi(pk.y)};
            *(GAS f32x4*)(a.ncp + (size_t)idx * 4) = v; }
        else { const int k = idx - NPV; const int c4 = k & 255, j = (k >> 8) % (KW - 1), b = k / ((KW - 1) * 256); const int id = j + DSQ; f32x4 v;
            if (id < KW - 1) v = *(const GAS f32x4*)(a.state_conv + ((size_t)b * (KW - 1) + id) * DC + 4 * c4);
            else { const v2u pk = *(const GAS v2u*)(a.UC + (size_t)(MP + b * DSQ + id - (KW - 1)) * DC + 4 * c4); v = (f32x4){bf_lo(pk.x), bf_hi(pk.x), bf_lo(pk.y), bf_hi(pk.y)}; }
            *(GAS f32x4*)(a.ncs + (size_t)k * 4) = v; }
    }
}

#define SSM_STEP(i) do { \
        const float nAr = __builtin_fmaf(aAr, hAr, __builtin_fmaf(-aAi, hAi, d00[i])), nAi = __builtin_fmaf(aAr, hAi, __builtin_fmaf(aAi, hAr, d01[i])); \
        const float nBr = __builtin_fmaf(aBr, hBr, __builtin_fmaf(-aBi, hBi, d10[i])), nBi = __builtin_fmaf(aBr, hBi, __builtin_fmaf(aBi, hBr, d11[i])); \
        hAr = nAr; hAi = nAi; hBr = nBr; hBi = nBi; } while (0)
#define SSM_MFMA(afrag) do { const f32x16 z16 = {0.f,0.f,0.f,0.f,0.f,0.f,0.f,0.f,0.f,0.f,0.f,0.f,0.f,0.f,0.f,0.f}; \
        d00 = __builtin_amdgcn_mfma_f32_32x32x16_bf16(afrag, bfr[0][0], z16, 0, 0, 0); d01 = __builtin_amdgcn_mfma_f32_32x32x16_bf16(afrag, bfr[0][1], z16, 0, 0, 0); \
        d10 = __builtin_amdgcn_mfma_f32_32x32x16_bf16(afrag, bfr[1][0], z16, 0, 0, 0); d11 = __builtin_amdgcn_mfma_f32_32x32x16_bf16(afrag, bfr[1][1], z16, 0, 0, 0); } while (0)
#define SSM_PUT_U(afrag) do { *(LAS bf16x8*)(utile + (s_r * 16 + i_r) * 32 + kc * 16) = afrag; } while (0)
#define SSM_EMIT(rowb0, rowb1) do { \
        LDS_WAIT(); __builtin_amdgcn_wave_barrier(); \
        _Pragma("unroll") for (int s_ = 0; s_ < 2; ++s_) { \
            f32x4 y_ = {0.f, 0.f, 0.f, 0.f}; \
            _Pragma("unroll") for (int ks = 0; ks < 4; ++ks) { const bf16x8 hf = *(const LAS bf16x8*)(tile + s_ * P2_TILE_B + (lane & 15) * P2_TROW + ks * 64 + (lane >> 4) * 16); \
                y_ = __builtin_amdgcn_mfma_f32_16x16x32_bf16(hf, cfr[ks], y_, 0, 0, 0); } \
            const int rb_ = s_ ? (rowb1) : (rowb0); float v_[4]; \
            _Pragma("unroll") for (int i_ = 0; i_ < 4; ++i_) { const unsigned short ub_ = *(const LAS unsigned short*)(utile + (s_ * 16 + 4 * (lane >> 4) + i_) * 32 + (lane & 15) * 2); \
                v_[i_] = gelu_tanh_f(y_[i_] + dsk * __builtin_bit_cast(float, (unsigned)ub_ << 16)); } \
            const unsigned w01_ = cvtpk(v_[0], v_[1]), w23_ = cvtpk(v_[2], v_[3]); \
            bf16* go_ = a.G + (size_t)(rb_ + 4 * (lane >> 4)) * DS + g * CH + (lane & 15); \
            go_[0] = (bf16)w01_; go_[DS] = (bf16)(w01_ >> 16); go_[2 * DS] = (bf16)w23_; go_[3 * DS] = (bf16)(w23_ >> 16); } \
        LDS_WAIT(); __builtin_amdgcn_wave_barrier(); } while (0)
#define SSM_TILE_ROW(i) do { v2u hw_; hw_.x = cvtpk(hAr, hAi); hw_.y = cvtpk(hBr, hBi); *(LAS v2u*)(mytile + (i) * P2_TROW) = hw_; } while (0)

__device__ __forceinline__ void p2_ssm(const P2Args& a, LAS unsigned char* lds, int vcu, int G, int wave, int lane, int tid) {
    const int col = lane & 31, half = lane >> 5;
    const int r = lane & 31, s_r = (r >> 2) & 1, i_r = (r & 3) + 4 * (r >> 3), kc = lane >> 5;
    LAS unsigned char* tile = lds + P2_TILE_OFF + wave * 2 * P2_TILE_B;
    LAS unsigned char* mytile = tile + half * P2_TILE_B + col * 8;
    LAS unsigned char* utile = lds + P2_UT_OFF + wave * 1024;
    LAS f32x4* SX = (LAS f32x4*)(lds + P2_SX_OFF);
    for (int it = vcu; it < BATCH * NG; it += G) {
        const int g = it & (NG - 1), pb = it >> 6;
        const float* AB = (const float*)(a.tab + TAB_AB) + (size_t)(g * NP + 2 * col) * 2;
        const f32x4 ab4 = *(const GAS f32x4*)AB;
        const float aAr = ab4.x, aAi = ab4.y, aBr = ab4.z, aBi = ab4.w;
        bf16x8 bfr[2][2], cfr[4];
#pragma unroll
        for (int pair = 0; pair < 2; ++pair)
#pragma unroll
            for (int ri = 0; ri < 2; ++ri) bfr[pair][ri] = *(const GAS bf16x8*)((const bf16*)(a.tab + TAB_BBT) + ((size_t)(g * 2 + ri) * NP + 2 * col + pair) * CH + 8 * kc);
#pragma unroll
        for (int ks = 0; ks < 4; ++ks) cfr[ks] = *(const GAS bf16x8*)((const bf16*)(a.tab + TAB_CQ) + ((size_t)g * CH + (lane & 15)) * 128 + 32 * ks + 8 * (lane >> 4));
        const float dsk = a.Dk[g * CH + (lane & 15)];
        f32x16 d00, d01, d10, d11;
        {
            const bf16* abase = a.SI + (size_t)(pb * SEQ + (2 * wave + s_r) * 128 + i_r) * DS + g * CH + 8 * kc;
            float hAr = 0.f, hAi = 0.f, hBr = 0.f, hBi = 0.f;
            bf16x8 a0 = *(const GAS bf16x8*)abase, a1 = *(const GAS bf16x8*)(abase + (size_t)1 * 16 * DS), a2 = *(const GAS bf16x8*)(abase + (size_t)2 * 16 * DS), a3 = *(const GAS bf16x8*)(abase + (size_t)3 * 16 * DS);
#pragma unroll 1
            for (int blk = 0; blk < 8; ++blk) {
                const bf16x8 an = *(const GAS bf16x8*)(abase + (size_t)((blk + 4) & 7) * 16 * DS);
                SSM_MFMA(a0);
#pragma unroll
                for (int i = 0; i < 16; ++i) SSM_STEP(i);
                a0 = a1; a1 = a2; a2 = a3; a3 = an;
            }
            __syncthreads();
            SX[(2 * wave + half) * 32 + col] = (f32x4){hAr, hAi, hBr, hBi};
            __syncthreads();
            float pAr = aAr, pAi = aAi, pBr = aBr, pBi = aBi;
#pragma unroll
            for (int sq = 0; sq < 7; ++sq) { const float t0 = pAr * pAr - pAi * pAi, t1 = 2.0f * pAr * pAi, t2 = pBr * pBr - pBi * pBi, t3 = 2.0f * pBr * pBi; pAr = t0; pAi = t1; pBr = t2; pBi = t3; }
            hAr = 0.f; hAi = 0.f; hBr = 0.f; hBi = 0.f;
            const int mine = 2 * wave + half;
            for (int s2 = 0; s2 < mine; ++s2) { const f32x4 sv = SX[s2 * 32 + col];
                const float nAr = pAr * hAr - pAi * hAi + sv.x, nAi = pAr * hAi + pAi * hAr + sv.y, nBr = pBr * hBr - pBi * hBi + sv.z, nBi = pBr * hBi + pBi * hBr + sv.w;
                hAr = nAr; hAi = nAi; hBr = nBr; hBi = nBi; }
#pragma unroll 1
            for (int blk = 0; blk < 8; ++blk) {
                const bf16x8 an = *(const GAS bf16x8*)(abase + (size_t)((blk + 4) & 7) * 16 * DS);
                SSM_MFMA(a0);
                SSM_PUT_U(a0);
#pragma unroll
                for (int i = 0; i < 16; ++i) { SSM_STEP(i); SSM_TILE_ROW(i); }
                const int rb = pb * SEQ + (2 * wave) * 128 + blk * 16;
                SSM_EMIT(rb, rb + 128);
                a0 = a1; a1 = a2; a2 = a3; a3 = an;
            }
            if (mine == 15) { const size_t o = ((size_t)pb * NG + g) * NP + 2 * col;
                *(GAS f32x2*)(a.nrp + o) = (f32x2){hAr, hBr}; *(GAS f32x2*)(a.nip + o) = (f32x2){hAi, hBi}; }
        }
        {
            const int bA_load = 32 * pb + 4 * wave + 2 * s_r, bA = 32 * pb + 4 * wave + 2 * half;
            const bf16x8 afS = *(const GAS bf16x8*)(a.SI + (size_t)(MP + bA_load * DSQ + i_r) * DS + g * CH + 8 * kc);
            size_t o = ((size_t)bA * NG + g) * NP + 2 * col;
            f32x2 t0 = *(const GAS f32x2*)(a.h0re + o), t1 = *(const GAS f32x2*)(a.h0im + o);
            SSM_MFMA(afS);
            SSM_PUT_U(afS);
            float hAr = t0.x, hBr = t0.y, hAi = t1.x, hBi = t1.y;
#pragma unroll
            for (int i = 0; i < 8; ++i) { SSM_STEP(i); SSM_TILE_ROW(i); }
            *(GAS f32x2*)(a.nrs + o) = (f32x2){hAr, hBr}; *(GAS f32x2*)(a.nis + o) = (f32x2){hAi, hBi};
            o += (size_t)NG * NP;
            t0 = *(const GAS f32x2*)(a.h0re + o); t1 = *(const GAS f32x2*)(a.h0im + o);
            hAr = t0.x; hBr = t0.y; hAi = t1.x; hBi = t1.y;
#pragma unroll
            for (int i = 8; i < 16; ++i) { SSM_STEP(i); SSM_TILE_ROW(i); }
            *(GAS f32x2*)(a.nrs + o) = (f32x2){hAr, hBr}; *(GAS f32x2*)(a.nis + o) = (f32x2){hAi, hBi};
            const int rb = MP + (32 * pb + 4 * wave) * DSQ;
            SSM_EMIT(rb, rb + 16);
        }
    }
    __syncthreads();
}

#ifndef NP_P1
#define NP_P1 0
#endif
#ifndef NP_P3
#define NP_P3 0
#endif
#ifndef NP_P5
#define NP_P5 16
#endif
#ifndef NP_P6
#define NP_P6 32
#endif
#ifndef NP_P7
#define NP_P7 16
#endif
struct Args { const float* in[28]; float* out; unsigned char* ws; int lo, hi, dryk, li; };
__global__ void __launch_bounds__(NWAVES * 64, 2) mk_fwd(Args args) {
    __shared__ __attribute__((aligned(16))) unsigned char lds_raw[LDS_BYTES];
    LAS unsigned char* lds = (LAS unsigned char*)lds_raw;
    volatile LAS unsigned* MISC = (volatile LAS unsigned*)(lds + MISC_OFF);
    const int tid = threadIdx.x, lane = tid & 63, wave = __builtin_amdgcn_readfirstlane(tid >> 6);
    const int G = gridDim.x; const int bx = blockIdx.x; const int vcu = (G % 8 == 0) ? (bx % 8) * (G / 8) + bx / 8 : bx;
    unsigned char* ws = args.ws;
    gu32* ctl = (gu32*)(ws + WS_CTL);
    for (int u = tid; u < (LDS_BYTES - LDSCTL_OFF) / 4; u += NWAVES * 64) ((LAS unsigned*)(lds + LDSCTL_OFF))[u] = 0u;
    __syncthreads();
    XcdBarrier bar; bar.bar = (unsigned*)(ctl + CW_BAR) + args.li * XCD_BAR_WORDS; bar.x = 0; bar.st = nullptr;
    if (N_LAUNCHES != NPH) bar = xcd_barrier_post((unsigned*)(ctl + CW_BAR) + args.li * XCD_BAR_WORDS, MISC + 8);
#ifndef STAMP_BX
#define STAMP_BX 0
#endif
#ifdef STAMP_A
#define STAMP(i) do { if (blockIdx.x == STAMP_BX && tid == 0) { const unsigned long long t_ = __builtin_amdgcn_s_memrealtime(); MISC[12 + 2 * (i)] = (unsigned)t_; MISC[13 + 2 * (i)] = (unsigned)(t_ >> 32); } } while (0)
#else
#define STAMP(i) do { } while (0)
#endif
    STAMP(0);
#define GRID_BAR(seam) do { GRID_BAR_(seam); STAMP((seam) + 1); } while (0)
#define GRID_BAR_(seam) do { if (N_LAUNCHES == NPH) { if (tid == 0) __hip_atomic_store(ctl + CW_TMO, 0xBADBA0u | (unsigned)(seam), RLX_AGENT); } else { xcd_barrier(bar); } } while (0)
    const int lo = args.lo, hi = args.hi, dryk = args.dryk;
#define DRY(k) (dryk == (k))
#ifndef ONLY_PHASE
#define ONLY_PHASE -1
#endif
#define IN(k) (ONLY_PHASE < 0 ? (lo <= (k) && (k) < hi) : (k) == ONLY_PHASE)
#define BOTH(k) (IN(k) && IN((k) + 1))
    float* out = args.out;
    float* Y = out;
    float* ncp = out + (size_t)M * D;
    float* nrp = ncp + (size_t)BATCH * (KW - 1) * DC;
    float* nip = nrp + (size_t)BATCH * NG * NP;
    float* ncs = nip + (size_t)BATCH * NG * NP;
    float* nrs = ncs + (size_t)DB * (KW - 1) * DC;
    float* nis = nrs + (size_t)DB * NG * NP;
    bf16 *WGU = (bf16*)(ws + WS_WGU), *WDN = (bf16*)(ws + WS_WDN), *XB = (bf16*)(ws + WS_XB), *WIN = (bf16*)(ws + WS_WIN), *WGL = (bf16*)(ws + WS_WGL), *WOUT = (bf16*)(ws + WS_WOUT);
    bf16 *UC = (bf16*)(ws + WS_U), *SI = (bf16*)(ws + WS_S), *GB = (bf16*)(ws + WS_G), *MIX = (bf16*)(ws + WS_MIX), *ACT = (bf16*)(ws + WS_ACT);
    float* ssq_dummy = (float*)(ws + WS_CTL) + CW_DUMMY;
    float* ssq_s = (float*)(ws + WS_CTL) + CW_SSQ_S; float* ssq_h = (float*)(ws + WS_CTL) + CW_SSQ_H; float* ssq_o = (float*)(ws + WS_CTL) + CW_SSQ_O; float* rx = (float*)(ws + WS_CTL) + CW_RX;
    const int gw = vcu * NWAVES + wave, NGW = G * NWAVES;

    if (IN(0)) {
        P0Args a; a.xp = args.in[0]; a.xs = args.in[1]; a.norm_mix = args.in[5]; a.w_in = args.in[6]; a.w_glu = args.in[19]; a.gn_conv = args.in[20]; a.gn_ssm = args.in[21]; a.w_out = args.in[22];
        a.norm_ffn = args.in[23]; a.w_gate = args.in[24]; a.w_up = args.in[25]; a.w_down = args.in[26];
        a.A_re = args.in[11]; a.A_im = args.in[12]; a.log_dt = args.in[13]; a.B_re = args.in[14]; a.B_im = args.in[15]; a.C_re = args.in[16]; a.C_im = args.in[17];
        a.WIN = WIN; a.WGL = WGL; a.WOUT = WOUT; a.WGU = WGU; a.WDN = WDN; a.XB = XB; a.rx = rx; a.tab = ws + WS_TAB;
        STAMP(13);
        p0_prologue(a, lds, vcu, G, wave, lane, tid); STAMP(14);
        if (BOTH(0)) GRID_BAR(0);
    }
    if (IN(1)) {
        pg8::Gemm g{XB, WIN, M, DIN, D};
#define SCHED(slot, slabo, N_, K_, NP_, RS_, MID_) typedef pg8::HybridOrder<N_, K_, NP_, RS_, MID_> Sch; Sch S; S.init((int)blockIdx.x, ws + (slabo), (unsigned*)(ctl + CW_FLAGS + (slot) * FLAG_SLOT), (unsigned*)(ctl + CW_TMO))
        SCHED(0, SLAB_P1, DIN, D, NP_P1, 0, 0);
        pg8::EpiIn E{UC, SI, rx};
        pg8::gemm_phase<pg8::EpiIn, Sch, true, true>(lds + RING_OFF, g, S, E);
        {
            static_assert(Sch::R == 2 && Sch::np == 1, "P1 runs two static rounds");
            constexpr int BUSY = Sch::q - Sch::per, IDLE = Sch::per - BUSY;
            const int jx = (int)blockIdx.x >> 3, xx = (int)blockIdx.x & 7;
            P0Args a; a.xp = args.in[0]; a.xs = args.in[1]; a.norm_mix = args.in[5]; a.w_in = args.in[6]; a.w_glu = args.in[19]; a.gn_conv = args.in[20]; a.gn_ssm = args.in[21]; a.w_out = args.in[22];
            a.norm_ffn = args.in[23]; a.w_gate = args.in[24]; a.w_up = args.in[25]; a.w_down = args.in[26];
            a.A_re = args.in[11]; a.A_im = args.in[12]; a.log_dt = args.in[13]; a.B_re = args.in[14]; a.B_im = args.in[15]; a.C_re = args.in[16]; a.C_im = args.in[17];
            a.WIN = WIN; a.WGL = WGL; a.WOUT = WOUT; a.WGU = WGU; a.WDN = WDN; a.XB = XB; a.rx = rx; a.tab = ws + WS_TAB;
            if (G != 256) p0_convert(a, lds, vcu * NWAVES + wave, G * NWAVES, P0_ITEMS_B, P0_ITEMS_ALL, wave, lane);
            if (G != 256) p0_tables(a, vcu * (NWAVES * 64) + tid); else if (jx >= BUSY) p0_tables(a, (xx * IDLE + (jx - BUSY)) * (NWAVES * 64) + tid);
            if (G == 256 && jx >= BUSY) p0_convert(a, lds, (xx * IDLE + (jx - BUSY)) * NWAVES + wave, 8 * IDLE * NWAVES, P0_ITEMS_B, P0_ITEMS_ALL, wave, lane);
        }
        if (BOTH(1)) GRID_BAR(1);
    }
    if (IN(2)) {
        P2Args a; a.UC = UC; a.SI = SI; a.G = GB; a.MIX = MIX; a.state_conv = args.in[2]; a.h0re = args.in[3]; a.h0im = args.in[4];
        a.conv_w = args.in[7]; a.conv_b = args.in[8]; a.ln_g = args.in[9]; a.ln_b = args.in[10]; a.Dk = args.in[18]; a.tab = ws + WS_TAB;
        a.ncp = ncp; a.nrp = nrp; a.nip = nip; a.ncs = ncs; a.nrs = nrs; a.nis = nis;
        p2_ssm(a, lds, vcu, G, wave, lane, tid); STAMP(10);
        if (BOTH(2)) GRID_BAR(2);
    }
    if (IN(3)) {
        constexpr int P3_OWNERS = (M / 256) * (DS / 256) / 8;
        const int jx = (int)blockIdx.x >> 3, xx = (int)blockIdx.x & 7;
        P2Args a; a.UC = UC; a.SI = SI; a.G = GB; a.MIX = MIX; a.state_conv = args.in[2]; a.h0re = args.in[3]; a.h0im = args.in[4];
        a.conv_w = args.in[7]; a.conv_b = args.in[8]; a.ln_g = args.in[9]; a.ln_b = args.in[10]; a.Dk = args.in[18]; a.tab = ws + WS_TAB;
        a.ncp = ncp; a.nrp = nrp; a.nip = nip; a.ncs = ncs; a.nrs = nrs; a.nis = nis;
        constexpr int NCW = 8 * (32 - P3_OWNERS), CONV_A = 1024 + DB;
        if (G != 256) { p2_conv(a, lds, vcu, G, 0, 1024 + DB, wave, lane, tid); p2_newconv(a, vcu, G, tid);
            { P0Args pa; pa.xp = args.in[0]; pa.xs = args.in[1]; pa.norm_mix = args.in[5]; pa.w_in = args.in[6]; pa.w_glu = args.in[19]; pa.gn_conv = args.in[20]; pa.gn_ssm = args.in[21]; pa.w_out = args.in[22];
              pa.norm_ffn = args.in[23]; pa.w_gate = args.in[24]; pa.w_up = args.in[25]; pa.w_down = args.in[26];
              pa.A_re = args.in[11]; pa.A_im = args.in[12]; pa.log_dt = args.in[13]; pa.B_re = args.in[14]; pa.B_im = args.in[15]; pa.C_re = args.in[16]; pa.C_im = args.in[17];
              pa.WIN = WIN; pa.WGL = WGL; pa.WOUT = WOUT; pa.WGU = WGU; pa.WDN = WDN; pa.XB = XB; pa.rx = rx; pa.tab = ws + WS_TAB;
              __syncthreads(); p0_convert(pa, lds, vcu * NWAVES + wave, G * NWAVES, P0_ITEMS_A, P0_ITEMS_B, wave, lane); __syncthreads(); }
            pg8::Gemm g{GB, WGL, M, DS, DS}; SCHED(1, SLAB_P3, DS, DS, NP_P3, 0, 0); pg8::EpiGlu E{GB, MIX, DRY(3) ? ssq_dummy : ssq_s};
            pg8::gemm_phase<pg8::EpiGlu, Sch, true, true>(lds + RING_OFF, g, S, E); }
        else if (jx < P3_OWNERS) {
            pg8::Gemm g{GB, WGL, M, DS, DS}; SCHED(1, SLAB_P3, DS, DS, NP_P3, 0, 0);
            pg8::EpiGlu E{GB, MIX, DRY(3) ? ssq_dummy : ssq_s};
            pg8::gemm_phase<pg8::EpiGlu, Sch, true, true>(lds + RING_OFF, g, S, E);
            __syncthreads();
            { P0Args pa; pa.xp = args.in[0]; pa.xs = args.in[1]; pa.norm_mix = args.in[5]; pa.w_in = args.in[6]; pa.w_glu = args.in[19]; pa.gn_conv = args.in[20]; pa.gn_ssm = args.in[21]; pa.w_out = args.in[22];
              pa.norm_ffn = args.in[23]; pa.w_gate = args.in[24]; pa.w_up = args.in[25]; pa.w_down = args.in[26];
              pa.A_re = args.in[11]; pa.A_im = args.in[12]; pa.log_dt = args.in[13]; pa.B_re = args.in[14]; pa.B_im = args.in[15]; pa.C_re = args.in[16]; pa.C_im = args.in[17];
              pa.WIN = WIN; pa.WGL = WGL; pa.WOUT = WOUT; pa.WGU = WGU; pa.WDN = WDN; pa.XB = XB; pa.rx = rx; pa.tab = ws + WS_TAB;
              p0_convert(pa, lds, (xx * P3_OWNERS + jx) * NWAVES + wave, 8 * P3_OWNERS * NWAVES, P0_ITEMS_A, P0_ITEMS_B, wave, lane); }
        } else {
            const int ci = xx * (32 - P3_OWNERS) + (jx - P3_OWNERS);
            static_assert(NCW == 112, "p2_conv_runs: 28 workgroups per prompt batch");
            p2_conv_runs(a, lds, ci, wave, lane, tid); STAMP(11);
            p2_newconv(a, ci, NCW, tid); STAMP(12);
        }
        if (BOTH(3)) GRID_BAR(3);
    }
    if (IN(5)) {
        pg8::Gemm g{MIX, WOUT, M, D, D}; SCHED(2, SLAB_P5, D, D, NP_P5, 8, 16);
        pg8::EpiOut E{XB, DRY(5) ? ssq_dummy : ssq_h, ssq_s};
        static_assert(Sch::S == 8 && Sch::ntp == 16, "remainder segments of 2 K-tile pairs never straddle K-tile 16");
        pg8::gemm_phase<pg8::EpiOut, Sch, true, true>(lds + RING_OFF, g, S, E);
        if (BOTH(5)) GRID_BAR(5);
    }
    if (IN(6)) {
        pg8::Gemm g{XB, WGU, M, 2 * DFF, D}; SCHED(3, SLAB_P6, 2 * DFF, D, NP_P6, 5, 0);
        pg8::EpiUp E{ACT, ssq_h};
        pg8::gemm_phase<pg8::EpiUp, Sch, true, true>(lds + RING_OFF, g, S, E);
        if (BOTH(6)) GRID_BAR(6);
    }
    if (IN(7)) {
        pg8::Gemm g{ACT, WDN, M, D, DFF}; SCHED(4, SLAB_P7, D, DFF, NP_P7, 8, 0);
        pg8::EpiDown E{XB, DRY(7) ? ssq_dummy : ssq_o, DRY(7) ? 0.0f : 1.0f};
        pg8::gemm_phase<pg8::EpiDown, Sch, true, true>(lds + RING_OFF, g, S, E);
        if (BOTH(7)) GRID_BAR(7);
    }
    if (IN(8)) {
        const float* gfin = args.in[27];
        for (int row = gw; row < M; row += NGW) {
            const float r = 1.0f / sqrtf(__hip_atomic_load(ssq_o + row, RLX_AGENT) * (1.0f / D) + 1e-6f);
            const GAS v4u* ob = (const GAS v4u*)(XB + (size_t)row * D) + lane; GAS f32x4* p = (GAS f32x4*)(Y + (size_t)row * D) + 2 * lane; const GAS f32x4* gp = (const GAS f32x4*)gfin + 2 * lane;
#pragma unroll
            for (int j = 0; j < 4; ++j) { const v4u w = ob[64 * j];
                p[128 * j] = (f32x4){bf_lo(w.x), bf_hi(w.x), bf_lo(w.y), bf_hi(w.y)} * r * gp[128 * j];
                p[128 * j + 1] = (f32x4){bf_lo(w.z), bf_hi(w.z), bf_lo(w.w), bf_hi(w.w)} * r * gp[128 * j + 1]; }
        }
    }
#ifdef STAMP_A
    STAMP(9);
    if (blockIdx.x == STAMP_BX && tid == 0) {
        const unsigned long long ta = ((unsigned long long)MISC[13 + 2 * STAMP_A] << 32) | MISC[12 + 2 * STAMP_A], tb = ((unsigned long long)MISC[13 + 2 * STAMP_B] << 32) | MISC[12 + 2 * STAMP_B];
        const unsigned long long d = tb - ta, t0 = __builtin_amdgcn_s_memrealtime();
        while (__builtin_amdgcn_s_memrealtime() - t0 < d) __builtin_amdgcn_s_sleep(8);
    }
#endif
#undef DRY
#undef IN
#undef BOTH
#undef GRID_BAR
#undef GRID_BAR_
#undef STAMP
}

extern "C" void kernel_launch(void* const* d_in, const int* in_sizes, int n_in, void* d_out, int out_size, void* d_ws, size_t ws_size, hipStream_t stream) {
    static int grid = 0;
    if (grid == 0) {
        const long want_out = (long)M * D + (long)(BATCH + DB) * ((KW - 1) * DC + 2 * NG * NP);
        if (n_in != 28 || in_sizes[0] != MP * D || (long)out_size != want_out || ws_size < WS_END) {
            fprintf(stderr, "kernel_launch: unexpected shapes (n_in %d, in0 %d, out %d (want %ld), ws %zu (need %zu)); nothing launched\n", n_in, n_in > 0 ? in_sizes[0] : -1, out_size, want_out, ws_size, (size_t)WS_END); grid = -1; return; }
        int dev = 0, cus = 0;
        if (hipGetDevice(&dev) != hipSuccess || hipDeviceGetAttribute(&cus, hipDeviceAttributeMultiprocessorCount, dev) != hipSuccess) { fprintf(stderr, "kernel_launch: device query failed\n"); grid = -1; return; }
        if (cus != 256) fprintf(stderr, "kernel_launch: built for 256 CUs, device has %d\n", cus);
        grid = 256;
    }
    if (grid < 0) return;
    if (hipMemsetAsync((char*)d_ws + WS_CTL, 0, CTL_ZERO_BYTES, stream) != hipSuccess) { fprintf(stderr, "kernel_launch: memset failed\n"); return; }
    Args a{};
    for (int i = 0; i < 28; ++i) a.in[i] = (const float*)d_in[i];
    a.out = (float*)d_out; a.ws = (unsigned char*)d_ws;
#ifdef PROBE_PHASE
    constexpr int NL = 2;
#else
    constexpr int NL = N_LAUNCHES;
#endif
    for (int li = 0; li < NL; ++li) {
        a.dryk = -1;
        if (N_LAUNCHES == NPH) { a.lo = li; a.hi = li + 1; } else { a.lo = 0; a.hi = NPH; }
#ifdef PROBE_PHASE
        if (li == 0) { a.lo = 0; a.hi = PROBE_PHASE + 1; } else { a.lo = PROBE_PHASE; a.hi = NPH; a.dryk = PROBE_PHASE; }
#endif
        a.li = li;
        hipLaunchKernelGGL(mk_fwd, dim3(grid), dim3(NWAVES * 64), 0, stream, a);
        const hipError_t le = hipPeekAtLastError();
        if (le != hipSuccess) { fprintf(stderr, "kernel_launch: launch %d failed: %s\n", li, hipGetErrorName(le)); break; }
    }
}
```

```cpp
#include <hip/hip_runtime.h>
#include <cstdio>
#include <cstdint>
#define MK_N_LAUNCHES 1
namespace pg8 {
#define PG8_LAS __attribute__((address_space(3)))
typedef unsigned short bf16_t;
typedef short bf16x8 __attribute__((ext_vector_type(8)));
typedef float f32x4 __attribute__((ext_vector_type(4)));
typedef unsigned u32x4 __attribute__((ext_vector_type(4)));
constexpr int BM = 256, BK = 64, HALF = 128, HTB = HALF * BK * 2  , STAGE_BYTES = 8 * HTB, NXCD = 8, WGM = 4;

__host__ __device__ __forceinline__ int lds_byte(int r, int c) { const int st = (r >> 4) * 2 + (c >> 5), rr = r & 15, cc = c & 31, ob = rr * 64 + cc * 2; return st * 1024 + (ob ^ (((ob >> 9) & 1) << 5)); }
__host__ __device__ __forceinline__ void stage_rc(int b, int& R, int& C) { const int st = b / 1024, sb = b % 1024, swz = sb ^ (((sb >> 9) & 1) << 5); R = (st >> 1) * 16 + swz / 64; C = (st & 1) * 32 + (swz % 64) / 2; }
__host__ __device__ __forceinline__ int perm32(int rho) { const int n = rho >> 4, i = rho & 15; return 8 * (i >> 2) + 4 * n + (i & 3); }

struct Unit { int pm, pn, k0, nt, mode, need; };
struct Gemm { const bf16_t* A; const bf16_t* Bt; int M, N, K; };

__device__ __forceinline__ unsigned cvt_pk_bf16(float lo, float hi) { unsigned r; asm volatile("v_cvt_pk_bf16_f32 %0, %1, %2" : "=v"(r) : "v"(lo), "v"(hi)); return r; }
template <class Epi, class Sched, bool ALIGN_EPI = false, bool SP2 = false>
__device__ __forceinline__ void gemm_phase(PG8_LAS unsigned char* lds, const Gemm g, Sched& S, const Epi& E) {
    const int tid = threadIdx.x, wid = __builtin_amdgcn_readfirstlane(tid >> 6), lane = tid & 63, wr = wid >> 2, wc = wid & 3, fr = lane & 15, fq = lane >> 4;
    constexpr int K = Sched::KK;
    unsigned voffA[2], voffB[2];
#pragma unroll
    for (int i = 0; i < 2; ++i) { int R, C; stage_rc(tid * 16 + i * 8192, R, C); const int Rb = Epi::PERM ? ((R & ~31) + perm32(R & 31)) : R;
        voffA[i] = (unsigned)(R * K + C) * 2u; voffB[i] = (unsigned)(Rb * K + C) * 2u; }
    const size_t kstep = (size_t)(BK * 2);
    const size_t hstep = (size_t)HALF * K * 2;
    const size_t tstep = 2 * hstep;
    const unsigned ldsw = (unsigned)wid * 1024u;
    const int aoff = lds_byte(wr * 64 + fr, fq * 8), boff = lds_byte(wc * 32 + fr, fq * 8);
#define PG8_SA(b, h) (((b) * 2 + (h)) * HTB)
#define PG8_SB(b, h) ((4 + (b) * 2 + (h)) * HTB)
#define PG8_STAGE(bufoff, gbase, voff) do { _Pragma("unroll") for (int _i = 0; _i < 2; ++_i) \
        __builtin_amdgcn_global_load_lds((const unsigned*)((const char*)(gbase) + (voff)[_i]), (PG8_LAS unsigned*)(lds + (bufoff) + ldsw + _i * 8192), 16, 0, 0); } while (0)
#define PG8_LDA(dst, b, h) do { _Pragma("unroll") for (int m = 0; m < 4; ++m) _Pragma("unroll") for (int k = 0; k < 2; ++k) dst[m][k] = *(const PG8_LAS bf16x8*)(lds + PG8_SA(b, h) + aoff + m * 2048 + k * 1024); } while (0)
#define PG8_LDB(dst, b, h) do { _Pragma("unroll") for (int n = 0; n < 2; ++n) _Pragma("unroll") for (int k = 0; k < 2; ++k) dst[n][k] = *(const PG8_LAS bf16x8*)(lds + PG8_SB(b, h) + boff + n * 2048 + k * 1024); } while (0)
#define PG8_MMA(ai, bj, At, Bt) do { __builtin_amdgcn_s_setprio(1); _Pragma("unroll") for (int m = 0; m < 4; ++m) _Pragma("unroll") for (int n = 0; n < 2; ++n) _Pragma("unroll") for (int k = 0; k < 2; ++k) \
        acc[ai][bj][m][n] = __builtin_amdgcn_mfma_f32_16x16x32_bf16(Bt[n][k], At[m][k], acc[ai][bj][m][n], 0, 0, 0); __builtin_amdgcn_s_setprio(0); } while (0)
#define PG8_WAIT_V(n) asm volatile("s_waitcnt vmcnt(" #n ")" ::: "memory")
#define PG8_WAIT_L(n) asm volatile("s_waitcnt lgkmcnt(" #n ")" ::: "memory")
#define PG8_BAR __builtin_amdgcn_s_barrier()
#define PG8_SCHED __builtin_amdgcn_sched_barrier(0)
    Unit cur, nxt; int ui = 0;
    if (!S.next(0, cur)) return;
    f32x4 acc[2][2][4][2];
#pragma unroll
    for (int a = 0; a < 2; ++a)
#pragma unroll
        for (int b = 0; b < 2; ++b)
#pragma unroll
            for (int m = 0; m < 4; ++m)
#pragma unroll
                for (int n = 0; n < 2; ++n) acc[a][b][m][n] = (f32x4){0.f, 0.f, 0.f, 0.f};
    bf16x8 At[4][2], B0[2][2], B1[2][2];
    const char* cA = (const char*)g.A + (size_t)cur.pm * tstep + (size_t)cur.k0 * kstep; const char* cB = (const char*)g.Bt + (size_t)cur.pn * tstep + (size_t)cur.k0 * kstep;
    S.a_ready(cur);
    if constexpr (SP2) {
        PG8_STAGE(PG8_SB(0, 0), cB, voffB); PG8_STAGE(PG8_SB(0, 1), cB + hstep, voffB); PG8_STAGE(PG8_SA(0, 0), cA, voffA); PG8_STAGE(PG8_SA(0, 1), cA + hstep, voffA);
        if (wr == 1) PG8_BAR;
        PG8_WAIT_V(2); PG8_BAR;
        PG8_STAGE(PG8_SB(1, 0), cB + kstep, voffB); PG8_STAGE(PG8_SA(1, 0), cA + kstep, voffA); PG8_STAGE(PG8_SB(1, 1), cB + hstep + kstep, voffB);
        PG8_WAIT_V(6); PG8_BAR;
    } else {
        PG8_STAGE(PG8_SB(0, 0), cB, voffB); PG8_STAGE(PG8_SA(0, 0), cA, voffA); PG8_STAGE(PG8_SB(0, 1), cB + hstep, voffB); PG8_STAGE(PG8_SA(0, 1), cA + hstep, voffA);
        if (wr == 1) PG8_BAR;
        PG8_WAIT_V(4); PG8_BAR;
        PG8_STAGE(PG8_SB(1, 0), cB + kstep, voffB); PG8_STAGE(PG8_SA(1, 0), cA + kstep, voffA); PG8_STAGE(PG8_SB(1, 1), cB + hstep + kstep, voffB);
        PG8_WAIT_V(6); PG8_BAR;
    }
    for (;;) {
        const bool has_next = S.next(ui + 1, nxt);
        const char* nA = has_next ? (const char*)g.A + (size_t)nxt.pm * tstep + (size_t)nxt.k0 * kstep : cA; const char* nB = has_next ? (const char*)g.Bt + (size_t)nxt.pn * tstep + (size_t)nxt.k0 * kstep : cB;
        const int nt = cur.nt;
        for (int t = 0; t < nt; t += 2) {
            const bool last = (t == nt - 2);
            const char* a1 = cA + (size_t)(t + 1) * kstep;
            const char* a2 = last ? nA : cA + (size_t)(t + 2) * kstep; const char* b2 = last ? nB : cB + (size_t)(t + 2) * kstep;
            const char* a3 = a2 + kstep; const char* b3 = b2 + kstep;
            if (last && has_next) S.a_ready(nxt);
            if constexpr (SP2) {
            PG8_LDB(B0, 0, 0); PG8_LDB(B1, 0, 1); PG8_SCHED; PG8_LDA(At, 0, 0); PG8_STAGE(PG8_SA(1, 1), a1 + hstep, voffA);
            PG8_WAIT_V(8); PG8_WAIT_L(0); PG8_BAR; PG8_MMA(0, 0, At, B0); PG8_MMA(0, 1, At, B1); PG8_BAR; PG8_SCHED;
            PG8_LDA(At, 0, 1); PG8_STAGE(PG8_SB(0, 0), b2, voffB); PG8_STAGE(PG8_SB(0, 1), b2 + hstep, voffB); PG8_STAGE(PG8_SA(0, 0), a2, voffA);
            PG8_WAIT_V(8); PG8_WAIT_L(0); PG8_BAR; PG8_MMA(1, 0, At, B0); PG8_MMA(1, 1, At, B1); PG8_BAR; PG8_SCHED;
            PG8_LDB(B0, 1, 0); PG8_LDB(B1, 1, 1); PG8_SCHED; PG8_LDA(At, 1, 0); PG8_STAGE(PG8_SA(0, 1), a2 + hstep, voffA);
            PG8_WAIT_V(8); PG8_WAIT_L(0); PG8_BAR; PG8_MMA(0, 0, At, B0); PG8_MMA(0, 1, At, B1); PG8_BAR; PG8_SCHED;
            PG8_LDA(At, 1, 1); PG8_STAGE(PG8_SB(1, 0), b3, voffB); PG8_STAGE(PG8_SB(1, 1), b3 + hstep, voffB); PG8_STAGE(PG8_SA(1, 0), a3, voffA);
            PG8_WAIT_V(8); PG8_WAIT_L(0); PG8_BAR; PG8_MMA(1, 0, At, B0); PG8_MMA(1, 1, At, B1); PG8_BAR; PG8_SCHED;
            } else {
            PG8_LDB(B0, 0, 0); PG8_SCHED; PG8_LDA(At, 0, 0); PG8_STAGE(PG8_SA(1, 1), a1 + hstep, voffA);
            PG8_WAIT_L(8); PG8_BAR; PG8_WAIT_L(0); PG8_MMA(0, 0, At, B0); PG8_BAR; PG8_SCHED;
            PG8_LDB(B1, 0, 1); PG8_STAGE(PG8_SB(0, 0), b2, voffB);
            PG8_BAR; PG8_WAIT_L(0); PG8_MMA(0, 1, At, B1); PG8_BAR;
            PG8_LDA(At, 0, 1); PG8_STAGE(PG8_SA(0, 0), a2, voffA);
            PG8_BAR; PG8_WAIT_L(0); PG8_MMA(1, 0, At, B0); PG8_BAR; PG8_SCHED;
            PG8_STAGE(PG8_SB(0, 1), b2 + hstep, voffB);
            PG8_WAIT_V(6); PG8_BAR; PG8_MMA(1, 1, At, B1); PG8_BAR;
            PG8_LDB(B0, 1, 0); PG8_SCHED; PG8_LDA(At, 1, 0); PG8_STAGE(PG8_SA(0, 1), a2 + hstep, voffA);
            PG8_WAIT_L(8); PG8_BAR; PG8_WAIT_L(0); PG8_MMA(0, 0, At, B0); PG8_BAR; PG8_SCHED;
            PG8_LDB(B1, 1, 1); PG8_STAGE(PG8_SB(1, 0), b3, voffB);
            PG8_BAR; PG8_WAIT_L(0); PG8_MMA(0, 1, At, B1); PG8_BAR;
            PG8_LDA(At, 1, 1); PG8_STAGE(PG8_SA(1, 0), a3, voffA);
            PG8_BAR; PG8_WAIT_L(0); PG8_MMA(1, 0, At, B0); PG8_BAR; PG8_SCHED;
            PG8_STAGE(PG8_SB(1, 1), b3 + hstep, voffB);
            PG8_WAIT_V(6); PG8_BAR; PG8_MMA(1, 1, At, B1); PG8_BAR;
            }
        }
        if constexpr (ALIGN_EPI) { if (wr == 0) PG8_BAR; }
        static_assert(ALIGN_EPI && !Epi::AFTER_DRAIN, "the slab exchange needs both halves aligned in the epilogue");
        S.finish(acc, cur, E, tid, wid, wr, wc, fr, fq);
        if (!has_next) break;
        if (cur.mode != 4)
#pragma unroll
        for (int a = 0; a < 2; ++a)
#pragma unroll
            for (int b = 0; b < 2; ++b)
#pragma unroll
                for (int m = 0; m < 4; ++m)
#pragma unroll
                    for (int n = 0; n < 2; ++n) acc[a][b][m][n] = (f32x4){0.f, 0.f, 0.f, 0.f};
        cur = nxt; cA = nA; cB = nB; ++ui;
        if constexpr (ALIGN_EPI) { if (wr == 1) PG8_BAR; }
    }
    PG8_WAIT_V(0);
    if constexpr (!ALIGN_EPI) { if (wr == 0) PG8_BAR; }
    PG8_BAR;
    S.finish_last(acc, cur, E, tid, wid, wr, wc, fr, fq);
#undef PG8_SA
#undef PG8_SB
#undef PG8_STAGE
#undef PG8_LDA
#undef PG8_LDB
#undef PG8_MMA
#undef PG8_WAIT_V
#undef PG8_WAIT_L
#undef PG8_BAR
#undef PG8_SCHED
}
}

namespace pg8 {
constexpr float RMS_EPS = 1e-6f;
__device__ __forceinline__ float fsig(float x) { return __builtin_amdgcn_rcpf(1.0f + __builtin_amdgcn_exp2f(x * -1.4426950408889634f)); }
typedef float f32x2 __attribute__((ext_vector_type(2)));
__device__ __forceinline__ f32x2 sig_arg2(f32x2 e) { e.x = __builtin_amdgcn_exp2f(e.x); e.y = __builtin_amdgcn_exp2f(e.y); e += 1.0f; e.x = __builtin_amdgcn_rcpf(e.x); e.y = __builtin_amdgcn_rcpf(e.y); return e; }
__device__ __forceinline__ float bflo(unsigned w) { return __builtin_bit_cast(float, w << 16); }
__device__ __forceinline__ float bfhi(unsigned w) { return __builtin_bit_cast(float, w & 0xffff0000u); }
__device__ __forceinline__ u32x4 pack8(const f32x4& a, const f32x4& b) { u32x4 w; w.x = cvt_pk_bf16(a[0], a[1]); w.y = cvt_pk_bf16(a[2], a[3]); w.z = cvt_pk_bf16(b[0], b[1]); w.w = cvt_pk_bf16(b[2], b[3]); return w; }
__device__ __forceinline__ float sq4(const f32x4& a) { return (a[0] * a[0] + a[1] * a[1]) + (a[2] * a[2] + a[3] * a[3]); }
__device__ __forceinline__ void row_atomic(float* p, float q, int fq) { q += __shfl_xor(q, 16); q += __shfl_xor(q, 32); if (fq == 0) (void)__hip_atomic_fetch_add(p, q, __ATOMIC_RELAXED, __HIP_MEMORY_SCOPE_AGENT); }


#define PG8_EPI_ALL __device__ __forceinline__ void operator()(const f32x4 (&acc)[2][2][4][2], const Unit& u, int wr, int wc, int fr, int fq) const { \
        grp<0, 0>(acc, u, wr, wc, fr, fq); grp<0, 1>(acc, u, wr, wc, fr, fq); grp<0, 2>(acc, u, wr, wc, fr, fq); grp<0, 3>(acc, u, wr, wc, fr, fq); \
        grp<1, 0>(acc, u, wr, wc, fr, fq); grp<1, 1>(acc, u, wr, wc, fr, fq); grp<1, 2>(acc, u, wr, wc, fr, fq); grp<1, 3>(acc, u, wr, wc, fr, fq); }
template <int N_, int K_, int NP_ = 32, int RS_ = 0, int MID_ = 0> struct HybridOrder {
    static constexpr size_t SLAB_BYTES = (size_t)BM * BM * 2;
    static constexpr int KK = K_, G = 256, nM = 9216 / BM, nN = N_ / BM, ntp = K_ / (2 * BK), nwg = nM * nN, per = G / 8, q = nwg / 8, R = NP_ > 0 ? q / per : (q + per - 1) / per, pairs = NP_ > 0 ? (q - R * per) * ntp : 0, np = NP_ <= 0 ? 1 : (NP_ < per ? NP_ : per), base = pairs / np, rem = pairs - base * np;
    static constexpr int Tr = q - R * per, S = RS_ > 0 ? RS_ : 1;
    static_assert(nwg % 8 == 0 && K_ % (2 * BK) == 0 && N_ % BM == 0 && (RS_ == 0 || (Tr * RS_ <= per && ntp >= RS_ && RS_ <= 8 && NP_ > 0)), "HybridOrder shapes");
    int x, j, rend, cur, vcu;
    unsigned char* slab; unsigned* flags; unsigned* tmo;
    __device__ __forceinline__ void init(int bx, unsigned char* slab_, unsigned* flags_, unsigned* tmo_) {
        x = bx & 7; j = bx >> 3;
        cur = j * base + (j < rem ? j : rem); rend = cur + base + (j < rem ? 1 : 0);
        if (j >= np) { cur = 0; rend = 0; }
        if (RS_ > 0) { cur = 0; rend = (j < Tr * S) ? 1 : 0; }
        vcu = x * per + j; slab = slab_; flags = flags_; tmo = tmo_;
    }
    __device__ __forceinline__ void tile_of(int wgid, Unit& u) const {
        constexpr int nig = WGM * nN; const int gid = wgid / nig, fm = gid * WGM, gsz = (nM - fm) < WGM ? (nM - fm) : WGM;
        u.pm = fm + ((wgid % nig) % gsz); u.pn = (wgid % nig) / gsz;
    }
    __device__ __forceinline__ bool next(int i, Unit& u) {
        if (MID_ > 0) { if (i < 2 * R) { const int ii = i >> 1; tile_of(x * q + ii * per + j, u); u.need = 0;
                if (i & 1) { u.k0 = MID_; u.nt = 2 * ntp - MID_; u.mode = 0; } else { u.k0 = 0; u.nt = MID_; u.mode = 4; } return true; } }
        else if (i < R) { if (i * per + j >= q) return false; tile_of(x * q + i * per + j, u); u.k0 = 0; u.nt = 2 * ntp; u.mode = 0; u.need = 0; return true; }
        if (cur >= rend) return false;
        if (RS_ > 0) { const int t = j / S, p = j - t * S; constexpr int b = ntp / S, e = ntp - b * S;
            tile_of(x * q + R * per + t, u); u.k0 = 2 * (p * b + (p < e ? p : e)); u.nt = 2 * (b + (p < e ? 1 : 0)); u.mode = 3; u.need = p; cur = rend; return true; }
        const int t = cur / ntp, off = cur - t * ntp; int len = ntp - off; if (len > rend - cur) len = rend - cur;
        tile_of(x * q + R * per + t, u); u.k0 = 2 * off; u.nt = 2 * len; u.need = ntp - off - len;
        u.mode = off > 0 ? 1 : (u.need > 0 ? 2 : 0);
        cur += len; return true;
    }
    __device__ __forceinline__ void a_ready(const Unit&) const {}
    template <class Epi> __device__ __forceinline__ void finish(f32x4 (&acc)[2][2][4][2], const Unit& u, const Epi& E, int tid, int wid, int wr, int wc, int fr, int fq) const {
        asm volatile("" : "+v"(tid), "+v"(fr), "+v"(fq));
        if constexpr (RS_ == 0 && NP_ > 0) if (u.mode == 1) {
            __amdgpu_buffer_rsrc_t rs = __builtin_amdgcn_make_buffer_rsrc(slab + (size_t)vcu * SLAB_BYTES, 0, (int)SLAB_BYTES, 0x00020000);
            const int vo = tid * 16;
#pragma unroll
            for (int ai = 0; ai < 2; ++ai)
#pragma unroll
                for (int bj = 0; bj < 2; ++bj)
#pragma unroll
                    for (int m = 0; m < 4; ++m) { __builtin_amdgcn_raw_buffer_store_b128(pack8(acc[ai][bj][m][0], acc[ai][bj][m][1]), rs, vo + (ai * 8 + bj * 4 + m) * 8192, 0, 16); asm volatile("" ::: "memory"); }
            asm volatile("s_waitcnt vmcnt(0)" ::: "memory");
            __builtin_amdgcn_s_barrier();
            if (tid == 0) __hip_atomic_store(flags + 64 * vcu, 1u, __ATOMIC_RELAXED, __HIP_MEMORY_SCOPE_AGENT);
            return;
        }
        if constexpr (Epi::MIDK > 0) { if (u.mode == 4) { E.midscale(acc, u, wr, fr); return; } }
        if (u.mode >= 2) return;
        E(acc, u, wr, wc, fr, fq);
    }
    template <class Epi> __device__ __forceinline__ void finish_rs(f32x4 (&acc)[2][2][4][2], const Unit& u, const Epi& E, int tid, int wid, int wr, int wc, int fr, int fq) const {
        const int p = u.need, first = vcu - p;
        if constexpr (Epi::MIDK > 0) { if (u.k0 + u.nt <= Epi::MIDK) E.midscale(acc, u, wr, fr); }
        { __amdgpu_buffer_rsrc_t rs = __builtin_amdgcn_make_buffer_rsrc(slab + (size_t)vcu * SLAB_BYTES, 0, (int)SLAB_BYTES, 0x00020000);
          const int vo = tid * 16;
#pragma unroll
          for (int ai = 0; ai < 2; ++ai)
#pragma unroll
              for (int bj = 0; bj < 2; ++bj)
#pragma unroll
                  for (int m = 0; m < 4; ++m) { __builtin_amdgcn_raw_buffer_store_b128(pack8(acc[ai][bj][m][0], acc[ai][bj][m][1]), rs, vo + (ai * 8 + bj * 4 + m) * 8192, 0, 16); asm volatile("" ::: "memory"); }
          asm volatile("s_waitcnt vmcnt(0)" ::: "memory");
          __builtin_amdgcn_s_barrier();
          if (tid == 0) __hip_atomic_store(flags + 64 * vcu, 1u, __ATOMIC_RELAXED, __HIP_MEMORY_SCOPE_AGENT); }
        if (wid == 0) {
            for (int k = 0; k < S; ++k) { unsigned sp = 0;
                while (__hip_atomic_load(flags + 64 * (first + k), __ATOMIC_RELAXED, __HIP_MEMORY_SCOPE_AGENT) == 0u) { __builtin_amdgcn_s_sleep(2);
                    if (++sp > (1u << 20)) { if (tid == 0) __hip_atomic_store(tmo, 0x5AB3u, __ATOMIC_RELAXED, __HIP_MEMORY_SCOPE_AGENT); break; } } }
            __builtin_amdgcn_fence(__ATOMIC_ACQUIRE, "agent"); asm volatile("s_waitcnt vmcnt(0)" ::: "memory");
        }
        asm volatile("" ::: "memory"); __builtin_amdgcn_s_barrier(); asm volatile("" ::: "memory");
        const u32x4* sl0 = (const u32x4*)(slab + (size_t)first * SLAB_BYTES) + tid;
#define PG8_RS_GROUP(AI, MM) if ((AI * 4 + MM) % S == p) { u32x4 w0[S], w1[S]; \
            _Pragma("unroll") for (int k = 0; k < S; ++k) { const u32x4* sk = sl0 + (size_t)k * (SLAB_BYTES / 16); w0[k] = sk[(AI * 8 + MM) * 512]; w1[k] = sk[(AI * 8 + 4 + MM) * 512]; } \
            f32x4 a00 = {0.f, 0.f, 0.f, 0.f}, a01 = a00, a10 = a00, a11 = a00; \
            _Pragma("unroll") for (int k = 0; k < S; ++k) { a00 += (f32x4){bflo(w0[k].x), bfhi(w0[k].x), bflo(w0[k].y), bfhi(w0[k].y)}; a01 += (f32x4){bflo(w0[k].z), bfhi(w0[k].z), bflo(w0[k].w), bfhi(w0[k].w)}; \
                a10 += (f32x4){bflo(w1[k].x), bfhi(w1[k].x), bflo(w1[k].y), bfhi(w1[k].y)}; a11 += (f32x4){bflo(w1[k].z), bfhi(w1[k].z), bflo(w1[k].w), bfhi(w1[k].w)}; } \
            acc[AI][0][MM][0] = a00; acc[AI][0][MM][1] = a01; acc[AI][1][MM][0] = a10; acc[AI][1][MM][1] = a11; \
            E.template grp<AI, MM>(acc, u, wr, wc, fr, fq); }
        PG8_RS_GROUP(0, 0) PG8_RS_GROUP(0, 1) PG8_RS_GROUP(0, 2) PG8_RS_GROUP(0, 3) PG8_RS_GROUP(1, 0) PG8_RS_GROUP(1, 1) PG8_RS_GROUP(1, 2) PG8_RS_GROUP(1, 3)
#undef PG8_RS_GROUP
    }
    template <class Epi> __device__ __forceinline__ void finish_last(f32x4 (&acc)[2][2][4][2], const Unit& u, const Epi& E, int tid, int wid, int wr, int wc, int fr, int fq) const {
        if constexpr (RS_ > 0) { if (u.mode == 3) finish_rs(acc, u, E, tid, wid, wr, wc, fr, fq); return; }
        if constexpr (NP_ <= 0) return;
        if (u.mode != 2) return;
        int ns = 0; { int need = u.need; for (int jj = j + 1; need > 0 && jj < np; ++jj) { const int len = base + (jj < rem ? 1 : 0); if (len == 0) break; need -= (len < need ? len : need); ++ns; } }
        if (wid == 0) {
            for (int k = 1; k <= ns; ++k) { unsigned sp = 0;
                while (__hip_atomic_load(flags + 64 * (vcu + k), __ATOMIC_RELAXED, __HIP_MEMORY_SCOPE_AGENT) == 0u) { __builtin_amdgcn_s_sleep(2);
                    if (++sp > (1u << 20)) { if (tid == 0) __hip_atomic_store(tmo, 0x5AB0u, __ATOMIC_RELAXED, __HIP_MEMORY_SCOPE_AGENT); break; } } }
            __builtin_amdgcn_fence(__ATOMIC_ACQUIRE, "agent"); asm volatile("s_waitcnt vmcnt(0)" ::: "memory");
        }
        asm volatile("" ::: "memory"); __builtin_amdgcn_s_barrier(); asm volatile("" ::: "memory");
        for (int k = 1; k <= ns; ++k) {
            const u32x4* sl = (const u32x4*)(slab + (size_t)(vcu + k) * SLAB_BYTES) + tid;
            u32x4 w[16];
#pragma unroll
            for (int i = 0; i < 16; ++i) w[i] = sl[i * 512];
#pragma unroll
            for (int ai = 0; ai < 2; ++ai)
#pragma unroll
                for (int bj = 0; bj < 2; ++bj)
#pragma unroll
                    for (int m = 0; m < 4; ++m) { const u32x4 v = w[ai * 8 + bj * 4 + m];
                        acc[ai][bj][m][0] += (f32x4){bflo(v.x), bfhi(v.x), bflo(v.y), bfhi(v.y)}; acc[ai][bj][m][1] += (f32x4){bflo(v.z), bfhi(v.z), bflo(v.w), bfhi(v.w)}; }
        }
        E(acc, u, wr, wc, fr, fq);
    }
};
struct EpiIn {
    static constexpr bool PERM = true, AFTER_DRAIN = false; static constexpr int MIDK = 0;
    bf16_t* U; bf16_t* S; const float* rx;
    template <int ai, int m> __device__ __forceinline__ void grp_r(const f32x4 (&acc)[2][2][4][2], const Unit& u, int wr, int wc, int fr, int fq, float r) const {
        const int row = u.pm * BM + wr * 64 + fr + ai * HALF + m * 16;
        if (u.pn < 8) {
            const int col0 = u.pn * 128 + wc * 32 + 8 * fq; const float rn = r * -1.4426950408889634f;
            u32x4 w;
#pragma unroll
            for (int n = 0; n < 2; ++n)
#pragma unroll
                for (int jp = 0; jp < 2; ++jp) { const f32x2 v = {acc[ai][0][m][n][2 * jp], acc[ai][0][m][n][2 * jp + 1]}, gt = {acc[ai][1][m][n][2 * jp], acc[ai][1][m][n][2 * jp + 1]};
                    const f32x2 o = (v * r) * sig_arg2(gt * rn);
                    w[n * 2 + jp] = cvt_pk_bf16(o.x, o.y); }
            *(u32x4*)(U + (size_t)row * 1024 + col0) = w;
        } else {
            const int col0 = (u.pn - 8) * 256 + wc * 32 + 8 * fq;
#pragma unroll
            for (int bj = 0; bj < 2; ++bj) *(u32x4*)(S + (size_t)row * 1024 + col0 + bj * HALF) = pack8(acc[ai][bj][m][0] * r, acc[ai][bj][m][1] * r);
        }
    }
    template <int ai, int m> __device__ __forceinline__ void grp(const f32x4 (&acc)[2][2][4][2], const Unit& u, int wr, int wc, int fr, int fq) const {
        grp_r<ai, m>(acc, u, wr, wc, fr, fq, rx[u.pm * BM + wr * 64 + fr + ai * HALF + m * 16]); }
    __device__ __forceinline__ void operator()(const f32x4 (&acc)[2][2][4][2], const Unit& u, int wr, int wc, int fr, int fq) const {
        const float* sp = rx + u.pm * BM + wr * 64 + fr;
        const float s00 = sp[0], s01 = sp[16], s02 = sp[32], s03 = sp[48], s10 = sp[HALF], s11 = sp[HALF + 16], s12 = sp[HALF + 32], s13 = sp[HALF + 48];
        grp_r<0, 0>(acc, u, wr, wc, fr, fq, s00); grp_r<0, 1>(acc, u, wr, wc, fr, fq, s01); grp_r<0, 2>(acc, u, wr, wc, fr, fq, s02); grp_r<0, 3>(acc, u, wr, wc, fr, fq, s03);
        grp_r<1, 0>(acc, u, wr, wc, fr, fq, s10); grp_r<1, 1>(acc, u, wr, wc, fr, fq, s11); grp_r<1, 2>(acc, u, wr, wc, fr, fq, s12); grp_r<1, 3>(acc, u, wr, wc, fr, fq, s13);
    }
};
struct EpiGlu {
    static constexpr bool PERM = true, AFTER_DRAIN = false; static constexpr int MIDK = 0;
    const bf16_t* G; bf16_t* MIX; float* ssq;
    template <int ai, int m> __device__ __forceinline__ void grp(const f32x4 (&acc)[2][2][4][2], const Unit& u, int wr, int wc, int fr, int fq) const {
        const int row0 = u.pm * BM + wr * 64 + fr, col0 = u.pn * BM + wc * 32 + 8 * fq;
            { const int row = row0 + ai * HALF + m * 16; float q = 0.f;
#pragma unroll
                for (int bj = 0; bj < 2; ++bj) { const u32x4 gw = *(const u32x4*)(G + (size_t)row * 1024 + col0 + bj * HALF);
                    f32x4 g0 = {bflo(gw.x), bfhi(gw.x), bflo(gw.y), bfhi(gw.y)}, g1 = {bflo(gw.z), bfhi(gw.z), bflo(gw.w), bfhi(gw.w)}, y0, y1;
#pragma unroll
                    for (int j = 0; j < 4; ++j) { y0[j] = g0[j] * fsig(acc[ai][bj][m][0][j]); y1[j] = g1[j] * fsig(acc[ai][bj][m][1][j]); }
                    q += sq4(y0) + sq4(y1);
                    *(u32x4*)(MIX + (size_t)row * 2048 + col0 + bj * HALF) = pack8(y0, y1); }
                row_atomic(ssq + row, q, fq); }
    }
    PG8_EPI_ALL
};
struct EpiOut {
    static constexpr bool PERM = true, AFTER_DRAIN = false; static constexpr int MIDK = 16;
    bf16_t* HB; float* ssq; const float* ssqs;
    __device__ __forceinline__ void midscale(f32x4 (&acc)[2][2][4][2], const Unit& u, int wr, int fr) const {
        const int row0 = u.pm * BM + wr * 64 + fr;
#pragma unroll
        for (int ai = 0; ai < 2; ++ai)
#pragma unroll
            for (int m = 0; m < 4; ++m) { const float r = __builtin_amdgcn_rsqf(ssqs[row0 + ai * HALF + m * 16] * (1.0f / 1024.0f) + RMS_EPS);
#pragma unroll
                for (int bj = 0; bj < 2; ++bj) { acc[ai][bj][m][0] *= r; acc[ai][bj][m][1] *= r; } }
    }
    template <int ai, int m> __device__ __forceinline__ float grp_w(const f32x4 (&acc)[2][2][4][2], const Unit& u, int wr, int wc, int fr, int fq, const u32x4 xw0, const u32x4 xw1) const {
        const int row = u.pm * BM + wr * 64 + fr + ai * HALF + m * 16, col0 = u.pn * BM + wc * 32 + 8 * fq; float q = 0.f;
#pragma unroll
        for (int bj = 0; bj < 2; ++bj) { const size_t off = (size_t)row * 2048 + col0 + bj * HALF; const u32x4 xw = bj ? xw1 : xw0;
            const f32x4 h0 = (f32x4){bflo(xw.x), bfhi(xw.x), bflo(xw.y), bfhi(xw.y)} + acc[ai][bj][m][0], h1 = (f32x4){bflo(xw.z), bfhi(xw.z), bflo(xw.w), bfhi(xw.w)} + acc[ai][bj][m][1];
            q += sq4(h0) + sq4(h1);
            *(u32x4*)(HB + off) = pack8(h0, h1); }
        return q;
    }
    template <int ai, int m> __device__ __forceinline__ void grp(const f32x4 (&acc)[2][2][4][2], const Unit& u, int wr, int wc, int fr, int fq) const {
        const int row = u.pm * BM + wr * 64 + fr + ai * HALF + m * 16, col0 = u.pn * BM + wc * 32 + 8 * fq; const bf16_t* p = HB + (size_t)row * 2048 + col0;
        const u32x4 xw0 = *(const u32x4*)p, xw1 = *(const u32x4*)(p + HALF);
        row_atomic(ssq + row, grp_w<ai, m>(acc, u, wr, wc, fr, fq, xw0, xw1), fq); }
    __device__ __forceinline__ void operator()(const f32x4 (&acc)[2][2][4][2], const Unit& u, int wr, int wc, int fr, int fq) const {
        const int row0 = u.pm * BM + wr * 64 + fr, col0 = u.pn * BM + wc * 32 + 8 * fq; const bf16_t* p0 = HB + (size_t)row0 * 2048 + col0;
#define PG8_LDG(g) const u32x4 a##g = *(const u32x4*)(p0 + (size_t)(((g) >> 2) * HALF + ((g) & 3) * 16) * 2048), b##g = *(const u32x4*)(p0 + (size_t)(((g) >> 2) * HALF + ((g) & 3) * 16) * 2048 + HALF)
        float* sp = ssq + row0;
        PG8_LDG(0); PG8_LDG(1);
        row_atomic(sp, grp_w<0, 0>(acc, u, wr, wc, fr, fq, a0, b0), fq); PG8_LDG(2);
        row_atomic(sp + 16, grp_w<0, 1>(acc, u, wr, wc, fr, fq, a1, b1), fq); PG8_LDG(3);
        row_atomic(sp + 32, grp_w<0, 2>(acc, u, wr, wc, fr, fq, a2, b2), fq); PG8_LDG(4);
        row_atomic(sp + 48, grp_w<0, 3>(acc, u, wr, wc, fr, fq, a3, b3), fq); PG8_LDG(5);
        row_atomic(sp + HALF, grp_w<1, 0>(acc, u, wr, wc, fr, fq, a4, b4), fq); PG8_LDG(6);
        row_atomic(sp + HALF + 16, grp_w<1, 1>(acc, u, wr, wc, fr, fq, a5, b5), fq); PG8_LDG(7);
        row_atomic(sp + HALF + 32, grp_w<1, 2>(acc, u, wr, wc, fr, fq, a6, b6), fq);
        row_atomic(sp + HALF + 48, grp_w<1, 3>(acc, u, wr, wc, fr, fq, a7, b7), fq);
#undef PG8_LDG
    }
};
struct EpiUp {
    static constexpr bool PERM = true, AFTER_DRAIN = false; static constexpr int MIDK = 0;
    bf16_t* ACT; const float* ssq;
    template <int ai, int m> __device__ __forceinline__ void grp_r(const f32x4 (&acc)[2][2][4][2], const Unit& u, int wr, int wc, int fr, int fq, float ss) const {
        const int row = u.pm * BM + wr * 64 + fr + ai * HALF + m * 16, col0 = u.pn * 128 + wc * 32 + 8 * fq;
        const float r = __builtin_amdgcn_rsqf(ss * (1.0f / 2048.0f) + RMS_EPS), rn = r * -1.4426950408889634f, r2 = r * r;
        u32x4 w;
#pragma unroll
        for (int n = 0; n < 2; ++n)
#pragma unroll
            for (int jp = 0; jp < 2; ++jp) { const f32x2 g = {acc[ai][0][m][n][2 * jp], acc[ai][0][m][n][2 * jp + 1]}, up = {acc[ai][1][m][n][2 * jp], acc[ai][1][m][n][2 * jp + 1]};
                const f32x2 o = (g * up) * (sig_arg2(g * rn) * r2);
                w[n * 2 + jp] = cvt_pk_bf16(o.x, o.y); }
        *(u32x4*)(ACT + (size_t)row * 5632 + col0) = w;
    }
    template <int ai, int m> __device__ __forceinline__ void grp(const f32x4 (&acc)[2][2][4][2], const Unit& u, int wr, int wc, int fr, int fq) const {
        grp_r<ai, m>(acc, u, wr, wc, fr, fq, ssq[u.pm * BM + wr * 64 + fr + ai * HALF + m * 16]); }
    __device__ __forceinline__ void operator()(const f32x4 (&acc)[2][2][4][2], const Unit& u, int wr, int wc, int fr, int fq) const {
        const float* sp = ssq + u.pm * BM + wr * 64 + fr;
        const float s00 = sp[0], s01 = sp[16], s02 = sp[32], s03 = sp[48], s10 = sp[HALF], s11 = sp[HALF + 16], s12 = sp[HALF + 32], s13 = sp[HALF + 48];
        grp_r<0, 0>(acc, u, wr, wc, fr, fq, s00); grp_r<0, 1>(acc, u, wr, wc, fr, fq, s01); grp_r<0, 2>(acc, u, wr, wc, fr, fq, s02); grp_r<0, 3>(acc, u, wr, wc, fr, fq, s03);
        grp_r<1, 0>(acc, u, wr, wc, fr, fq, s10); grp_r<1, 1>(acc, u, wr, wc, fr, fq, s11); grp_r<1, 2>(acc, u, wr, wc, fr, fq, s12); grp_r<1, 3>(acc, u, wr, wc, fr, fq, s13);
    }
};
struct EpiDown {
    static constexpr bool PERM = true, AFTER_DRAIN = false; static constexpr int MIDK = 0;
    bf16_t* HB; float* ssq; float zmul;
    template <int ai, int m> __device__ __forceinline__ float grp_w(const f32x4 (&acc)[2][2][4][2], const Unit& u, int wr, int wc, int fr, int fq, const u32x4 hw0, const u32x4 hw1) const {
        const int row = u.pm * BM + wr * 64 + fr + ai * HALF + m * 16, col0 = u.pn * BM + wc * 32 + 8 * fq; float q = 0.f;
#pragma unroll
        for (int bj = 0; bj < 2; ++bj) { bf16_t* p = HB + (size_t)row * 2048 + col0 + bj * HALF; const u32x4 hw = bj ? hw1 : hw0;
            const f32x4 o0 = (f32x4){bflo(hw.x), bfhi(hw.x), bflo(hw.y), bfhi(hw.y)} + acc[ai][bj][m][0] * zmul, o1 = (f32x4){bflo(hw.z), bfhi(hw.z), bflo(hw.w), bfhi(hw.w)} + acc[ai][bj][m][1] * zmul;
            q += sq4(o0) + sq4(o1);
            *(u32x4*)p = pack8(o0, o1); }
        return q;
    }
    template <int ai, int m> __device__ __forceinline__ void grp(const f32x4 (&acc)[2][2][4][2], const Unit& u, int wr, int wc, int fr, int fq) const {
        const int row = u.pm * BM + wr * 64 + fr + ai * HALF + m * 16, col0 = u.pn * BM + wc * 32 + 8 * fq; const bf16_t* p = HB + (size_t)row * 2048 + col0;
        const u32x4 hw0 = *(const u32x4*)p, hw1 = *(const u32x4*)(p + HALF);
        row_atomic(ssq + row, grp_w<ai, m>(acc, u, wr, wc, fr, fq, hw0, hw1), fq); }
    __device__ __forceinline__ void operator()(const f32x4 (&acc)[2][2][4][2], const Unit& u, int wr, int wc, int fr, int fq) const {
        const int row0 = u.pm * BM + wr * 64 + fr, col0 = u.pn * BM + wc * 32 + 8 * fq; const bf16_t* p0 = HB + (size_t)row0 * 2048 + col0;
#define PG8_LDG(g) const u32x4 a##g = *(const u32x4*)(p0 + (size_t)(((g) >> 2) * HALF + ((g) & 3) * 16) * 2048), b##g = *(const u32x4*)(p0 + (size_t)(((g) >> 2) * HALF + ((g) & 3) * 16) * 2048 + HALF)
        float* sp = ssq + row0;
        PG8_LDG(0); PG8_LDG(1);
        row_atomic(sp, grp_w<0, 0>(acc, u, wr, wc, fr, fq, a0, b0), fq); PG8_LDG(2);
        row_atomic(sp + 16, grp_w<0, 1>(acc, u, wr, wc, fr, fq, a1, b1), fq); PG8_LDG(3);
        row_atomic(sp + 32, grp_w<0, 2>(acc, u, wr, wc, fr, fq, a2, b2), fq); PG8_LDG(4);
        row_atomic(sp + 48, grp_w<0, 3>(acc, u, wr, wc, fr, fq, a3, b3), fq); PG8_LDG(5);
        row_atomic(sp + HALF, grp_w<1, 0>(acc, u, wr, wc, fr, fq, a4, b4), fq); PG8_LDG(6);
        row_atomic(sp + HALF + 16, grp_w<1, 1>(acc, u, wr, wc, fr, fq, a5, b5), fq); PG8_LDG(7);
        row_atomic(sp + HALF + 32, grp_w<1, 2>(acc, u, wr, wc, fr, fq, a6, b6), fq);
        row_atomic(sp + HALF + 48, grp_w<1, 3>(acc, u, wr, wc, fr, fq, a7, b7), fq);
#undef PG8_LDG
    }
};
}
typedef pg8::f32x2 f32x2;

constexpr int NWAVES = 8;
#ifndef MK_N_LAUNCHES
#define MK_N_LAUNCHES 1
#endif
constexpr int NPH = 9;
constexpr int N_LAUNCHES = MK_N_LAUNCHES;

constexpr int D = 2048, DC = 1024, DS = 1024, DIN = 3072, DFF = 5632, NG = 64, NP = 64, CH = 16, KW = 31;
constexpr int BATCH = 4, SEQ = 2048, DB = 128, DSQ = 8;
constexpr int MP = BATCH * SEQ, MS = DB * DSQ, M = MP + MS;

constexpr size_t MiB = 1u << 20;
constexpr size_t WS_CTL = 0, CTL_ZERO_BYTES = 1 * MiB;
constexpr size_t WS_TAB = 1 * MiB;
constexpr size_t WS_WGU = 2 * MiB, WS_WDN = 46 * MiB, WS_XB = 68 * MiB;
constexpr size_t WS_WIN = 104 * MiB, WS_WGL = 116 * MiB, WS_WOUT = 118 * MiB;
constexpr size_t WS_U = 126 * MiB, WS_S = 144 * MiB, WS_G = 162 * MiB, WS_MIX = 180 * MiB;
constexpr size_t WS_ACT = 104 * MiB;
constexpr size_t WS_END = 235 * MiB;
constexpr size_t SLAB_P1 = 162 * MiB, SLAB_P3 = 126 * MiB, SLAB_P5 = 126 * MiB, SLAB_P6 = 203 * MiB, SLAB_P7 = 2 * MiB;
static_assert(WS_WGU + (size_t)2 * DFF * D * 2 <= WS_WDN && WS_WDN + (size_t)D * DFF * 2 <= WS_XB && WS_XB + (size_t)M * D * 2 <= WS_WIN, "ws map 1");
static_assert(WS_WIN + (size_t)DIN * D * 2 <= WS_WGL && WS_WGL + (size_t)DS * DS * 2 <= WS_WOUT && WS_WOUT + (size_t)D * D * 2 <= WS_U, "ws map 2");
static_assert(WS_U + (size_t)M * DC * 2 <= WS_S && WS_S + (size_t)M * DS * 2 <= WS_G && WS_G + (size_t)M * DS * 2 <= WS_MIX && WS_MIX + (size_t)M * D * 2 <= WS_END, "ws map 3");
static_assert(WS_ACT + (size_t)M * DFF * 2 <= SLAB_P6 && SLAB_P6 + 32 * MiB <= WS_END && WS_END <= 256 * MiB, "ws map 4");
constexpr int CW_TMO = 0, CW_CODE = 1;
constexpr int CW_BAR = 4096;
constexpr int CW_SSQ_S = 16384, CW_SSQ_H = CW_SSQ_S + M, CW_SSQ_O = CW_SSQ_H + M;
constexpr int CW_DUMMY = CW_SSQ_O + M;
constexpr int CW_FLAGS = 81920, FLAG_SLOT = 16384;
constexpr int CW_RX = 65536;
static_assert((CW_RX + M) * 4 <= (int)CTL_ZERO_BYTES && CW_DUMMY + M <= CW_RX, "ctl map");
constexpr size_t TAB_AB = 0;
constexpr size_t TAB_BBT = 64 * 1024;
constexpr size_t TAB_CQ = 512 * 1024;

constexpr int RING_OFF = 0, RING_BYTES = 131072;
constexpr int LDSCTL_OFF = RING_BYTES, MISC_OFF = LDSCTL_OFF + 320;
constexpr int LDS_BYTES = 147456;
static_assert(MISC_OFF + 128 <= LDS_BYTES, "LDS map");

#define GAS __attribute__((address_space(1)))
#define LAS __attribute__((address_space(3)))
typedef unsigned short bf16;
typedef unsigned v4u __attribute__((ext_vector_type(4)));
typedef unsigned v2u __attribute__((ext_vector_type(2)));
typedef float f32x4 __attribute__((ext_vector_type(4)));

typedef float f32x16 __attribute__((ext_vector_type(16)));
typedef short bf16x8 __attribute__((ext_vector_type(8)));
typedef GAS unsigned gu32;
#define RLX_AGENT __ATOMIC_RELAXED, __HIP_MEMORY_SCOPE_AGENT
#define LDS_WAIT() asm volatile("s_waitcnt lgkmcnt(0)" ::: "memory")
#define VM_WAIT() asm volatile("s_waitcnt vmcnt(0)" ::: "memory")
__device__ __forceinline__ unsigned f2bf(float f) { unsigned u = __builtin_bit_cast(unsigned, f); return (u + 0x7fffu + ((u >> 16) & 1u)) >> 16; }
__device__ __forceinline__ unsigned pk2(float lo, float hi) { return f2bf(lo) | (f2bf(hi) << 16); }
__device__ __forceinline__ float bf_lo(unsigned w) { return __builtin_bit_cast(float, w << 16); }
__device__ __forceinline__ float bf_hi(unsigned w) { return __builtin_bit_cast(float, w & 0xffff0000u); }
#define WS_DPP(v, ctrl, rm) ((v) + __builtin_bit_cast(float, __builtin_amdgcn_update_dpp(0, __builtin_bit_cast(int, (v)), (ctrl), (rm), 0xF, true)))
__device__ __forceinline__ float wave_sum63(float v) {
    v = WS_DPP(v, 0xB1, 0xF); v = WS_DPP(v, 0x4E, 0xF); v = WS_DPP(v, 0x141, 0xF); v = WS_DPP(v, 0x140, 0xF); v = WS_DPP(v, 0x142, 0xA); v = WS_DPP(v, 0x143, 0xC);
    return v;
}
__device__ __forceinline__ float fsigm(float x) { return __builtin_amdgcn_rcpf(1.0f + __builtin_amdgcn_exp2f(x * -1.4426950408889634f)); }
__device__ __forceinline__ float gelu_tanh_f(float x) {
    const float u2 = 1.5957691216057308f * (x + 0.044715f * x * x * x);
    return x * fsigm(u2);
}

#define XB_TMO      128
#define XB_XCNT(j)  (256  + 64 * (j))
#define XB_XSUB(j)  (1280 + 64 * (j))
#define XB_XGEN(j)  (2304 + 64 * (j))
#define XB_TOP      3328
#define XB_TOPGEN   3392
#define XCD_BAR_WORDS 3456
#define XB_SPIN_CAP (1u << 18)

__device__ __forceinline__ unsigned xb_ld(unsigned* p)              { return __hip_atomic_load(p, __ATOMIC_RELAXED, __HIP_MEMORY_SCOPE_AGENT); }
__device__ __forceinline__ unsigned xb_add(unsigned* p, unsigned v) { return __hip_atomic_fetch_add(p, v, __ATOMIC_RELAXED, __HIP_MEMORY_SCOPE_AGENT); }
__device__ __forceinline__ unsigned xb_xcc_id() { return (unsigned)__builtin_amdgcn_s_getreg((3 << 11) | 20) & 0xFu; }
#define XB_SPIN(cond, bar) do { unsigned _sp = 0; while (cond) { __builtin_amdgcn_s_sleep(1); \
    if ((++_sp & 255u) == 0u) { if (xb_ld(&(bar)[XB_TMO])) break; if (_sp > XB_SPIN_CAP) { atomicAdd(&(bar)[XB_TMO], 1u); break; } } } } while (0)

struct XcdBarrier {
    unsigned* bar; unsigned x;
    volatile LAS unsigned* st;
};

__device__ __forceinline__ XcdBarrier xcd_barrier_post(unsigned* bar, volatile LAS unsigned* st) {
    XcdBarrier b; b.bar = bar; b.x = xb_xcc_id(); b.st = st;
    if (threadIdx.x == 0) (void)xb_add(&bar[XB_XCNT(b.x)], 1u);
    return b;
}
__device__ __forceinline__ void xcd_barrier_complete(unsigned* bar, unsigned x, unsigned& nloc, unsigned& nx) {
    const unsigned G = gridDim.x * gridDim.y * gridDim.z;
    unsigned sum, cnt, mine, sp = 0u;
    for (;;) {
        sum = 0u; cnt = 0u; mine = 0u;
#pragma unroll
        for (unsigned j = 0; j < 16; ++j) { const unsigned c = xb_ld(&bar[XB_XCNT(j)]); sum += c; cnt += (c > 0u) ? 1u : 0u; mine = (j == x) ? c : mine; }
        if (sum == G) break;
        __builtin_amdgcn_s_sleep(1);
        if ((++sp & 255u) == 0u) { if (xb_ld(&bar[XB_TMO])) break; if (sp > XB_SPIN_CAP) { atomicAdd(&bar[XB_TMO], 1u); break; } }
    }
    nloc = mine > 0u ? mine : 1u; nx = cnt > 0u ? cnt : 1u;
}

__device__ __forceinline__ void xcd_barrier(const XcdBarrier& b) {
    asm volatile("s_waitcnt vmcnt(0)" ::: "memory");
    __syncthreads();
    if (threadIdx.x == 0) {
        unsigned* bar = b.bar;
        __builtin_amdgcn_s_waitcnt(0);
        unsigned nloc = b.st[0], nx = b.st[1];
        if (nloc == 0u) { xcd_barrier_complete(bar, b.x, nloc, nx); b.st[0] = nloc; b.st[1] = nx; }
        const unsigned old = xb_add(&bar[XB_XSUB(b.x)], 1u);
        const unsigned gen = old / nloc;
        if (old + 1u == (gen + 1u) * nloc) {
            __builtin_amdgcn_fence(__ATOMIC_RELEASE, "agent");
            asm volatile("s_waitcnt vmcnt(0)" ::: "memory");
            const unsigned og = xb_add(&bar[XB_TOP], 1u);
            const unsigned tg = og / nx;
            if (og + 1u == (tg + 1u) * nx) xb_add(&bar[XB_TOPGEN], 1u);
            else XB_SPIN(xb_ld(&bar[XB_TOPGEN]) == tg, bar);
            __builtin_amdgcn_fence(__ATOMIC_ACQUIRE, "agent");
            xb_add(&bar[XB_XGEN(b.x)], 1u);
            asm volatile("s_waitcnt vmcnt(0)" ::: "memory");
        } else {
            XB_SPIN(xb_ld(&bar[XB_XGEN(b.x)]) == gen, bar);
            __builtin_amdgcn_fence(__ATOMIC_ACQUIRE, "agent");
            asm volatile("s_waitcnt vmcnt(0)" ::: "memory");
        }
    }
    __syncthreads();
}
__device__ __forceinline__ unsigned cvtpk(float lo, float hi) { unsigned r; asm("v_cvt_pk_bf16_f32 %0, %1, %2" : "=v"(r) : "v"(lo), "v"(hi)); return r; }

struct P0Item { const float* W; const float* gp; bf16* WT; int N, K, orow, k0, n0, gain_on, kdst; };
__device__ __forceinline__ void p0_item_load(const P0Item& t, f32x4 (&v)[8], float (&gk)[8], int lane) {
    const int kr = lane >> 3, nq = lane & 7;
#pragma unroll
    for (int i = 0; i < 8; ++i) { const int kk = 8 * i + kr; v[i] = __builtin_nontemporal_load((const GAS f32x4*)(t.W + (size_t)(t.k0 + kk) * t.N + t.n0 + 4 * nq));
        const float gl = t.gp[t.gain_on ? t.k0 + kk : 0]; gk[i] = t.gain_on ? gl : 1.0f; }
}
__device__ __forceinline__ void p0_item_finish(const P0Item& t, const f32x4 (&v)[8], const float (&gk)[8], LAS float* scr, int lane) {
    const int kr = lane >> 3, nq = lane & 7;
#pragma unroll
    for (int i = 0; i < 8; ++i) { const int kk = 8 * i + kr; LAS float* d = scr + kk * 33 + 4 * nq; d[0] = v[i].x * gk[i]; d[1] = v[i].y * gk[i]; d[2] = v[i].z * gk[i]; d[3] = v[i].w * gk[i]; }
    LDS_WAIT(); asm volatile("" ::: "memory");
    const int c = lane & 7;
#pragma unroll
    for (int j = 0; j < 4; ++j) { const int n = (lane >> 3) + 8 * j; const LAS float* s = scr + (8 * c) * 33 + n;
        v4u o; o.x = cvtpk(s[0 * 33], s[1 * 33]); o.y = cvtpk(s[2 * 33], s[3 * 33]); o.z = cvtpk(s[4 * 33], s[5 * 33]); o.w = cvtpk(s[6 * 33], s[7 * 33]);
        *(GAS v4u*)(t.WT + (size_t)(t.orow + n) * t.K + t.kdst + 8 * c) = o; }
    LDS_WAIT(); asm volatile("" ::: "memory");
}

struct P0Args {
    const float *xp, *xs, *norm_mix, *w_in, *w_glu, *gn_conv, *gn_ssm, *w_out, *norm_ffn, *w_gate, *w_up, *w_down;
    const float *A_re, *A_im, *log_dt, *B_re, *B_im, *C_re, *C_im;
    bf16 *WIN, *WGL, *WOUT, *WGU, *WDN, *XB; float* rx; unsigned char* tab;
};
__device__ __forceinline__ void p0_convert(const P0Args& a, LAS unsigned char* lds, int first, int stride, int lo, int hi, int wave, int lane) {
    LAS float* scr = (LAS float*)(lds + RING_OFF + wave * 16384);
    constexpr int I_IN = (D / 64) * (DIN / 32), I_GL = (DS / 64) * (DS / 32), I_OUT = (D / 64) * (D / 32), I_GA = (D / 64) * (DFF / 32), I_DN = (DFF / 64) * (D / 32);
    constexpr int NITEMS = I_IN + I_GL + I_OUT + 2 * I_GA + I_DN;
#define P0_DECODE(t, it_) do { int r_ = (it_); \
        if (r_ < I_IN) { const int nb = r_ % (DIN / 32), kb = r_ / (DIN / 32), n0 = 32 * nb; \
            int orow; if (n0 < 2048) { const int bjv = n0 >> 10, ch = n0 & 1023; orow = 256 * (ch >> 7) + 128 * bjv + (ch & 127); } else orow = n0; \
            t.W = a.w_in; t.N = DIN; t.gp = a.norm_mix; t.gain_on = 1; t.WT = a.WIN; t.K = D; t.orow = orow; t.k0 = 64 * kb; t.kdst = 64 * kb; t.n0 = n0; break; } r_ -= I_IN; \
        if (r_ < I_GL) { const int nb = r_ % (DS / 32), kb = r_ / (DS / 32); \
            t.W = a.w_glu; t.N = DS; t.gp = a.norm_mix; t.gain_on = 0; t.WT = a.WGL; t.K = DS; t.orow = 32 * nb; t.k0 = 64 * kb; t.kdst = 64 * kb; t.n0 = 32 * nb; break; } r_ -= I_GL; \
        if (r_ < I_OUT) { const int nb = r_ % (D / 32), kb = r_ / (D / 32), k0 = 64 * kb; \
            t.W = a.w_out; t.N = D; t.gp = k0 < 1024 ? a.gn_conv : a.gn_ssm - 1024; t.gain_on = 1; t.WT = a.WOUT; t.K = D; t.orow = 32 * nb; t.k0 = k0; t.kdst = k0 ^ 1024; t.n0 = 32 * nb; break; }     r_ -= I_OUT; \
        if (r_ < I_GA) { const int nb = r_ % (DFF / 32), kb = r_ / (DFF / 32), n0 = 32 * nb; \
            t.W = a.w_gate; t.N = DFF; t.gp = a.norm_ffn; t.gain_on = 1; t.WT = a.WGU; t.K = D; t.orow = 256 * (n0 >> 7) + (n0 & 127); t.k0 = 64 * kb; t.kdst = 64 * kb; t.n0 = n0; break; } r_ -= I_GA; \
        if (r_ < I_GA) { const int nb = r_ % (DFF / 32), kb = r_ / (DFF / 32), n0 = 32 * nb; \
            t.W = a.w_up; t.N = DFF; t.gp = a.norm_ffn; t.gain_on = 1; t.WT = a.WGU; t.K = D; t.orow = 256 * (n0 >> 7) + 128 + (n0 & 127); t.k0 = 64 * kb; t.kdst = 64 * kb; t.n0 = n0; break; } r_ -= I_GA; \
        { const int nb = r_ % (D / 32), kb = r_ / (D / 32); \
            t.W = a.w_down; t.N = D; t.gp = a.norm_mix; t.gain_on = 0; t.WT = a.WDN; t.K = DFF; t.orow = 32 * nb; t.k0 = 64 * kb; t.kdst = 64 * kb; t.n0 = 32 * nb; } } while (0)
    {
        P0Item t0, t1, t2; f32x4 va[8], vb[8], vc[8]; float ga[8], gb[8], gc[8];
        if (lo + first < hi) { P0_DECODE(t0, lo + first); p0_item_load(t0, va, ga, lane); }
        if (lo + first + stride < hi) { P0_DECODE(t1, lo + first + stride); p0_item_load(t1, vb, gb, lane); }
        for (int it = lo + first; it < hi; it += stride) {
            const int itn = it + 2 * stride;
            if (itn < hi) { P0_DECODE(t2, itn); p0_item_load(t2, vc, gc, lane); }
            p0_item_finish(t0, va, ga, scr, lane);
            t0 = t1; t1 = t2;
#pragma unroll
            for (int i = 0; i < 8; ++i) { va[i] = vb[i]; ga[i] = gb[i]; vb[i] = vc[i]; gb[i] = gc[i]; }
        }
    }
#undef P0_DECODE
}
__device__ __forceinline__ void p0_tables(const P0Args& a, int gt) {
    {
      if (gt < NG * NP) { const int g = gt >> 6, p = gt & 63;
        const float ar = a.A_re[gt], ai = a.A_im[gt], dt = expf(a.log_dt[g]);
        const float th = dt * ai, e1 = expm1f(dt * ar), sh = sinf(0.5f * th), cm1 = -2.0f * sh * sh, cs = 1.0f + cm1;
        const float nr = e1 * cs + cm1, ni = (1.0f + e1) * sinf(th);
        const float abr = 1.0f + nr, abi = ni, den = ar * ar + ai * ai;
        const float kr = (nr * ar + ni * ai) / den, ki = (ni * ar - nr * ai) / den;
        float* AB = (float*)(a.tab + TAB_AB); AB[gt * 2] = abr; AB[gt * 2 + 1] = abi;
        bf16* BBT = (bf16*)(a.tab + TAB_BBT); bf16* CQ = (bf16*)(a.tab + TAB_CQ);
#pragma unroll
        for (int c = 0; c < 16; ++c) { const float br = a.B_re[(size_t)gt * CH + c], bi = a.B_im[(size_t)gt * CH + c];
            BBT[((size_t)(g * 2 + 0) * NP + p) * CH + c] = (bf16)f2bf(kr * br - ki * bi);
            BBT[((size_t)(g * 2 + 1) * NP + p) * CH + c] = (bf16)f2bf(kr * bi + ki * br);
            CQ[((size_t)g * CH + c) * 128 + 2 * p] = (bf16)f2bf(a.C_re[((size_t)g * CH + c) * NP + p]);
            CQ[((size_t)g * CH + c) * 128 + 2 * p + 1] = (bf16)f2bf(-a.C_im[((size_t)g * CH + c) * NP + p]); }
      } }
}
constexpr int P0_ITEMS_P3 = 8704;
constexpr int P0_ITEMS_B = (D / 64) * (DIN / 32) + (DS / 64) * (DS / 32) + (D / 64) * (D / 32) + 2 * (D / 64) * (DFF / 32), P0_ITEMS_A = P0_ITEMS_B - P0_ITEMS_P3;
constexpr int P0_ITEMS_ALL = P0_ITEMS_B + (DFF / 64) * (D / 32);
__device__ __forceinline__ void p0_prologue(const P0Args& a, LAS unsigned char* lds, int vcu, int G, int wave, int lane, int tid) {
    const int gw = vcu * NWAVES + wave, NGW = G * NWAVES;
    p0_convert(a, lds, gw, NGW, 0, P0_ITEMS_A, wave, lane);
#ifdef STAMP_A
    __syncthreads(); if (blockIdx.x == 0 && tid == 0) { const unsigned long long t_ = __builtin_amdgcn_s_memrealtime(); volatile LAS unsigned* M_ = (volatile LAS unsigned*)(lds + MISC_OFF); M_[12 + 2 * 15] = (unsigned)t_; M_[13 + 2 * 15] = (unsigned)(t_ >> 32); }
#endif
    {
        f32x4 v[8], vn[8];
        if (gw < M) { const GAS f32x4* xr = (const GAS f32x4*)(gw < MP ? a.xp + (size_t)gw * D : a.xs + (size_t)(gw - MP) * D) + lane;
#pragma unroll
            for (int j = 0; j < 8; ++j) v[j] = xr[64 * j]; }
        for (int row = gw; row < M; row += NGW) {
            const int rn = row + NGW;
            if (rn < M) { const GAS f32x4* xr = (const GAS f32x4*)(rn < MP ? a.xp + (size_t)rn * D : a.xs + (size_t)(rn - MP) * D) + lane;
#pragma unroll
                for (int j = 0; j < 8; ++j) vn[j] = xr[64 * j]; }
            float s = 0.f;
#pragma unroll
            for (int j = 0; j < 8; ++j) s += (v[j].x * v[j].x + v[j].y * v[j].y) + (v[j].z * v[j].z + v[j].w * v[j].w);
            s = wave_sum63(s);
            if (lane == 63) a.rx[row] = 1.0f / sqrtf(s * (1.0f / D) + 1e-6f);
            GAS v2u* o8 = (GAS v2u*)(a.XB + (size_t)row * D) + lane;
#pragma unroll
            for (int j = 0; j < 8; ++j) { v2u o; o.x = cvtpk(v[j].x, v[j].y); o.y = cvtpk(v[j].z, v[j].w); o8[64 * j] = o; }
#pragma unroll
            for (int j = 0; j < 8; ++j) v[j] = vn[j];
        }
    }
}

struct P2Args {
    const bf16* UC; const bf16* SI; bf16* G; bf16* MIX;
    const float *state_conv, *h0re, *h0im, *conv_w, *conv_b, *ln_g, *ln_b, *Dk;
    const unsigned char* tab;
    float *ncp, *nrp, *nip, *ncs, *nrs, *nis;
};
constexpr int P2_RED_OFF = 0, P2_TILE_OFF = 4096, P2_TILE_B = 4352, P2_TROW = 272, P2_UT_OFF = 73728, P2_SX_OFF = 81920;

#define CONV_LOAD_ROWS(rows, it_) do { \
        if ((it_) < 1024) { const int t0_ = ((it_) & 255) * 8, neg_ = (KW - 1) - t0_; const bf16* ub_ = a.UC + (size_t)(((it_) >> 8) * SEQ) * DC + c0; \
            _Pragma("unroll") for (int r_ = 0; r_ < 8 + KW - 1; ++r_) { const int tt_ = t0_ - (KW - 1) + r_; \
                const unsigned ld_ = *(const GAS unsigned*)(ub_ + (size_t)(tt_ > 0 ? tt_ : 0) * DC); rows[r_] = ld_ & (r_ >= neg_ ? 0xffffffffu : 0u); } } \
        else { const int b_ = (it_) - 1024; const float* hist_ = a.state_conv + (size_t)b_ * (KW - 1) * DC + c0; const bf16* ub_ = a.UC + (size_t)(MP + b_ * DSQ) * DC + c0; \
            _Pragma("unroll") for (int r_ = 0; r_ < KW - 1; ++r_) { const f32x2 hv_ = *(const GAS f32x2*)(hist_ + (size_t)r_ * DC); rows[r_] = cvtpk(hv_.x, hv_.y); } \
            _Pragma("unroll") for (int r_ = 0; r_ < 8; ++r_) rows[KW - 1 + r_] = *(const GAS unsigned*)(ub_ + (size_t)r_ * DC); } } while (0)

#define CONV_COMPUTE(rows, orow) do { \
        float ax_[8], ay_[8]; \
        _Pragma("unroll") for (int j = 0; j < 8; ++j) { ax_[j] = bias.x; ay_[j] = bias.y; } \
        _Pragma("unroll") for (int r = 0; r < 8 + KW - 1; ++r) { const float vx_ = bf_lo(rows[r]), vy_ = bf_hi(rows[r]); \
            _Pragma("unroll") for (int j = 0; j < 8; ++j) { const int k = r - j; if (k >= 0 && k < KW) { \
                asm("v_fmac_f32 %0, %1, %2" : "+v"(ax_[j]) : "v"(w[k].x), "v"(vx_)); asm("v_fmac_f32 %0, %1, %2" : "+v"(ay_[j]) : "v"(w[k].y), "v"(vy_)); } } }     \
        f32x2 acc[8]; \
        _Pragma("unroll") for (int j = 0; j < 8; ++j) acc[j] = (f32x2){ax_[j], ay_[j]}; \
        float st[16]; \
        _Pragma("unroll") for (int j = 0; j < 8; ++j) { st[j] = acc[j].x + acc[j].y; st[8 + j] = acc[j].x * acc[j].x + acc[j].y * acc[j].y; } \
        _Pragma("unroll") for (int j = 0; j < 16; ++j) st[j] = wave_sum63(st[j]); \
        if (lane == 63) { _Pragma("unroll") for (int j = 0; j < 16; ++j) red[wave * 16 + j] = st[j]; } \
        __syncthreads(); \
        if (tid < 16) { float s = 0.f; _Pragma("unroll") for (int wv = 0; wv < 8; ++wv) s += red[wv * 16 + tid]; tot[tid] = s; } \
        __syncthreads(); \
        float q[8]; \
        _Pragma("unroll") for (int j = 0; j < 8; ++j) { const float mu = tot[j] * (1.0f / DC), var = __builtin_fmaxf(tot[8 + j] * (1.0f / DC) - mu * mu, 0.0f), rs = __builtin_amdgcn_rsqf(var + 1e-6f); \
            f32x2 y = (acc[j] - mu) * rs * lg + lb; y.x = y.x * fsigm(y.x); y.y = y.y * fsigm(y.y); acc[j] = y; q[j] = y.x * y.x + y.y * y.y; } \
        _Pragma("unroll") for (int j = 0; j < 8; ++j) q[j] = wave_sum63(q[j]); \
        if (lane == 63) { _Pragma("unroll") for (int j = 0; j < 8; ++j) red[128 + wave * 16 + j] = q[j]; } \
        __syncthreads(); \
        if (tid < 8) { float s = 0.f; _Pragma("unroll") for (int wv = 0; wv < 8; ++wv) s += red[128 + wv * 16 + tid]; tot[16 + tid] = s; } \
        __syncthreads(); \
        _Pragma("unroll") for (int j = 0; j < 8; ++j) { const float r2 = __builtin_amdgcn_rsqf(tot[16 + j] * (1.0f / DC) + 1e-6f); \
            *(GAS unsigned*)(a.MIX + (size_t)((orow) + j) * D + DC + c0) = cvtpk(acc[j].x * r2, acc[j].y * r2); } } while (0)

__device__ __forceinline__ void p2_conv(const P2Args& a, LAS unsigned char* lds, int idx, int cnt, int ibeg, int iend, int wave, int lane, int tid) {
    LAS float* red = (LAS float*)(lds + P2_RED_OFF);
    LAS float* tot = red + 256;
    const int c0 = 2 * tid;
    f32x2 w[KW];
#pragma unroll
    for (int k = 0; k < KW; ++k) w[k] = *(const GAS f32x2*)(a.conv_w + k * DC + c0);
    const f32x2 bias = *(const GAS f32x2*)(a.conv_b + c0), lg = *(const GAS f32x2*)(a.ln_g + c0), lb = *(const GAS f32x2*)(a.ln_b + c0);
    unsigned rows[8 + KW - 1], rowsN[8 + KW - 1];
    if (ibeg + idx < iend) CONV_LOAD_ROWS(rows, ibeg + idx);
    for (int it = ibeg + idx; it < iend; it += cnt) {
        const int itn = it + cnt;
        if (itn < iend) CONV_LOAD_ROWS(rowsN, itn);
        const int orow = it < 1024 ? (it >> 8) * SEQ + (it & 255) * 8 : MP + (it - 1024) * DSQ;
        CONV_COMPUTE(rows, orow);
#pragma unroll
        for (int r = 0; r < 8 + KW - 1; ++r) rows[r] = rowsN[r];
    }
    __syncthreads();
}
__device__ __forceinline__ void p2_conv_runs(const P2Args& a, LAS unsigned char* lds, int ci, int wave, int lane, int tid) {
    LAS float* red = (LAS float*)(lds + P2_RED_OFF);
    LAS float* tot = red + 256;
    const int c0 = 2 * tid;
    f32x2 w[KW];
#pragma unroll
    for (int k = 0; k < KW; ++k) w[k] = *(const GAS f32x2*)(a.conv_w + k * DC + c0);
    const f32x2 bias = *(const GAS f32x2*)(a.conv_b + c0), lg = *(const GAS f32x2*)(a.ln_g + c0), lb = *(const GAS f32x2*)(a.ln_b + c0);
    const int b = ci / 28, k28 = ci - b * 28, len = k28 < 4 ? 10 : 9, start = b * 256 + (k28 < 4 ? k28 * 10 : 40 + (k28 - 4) * 9);
    unsigned rows[8 + KW - 1], rowsS[8 + KW - 1], pfA[8], pfB[8];
    CONV_LOAD_ROWS(rows, start);
    { const int its = 1024 + ci; CONV_LOAD_ROWS(rowsS, its); }
    const bf16* ub = a.UC + (size_t)(b * SEQ) * DC + c0;
    const int t0s = (start & 255) * 8;
#pragma unroll
    for (int i = 0; i < 8; ++i) { pfA[i] = *(const GAS unsigned*)(ub + (size_t)(t0s + 8 + i) * DC); pfB[i] = *(const GAS unsigned*)(ub + (size_t)(t0s + 16 + i) * DC); }
    for (int n = 0; n < len; ++n) {
        const int t0 = t0s + 8 * n;
        unsigned pfC[8];
        { const int tn = t0 + 24; const int tc = tn + 7 < SEQ ? tn : SEQ - 8;
#pragma unroll
          for (int i = 0; i < 8; ++i) pfC[i] = *(const GAS unsigned*)(ub + (size_t)(tc + i) * DC); }
        CONV_COMPUTE(rows, b * SEQ + t0);
#pragma unroll
        for (int r = 0; r < KW - 1; ++r) rows[r] = rows[r + 8];
#pragma unroll
        for (int i = 0; i < 8; ++i) { rows[KW - 1 + i] = pfA[i]; pfA[i] = pfB[i]; pfB[i] = pfC[i]; }
    }
    CONV_COMPUTE(rowsS, MP + ci * DSQ);
    if (ci >= 4 && ci < 20) { const int its = 1024 + 112 + (ci - 4); CONV_LOAD_ROWS(rowsS, its); CONV_COMPUTE(rowsS, MP + (112 + ci - 4) * DSQ); }
    __syncthreads();
}

__device__ __forceinline__ void p2_newconv(const P2Args& a, int vcu, int G, int tid) {
    constexpr int NPV = BATCH * (KW - 1) * (DC / 4), NSV = DB * (KW - 1) * (DC / 4);
    for (int idx = vcu * (NWAVES * 64) + tid; idx < NPV + NSV; idx += G * NWAVES * 64) {
        if (idx < NPV) { const int c4 = idx & 255, j = (idx >> 8) % (KW - 1), b = idx / ((KW - 1) * 256);
            const v2u pk = *(const GAS v2u*)(a.UC + (size_t)(b * SEQ + SEQ - (KW - 1) + j) * DC + 4 * c4);
            const f32x4 v = {bf_lo(pk.x), bf_hi(pk.x), bf_lo(pk.y), bf_hi(pk.y)};
            *(GAS f32x4*)(a.ncp + (size_t)idx * 4) = v; }
        else { const int k = idx - NPV; const int c4 = k & 255, j = (k >> 8) % (KW - 1), b = k / ((KW - 1) * 256); const int id = j + DSQ; f32x4 v;
            if (id < KW - 1) v = *(const GAS f32x4*)(a.state_conv + ((size_t)b * (KW - 1) + id) * DC + 4 * c4);
            else { const v2u pk = *(const GAS v2u*)(a.UC + (size_t)(MP + b * DSQ + id - (KW - 1)) * DC + 4 * c4); v = (f32x4){bf_lo(pk.x), bf_hi(pk.x), bf_lo(pk.y), bf_hi(pk.y)}; }
            *(GAS f32x4*)(a.ncs + (size_t)k * 4) = v; }
    }
}

#define SSM_STEP(i) do { \
        const float nAr = __builtin_fmaf(aAr, hAr, __builtin_fmaf(-aAi, hAi, d00[i])), nAi = __builtin_fmaf(aAr, hAi, __builtin_fmaf(aAi, hAr, d01[i])); \
        const float nBr = __builtin_fmaf(aBr, hBr, __builtin_fmaf(-aBi, hBi, d10[i])), nBi = __builtin_fmaf(aBr, hBi, __builtin_fmaf(aBi, hBr, d11[i])); \
        hAr = nAr; hAi = nAi; hBr = nBr; hBi = nBi; } while (0)
#define SSM_MFMA(afrag) do { const f32x16 z16 = {0.f,0.f,0.f,0.f,0.f,0.f,0.f,0.f,0.f,0.f,0.f,0.f,0.f,0.f,0.f,0.f}; \
        d00 = __builtin_amdgcn_mfma_f32_32x32x16_bf16(afrag, bfr[0][0], z16, 0, 0, 0); d01 = __builtin_amdgcn_mfma_f32_32x32x16_bf16(afrag, bfr[0][1], z16, 0, 0, 0); \
        d10 = __builtin_amdgcn_mfma_f32_32x32x16_bf16(afrag, bfr[1][0], z16, 0, 0, 0); d11 = __builtin_amdgcn_mfma_f32_32x32x16_bf16(afrag, bfr[1][1], z16, 0, 0, 0); } while (0)
#define SSM_PUT_U(afrag) do { *(LAS bf16x8*)(utile + (s_r * 16 + i_r) * 32 + kc * 16) = afrag; } while (0)
#define SSM_EMIT(rowb0, rowb1) do { \
        LDS_WAIT(); __builtin_amdgcn_wave_barrier(); \
        _Pragma("unroll") for (int s_ = 0; s_ < 2; ++s_) { \
            f32x4 y_ = {0.f, 0.f, 0.f, 0.f}; \
            _Pragma("unroll") for (int ks = 0; ks < 4; ++ks) { const bf16x8 hf = *(const LAS bf16x8*)(tile + s_ * P2_TILE_B + (lane & 15) * P2_TROW + ks * 64 + (lane >> 4) * 16); \
                y_ = __builtin_amdgcn_mfma_f32_16x16x32_bf16(hf, cfr[ks], y_, 0, 0, 0); } \
            const int rb_ = s_ ? (rowb1) : (rowb0); float v_[4]; \
            _Pragma("unroll") for (int i_ = 0; i_ < 4; ++i_) { const unsigned short ub_ = *(const LAS unsigned short*)(utile + (s_ * 16 + 4 * (lane >> 4) + i_) * 32 + (lane & 15) * 2); \
                v_[i_] = gelu_tanh_f(y_[i_] + dsk * __builtin_bit_cast(float, (unsigned)ub_ << 16)); } \
            const unsigned w01_ = cvtpk(v_[0], v_[1]), w23_ = cvtpk(v_[2], v_[3]); \
            bf16* go_ = a.G + (size_t)(rb_ + 4 * (lane >> 4)) * DS + g * CH + (lane & 15); \
            go_[0] = (bf16)w01_; go_[DS] = (bf16)(w01_ >> 16); go_[2 * DS] = (bf16)w23_; go_[3 * DS] = (bf16)(w23_ >> 16); } \
        LDS_WAIT(); __builtin_amdgcn_wave_barrier(); } while (0)
#define SSM_TILE_ROW(i) do { v2u hw_; hw_.x = cvtpk(hAr, hAi); hw_.y = cvtpk(hBr, hBi); *(LAS v2u*)(mytile + (i) * P2_TROW) = hw_; } while (0)

__device__ __forceinline__ void p2_ssm(const P2Args& a, LAS unsigned char* lds, int vcu, int G, int wave, int lane, int tid) {
    const int col = lane & 31, half = lane >> 5;
    const int r = lane & 31, s_r = (r >> 2) & 1, i_r = (r & 3) + 4 * (r >> 3), kc = lane >> 5;
    LAS unsigned char* tile = lds + P2_TILE_OFF + wave * 2 * P2_TILE_B;
    LAS unsigned char* mytile = tile + half * P2_TILE_B + col * 8;
    LAS unsigned char* utile = lds + P2_UT_OFF + wave * 1024;
    LAS f32x4* SX = (LAS f32x4*)(lds + P2_SX_OFF);
    for (int it = vcu; it < BATCH * NG; it += G) {
        const int g = it & (NG - 1), pb = it >> 6;
        const float* AB = (const float*)(a.tab + TAB_AB) + (size_t)(g * NP + 2 * col) * 2;
        const f32x4 ab4 = *(const GAS f32x4*)AB;
        const float aAr = ab4.x, aAi = ab4.y, aBr = ab4.z, aBi = ab4.w;
        bf16x8 bfr[2][2], cfr[4];
#pragma unroll
        for (int pair = 0; pair < 2; ++pair)
#pragma unroll
            for (int ri = 0; ri < 2; ++ri) bfr[pair][ri] = *(const GAS bf16x8*)((const bf16*)(a.tab + TAB_BBT) + ((size_t)(g * 2 + ri) * NP + 2 * col + pair) * CH + 8 * kc);
#pragma unroll
        for (int ks = 0; ks < 4; ++ks) cfr[ks] = *(const GAS bf16x8*)((const bf16*)(a.tab + TAB_CQ) + ((size_t)g * CH + (lane & 15)) * 128 + 32 * ks + 8 * (lane >> 4));
        const float dsk = a.Dk[g * CH + (lane & 15)];
        f32x16 d00, d01, d10, d11;
        {
            const bf16* abase = a.SI + (size_t)(pb * SEQ + (2 * wave + s_r) * 128 + i_r) * DS + g * CH + 8 * kc;
            float hAr = 0.f, hAi = 0.f, hBr = 0.f, hBi = 0.f;
            bf16x8 a0 = *(const GAS bf16x8*)abase, a1 = *(const GAS bf16x8*)(abase + (size_t)1 * 16 * DS), a2 = *(const GAS bf16x8*)(abase + (size_t)2 * 16 * DS), a3 = *(const GAS bf16x8*)(abase + (size_t)3 * 16 * DS);
#pragma unroll 1
            for (int blk = 0; blk < 8; ++blk) {
                const bf16x8 an = *(const GAS bf16x8*)(abase + (size_t)((blk + 4) & 7) * 16 * DS);
                SSM_MFMA(a0);
#pragma unroll
                for (int i = 0; i < 16; ++i) SSM_STEP(i);
                a0 = a1; a1 = a2; a2 = a3; a3 = an;
            }
            __syncthreads();
            SX[(2 * wave + half) * 32 + col] = (f32x4){hAr, hAi, hBr, hBi};
            __syncthreads();
            float pAr = aAr, pAi = aAi, pBr = aBr, pBi = aBi;
#pragma unroll
            for (int sq = 0; sq < 7; ++sq) { const float t0 = pAr * pAr - pAi * pAi, t1 = 2.0f * pAr * pAi, t2 = pBr * pBr - pBi * pBi, t3 = 2.0f * pBr * pBi; pAr = t0; pAi = t1; pBr = t2; pBi = t3; }
            hAr = 0.f; hAi = 0.f; hBr = 0.f; hBi = 0.f;
            const int mine = 2 * wave + half;
            for (int s2 = 0; s2 < mine; ++s2) { const f32x4 sv = SX[s2 * 32 + col];
                const float nAr = pAr * hAr - pAi * hAi + sv.x, nAi = pAr * hAi + pAi * hAr + sv.y, nBr = pBr * hBr - pBi * hBi + sv.z, nBi = pBr * hBi + pBi * hBr + sv.w;
                hAr = nAr; hAi = nAi; hBr = nBr; hBi = nBi; }
#pragma unroll 1
            for (int blk = 0; blk < 8; ++blk) {
                const bf16x8 an = *(const GAS bf16x8*)(abase + (size_t)((blk + 4) & 7) * 16 * DS);
                SSM_MFMA(a0);
                SSM_PUT_U(a0);
#pragma unroll
                for (int i = 0; i < 16; ++i) { SSM_STEP(i); SSM_TILE_ROW(i); }
                const int rb = pb * SEQ + (2 * wave) * 128 + blk * 16;
                SSM_EMIT(rb, rb + 128);
                a0 = a1; a1 = a2; a2 = a3; a3 = an;
            }
            if (mine == 15) { const size_t o = ((size_t)pb * NG + g) * NP + 2 * col;
                *(GAS f32x2*)(a.nrp + o) = (f32x2){hAr, hBr}; *(GAS f32x2*)(a.nip + o) = (f32x2){hAi, hBi}; }
        }
        {
            const int bA_load = 32 * pb + 4 * wave + 2 * s_r, bA = 32 * pb + 4 * wave + 2 * half;
            const bf16x8 afS = *(const GAS bf16x8*)(a.SI + (size_t)(MP + bA_load * DSQ + i_r) * DS + g * CH + 8 * kc);
            size_t o = ((size_t)bA * NG + g) * NP + 2 * col;
            f32x2 t0 = *(const GAS f32x2*)(a.h0re + o), t1 = *(const GAS f32x2*)(a.h0im + o);
            SSM_MFMA(afS);
            SSM_PUT_U(afS);
            float hAr = t0.x, hBr = t0.y, hAi = t1.x, hBi = t1.y;
#pragma unroll
            for (int i = 0; i < 8; ++i) { SSM_STEP(i); SSM_TILE_ROW(i); }
            *(GAS f32x2*)(a.nrs + o) = (f32x2){hAr, hBr}; *(GAS f32x2*)(a.nis + o) = (f32x2){hAi, hBi};
            o += (size_t)NG * NP;
            t0 = *(const GAS f32x2*)(a.h0re + o); t1 = *(const GAS f32x2*)(a.h0im + o);
            hAr = t0.x; hBr = t0.y; hAi = t1.x; hBi = t1.y;
#pragma unroll
            for (int i = 8; i < 16; ++i) { SSM_STEP(i); SSM_TILE_ROW(i); }
            *(GAS f32x2*)(a.nrs + o) = (f32x2){hAr, hBr}; *(GAS f32x2*)(a.nis + o) = (f32x2){hAi, hBi};
            const int rb = MP + (32 * pb + 4 * wave) * DSQ;
            SSM_EMIT(rb, rb + 16);
        }
    }
    __syncthreads();
}

#ifndef NP_P1
#define NP_P1 0
#endif
#ifndef NP_P3
#define NP_P3 0
#endif
#ifndef NP_P5
#define NP_P5 16
#endif
#ifndef NP_P6
#define NP_P6 32
#endif
#ifndef NP_P7
#define NP_P7 16
#endif
struct Args { const float* in[28]; float* out; unsigned char* ws; int lo, hi, dryk, li; };
__global__ void __launch_bounds__(NWAVES * 64, 2) mk_fwd(Args args) {
    __shared__ __attribute__((aligned(16))) unsigned char lds_raw[LDS_BYTES];
    LAS unsigned char* lds = (LAS unsigned char*)lds_raw;
    volatile LAS unsigned* MISC = (volatile LAS unsigned*)(lds + MISC_OFF);
    const int tid = threadIdx.x, lane = tid & 63, wave = __builtin_amdgcn_readfirstlane(tid >> 6);
    const int G = gridDim.x; const int bx = blockIdx.x; const int vcu = (G % 8 == 0) ? (bx % 8) * (G / 8) + bx / 8 : bx;
    unsigned char* ws = args.ws;
    gu32* ctl = (gu32*)(ws + WS_CTL);
    for (int u = tid; u < (LDS_BYTES - LDSCTL_OFF) / 4; u += NWAVES * 64) ((LAS unsigned*)(lds + LDSCTL_OFF))[u] = 0u;
    __syncthreads();
    XcdBarrier bar; bar.bar = (unsigned*)(ctl + CW_BAR) + args.li * XCD_BAR_WORDS; bar.x = 0; bar.st = nullptr;
    if (N_LAUNCHES != NPH) bar = xcd_barrier_post((unsigned*)(ctl + CW_BAR) + args.li * XCD_BAR_WORDS, MISC + 8);
#ifndef STAMP_BX
#define STAMP_BX 0
#endif
#ifdef STAMP_A
#define STAMP(i) do { if (blockIdx.x == STAMP_BX && tid == 0) { const unsigned long long t_ = __builtin_amdgcn_s_memrealtime(); MISC[12 + 2 * (i)] = (unsigned)t_; MISC[13 + 2 * (i)] = (unsigned)(t_ >> 32); } } while (0)
#else
#define STAMP(i) do { } while (0)
#endif
    STAMP(0);
#define GRID_BAR(seam) do { GRID_BAR_(seam); STAMP((seam) + 1); } while (0)
#define GRID_BAR_(seam) do { if (N_LAUNCHES == NPH) { if (tid == 0) __hip_atomic_store(ctl + CW_TMO, 0xBADBA0u | (unsigned)(seam), RLX_AGENT); } else { xcd_barrier(bar); } } while (0)
    const int lo = args.lo, hi = args.hi, dryk = args.dryk;
#define DRY(k) (dryk == (k))
#ifndef ONLY_PHASE
#define ONLY_PHASE -1
#endif
#define IN(k) (ONLY_PHASE < 0 ? (lo <= (k) && (k) < hi) : (k) == ONLY_PHASE)
#define BOTH(k) (IN(k) && IN((k) + 1))
    float* out = args.out;
    float* Y = out;
    float* ncp = out + (size_t)M * D;
    float* nrp = ncp + (size_t)BATCH * (KW - 1) * DC;
    float* nip = nrp + (size_t)BATCH * NG * NP;
    float* ncs = nip + (size_t)BATCH * NG * NP;
    float* nrs = ncs + (size_t)DB * (KW - 1) * DC;
    float* nis = nrs + (size_t)DB * NG * NP;
    bf16 *WGU = (bf16*)(ws + WS_WGU), *WDN = (bf16*)(ws + WS_WDN), *XB = (bf16*)(ws + WS_XB), *WIN = (bf16*)(ws + WS_WIN), *WGL = (bf16*)(ws + WS_WGL), *WOUT = (bf16*)(ws + WS_WOUT);
    bf16 *UC = (bf16*)(ws + WS_U), *SI = (bf16*)(ws + WS_S), *GB = (bf16*)(ws + WS_G), *MIX = (bf16*)(ws + WS_MIX), *ACT = (bf16*)(ws + WS_ACT);
    float* ssq_dummy = (float*)(ws + WS_CTL) + CW_DUMMY;
    float* ssq_s = (float*)(ws + WS_CTL) + CW_SSQ_S; float* ssq_h = (float*)(ws + WS_CTL) + CW_SSQ_H; float* ssq_o = (float*)(ws + WS_CTL) + CW_SSQ_O; float* rx = (float*)(ws + WS_CTL) + CW_RX;
    const int gw = vcu * NWAVES + wave, NGW = G * NWAVES;

    if (IN(0)) {
        P0Args a; a.xp = args.in[0]; a.xs = args.in[1]; a.norm_mix = args.in[5]; a.w_in = args.in[6]; a.w_glu = args.in[19]; a.gn_conv = args.in[20]; a.gn_ssm = args.in[21]; a.w_out = args.in[22];
        a.norm_ffn = args.in[23]; a.w_gate = args.in[24]; a.w_up = args.in[25]; a.w_down = args.in[26];
        a.A_re = args.in[11]; a.A_im = args.in[12]; a.log_dt = args.in[13]; a.B_re = args.in[14]; a.B_im = args.in[15]; a.C_re = args.in[16]; a.C_im = args.in[17];
        a.WIN = WIN; a.WGL = WGL; a.WOUT = WOUT; a.WGU = WGU; a.WDN = WDN; a.XB = XB; a.rx = rx; a.tab = ws + WS_TAB;
        STAMP(13);
        p0_prologue(a, lds, vcu, G, wave, lane, tid); STAMP(14);
        if (BOTH(0)) GRID_BAR(0);
    }
    if (IN(1)) {
        pg8::Gemm g{XB, WIN, M, DIN, D};
#define SCHED(slot, slabo, N_, K_, NP_, RS_, MID_) typedef pg8::HybridOrder<N_, K_, NP_, RS_, MID_> Sch; Sch S; S.init((int)blockIdx.x, ws + (slabo), (unsigned*)(ctl + CW_FLAGS + (slot) * FLAG_SLOT), (unsigned*)(ctl + CW_TMO))
        SCHED(0, SLAB_P1, DIN, D, NP_P1, 0, 0);
        pg8::EpiIn E{UC, SI, rx};
        pg8::gemm_phase<pg8::EpiIn, Sch, true, true>(lds + RING_OFF, g, S, E);
        {
            static_assert(Sch::R == 2 && Sch::np == 1, "P1 runs two static rounds");
            constexpr int BUSY = Sch::q - Sch::per, IDLE = Sch::per - BUSY;
            const int jx = (int)blockIdx.x >> 3, xx = (int)blockIdx.x & 7;
            P0Args a; a.xp = args.in[0]; a.xs = args.in[1]; a.norm_mix = args.in[5]; a.w_in = args.in[6]; a.w_glu = args.in[19]; a.gn_conv = args.in[20]; a.gn_ssm = args.in[21]; a.w_out = args.in[22];
            a.norm_ffn = args.in[23]; a.w_gate = args.in[24]; a.w_up = args.in[25]; a.w_down = args.in[26];
            a.A_re = args.in[11]; a.A_im = args.in[12]; a.log_dt = args.in[13]; a.B_re = args.in[14]; a.B_im = args.in[15]; a.C_re = args.in[16]; a.C_im = args.in[17];
            a.WIN = WIN; a.WGL = WGL; a.WOUT = WOUT; a.WGU = WGU; a.WDN = WDN; a.XB = XB; a.rx = rx; a.tab = ws + WS_TAB;
            if (G != 256) p0_convert(a, lds, vcu * NWAVES + wave, G * NWAVES, P0_ITEMS_B, P0_ITEMS_ALL, wave, lane);
            if (G != 256) p0_tables(a, vcu * (NWAVES * 64) + tid); else if (jx >= BUSY) p0_tables(a, (xx * IDLE + (jx - BUSY)) * (NWAVES * 64) + tid);
            if (G == 256 && jx >= BUSY) p0_convert(a, lds, (xx * IDLE + (jx - BUSY)) * NWAVES + wave, 8 * IDLE * NWAVES, P0_ITEMS_B, P0_ITEMS_ALL, wave, lane);
        }
        if (BOTH(1)) GRID_BAR(1);
    }
    if (IN(2)) {
        P2Args a; a.UC = UC; a.SI = SI; a.G = GB; a.MIX = MIX; a.state_conv = args.in[2]; a.h0re = args.in[3]; a.h0im = args.in[4];
        a.conv_w = args.in[7]; a.conv_b = args.in[8]; a.ln_g = args.in[9]; a.ln_b = args.in[10]; a.Dk = args.in[18]; a.tab = ws + WS_TAB;
        a.ncp = ncp; a.nrp = nrp; a.nip = nip; a.ncs = ncs; a.nrs = nrs; a.nis = nis;
        p2_ssm(a, lds, vcu, G, wave, lane, tid); STAMP(10);
        if (BOTH(2)) GRID_BAR(2);
    }
    if (IN(3)) {
        constexpr int P3_OWNERS = (M / 256) * (DS / 256) / 8;
        const int jx = (int)blockIdx.x >> 3, xx = (int)blockIdx.x & 7;
        P2Args a; a.UC = UC; a.SI = SI; a.G = GB; a.MIX = MIX; a.state_conv = args.in[2]; a.h0re = args.in[3]; a.h0im = args.in[4];
        a.conv_w = args.in[7]; a.conv_b = args.in[8]; a.ln_g = args.in[9]; a.ln_b = args.in[10]; a.Dk = args.in[18]; a.tab = ws + WS_TAB;
        a.ncp = ncp; a.nrp = nrp; a.nip = nip; a.ncs = ncs; a.nrs = nrs; a.nis = nis;
        constexpr int NCW = 8 * (32 - P3_OWNERS), CONV_A = 1024 + DB;
        if (G != 256) { p2_conv(a, lds, vcu, G, 0, 1024 + DB, wave, lane, tid); p2_newconv(a, vcu, G, tid);
            { P0Args pa; pa.xp = args.in[0]; pa.xs = args.in[1]; pa.norm_mix = args.in[5]; pa.w_in = args.in[6]; pa.w_glu = args.in[19]; pa.gn_conv = args.in[20]; pa.gn_ssm = args.in[21]; pa.w_out = args.in[22];
              pa.norm_ffn = args.in[23]; pa.w_gate = args.in[24]; pa.w_up = args.in[25]; pa.w_down = args.in[26];
              pa.A_re = args.in[11]; pa.A_im = args.in[12]; pa.log_dt = args.in[13]; pa.B_re = args.in[14]; pa.B_im = args.in[15]; pa.C_re = args.in[16]; pa.C_im = args.in[17];
              pa.WIN = WIN; pa.WGL = WGL; pa.WOUT = WOUT; pa.WGU = WGU; pa.WDN = WDN; pa.XB = XB; pa.rx = rx; pa.tab = ws + WS_TAB;
              __syncthreads(); p0_convert(pa, lds, vcu * NWAVES + wave, G * NWAVES, P0_ITEMS_A, P0_ITEMS_B, wave, lane); __syncthreads(); }
            pg8::Gemm g{GB, WGL, M, DS, DS}; SCHED(1, SLAB_P3, DS, DS, NP_P3, 0, 0); pg8::EpiGlu E{GB, MIX, DRY(3) ? ssq_dummy : ssq_s};
            pg8::gemm_phase<pg8::EpiGlu, Sch, true, true>(lds + RING_OFF, g, S, E); }
        else if (jx < P3_OWNERS) {
            pg8::Gemm g{GB, WGL, M, DS, DS}; SCHED(1, SLAB_P3, DS, DS, NP_P3, 0, 0);
            pg8::EpiGlu E{GB, MIX, DRY(3) ? ssq_dummy : ssq_s};
            pg8::gemm_phase<pg8::EpiGlu, Sch, true, true>(lds + RING_OFF, g, S, E);
            __syncthreads();
            { P0Args pa; pa.xp = args.in[0]; pa.xs = args.in[1]; pa.norm_mix = args.in[5]; pa.w_in = args.in[6]; pa.w_glu = args.in[19]; pa.gn_conv = args.in[20]; pa.gn_ssm = args.in[21]; pa.w_out = args.in[22];
              pa.norm_ffn = args.in[23]; pa.w_gate = args.in[24]; pa.w_up = args.in[25]; pa.w_down = args.in[26];
              pa.A_re = args.in[11]; pa.A_im = args.in[12]; pa.log_dt = args.in[13]; pa.B_re = args.in[14]; pa.B_im = args.in[15]; pa.C_re = args.in[16]; pa.C_im = args.in[17];
              pa.WIN = WIN; pa.WGL = WGL; pa.WOUT = WOUT; pa.WGU = WGU; pa.WDN = WDN; pa.XB = XB; pa.rx = rx; pa.tab = ws + WS_TAB;
              p0_convert(pa, lds, (xx * P3_OWNERS + jx) * NWAVES + wave, 8 * P3_OWNERS * NWAVES, P0_ITEMS_A, P0_ITEMS_B, wave, lane); }
        } else {
            const int ci = xx * (32 - P3_OWNERS) + (jx - P3_OWNERS);
            static_assert(NCW == 112, "p2_conv_runs: 28 workgroups per prompt batch");
            p2_conv_runs(a, lds, ci, wave, lane, tid); STAMP(11);
            p2_newconv(a, ci, NCW, tid); STAMP(12);
        }
        if (BOTH(3)) GRID_BAR(3);
    }
    if (IN(5)) {
        pg8::Gemm g{MIX, WOUT, M, D, D}; SCHED(2, SLAB_P5, D, D, NP_P5, 8, 16);
        pg8::EpiOut E{XB, DRY(5) ? ssq_dummy : ssq_h, ssq_s};
        static_assert(Sch::S == 8 && Sch::ntp == 16, "remainder segments of 2 K-tile pairs never straddle K-tile 16");
        pg8::gemm_phase<pg8::EpiOut, Sch, true, true>(lds + RING_OFF, g, S, E);
        if (BOTH(5)) GRID_BAR(5);
    }
    if (IN(6)) {
        pg8::Gemm g{XB, WGU, M, 2 * DFF, D}; SCHED(3, SLAB_P6, 2 * DFF, D, NP_P6, 5, 0);
        pg8::EpiUp E{ACT, ssq_h};
        pg8::gemm_phase<pg8::EpiUp, Sch, true, true>(lds + RING_OFF, g, S, E);
        if (BOTH(6)) GRID_BAR(6);
    }
    if (IN(7)) {
        pg8::Gemm g{ACT, WDN, M, D, DFF}; SCHED(4, SLAB_P7, D, DFF, NP_P7, 8, 0);
        pg8::EpiDown E{XB, DRY(7) ? ssq_dummy : ssq_o, DRY(7) ? 0.0f : 1.0f};
        pg8::gemm_phase<pg8::EpiDown, Sch, true, true>(lds + RING_OFF, g, S, E);
        if (BOTH(7)) GRID_BAR(7);
    }
    if (IN(8)) {
        const float* gfin = args.in[27];
        for (int row = gw; row < M; row += NGW) {
            const float r = 1.0f / sqrtf(__hip_atomic_load(ssq_o + row, RLX_AGENT) * (1.0f / D) + 1e-6f);
            const GAS v4u* ob = (const GAS v4u*)(XB + (size_t)row * D) + lane; GAS f32x4* p = (GAS f32x4*)(Y + (size_t)row * D) + 2 * lane; const GAS f32x4* gp = (const GAS f32x4*)gfin + 2 * lane;
#pragma unroll
            for (int j = 0; j < 4; ++j) { const v4u w = ob[64 * j];
                p[128 * j] = (f32x4){bf_lo(w.x), bf_hi(w.x), bf_lo(w.y), bf_hi(w.y)} * r * gp[128 * j];
                p[128 * j + 1] = (f32x4){bf_lo(w.z), bf_hi(w.z), bf_lo(w.w), bf_hi(w.w)} * r * gp[128 * j + 1]; }
        }
    }
#ifdef STAMP_A
    STAMP(9);
    if (blockIdx.x == STAMP_BX && tid == 0) {
        const unsigned long long ta = ((unsigned long long)MISC[13 + 2 * STAMP_A] << 32) | MISC[12 + 2 * STAMP_A], tb = ((unsigned long long)MISC[13 + 2 * STAMP_B] << 32) | MISC[12 + 2 * STAMP_B];
        const unsigned long long d = tb - ta, t0 = __builtin_amdgcn_s_memrealtime();
        while (__builtin_amdgcn_s_memrealtime() - t0 < d) __builtin_amdgcn_s_sleep(8);
    }
#endif
#undef DRY
#undef IN
#undef BOTH
#undef GRID_BAR
#undef GRID_BAR_
#undef STAMP
}

extern "C" void kernel_launch(void* const* d_in, const int* in_sizes, int n_in, void* d_out, int out_size, void* d_ws, size_t ws_size, hipStream_t stream) {
    static int grid = 0;
    if (grid == 0) {
        const long want_out = (long)M * D + (long)(BATCH + DB) * ((KW - 1) * DC + 2 * NG * NP);
        if (n_in != 28 || in_sizes[0] != MP * D || (long)out_size != want_out || ws_size < WS_END) {
            fprintf(stderr, "kernel_launch: unexpected shapes (n_in %d, in0 %d, out %d (want %ld), ws %zu (need %zu)); nothing launched\n", n_in, n_in > 0 ? in_sizes[0] : -1, out_size, want_out, ws_size, (size_t)WS_END); grid = -1; return; }
        int dev = 0, cus = 0;
        if (hipGetDevice(&dev) != hipSuccess || hipDeviceGetAttribute(&cus, hipDeviceAttributeMultiprocessorCount, dev) != hipSuccess) { fprintf(stderr, "kernel_launch: device query failed\n"); grid = -1; return; }
        if (cus != 256) fprintf(stderr, "kernel_launch: built for 256 CUs, device has %d\n", cus);
        grid = 256;
    }
    if (grid < 0) return;
    if (hipMemsetAsync((char*)d_ws + WS_CTL, 0, CTL_ZERO_BYTES, stream) != hipSuccess) { fprintf(stderr, "kernel_launch: memset failed\n"); return; }
    Args a{};
    for (int i = 0; i < 28; ++i) a.in[i] = (const float*)d_in[i];
    a.out = (float*)d_out; a.ws = (unsigned char*)d_ws;
#ifdef PROBE_PHASE
    constexpr int NL = 2;
#else
    constexpr int NL = N_LAUNCHES;
#endif
    for (int li = 0; li < NL; ++li) {
        a.dryk = -1;
        if (N_LAUNCHES == NPH) { a.lo = li; a.hi = li + 1; } else { a.lo = 0; a.hi = NPH; }
#ifdef PROBE_PHASE
        if (li == 0) { a.lo = 0; a.hi = PROBE_PHASE + 1; } else { a.lo = PROBE_PHASE; a.hi = NPH; a.dryk = PROBE_PHASE; }
#endif
        a.li = li;
        hipLaunchKernelGGL(mk_fwd, dim3(grid), dim3(NWAVES * 64), 0, stream, a);
        const hipError_t le = hipPeekAtLastError();
        if (le != hipSuccess) { fprintf(stderr, "kernel_launch: launch %d failed: %s\n", li, hipGetErrorName(le)); break; }
    }
}
```
